# Optimizing an MI355X kernel written in HIP

```python
import math
import jax, jax.numpy as jnp
from jax import lax
import numpy as np

D_MODEL = 1024
BATCH = 4
SEQ = 8192
DEPTH = 2

N_A_LAYERS = DEPTH // 2
N_B_LAYERS = DEPTH - N_A_LAYERS
HEAD_DIM = 64
A_HEADS = D_MODEL // HEAD_DIM
A_WIDTH = A_HEADS * HEAD_DIM
B_WINDOWS = (128, 512, 2048)
B_DILATIONS = (1, 4, 16)
B_GROUPS = len(B_DILATIONS)
B_HEADS_PER_GROUP = D_MODEL // (2 * HEAD_DIM)
B_HEADS = B_GROUPS * B_HEADS_PER_GROUP
B_WIDTH = B_HEADS * HEAD_DIM
B_OUT_WIDTH = B_HEADS_PER_GROUP * HEAD_DIM
BLOCK = 128
NUM_BUCKETS = 32
MAX_DISTANCE = 2048
N_GROUPS = 4
EXPERTS_PER_GROUP = 4
N_EXPERTS = N_GROUPS * EXPERTS_PER_GROUP
TOP_K = 2
D_EXPERT = D_MODEL // 2
EPS = 1e-6
NEG = -1e30
SCALE = HEAD_DIM ** -0.5

kernel_name = "fox_dilated_yoco_hmoe"


def rms_norm(x, g):
    xf = x.astype(jnp.float32)
    y = xf * lax.rsqrt(jnp.mean(xf * xf, axis=-1, keepdims=True) + EPS)
    return (y * g.astype(jnp.float32)).astype(x.dtype)


def fox_mixer(xn, w_in, b_f, q_gain, k_gain, w_out):
    B, S, _ = xn.shape
    nb = S // BLOCK
    proj = jnp.einsum('bsd,de->bse', xn, w_in)
    q = rms_norm(proj[..., :A_WIDTH].reshape(B, S, A_HEADS, HEAD_DIM), q_gain)
    k = rms_norm(proj[..., A_WIDTH:2 * A_WIDTH].reshape(B, S, A_HEADS, HEAD_DIM), k_gain)
    v = proj[..., 2 * A_WIDTH:3 * A_WIDTH].reshape(B, S, A_HEADS, HEAD_DIM)
    log_f = jax.nn.log_sigmoid((proj[..., 3 * A_WIDTH:] + b_f).astype(jnp.float32))
    cum = jnp.transpose(jnp.cumsum(log_f, axis=1), (0, 2, 1))
    qb = jnp.moveaxis(q.reshape(B, nb, BLOCK, A_HEADS, HEAD_DIM), 1, 0)
    cum_q = jnp.moveaxis(cum.reshape(B, A_HEADS, nb, BLOCK), 2, 0)
    key_pos = jnp.arange(S)

    def attend_block(args):
        blk, q_blk, cq = args
        s = jnp.einsum('bqhd,bkhd->bhqk', q_blk, k, preferred_element_type=jnp.float32) * SCALE
        s = s + cq[..., :, None] - cum[:, :, None, :]
        q_pos = blk * BLOCK + jnp.arange(BLOCK)
        s = jnp.where(key_pos[None, :] <= q_pos[:, None], s, NEG)
        p = jax.nn.softmax(s, axis=-1)
        return jnp.einsum('bhqk,bkhd->bqhd', p.astype(v.dtype), v)

    out = lax.map(attend_block, (jnp.arange(nb), qb, cum_q))
    out = jnp.moveaxis(out, 0, 1).reshape(B, S, A_WIDTH)
    return jnp.einsum('bse,ed->bsd', out, w_out)


def hier_moe(xn, w_group, b_group, w_expert, b_expert, w_gate, w_up, w_down):
    B, S, D = xn.shape
    N = B * S
    xt = xn.reshape(N, D)
    g_prob = jax.nn.softmax((xt @ w_group + b_group).astype(jnp.float32), axis=-1)
    g_val, g_idx = lax.top_k(g_prob, 1)
    e_logits = (xt @ w_expert + b_expert).astype(jnp.float32).reshape(N, N_GROUPS, EXPERTS_PER_GROUP)
    sel = jnp.broadcast_to(g_idx[:, :, None], (N, 1, EXPERTS_PER_GROUP))
    e_logits = jnp.take_along_axis(e_logits, sel, axis=1)[:, 0]
    e_val, e_idx = lax.top_k(jax.nn.softmax(e_logits, axis=-1), TOP_K)
    e_val = e_val / jnp.sum(e_val, axis=-1, keepdims=True)
    expert_id = g_idx * EXPERTS_PER_GROUP + e_idx
    gates = jnp.sum(jax.nn.one_hot(expert_id, N_EXPERTS, dtype=jnp.float32)
                    * (g_val * e_val)[..., None], axis=1)
    out = jnp.zeros((N, D), jnp.float32)
    for e in range(N_EXPERTS):
        hid = jax.nn.silu(xt @ w_gate[e]) * (xt @ w_up[e])
        out = out + gates[:, e:e + 1] * (hid @ w_down[e]).astype(jnp.float32)
    return out.astype(xn.dtype).reshape(B, S, D)


def to_strided_blocks(x, d):
    B, S = x.shape[:2]
    rest = x.shape[2:]
    span = d * BLOCK
    s_pad = -(-S // span) * span
    x = jnp.pad(x, [(0, 0), (0, s_pad - S)] + [(0, 0)] * len(rest))
    x = jnp.moveaxis(x.reshape(B, s_pad // d, d, *rest), 2, 1)
    return x.reshape(B, d, s_pad // span, BLOCK, *rest)


def from_strided_blocks(xb, S):
    B, d, nb = xb.shape[:3]
    rest = xb.shape[4:]
    x = jnp.moveaxis(xb.reshape(B, d, nb * BLOCK, *rest), 1, 2)
    return x.reshape(B, nb * BLOCK * d, *rest)[:, :S]


def with_prev_block(xb):
    prev = jnp.concatenate([jnp.zeros_like(xb[:, :, :1]), xb[:, :, :-1]], axis=2)
    return jnp.concatenate([prev, xb], axis=3)


def t5_bucket(dist):
    max_exact = NUM_BUCKETS // 2
    d_f = jnp.maximum(dist, max_exact).astype(jnp.float32)
    large = max_exact + (jnp.log(d_f / max_exact) / math.log(MAX_DISTANCE / max_exact)
                         * (NUM_BUCKETS - max_exact)).astype(jnp.int32)
    large = jnp.minimum(large, NUM_BUCKETS - 1)
    return jnp.where(dist < max_exact, dist, large)


def branch_bias(rel_bias, g, d):
    a = jnp.arange(BLOCK)[:, None]
    b = jnp.arange(2 * BLOCK)[None, :]
    n = BLOCK + a - b
    band = (n >= 0) & (n <= B_WINDOWS[g] // d)
    bucket = t5_bucket(jnp.maximum(n, 0) * d)
    bias = rel_bias[bucket][:, :, g * B_HEADS_PER_GROUP:(g + 1) * B_HEADS_PER_GROUP]
    return jnp.moveaxis(bias, 2, 0).astype(jnp.float32), band


def shared_kv(h, kv_norm, kv_w, k_gain):
    B, S, _ = h.shape
    kv = jnp.einsum('bsd,de->bse', rms_norm(h, kv_norm), kv_w)
    k = rms_norm(kv[..., :B_WIDTH].reshape(B, S, B_HEADS, HEAD_DIM), k_gain)
    v = kv[..., B_WIDTH:].reshape(B, S, B_HEADS, HEAD_DIM)
    branches = []
    for g, d in enumerate(B_DILATIONS):
        sl = slice(g * B_HEADS_PER_GROUP, (g + 1) * B_HEADS_PER_GROUP)
        branches.append((with_prev_block(to_strided_blocks(k[:, :, sl], d)),
                         with_prev_block(to_strided_blocks(v[:, :, sl], d))))
    return branches


def dilated_mixer(xn, w_q, q_gain, w_out, branches, biases):
    B, S, _ = xn.shape
    q = rms_norm(jnp.einsum('bsd,de->bse', xn, w_q).reshape(B, S, B_HEADS, HEAD_DIM), q_gain)
    outs, lses = [], []
    for g, d in enumerate(B_DILATIONS):
        kb, vb = branches[g]
        bias, band = biases[g]
        qb = to_strided_blocks(q[:, :, g * B_HEADS_PER_GROUP:(g + 1) * B_HEADS_PER_GROUP], d)
        nb = qb.shape[2]
        valid = band[None] & ((jnp.arange(nb)[:, None, None] > 0)
                              | (jnp.arange(2 * BLOCK) >= BLOCK)[None, None, :])
        s = jnp.einsum('brnqhd,brnkhd->brnhqk', qb, kb, preferred_element_type=jnp.float32) * SCALE
        s = jnp.where(valid[None, None, :, None], s + bias[None, None, None], NEG)
        m = jnp.max(s, axis=-1, keepdims=True)
        ex = jnp.exp(s - m)
        den = jnp.sum(ex, axis=-1, keepdims=True)
        o = jnp.einsum('brnhqk,brnkhd->brnqhd', (ex / den).astype(vb.dtype), vb)
        lse = jnp.swapaxes((m + jnp.log(den))[..., 0], 3, 4)
        outs.append(from_strided_blocks(o, S))
        lses.append(from_strided_blocks(lse, S))
    o = jnp.stack(outs, axis=0).astype(jnp.float32)
    alpha = jax.nn.softmax(jnp.stack(lses, axis=0), axis=0)
    merged = jnp.sum(alpha[..., None] * o, axis=0).astype(xn.dtype).reshape(B, S, B_OUT_WIDTH)
    return jnp.einsum('bse,ed->bsd', merged, w_out)


def setup_inputs(seed: int = 0) -> dict:
    key = jax.random.key(seed)
    ks = jax.random.split(key, 24)
    f32 = jnp.float32

    def nrm(k, shape, scale):
        return scale * jax.random.normal(k, shape, f32)

    def gain(k, shape):
        return 1.0 + 0.05 * jax.random.normal(k, shape, f32)

    res = (2 * DEPTH) ** -0.5
    return {
        "x": jax.random.normal(ks[0], (BATCH, SEQ, D_MODEL), f32),
        "a_norm": gain(ks[1], (N_A_LAYERS, D_MODEL)),
        "a_w_in": nrm(ks[2], (N_A_LAYERS, D_MODEL, 3 * A_WIDTH + A_HEADS), D_MODEL ** -0.5),
        "a_b_f": 2.0 + 0.5 * jax.random.normal(ks[3], (N_A_LAYERS, A_HEADS), f32),
        "a_q_gain": gain(ks[4], (N_A_LAYERS, HEAD_DIM)),
        "a_k_gain": gain(ks[5], (N_A_LAYERS, HEAD_DIM)),
        "a_w_out": nrm(ks[6], (N_A_LAYERS, A_WIDTH, D_MODEL), A_WIDTH ** -0.5 * res),
        "kv_norm": gain(ks[7], (D_MODEL,)),
        "kv_w": nrm(ks[8], (D_MODEL, 2 * B_WIDTH), D_MODEL ** -0.5),
        "kv_k_gain": gain(ks[9], (HEAD_DIM,)),
        "rel_bias": nrm(ks[10], (NUM_BUCKETS, B_HEADS), 0.5),
        "b_norm": gain(ks[11], (N_B_LAYERS, D_MODEL)),
        "b_w_q": nrm(ks[12], (N_B_LAYERS, D_MODEL, B_WIDTH), D_MODEL ** -0.5),
        "b_q_gain": gain(ks[13], (N_B_LAYERS, HEAD_DIM)),
        "b_w_out": nrm(ks[14], (N_B_LAYERS, B_OUT_WIDTH, D_MODEL), B_OUT_WIDTH ** -0.5 * res),
        "ffn_norm": gain(ks[15], (DEPTH, D_MODEL)),
        "moe_w_group": nrm(ks[16], (DEPTH, D_MODEL, N_GROUPS), D_MODEL ** -0.5),
        "moe_b_group": nrm(ks[17], (DEPTH, N_GROUPS), 0.01),
        "moe_w_expert": nrm(ks[18], (DEPTH, D_MODEL, N_EXPERTS), D_MODEL ** -0.5),
        "moe_b_expert": nrm(ks[19], (DEPTH, N_EXPERTS), 0.01),
        "moe_w_gate": nrm(ks[20], (DEPTH, N_EXPERTS, D_MODEL, D_EXPERT), D_MODEL ** -0.5),
        "moe_w_up": nrm(ks[21], (DEPTH, N_EXPERTS, D_MODEL, D_EXPERT), D_MODEL ** -0.5),
        "moe_w_down": nrm(ks[22], (DEPTH, N_EXPERTS, D_EXPERT, D_MODEL), D_EXPERT ** -0.5 * res),
    }


def reference(x, a_norm, a_w_in, a_b_f, a_q_gain, a_k_gain, a_w_out, kv_norm, kv_w, kv_k_gain,
              rel_bias, b_norm, b_w_q, b_q_gain, b_w_out, ffn_norm, moe_w_group, moe_b_group,
              moe_w_expert, moe_b_expert, moe_w_gate, moe_w_up, moe_w_down):
    h = x
    branches = None
    biases = [branch_bias(rel_bias, g, d) for g, d in enumerate(B_DILATIONS)]
    for layer in range(DEPTH):
        if layer < N_A_LAYERS:
            i = layer
            h = h + fox_mixer(rms_norm(h, a_norm[i]), a_w_in[i], a_b_f[i], a_q_gain[i],
                              a_k_gain[i], a_w_out[i])
        else:
            i = layer - N_A_LAYERS
            h = h + dilated_mixer(rms_norm(h, b_norm[i]), b_w_q[i], b_q_gain[i], b_w_out[i],
                                  branches, biases)
        h = h + hier_moe(rms_norm(h, ffn_norm[layer]), moe_w_group[layer], moe_b_group[layer],
                         moe_w_expert[layer], moe_b_expert[layer], moe_w_gate[layer],
                         moe_w_up[layer], moe_w_down[layer])
        if layer == N_A_LAYERS - 1:
            branches = shared_kv(h, kv_norm, kv_w, kv_k_gain)
    return h
```

```cpp
#include <hip/hip_runtime.h>
#include <hip/hip_bf16.h>
#include <cstdio>
#include <cstdint>
#include <cmath>

#ifndef RUN_UPTO
#define RUN_UPTO 99
#endif

#define GAS __attribute__((address_space(1)))
#define LAS __attribute__((address_space(3)))
typedef unsigned short bf16_t;
typedef short bf16x8 __attribute__((ext_vector_type(8)));
typedef float f32x2 __attribute__((ext_vector_type(2)));
typedef float f32x4 __attribute__((ext_vector_type(4)));
typedef float f32x16 __attribute__((ext_vector_type(16)));
typedef unsigned u32x2 __attribute__((ext_vector_type(2)));
typedef unsigned u32x4 __attribute__((ext_vector_type(4)));
typedef short s16x4 __attribute__((ext_vector_type(4)));
typedef GAS unsigned gu32;

constexpr int NTOK = 32768, DM = 1024, SEQ = 8192, NBATCH = 4;
constexpr int KVW = 1536;
constexpr float EPS = 1e-6f;
constexpr float LOG2E = 1.4426950408889634f;
constexpr float C2 = 0.125f * LOG2E;
constexpr int NCLASS = 24, CAP = 32768;

constexpr size_t MiB = 1u << 20;
constexpr size_t WS_CTL = 0, CTL_ZERO_BYTES = 1 * MiB;
constexpr size_t WS_RSTD0 = 2 * MiB, WS_RSTD1 = 2 * MiB + 128 * 1024, WS_RSTD3 = 2 * MiB + 256 * 1024;
constexpr size_t WS_STATS1 = 3 * MiB, WS_STATS2 = 5 * MiB, WS_STATS3 = 7 * MiB;
constexpr size_t WS_GATES = 9 * MiB;
constexpr size_t WS_LC = 10 * MiB;
constexpr size_t WS_CT = 12 * MiB;
constexpr size_t WS_WF = 12 * MiB + 64 * 1024;
constexpr size_t WS_WR = 12 * MiB + 128 * 1024;
constexpr size_t WS_GTAB = 12 * MiB + 32 * 1024;
constexpr size_t WS_PERM = 13 * MiB;
constexpr size_t WS_WQKVA = 16 * MiB, WS_WOA = 22 * MiB, WS_WKVQ = 24 * MiB, WS_WOB = 33 * MiB;
constexpr size_t WS_WGU = 34 * MiB;
constexpr size_t WS_WD = 98 * MiB;
constexpr size_t WS_XB = 132 * MiB;
constexpr size_t WS_R = 196 * MiB;
constexpr size_t WS_QA = WS_R, WS_KA = WS_R + 64 * MiB, WS_VA = WS_R + 128 * MiB;
constexpr size_t WS_HID = WS_R;
constexpr size_t WS_KB = WS_R, WS_VB = WS_R + 96 * MiB, WS_QB = WS_R + 192 * MiB;
constexpr size_t WS_END = WS_R + 288 * MiB;
constexpr int CW_BAR = 4096, CW_QUEUE = 8192, CW_CNT0 = 9216, CW_CNT1 = 9216 + 64;

constexpr int RING_BYTES = 131072;
constexpr int MISC_OFF = RING_BYTES;
constexpr int AUX_OFF = RING_BYTES + 512;
constexpr int LDS_BYTES = 147456;
constexpr int AUX_BYTES = LDS_BYTES - AUX_OFF;

#define LDS_WAIT() asm volatile("s_waitcnt lgkmcnt(0)" ::: "memory")
#define VM_WAIT() asm volatile("s_waitcnt vmcnt(0)" ::: "memory")
#define RLX_AGENT __ATOMIC_RELAXED, __HIP_MEMORY_SCOPE_AGENT

__device__ __forceinline__ unsigned f2bf(float f) { unsigned u = __builtin_bit_cast(unsigned, f); return (u + 0x7fffu + ((u >> 16) & 1u)) >> 16; }
__device__ __forceinline__ float bf2f(unsigned b) { return __builtin_bit_cast(float, b << 16); }
__device__ __forceinline__ unsigned pk2(float lo, float hi) { return f2bf(lo) | (f2bf(hi) << 16); }
__device__ __forceinline__ unsigned cvt_pk_bf16(float lo, float hi) { unsigned r; asm volatile("v_cvt_pk_bf16_f32 %0, %1, %2" : "=v"(r) : "v"(lo), "v"(hi)); return r; }

namespace pg8 {
constexpr int BM = 256, BK = 64, HALF = 128, HTB = HALF * BK * 2, STAGE_BYTES = 8 * HTB, NXCD = 8, WGM = 8;
__host__ __device__ __forceinline__ int lds_byte(int r, int c) { const int st = (r >> 4) * 2 + (c >> 5), rr = r & 15, cc = c & 31, ob = rr * 64 + cc * 2; return st * 1024 + (ob ^ (((ob >> 9) & 1) << 5)); }
__host__ __device__ __forceinline__ void stage_rc(int b, int& R, int& C) { const int st = b / 1024, sb = b % 1024, swz = sb ^ (((sb >> 9) & 1) << 5); R = (st >> 1) * 16 + swz / 64; C = (st & 1) * 32 + (swz % 64) / 2; }
__host__ __device__ __forceinline__ int perm32(int rho) { const int n = rho >> 4, i = rho & 15; return 8 * (i >> 2) + 4 * n + (i & 3); }

struct Unit { int rowbase; int pn; int permoff; int nvalid; int e1; int e2; };
struct GemmP { const bf16_t* A; int lda; int ldb; int K; int nsplit; int hstepB; int bmode; };

struct StaticOrder {
    int nM, nN, nwg, G, c;
    __device__ void init(int M, int N, int G_, int c_) { nM = M / BM; nN = N / BM; nwg = nM * nN; G = G_; c = c_; }
    __device__ bool next(int i, int& pm, int& pn) const {
        const long L = (long)i * G + c; if (L >= nwg) return false;
        int wgid = (int)L; { const int q = nwg / NXCD, r = nwg % NXCD, xcd = wgid % NXCD, off = wgid / NXCD; wgid = (xcd < r ? xcd * (q + 1) : r * (q + 1) + (xcd - r) * q) + off; }
        const int nig = WGM * nN, gid = wgid / nig, fm = gid * WGM, gsz = (nM - fm) < WGM ? (nM - fm) : WGM;
        pm = fm + ((wgid % nig) % gsz); pn = (wgid % nig) / gsz; return true;
    }
};
struct DenseSched {
    StaticOrder so; const bf16_t* Bt; int lda, ldb;
    __device__ __forceinline__ bool next(int i, Unit& u) const { int pm, pn; if (!so.next(i, pm, pn)) return false; u.rowbase = pm * BM; u.pn = pn; u.permoff = 0; u.nvalid = 256; u.e1 = 0; u.e2 = 0; return true; }
    __device__ __forceinline__ void aoff(const Unit& u, const int (&R)[2], const int (&C)[2], unsigned (&v)[2][2]) const {
#pragma unroll
        for (int h = 0; h < 2; ++h)
#pragma unroll
            for (int i = 0; i < 2; ++i) v[h][i] = (unsigned)((u.rowbase + 128 * h + R[i]) * lda + C[i]) * 2u; }
    __device__ __forceinline__ const char* blo(const Unit& u) const { return (const char*)Bt + (size_t)u.pn * 256 * ldb * 2; }
    __device__ __forceinline__ const char* bhi(const Unit& u) const { return blo(u); }
};
__device__ __forceinline__ bool moe_unit(int L, int npn, const volatile LAS int* TP, const int* cnt, Unit& u) {
    const int TT = TP[NCLASS]; if (L >= TT * npn) return false;
    const int tau = L / npn; u.pn = L % npn;
    int c = 0;
#pragma unroll 1
    for (int k = 1; k < NCLASS; ++k) if (TP[k] <= tau) c = k;
    const int rt = tau - TP[c]; const int n = cnt[c] - 256 * rt;
    u.rowbase = tau * 256; u.permoff = c * CAP + rt * 256; u.nvalid = n < 256 ? n : 256;
    const int g = c / 6, p = c % 6; const int a = (p < 3) ? 0 : (p < 5) ? 1 : 2; const int b = (p < 3) ? p + 1 : (p < 5) ? p - 1 : 3;
    u.e1 = 4 * g + a; u.e2 = 4 * g + b;
    u.rowbase = __builtin_amdgcn_readfirstlane(u.rowbase); u.pn = __builtin_amdgcn_readfirstlane(u.pn); u.permoff = __builtin_amdgcn_readfirstlane(u.permoff);
    u.nvalid = __builtin_amdgcn_readfirstlane(u.nvalid); u.e1 = __builtin_amdgcn_readfirstlane(u.e1); u.e2 = __builtin_amdgcn_readfirstlane(u.e2);
    return true;
}
struct Moe1Sched {
    const volatile LAS int* TP; const int* cnt; const int* perm; const bf16_t* Wgu; int G, c;
    __device__ __forceinline__ bool next(int i, Unit& u) const { return moe_unit(i * G + c, 8, TP, cnt, u); }
    __device__ __forceinline__ void aoff(const Unit& u, const int (&R)[2], const int (&C)[2], unsigned (&v)[2][2]) const {
#pragma unroll
        for (int h = 0; h < 2; ++h)
#pragma unroll
            for (int i = 0; i < 2; ++i) { const int r = 128 * h + R[i]; const int tok = (r < u.nvalid) ? perm[u.permoff + r] : 0; v[h][i] = (unsigned)(tok * 1024 + C[i]) * 2u; } }
    __device__ __forceinline__ const char* blo(const Unit& u) const { const int e = (u.pn < 4) ? u.e1 : u.e2; return (const char*)Wgu + ((size_t)e * 1024 + 128 * (u.pn & 3)) * 1024 * 2; }
    __device__ __forceinline__ const char* bhi(const Unit& u) const { return blo(u); }
};
struct Moe2Sched {
    const volatile LAS int* TP; const int* cnt; const bf16_t* Wd; int G, c;
    __device__ __forceinline__ bool next(int i, Unit& u) const { return moe_unit(i * G + c, 4, TP, cnt, u); }
    __device__ __forceinline__ void aoff(const Unit& u, const int (&R)[2], const int (&C)[2], unsigned (&v)[2][2]) const {
#pragma unroll
        for (int h = 0; h < 2; ++h)
#pragma unroll
            for (int i = 0; i < 2; ++i) v[h][i] = (unsigned)((u.rowbase + 128 * h + R[i]) * 1024 + C[i]) * 2u; }
    __device__ __forceinline__ const char* blo(const Unit& u) const { return (const char*)Wd + ((size_t)u.e1 * 1024 + 256 * u.pn) * 512 * 2; }
    __device__ __forceinline__ const char* bhi(const Unit& u) const { return (const char*)Wd + ((size_t)u.e2 * 1024 + 256 * u.pn) * 512 * 2 - 8 * 128; }
};

__device__ __forceinline__ float row_rstd16(const float* stats, int row) {
    const f32x4* p = (const f32x4*)(stats + (size_t)row * 16); const f32x4 a = p[0], b = p[1], c = p[2], d = p[3];
    const float s = ((a[0] + a[1]) + (a[2] + a[3])) + ((b[0] + b[1]) + (b[2] + b[3])) + ((c[0] + c[1]) + (c[2] + c[3])) + ((d[0] + d[1]) + (d[2] + d[3]));
    return 1.0f / sqrtf(s * (1.0f / 1024.0f) + EPS);
}
struct EpiHead {
    static constexpr int BMODE = 2;
    bf16_t* dbase; size_t dstride; const float* gtab; int plain_seg; int e0, e1;
    int ldc; const float* rstd; const float* stats;
    __device__ __forceinline__ void operator()(const f32x4 (&acc)[2][2][4][2], const Unit& u, int wr, int wc, int fr, int fq) const {
        const int pn = u.pn; const int seg = (pn < e0) ? 0 : (pn < e1) ? 1 : 2;
        bf16_t* dst = dbase + (size_t)seg * dstride; const float* gain = gtab + 64 * seg; const bool norm = (seg != plain_seg);
        const int pnl = pn - (seg == 0 ? 0 : seg == 1 ? e0 : e1);
        const int col0 = 64 * (4 * pnl + wc) + 8 * fq;
        f32x4 gv[2][2];
#pragma unroll
        for (int bj = 0; bj < 2; ++bj)
#pragma unroll
            for (int n = 0; n < 2; ++n) gv[bj][n] = *(const f32x4*)(gain + 32 * bj + 8 * fq + 4 * n);
#pragma unroll
        for (int ai = 0; ai < 2; ++ai)
#pragma unroll
            for (int m = 0; m < 4; ++m) {
                const int row = u.rowbase + ai * HALF + wr * 64 + m * 16 + fr;
                const float rs = rstd ? rstd[row] : row_rstd16(stats, row);
                float hr = rs;
                if (norm) {
                    float ss = 0.f;
#pragma unroll
                    for (int bj = 0; bj < 2; ++bj)
#pragma unroll
                        for (int n = 0; n < 2; ++n) { const f32x4 x = acc[ai][bj][m][n]; ss += (x[0] * x[0] + x[1] * x[1]) + (x[2] * x[2] + x[3] * x[3]); }
                    ss += __shfl_xor(ss, 16); ss += __shfl_xor(ss, 32);
                    hr = rs / sqrtf(ss * rs * rs * (1.0f / 64.0f) + EPS);
                }
                bf16_t* rowp = dst + (size_t)row * ldc + col0;
#pragma unroll
                for (int bj = 0; bj < 2; ++bj) {
                    const f32x4 v0 = acc[ai][bj][m][0] * hr * gv[bj][0], v1 = acc[ai][bj][m][1] * hr * gv[bj][1];
                    u32x4 w; w.x = cvt_pk_bf16(v0[0], v0[1]); w.y = cvt_pk_bf16(v0[2], v0[3]); w.z = cvt_pk_bf16(v1[0], v1[1]); w.w = cvt_pk_bf16(v1[2], v1[3]);
                    *(u32x4*)(rowp + 32 * bj) = w; }
            }
    }
};
struct EpiResid {
    static constexpr int BMODE = 0;
    const float* base; float* out; bf16_t* xb; float* stats;
    __device__ __forceinline__ void operator()(const f32x4 (&acc)[2][2][4][2], const Unit& u, int wr, int wc, int fr, int fq) const {
        const int col0 = u.pn * BM + wc * 32 + 4 * fq;
#pragma unroll
        for (int ai = 0; ai < 2; ++ai)
#pragma unroll
            for (int m = 0; m < 4; ++m) {
                const int row = u.rowbase + ai * HALF + wr * 64 + m * 16 + fr; const size_t off = (size_t)row * 1024 + col0; float ss = 0.f;
#pragma unroll
                for (int bj = 0; bj < 2; ++bj)
#pragma unroll
                    for (int n = 0; n < 2; ++n) { const size_t o = off + bj * HALF + n * 16; const f32x4 v = *(const f32x4*)(base + o) + acc[ai][bj][m][n];
                        *(f32x4*)(out + o) = v; ss += (v[0] * v[0] + v[1] * v[1]) + (v[2] * v[2] + v[3] * v[3]);
                        u32x2 w; w.x = cvt_pk_bf16(v[0], v[1]); w.y = cvt_pk_bf16(v[2], v[3]); *(u32x2*)(xb + o) = w; }
                ss += __shfl_xor(ss, 16); ss += __shfl_xor(ss, 32);
                if (fq == 0) stats[(size_t)row * 16 + u.pn * 4 + wc] = ss;
            }
    }
};
struct EpiSwiglu {
    static constexpr int BMODE = 1;
    bf16_t* hid; const int* perm; const float* rstd; const float* gates;
    __device__ __forceinline__ void operator()(const f32x4 (&acc)[2][2][4][2], const Unit& u, int wr, int wc, int fr, int fq) const {
        const int col0 = 512 * (u.pn >> 2) + 128 * (u.pn & 3) + 32 * wc + 8 * fq; const int gsel = u.pn >> 2;
#pragma unroll
        for (int ai = 0; ai < 2; ++ai)
#pragma unroll
            for (int m = 0; m < 4; ++m) {
                const int r = ai * HALF + wr * 64 + m * 16 + fr; const bool valid = r < u.nvalid; const int tok = valid ? perm[u.permoff + r] : 0;
                const float rs = rstd[tok]; const float gw = valid ? gates[2 * tok + gsel] : 0.f;
                float h[8];
#pragma unroll
                for (int n = 0; n < 2; ++n)
#pragma unroll
                    for (int i = 0; i < 4; ++i) { const float g = acc[ai][0][m][n][i] * rs, up = acc[ai][1][m][n][i] * rs; const float sg = g * __builtin_amdgcn_rcpf(1.0f + __builtin_amdgcn_exp2f(-g * LOG2E)); h[4 * n + i] = sg * up * gw; }
                u32x4 w; w.x = cvt_pk_bf16(h[0], h[1]); w.y = cvt_pk_bf16(h[2], h[3]); w.z = cvt_pk_bf16(h[4], h[5]); w.w = cvt_pk_bf16(h[6], h[7]);
                *(u32x4*)(hid + (size_t)(u.rowbase + r) * 1024 + col0) = w;
            }
    }
};
struct EpiScatter {
    static constexpr int BMODE = 0;
    const float* base; float* out; bf16_t* xb; float* stats; const int* perm;
    __device__ __forceinline__ void operator()(const f32x4 (&acc)[2][2][4][2], const Unit& u, int wr, int wc, int fr, int fq) const {
        const int col0 = u.pn * BM + wc * 32 + 4 * fq;
#pragma unroll
        for (int ai = 0; ai < 2; ++ai)
#pragma unroll
            for (int m = 0; m < 4; ++m) {
                const int r = ai * HALF + wr * 64 + m * 16 + fr; const bool valid = r < u.nvalid; const int tok = valid ? perm[u.permoff + r] : 0;
                const size_t off = (size_t)tok * 1024 + col0; float ss = 0.f;
#pragma unroll
                for (int bj = 0; bj < 2; ++bj)
#pragma unroll
                    for (int n = 0; n < 2; ++n) { const size_t o = off + bj * HALF + n * 16; const f32x4 v = *(const f32x4*)(base + o) + acc[ai][bj][m][n];
                        ss += (v[0] * v[0] + v[1] * v[1]) + (v[2] * v[2] + v[3] * v[3]);
                        if (valid) { *(f32x4*)(out + o) = v; if (xb) { u32x2 w; w.x = cvt_pk_bf16(v[0], v[1]); w.y = cvt_pk_bf16(v[2], v[3]); *(u32x2*)(xb + o) = w; } } }
                ss += __shfl_xor(ss, 16); ss += __shfl_xor(ss, 32);
                if (stats && valid && fq == 0) stats[(size_t)tok * 16 + u.pn * 4 + wc] = ss;
            }
    }
};

template <class Epi, class Sched>
__device__ __forceinline__ void gemm_phase(LAS unsigned char* lds, const GemmP g, const Sched& S, const Epi& E) {
    int tid = threadIdx.x; asm volatile("" : "+v"(tid));
    const int wid = __builtin_amdgcn_readfirstlane(tid >> 6), lane = tid & 63, wr = wid >> 2, wc = wid & 3, fr = lane & 15, fq = lane >> 4;
    const int nt = g.K / BK;
    int R[2], C[2]; unsigned voffB[2];
#pragma unroll
    for (int i = 0; i < 2; ++i) { stage_rc(tid * 16 + i * 8192, R[i], C[i]);
        const int Rb = (Epi::BMODE == 0) ? R[i] : (Epi::BMODE == 1) ? ((R[i] & ~31) + perm32(R[i] & 31)) : (64 * (R[i] >> 5) + perm32(R[i] & 31));
        voffB[i] = (unsigned)(Rb * g.ldb + C[i]) * 2u; }
    const size_t kstep = (size_t)(BK * 2);
    const size_t hstepB = (size_t)g.hstepB * g.ldb * 2;
    const unsigned ldsw = (unsigned)wid * 1024u;
    const int aoff = lds_byte(wr * 64 + fr, fq * 8), boff = lds_byte(wc * 32 + fr, fq * 8);
    const char* const Ab = (const char*)g.A;
#define PG8_SA(b, h) (((b) * 2 + (h)) * HTB)
#define PG8_SB(b, h) ((4 + (b) * 2 + (h)) * HTB)
#define PG8_STAGE(bufoff, gbase, voff) do { _Pragma("unroll") for (int _i = 0; _i < 2; ++_i) \
        __builtin_amdgcn_global_load_lds((const unsigned*)((const char*)(gbase) + (voff)[_i]), (LAS unsigned*)(lds + (bufoff) + ldsw + _i * 8192), 16, 0, 0); } while (0)
#define PG8_LDA(dst, b, h) do { _Pragma("unroll") for (int m = 0; m < 4; ++m) _Pragma("unroll") for (int k = 0; k < 2; ++k) dst[m][k] = *(const LAS bf16x8*)(lds + PG8_SA(b, h) + aoff + m * 2048 + k * 1024); } while (0)
#define PG8_LDB(dst, b, h) do { _Pragma("unroll") for (int n = 0; n < 2; ++n) _Pragma("unroll") for (int k = 0; k < 2; ++k) dst[n][k] = *(const LAS bf16x8*)(lds + PG8_SB(b, h) + boff + n * 2048 + k * 1024); } while (0)
#define PG8_MMA(ai, bj, At, Bt) do { __builtin_amdgcn_s_setprio(1); _Pragma("unroll") for (int m = 0; m < 4; ++m) _Pragma("unroll") for (int n = 0; n < 2; ++n) _Pragma("unroll") for (int k = 0; k < 2; ++k) \
        acc[ai][bj][m][n] = __builtin_amdgcn_mfma_f32_16x16x32_bf16(Bt[n][k], At[m][k], acc[ai][bj][m][n], 0, 0, 0); __builtin_amdgcn_s_setprio(0); } while (0)
#define PG8_WAIT_V(n) asm volatile("s_waitcnt vmcnt(" #n ")" ::: "memory")
#define PG8_WAIT_L(n) asm volatile("s_waitcnt lgkmcnt(" #n ")" ::: "memory")
#define PG8_BAR __builtin_amdgcn_s_barrier()
#define PG8_SCHED __builtin_amdgcn_sched_barrier(0)
    Unit cur, nxt; int ui = 0;
    if (!S.next(0, cur)) return;
    unsigned vc[2][2];
    LAS u32x4* const vnl = (LAS u32x4*)(lds + AUX_OFF + 2048) + tid;
    S.aoff(cur, R, C, vc);
    f32x4 acc[2][2][4][2];
#pragma unroll
    for (int a = 0; a < 2; ++a)
#pragma unroll
        for (int b = 0; b < 2; ++b)
#pragma unroll
            for (int m = 0; m < 4; ++m)
#pragma unroll
                for (int n = 0; n < 2; ++n) acc[a][b][m][n] = (f32x4){0.f, 0.f, 0.f, 0.f};
    bf16x8 At[4][2], B0[2][2], B1[2][2];
    const char* cBl = S.blo(cur); const char* cBh = S.bhi(cur);
    PG8_STAGE(PG8_SB(0, 0), cBl, voffB); PG8_STAGE(PG8_SB(0, 1), cBl + hstepB, voffB); PG8_STAGE(PG8_SA(0, 0), Ab, vc[0]); PG8_STAGE(PG8_SA(0, 1), Ab, vc[1]);
    if (wr == 1) PG8_BAR;
    PG8_WAIT_V(2); PG8_BAR;
    PG8_STAGE(PG8_SB(1, 0), cBl + kstep, voffB); PG8_STAGE(PG8_SA(1, 0), Ab + kstep, vc[0]); PG8_STAGE(PG8_SB(1, 1), cBl + hstepB + kstep, voffB);
    PG8_WAIT_V(6); PG8_BAR;
    for (;;) {
        const bool has_next = S.next(ui + 1, nxt);
        { unsigned vn[2][2];
          if (has_next) S.aoff(nxt, R, C, vn); else {
#pragma unroll
            for (int h = 0; h < 2; ++h)
#pragma unroll
                for (int i = 0; i < 2; ++i) vn[h][i] = vc[h][i]; }
          *vnl = (u32x4){vn[0][0], vn[0][1], vn[1][0], vn[1][1]}; }
        const char* nBl = has_next ? S.blo(nxt) : cBl; const char* nBh = has_next ? S.bhi(nxt) : cBh;
        for (int t = 0; t < nt; t += 2) {
            const bool last = (t == nt - 2);
            const char* a1 = Ab + (size_t)(t + 1) * kstep;
            const char* a2 = last ? Ab : Ab + (size_t)(t + 2) * kstep;
            const char* b2 = last ? nBl : (((t + 2) < g.nsplit) ? cBl : cBh) + (size_t)(t + 2) * kstep;
            const char* a3 = a2 + kstep; const char* b3 = b2 + kstep;
            PG8_LDB(B0, 0, 0); PG8_LDB(B1, 0, 1); PG8_SCHED; PG8_LDA(At, 0, 0); PG8_STAGE(PG8_SA(1, 1), a1, vc[1]);
            PG8_WAIT_V(8); PG8_WAIT_L(0); PG8_BAR; PG8_MMA(0, 0, At, B0); PG8_MMA(0, 1, At, B1); PG8_BAR; PG8_SCHED;
            if (last) { const u32x4 v_ = *vnl; vc[0][0] = v_[0]; vc[0][1] = v_[1]; vc[1][0] = v_[2]; vc[1][1] = v_[3]; }
            PG8_LDA(At, 0, 1); PG8_STAGE(PG8_SB(0, 0), b2, voffB); PG8_STAGE(PG8_SB(0, 1), b2 + hstepB, voffB); PG8_STAGE(PG8_SA(0, 0), a2, vc[0]);
            PG8_WAIT_V(8); PG8_WAIT_L(0); PG8_BAR; PG8_MMA(1, 0, At, B0); PG8_MMA(1, 1, At, B1); PG8_BAR; PG8_SCHED;
            PG8_LDB(B0, 1, 0); PG8_LDB(B1, 1, 1); PG8_SCHED; PG8_LDA(At, 1, 0); PG8_STAGE(PG8_SA(0, 1), a2, vc[1]);
            PG8_WAIT_V(8); PG8_WAIT_L(0); PG8_BAR; PG8_MMA(0, 0, At, B0); PG8_MMA(0, 1, At, B1); PG8_BAR; PG8_SCHED;
            PG8_LDA(At, 1, 1); PG8_STAGE(PG8_SB(1, 0), b3, voffB); PG8_STAGE(PG8_SB(1, 1), b3 + hstepB, voffB); PG8_STAGE(PG8_SA(1, 0), a3, vc[0]);
            PG8_WAIT_V(8); PG8_WAIT_L(0); PG8_BAR; PG8_MMA(1, 0, At, B0); PG8_MMA(1, 1, At, B1); PG8_BAR; PG8_SCHED;
        }
        if (wr == 0) PG8_BAR;
        E(acc, cur, wr, wc, fr, fq);
        if (!has_next) break;
#pragma unroll
        for (int a = 0; a < 2; ++a)
#pragma unroll
            for (int b = 0; b < 2; ++b)
#pragma unroll
                for (int m = 0; m < 4; ++m)
#pragma unroll
                    for (int n = 0; n < 2; ++n) acc[a][b][m][n] = (f32x4){0.f, 0.f, 0.f, 0.f};
        cur = nxt; cBl = nBl; cBh = nBh; ++ui;
        if (wr == 1) PG8_BAR;
    }
    PG8_WAIT_V(0);
    PG8_BAR;
#undef PG8_SA
#undef PG8_SB
#undef PG8_STAGE
#undef PG8_LDA
#undef PG8_LDB
#undef PG8_MMA
#undef PG8_WAIT_V
#undef PG8_WAIT_L
#undef PG8_BAR
#undef PG8_SCHED
}
}

namespace attn_body {
using bf16 = __hip_bfloat16;
constexpr int NHEAD = 16, D = 64, DMQ = NHEAD * D;
constexpr int NW = 8, QBLK = 32, QB = QBLK * NW, KVBLK = 64;
__device__ __forceinline__ int crow(int r, int hi) { return (r & 3) + 8 * (r >> 2) + 4 * hi; }
#define SBAR() __builtin_amdgcn_sched_barrier(0)
__device__ __forceinline__ void cmask(f32x16& p0, f32x16& p1, int jb, int qrel, int hi) {
  const float NEG = -INFINITY; int kb = 64 * jb + 4 * hi;
  #pragma unroll
  for (int r = 0; r < 16; ++r) { int kv = kb + (r & 3) + 8 * (r >> 2); if (kv > qrel) p0[r] = NEG; if (kv + 32 > qrel) p1[r] = NEG; }
}
constexpr int NSLOT = 3, SLOTB = 8192;
constexpr int LDS_K = 0, LDS_V = NSLOT * SLOTB, LDS_WS = 2 * NSLOT * SLOTB, LDS_OST = LDS_WS + NW * 64 * 4, ATT_LDS_BYTES = LDS_OST + NW * 4096;
constexpr int LDS_NCK = 86016;
__device__ __forceinline__ void glds16(const void* gsrc, unsigned lds_dst) { unsigned keep;
  asm volatile("s_mov_b32 %0, m0\n\ts_mov_b32 m0, %2\n\ts_nop 0\n\tglobal_load_lds_dwordx4 %1, off\n\ts_mov_b32 m0, %0" : "=&s"(keep) : "v"(gsrc), "s"(lds_dst) : "memory"); }
__device__ __forceinline__ float max3f(float a, float b, float c) { float r; asm("v_max3_f32 %0, %1, %2, %3" : "=v"(r) : "v"(a), "v"(b), "v"(c)); return r; }
__device__ __forceinline__ float max2f(float a, float b) { float r; asm("v_max_f32_e32 %0, %1, %2" : "=v"(r) : "v"(a), "v"(b)); return r; }
__device__ __forceinline__ float fadd_s(float a, float b) { float r; asm("v_add_f32_e32 %0, %1, %2" : "=v"(r) : "v"(a), "v"(b)); return r; }
__device__ __forceinline__ float fsub_s(float a, float b) { float r; asm("v_sub_f32_e32 %0, %1, %2" : "=v"(r) : "v"(a), "v"(b)); return r; }
typedef __bf16 bf16x2_t __attribute__((ext_vector_type(2)));
__device__ __forceinline__ unsigned cvtpk_s(float lo, float hi) { f32x2 v = {lo, hi}; bf16x2_t b = __builtin_convertvector(v, bf16x2_t); return __builtin_bit_cast(unsigned, b); }
#define WAIT_BAR(N) asm volatile("s_waitcnt vmcnt(" #N ") lgkmcnt(0)\n\ts_barrier" ::: "memory")
typedef LAS const char* lds_cptr;
typedef short v4i16_t __attribute__((ext_vector_type(4)));
__device__ __forceinline__ void qkt(f32x16& p0, f32x16& p1, lds_cptr Kslot, const bf16x8* qr, const f32x16& negm, int r32, int hi) {
  lds_cptr kb = Kslot + hi * 1024 + r32 * 16;
  #pragma unroll
  for (int d0 = 0; d0 < 4; ++d0) {
    const bf16x8 b0 = *(const LAS bf16x8*)(kb + d0 * 2048);
    const bf16x8 b1 = *(const LAS bf16x8*)(kb + d0 * 2048 + 512);
    if (d0 == 0) { p0 = __builtin_amdgcn_mfma_f32_32x32x16_bf16(b0, qr[0], negm, 0, 0, 0); p1 = __builtin_amdgcn_mfma_f32_32x32x16_bf16(b1, qr[0], negm, 0, 0, 0); }
    else { p0 = __builtin_amdgcn_mfma_f32_32x32x16_bf16(b0, qr[d0], p0, 0, 0, 0); p1 = __builtin_amdgcn_mfma_f32_32x32x16_bf16(b1, qr[d0], p1, 0, 0, 0); } }
}
__device__ __forceinline__ void kload8(bf16x8* kf, lds_cptr kp) {
  kf[0] = *(const LAS bf16x8*)(kp);        kf[1] = *(const LAS bf16x8*)(kp + 512);
  kf[2] = *(const LAS bf16x8*)(kp + 2048); kf[3] = *(const LAS bf16x8*)(kp + 2560);
  kf[4] = *(const LAS bf16x8*)(kp + 4096); kf[5] = *(const LAS bf16x8*)(kp + 4608);
  kf[6] = *(const LAS bf16x8*)(kp + 6144); kf[7] = *(const LAS bf16x8*)(kp + 6656);
}
__device__ __forceinline__ void kload2(bf16x8* kf, lds_cptr kp, int j) { kf[2 * j] = *(const LAS bf16x8*)(kp + j * 2048); kf[2 * j + 1] = *(const LAS bf16x8*)(kp + j * 2048 + 512); }
__device__ __forceinline__ s16x4 vtr(lds_cptr p) { return __builtin_bit_cast(s16x4, __builtin_amdgcn_ds_read_tr16_b64_v4i16((LAS v4i16_t*)p)); }
__device__ __forceinline__ float rowmax(const f32x16& p0, const f32x16& p1) {
  float a = max3f(p0[0], p0[1], p1[0]), b = max3f(p0[2], p0[3], p1[1]); a = max3f(a, p1[2], p1[3]);
  #pragma unroll
  for (int r = 4; r < 16; r += 4) { a = max3f(a, p0[r], p0[r + 1]); b = max3f(b, p0[r + 2], p0[r + 3]); a = max3f(a, p1[r], p1[r + 1]); b = max3f(b, p1[r + 2], p1[r + 3]); }
  const float m = max2f(a, b);
  auto rr = __builtin_amdgcn_permlane32_swap(__float_as_uint(m), __float_as_uint(m), false, false);
  return max2f(__uint_as_float(rr[0]), __uint_as_float(rr[1]));
}
__device__ __forceinline__ void pv(f32x16* o, int vb, bf16x8 pa0, bf16x8 pa1, bf16x8 pa2, bf16x8 pa3) {
  #pragma unroll
  for (int d0 = 0; d0 < 2; ++d0) { s16x4 lo[4], hi[4];
    #pragma unroll
    for (int ks = 0; ks < 4; ++ks) {
      asm volatile("ds_read_b64_tr_b16 %0,%1 offset:%c2" : "=&v"(lo[ks]) : "v"(vb), "i"(d0 * 4096 + ks * 1024) : "memory");
      asm volatile("ds_read_b64_tr_b16 %0,%1 offset:%c2" : "=&v"(hi[ks]) : "v"(vb), "i"(d0 * 4096 + ks * 1024 + 512) : "memory"); }
    asm volatile("s_waitcnt lgkmcnt(0)" ::: "memory"); SBAR();
    #define PK(k) (bf16x8){lo[k][0], lo[k][1], lo[k][2], lo[k][3], hi[k][0], hi[k][1], hi[k][2], hi[k][3]}
    o[d0] = __builtin_amdgcn_mfma_f32_32x32x16_bf16(pa0, PK(0), o[d0], 0, 0, 0);
    o[d0] = __builtin_amdgcn_mfma_f32_32x32x16_bf16(pa1, PK(1), o[d0], 0, 0, 0);
    o[d0] = __builtin_amdgcn_mfma_f32_32x32x16_bf16(pa2, PK(2), o[d0], 0, 0, 0);
    o[d0] = __builtin_amdgcn_mfma_f32_32x32x16_bf16(pa3, PK(3), o[d0], 0, 0, 0);
    #undef PK
  }
}

template<int THRL> __device__ __forceinline__ void attn_unit(int b, int h, int qb, int T0, const bf16* Q, const bf16* __restrict__ K, const bf16* __restrict__ V, bf16* O, char* shm) {
  int tid = threadIdx.x; asm volatile("" : "+v"(tid));
  const int lane = tid & 63, r32 = lane & 31, hi = lane >> 5; const int wid = __builtin_amdgcn_readfirstlane(tid >> 6);
  const long rowbase = (long)b * SEQ; const int q0 = qb * QB;
  const bf16* Qw = Q + (rowbase + q0 + wid * QBLK) * DMQ + h * D;
  const bf16* Kh = K + (rowbase + (long)T0 * KVBLK) * DMQ + h * D, *Vh = V + (rowbase + (long)T0 * KVBLK) * DMQ + h * D;
  const unsigned lds0 = (unsigned)(uintptr_t)shm; const lds_cptr shm3 = (lds_cptr)shm;
  float* wsf = (float*)(shm + LDS_WS) + wid * 64;
  const LAS float* nck0 = (const LAS float*)((lds_cptr)shm + LDS_NCK) + T0 * KVBLK + 4 * hi;
  const float cq2 = -((const LAS float*)((lds_cptr)shm + LDS_NCK))[q0 + wid * QBLK + r32];
  const bf16* ksrc = Kh + (long)lane * DMQ + wid * 8;
  const bf16* vsrc = Vh + (long)(16 * (wid & 3) + (lane >> 2)) * DMQ + (wid >> 2) * 32 + (lane & 3) * 8;
  const unsigned kdst = lds0 + LDS_K + wid * 1024, vdst = lds0 + LDS_V + wid * 1024;
  #define DMA_K(t, slot) glds16(ksrc + (long)(t) * KVBLK * DMQ, (unsigned)__builtin_amdgcn_readfirstlane(kdst + (slot)))
  #define DMA_V(t, slot) glds16(vsrc + (long)(t) * KVBLK * DMQ, (unsigned)__builtin_amdgcn_readfirstlane(vdst + (slot)))
  const int vb0 = (int)(lds0 + LDS_V) + ((lane >> 4) & 1) * 32 + (lane & 3) * 8 + (4 * hi + ((lane & 15) >> 2)) * 64;
  bf16x8 kf[8];
  const lds_cptr kp0 = shm3 + LDS_K + hi * 1024 + r32 * 16; const lds_cptr vp0 = shm3 + LDS_V + ((lane >> 4) & 1) * 32 + (lane & 3) * 8 + (4 * hi + ((lane & 15) >> 2)) * 64;
  const int NT = (q0 + QB) / KVBLK - T0;
  DMA_K(0, 0); DMA_V(0, 0); DMA_K(1, SLOTB);
  bf16x8 qr[4];
  #pragma unroll
  for (int d0 = 0; d0 < 4; ++d0) qr[d0] = *reinterpret_cast<const bf16x8*>(&Qw[(long)r32 * DMQ + d0 * 16 + hi * 8]);
  const lds_cptr qp = shm3 + LDS_OST + wid * 4096 + lane * 16;
  #pragma unroll
  for (int d0 = 0; d0 < 4; ++d0) *(LAS bf16x8*)(qp + d0 * 1024) = qr[d0];
  #define QLD(d) (*(const LAS bf16x8*)(qp + (d) * 1024))
  float nm = cq2, l_reg = 0.f; f32x16 o[2]; o[0] = f32x16{}; o[1] = f32x16{};
  const int qrel = wid * QBLK + r32;
  #define CMASK(P0, P1, t) do { int jb_ = (t) - (NT - 4); if (jb_ >= 0) cmask(P0, P1, jb_, qrel, hi); } while (0)
  #define DECAY(P0, P1, t) do { const LAS float* nk_ = nck0 + ((t) << 6); \
    _Pragma("unroll") for (int g_ = 0; g_ < 4; ++g_) { const f32x4 a_ = *(const LAS f32x4*)(nk_ + 8 * g_); const f32x4 b_ = *(const LAS f32x4*)(nk_ + 32 + 8 * g_); \
      P0[4 * g_] += a_[0]; P0[4 * g_ + 1] += a_[1]; P0[4 * g_ + 2] += a_[2]; P0[4 * g_ + 3] += a_[3]; P1[4 * g_] += b_[0]; P1[4 * g_ + 1] += b_[1]; P1[4 * g_ + 2] += b_[2]; P1[4 * g_ + 3] += b_[3]; SBAR(); } } while (0)
  bool resc = false;
  #define START(P0, P1) do { const float rm = rowmax(P0, P1); resc = false; \
    { const float dl = rm; nm = fsub_s(nm, dl); \
      _Pragma("unroll") for (int r = 0; r < 16; ++r) { P0[r] = fsub_s(P0[r], dl); P1[r] = fsub_s(P1[r], dl); } } \
    _Pragma("unroll") for (int r = 0; r < 16; ++r) P0[r] = __builtin_amdgcn_exp2f(P0[r]); } while (0)
  #define RESC() do { if (resc) { asm volatile("s_waitcnt lgkmcnt(0)" ::: "memory"); \
      _Pragma("unroll") for (int d_ = 0; d_ < 2; ++d_) _Pragma("unroll") for (int r = 0; r < 16; ++r) o[d_][r] *= wsf[crow(r, hi)]; } } while (0)
  f32x16 pA0, pA1, pB0, pB1;
  int sl_prev = 0, sl_cur = 0, sl_next = SLOTB;
  #define ROT() do { sl_prev = sl_cur; sl_cur = sl_next; sl_next = (sl_next == (NSLOT - 1) * SLOTB) ? 0 : sl_next + SLOTB; } while (0)
  DMA_K(2, 2 * SLOTB);
  WAIT_BAR(3);
  { f32x16 negm;
    #pragma unroll
    for (int r = 0; r < 16; ++r) negm[r] = nm;
    qkt(pA0, pA1, shm3 + LDS_K, qr, negm, r32, hi); }
  asm volatile("s_nop 15\n\ts_nop 7" : "+v"(pA0), "+v"(pA1)); DECAY(pA0, pA1, 0); CMASK(pA0, pA1, 0);
  asm volatile("s_nop 1" : "+v"(pA0), "+v"(pA1));
  START(pA0, pA1);
  _Pragma("unroll") for (int r = 0; r < 16; ++r) pA1[r] = __builtin_amdgcn_exp2f(pA1[r]);
  WAIT_BAR(0);
  DMA_K(3, 0); DMA_V(1, SLOTB);
  ROT();
  kload8(kf, kp0 + sl_cur);
  WAIT_BAR(2);
  s16x4 vlo[8], vhi[8]; u32x4 pw0, pw1, pw2, pw3; bf16x8 qfa = QLD(0), qfb = QLD(1);
  #define PKW(P, B) cvtpk_s(P[B], P[B + 1])
  #define PAF(k) __builtin_bit_cast(bf16x8, pw##k)
  #define VFR(i) (bf16x8){vlo[i][0], vlo[i][1], vlo[i][2], vlo[i][3], vhi[i][0], vhi[i][1], vhi[i][2], vhi[i][3]}
  #define PIN(x) asm volatile("" : "+v"(x))
  #define MX3(a, b, c) __builtin_fmaxf(__builtin_fmaxf((a), (b)), (c))
  #define SPLAT(X) do { _Pragma("unroll") for (int r_ = 0; r_ < 16; ++r_) X[r_] = nm; PIN(X); } while (0)
  #define GAPA(MF, A0, A1, A2, A3, W0, W1, PW) do { MF; sacc += A0; sacc += A1; sacc += A2; sacc += A3; PIN(sacc); W0; W1; PIN(PW); SBAR(); } while (0)
  #define EX(v) __builtin_amdgcn_exp2f(v)
  #define GAPB(MF, X, B) do { MF; X[B] = EX(X[B]); X[B + 1] = EX(X[B + 1]); X[B + 2] = EX(X[B + 2]); X[B + 3] = EX(X[B + 3]); PIN(X); SBAR(); } while (0)
  #define VRD(i) do { vlo[i] = vtr(vp_ + (((i) >> 2) * 4096 + ((i) & 3) * 1024)); vhi[i] = vtr(vp_ + (((i) >> 2) * 4096 + ((i) & 3) * 1024 + 512)); } while (0)
  #define KRD(G, j) do { if (G) { kload2(kf, kp0 + sl_next, j); SBAR(); } } while (0)
  #define STEP(C0, C1, P0, P1, t, GK, GV, GL) do { SBAR(); \
    const lds_cptr vp_ = vp0 + sl_prev; \
    SPLAT(C0); VRD(0); SBAR(); float sacc = (P0[0] + P0[1]); \
    GAPA(C0 = __builtin_amdgcn_mfma_f32_32x32x16_bf16(kf[0], qfa, C0, 0, 0, 0), P0[2], P0[3], P0[4], P0[5],     pw0[0] = PKW(P0, 0), pw0[1] = PKW(P0, 2), pw0); \
    SPLAT(C1); VRD(4); SBAR(); GAPA(C1 = __builtin_amdgcn_mfma_f32_32x32x16_bf16(kf[1], qfa, C1, 0, 0, 0), P0[6], P0[7], P0[8], P0[9],     pw0[2] = PKW(P0, 4), pw0[3] = PKW(P0, 6), pw0); \
    qfa = QLD(2); VRD(1); SBAR(); GAPA(C0 = __builtin_amdgcn_mfma_f32_32x32x16_bf16(kf[2], qfb, C0, 0, 0, 0),   P0[10], P0[11], P0[12], P0[13], pw1[0] = PKW(P0, 8), pw1[1] = PKW(P0, 10), pw1); \
    VRD(5); SBAR(); GAPA(C1 = __builtin_amdgcn_mfma_f32_32x32x16_bf16(kf[3], qfb, C1, 0, 0, 0),   P0[14], P0[15], P1[0], P1[1],   pw1[2] = PKW(P0, 12), pw1[3] = PKW(P0, 14), pw1); \
    qfb = QLD(3); VRD(2); SBAR(); GAPA(C0 = __builtin_amdgcn_mfma_f32_32x32x16_bf16(kf[4], qfa, C0, 0, 0, 0),   P1[2], P1[3], P1[4], P1[5],     pw2[0] = PKW(P1, 0), pw2[1] = PKW(P1, 2), pw2); \
    VRD(6); SBAR(); GAPA(C1 = __builtin_amdgcn_mfma_f32_32x32x16_bf16(kf[5], qfa, C1, 0, 0, 0),   P1[6], P1[7], P1[8], P1[9],     pw2[2] = PKW(P1, 4), pw2[3] = PKW(P1, 6), pw2); \
    VRD(3); SBAR(); GAPA(C0 = __builtin_amdgcn_mfma_f32_32x32x16_bf16(kf[6], qfb, C0, 0, 0, 0),   P1[10], P1[11], P1[12], P1[13], pw3[0] = PKW(P1, 8), pw3[1] = PKW(P1, 10), pw3); \
    VRD(7); SBAR(); GAPA(C1 = __builtin_amdgcn_mfma_f32_32x32x16_bf16(kf[7], qfb, C1, 0, 0, 0),   P1[14], P1[15], 0.f, 0.f,       pw3[2] = PKW(P1, 12), pw3[3] = PKW(P1, 14), pw3); \
    l_reg += sacc; \
    if (GK) { DMA_K((t) + 3, sl_cur); } if (GV) { DMA_V((t) + 1, sl_next); } \
    DECAY(C0, C1, t); \
    CMASK(C0, C1, t); \
    { float a = MX3(C0[0], C0[1], C1[0]), b = MX3(C0[2], C0[3], C1[1]); a = MX3(a, C1[2], C1[3]); \
      _Pragma("unroll") for (int r = 4; r < 16; r += 4) { a = MX3(a, C0[r], C0[r + 1]); b = MX3(b, C0[r + 2], C0[r + 3]); a = MX3(a, C1[r], C1[r + 1]); b = MX3(b, C1[r + 2], C1[r + 3]); } \
      float rm = __builtin_fmaxf(a, b); { auto rr = __builtin_amdgcn_permlane32_swap(__float_as_uint(rm), __float_as_uint(rm), false, false); rm = __builtin_fmaxf(__uint_as_float(rr[0]), __uint_as_float(rr[1])); } \
      resc = false; \
      if (__builtin_expect(__any(rm > (float)THRL), 0)) { const float dl = __builtin_fmaxf(rm, 0.f); nm -= dl; \
        _Pragma("unroll") for (int r = 0; r < 16; ++r) { C0[r] -= dl; C1[r] -= dl; } \
        const float f = __builtin_amdgcn_exp2f(-dl); l_reg *= f; if (hi == 0) wsf[r32] = f; resc = true; } } \
    SBAR(); \
    GAPB(o[0] = __builtin_amdgcn_mfma_f32_32x32x16_bf16(PAF(0), VFR(0), o[0], 0, 0, 0), C0, 0); \
    GAPB(o[1] = __builtin_amdgcn_mfma_f32_32x32x16_bf16(PAF(0), VFR(4), o[1], 0, 0, 0), C0, 4); \
    KRD(GL, 0); GAPB(o[0] = __builtin_amdgcn_mfma_f32_32x32x16_bf16(PAF(1), VFR(1), o[0], 0, 0, 0), C0, 8); \
    KRD(GL, 1); GAPB(o[1] = __builtin_amdgcn_mfma_f32_32x32x16_bf16(PAF(1), VFR(5), o[1], 0, 0, 0), C0, 12); \
    KRD(GL, 2); GAPB(o[0] = __builtin_amdgcn_mfma_f32_32x32x16_bf16(PAF(2), VFR(2), o[0], 0, 0, 0), C1, 0); \
    KRD(GL, 3); GAPB(o[1] = __builtin_amdgcn_mfma_f32_32x32x16_bf16(PAF(2), VFR(6), o[1], 0, 0, 0), C1, 4); \
    GAPB(o[0] = __builtin_amdgcn_mfma_f32_32x32x16_bf16(PAF(3), VFR(3), o[0], 0, 0, 0), C1, 8); \
    qfa = QLD(0); qfb = QLD(1); SBAR(); \
    GAPB(o[1] = __builtin_amdgcn_mfma_f32_32x32x16_bf16(PAF(3), VFR(7), o[1], 0, 0, 0), C1, 12); \
    } while (0)
  int t = 1;
  #undef CMASK
  #define CMASK(P0, P1, t) do {} while (0)
  for (; t + 5 < NT; t += 2) {
    STEP(pB0, pB1, pA0, pA1, t, true, true, true);     WAIT_BAR(2); RESC(); ROT();
    STEP(pA0, pA1, pB0, pB1, t + 1, true, true, true); WAIT_BAR(2); RESC(); ROT();
  }
  #undef CMASK
  #define CMASK(P0, P1, t) do { int jb_ = (t) - (NT - 4); if (jb_ >= 0) cmask(P0, P1, jb_, qrel, hi); } while (0)
  #define ENDW(tt) do { if ((tt) + 3 < NT) { WAIT_BAR(2); } else if ((tt) + 2 < NT) { WAIT_BAR(1); } else { WAIT_BAR(0); } } while (0)
  for (; t + 1 < NT; t += 2) {
    STEP(pB0, pB1, pA0, pA1, t, (t + 3 < NT), (t + 1 < NT), (t + 1 < NT));       ENDW(t);     RESC(); ROT();
    STEP(pA0, pA1, pB0, pB1, t + 1, (t + 4 < NT), (t + 2 < NT), (t + 2 < NT));   ENDW(t + 1); RESC(); ROT();
  }
  STEP(pB0, pB1, pA0, pA1, NT - 1, false, false, false); RESC();
  { float sacc = pB0[0] + pB0[1]; _Pragma("unroll") for (int r = 2; r < 16; ++r) sacc += pB0[r]; _Pragma("unroll") for (int r = 0; r < 16; ++r) sacc += pB1[r]; l_reg += sacc;
    pw0 = (u32x4){PKW(pB0, 0), PKW(pB0, 2), PKW(pB0, 4), PKW(pB0, 6)}; pw1 = (u32x4){PKW(pB0, 8), PKW(pB0, 10), PKW(pB0, 12), PKW(pB0, 14)}; pw2 = (u32x4){PKW(pB1, 0), PKW(pB1, 2), PKW(pB1, 4), PKW(pB1, 6)}; pw3 = (u32x4){PKW(pB1, 8), PKW(pB1, 10), PKW(pB1, 12), PKW(pB1, 14)};
    SBAR(); pv(o, vb0 + sl_cur, PAF(0), PAF(1), PAF(2), PAF(3)); }
  #undef PKW
  #undef PAF
  #undef VFR
  #undef PIN
  #undef MX3
  #undef GAPA
  #undef SPLAT
  #undef GAPB
  #undef EX
  #undef VRD
  #undef KRD
  #undef STEP
  #undef ENDW
  { auto rr = __builtin_amdgcn_permlane32_swap(__float_as_uint(l_reg), __float_as_uint(l_reg), false, false); l_reg = __uint_as_float(rr[0]) + __uint_as_float(rr[1]); }
  if (hi == 0) wsf[32 + r32] = l_reg; asm volatile("s_waitcnt lgkmcnt(0)" ::: "memory");
  float rli[16];
  #pragma unroll
  for (int r = 0; r < 16; ++r) rli[r] = __builtin_amdgcn_rcpf(wsf[32 + crow(r, hi)]);
  bf16* Ow = O + (rowbase + q0 + wid * QBLK) * DMQ + h * D;
  { bf16* stg = (bf16*)(shm + LDS_OST) + wid * 2048;
    #pragma unroll
    for (int r = 0; r < 16; ++r) { const int orow = crow(r, hi);
      #pragma unroll
      for (int d0 = 0; d0 < 2; ++d0) stg[orow * 64 + d0 * 32 + r32] = __float2bfloat16(o[d0][r] * rli[r]); }
    asm volatile("s_waitcnt lgkmcnt(0)" ::: "memory");
    #pragma unroll
    for (int i = 0; i < 4; ++i) { const int row = i * 8 + (lane >> 3), ch = lane & 7; const u32x4 v = *(const u32x4*)(stg + row * 64 + ch * 8); *(u32x4*)(Ow + (long)row * DMQ + ch * 8) = v; } }
  asm volatile("s_waitcnt lgkmcnt(0)\n\ts_barrier" ::: "memory");
  #undef DMA_K
  #undef DMA_V
  #undef CMASK
  #undef DECAY
  #undef START
  #undef RESC
  #undef ROT
  #undef QLD
}
#undef WAIT_BAR
}

namespace dil {
using attn_body::crow; using attn_body::glds16; using attn_body::qkt; using attn_body::pv; using attn_body::rowmax; using attn_body::lds_cptr; using attn_body::cvtpk_s;
constexpr int TB_OFF0 = 0, TB_N0 = 1136, TB_MIN0 = -511;
constexpr int TB_OFF1 = 1136, TB_N1 = 380, TB_MIN1 = -127;
constexpr int TB_OFF2 = 1516, TB_N2 = 224, TB_MIN2 = -63;
constexpr int TB_TOTAL = 1740;
constexpr int WSCR_OFF = 7168;
constexpr float NEGBIG = -1.0e30f;
__device__ __forceinline__ int t5_bucket(int dist) {
    if (dist < 16) return dist;
    const float v = logf((float)dist / 16.0f) / 4.852030263919617f * 16.0f;
    const int l = 16 + (int)v; return l < 31 ? l : 31;
}
__device__ __forceinline__ void build_tables(LAS float* tb, const float* rel_bias, int j, int tid) {
    for (int e = tid; e < TB_TOTAL; e += 512) {
        int g, n, d;
        if (e < TB_OFF1) { g = 0; n = e - TB_OFF0 + TB_MIN0; d = 1; } else if (e < TB_OFF2) { g = 1; n = e - TB_OFF1 + TB_MIN1; d = 4; } else { g = 2; n = e - TB_OFF2 + TB_MIN2; d = 16; }
        float v = NEGBIG;
        if (n >= 0 && n <= 128) v = rel_bias[t5_bucket(n * d) * 24 + 8 * g + j] * LOG2E;
        tb[e] = v;
    }
}
template <int THRL>
__device__ __forceinline__ void wave_unit(int b, int j, int P0, int rho, const bf16_t* Qb, const bf16_t* Kb, const bf16_t* Vb, bf16_t* Ob,
                                          LAS unsigned char* ldsbase, int area_off, LAS float* tb, LAS float* wsf, int lane) {
    const int r32 = lane & 31, hi = lane >> 5;
    const long brow = (long)b * SEQ;
    const int pos0 = P0 + rho;
    const unsigned kdst = (unsigned)(uintptr_t)(ldsbase + area_off), vdst = kdst + 8192;
    const lds_cptr Kslot = (lds_cptr)(ldsbase + area_off);
    const int vb0 = (int)vdst + ((lane >> 4) & 1) * 32 + (lane & 3) * 8 + (4 * hi + ((lane & 15) >> 2)) * 64;
    float mhat = -1000.f, l_reg = 0.f; f32x16 o[2]; o[0] = f32x16{}; o[1] = f32x16{}; f32x16 negm;
#pragma unroll
    for (int r = 0; r < 16; ++r) negm[r] = 1000.f;
#define DIL_DESC(n, g, tau) do { g = ((n) < 10) ? 0 : ((n) < 14) ? 1 : 2; tau = (n) - (((n) < 10) ? 0 : ((n) < 14) ? 10 : 14); } while (0)
#define DIL_ISSUE_K(n) do { int g_, tau_; DIL_DESC(n, g_, tau_); const int D4_ = 2 * g_; int ks_ = (pos0 >> D4_) - 128 + 64 * tau_ + lane; ks_ = ks_ < 0 ? 0 : ks_; \
        const bf16_t* src_ = Kb + (brow + ((long)ks_ << D4_) + (pos0 & ((1 << D4_) - 1))) * KVW + 512 * g_ + 64 * j; \
        _Pragma("unroll") for (int pc_ = 0; pc_ < 8; ++pc_) glds16(src_ + 8 * pc_, (unsigned)__builtin_amdgcn_readfirstlane(kdst + pc_ * 1024)); } while (0)
#define DIL_ISSUE_V(n) do { int g_, tau_; DIL_DESC(n, g_, tau_); const int D4_ = 2 * g_; \
        _Pragma("unroll") for (int pv_ = 0; pv_ < 8; ++pv_) { int ks_ = (pos0 >> D4_) - 128 + 64 * tau_ + 16 * (pv_ & 3) + (lane >> 2); ks_ = ks_ < 0 ? 0 : ks_; \
            const bf16_t* src_ = Vb + (brow + ((long)ks_ << D4_) + (pos0 & ((1 << D4_) - 1))) * KVW + 512 * g_ + 64 * j + 32 * (pv_ >> 2) + 8 * (lane & 3); \
            glds16(src_, (unsigned)__builtin_amdgcn_readfirstlane(vdst + pv_ * 1024)); } } while (0)
    DIL_ISSUE_K(0); DIL_ISSUE_V(0);
    bf16x8 qr[4];
#pragma unroll 1
    for (int n = 0; n < 17; ++n) {
        int g, tau; DIL_DESC(n, g, tau);
        if (tau == 0) {
            const bf16_t* qp = Qb + (brow + pos0 + 16 * r32) * KVW + 512 * g + 64 * j + 8 * hi;
#pragma unroll
            for (int d0 = 0; d0 < 4; ++d0) qr[d0] = *(const bf16x8*)(qp + 16 * d0);
        }
        const int D4 = 2 * g, sq = 16 >> D4;
        const int tboff = (g == 0) ? TB_OFF0 : (g == 1) ? TB_OFF1 : TB_OFF2, tbmin = (g == 0) ? TB_MIN0 : (g == 1) ? TB_MIN1 : TB_MIN2;
        const LAS float* tp = tb + (tboff - tbmin + 128 + sq * r32 - 64 * tau - 4 * hi - 59);
        asm volatile("s_waitcnt vmcnt(8)" ::: "memory");
        f32x16 p0, p1;
        qkt(p0, p1, Kslot, qr, negm, r32, hi);
        asm volatile("s_waitcnt lgkmcnt(0)" ::: "memory");
#pragma unroll
        for (int r = 0; r < 16; ++r) { const int cr = (r & 3) + 8 * (r >> 2); p0[r] += tp[59 - cr]; p1[r] += tp[59 - cr - 32]; }
        if (n + 1 < 17) DIL_ISSUE_K(n + 1);
        const int kslo = (pos0 >> D4) - 128 + 64 * tau;
        if (kslo < 0) {
            const int cl = -kslo - 4 * hi;
#pragma unroll
            for (int r = 0; r < 16; ++r) { const int cr = (r & 3) + 8 * (r >> 2); if (cr < cl) p0[r] = NEGBIG; if (cr + 32 < cl) p1[r] = NEGBIG; }
        }
        const float rm = rowmax(p0, p1);
        if (__any(rm > (float)THRL)) {
            const float dl = __builtin_fmaxf(rm, 0.f); mhat += dl;
#pragma unroll
            for (int r = 0; r < 16; ++r) { p0[r] -= dl; p1[r] -= dl; }
#pragma unroll
            for (int r = 0; r < 16; ++r) negm[r] = -mhat;
            const float f = __builtin_amdgcn_exp2f(-dl); l_reg *= f; if (hi == 0) wsf[r32] = f;
            asm volatile("s_waitcnt lgkmcnt(0)" ::: "memory");
#pragma unroll
            for (int d_ = 0; d_ < 2; ++d_)
#pragma unroll
                for (int r = 0; r < 16; ++r) o[d_][r] *= wsf[crow(r, hi)];
        }
        float sacc = 0.f;
#pragma unroll
        for (int r = 0; r < 16; ++r) { p0[r] = __builtin_amdgcn_exp2f(p0[r]); p1[r] = __builtin_amdgcn_exp2f(p1[r]); sacc += p0[r] + p1[r]; }
        l_reg += sacc;
        u32x4 pw0, pw1, pw2, pw3;
#define PKW(P, B) cvtpk_s(P[B], P[B + 1])
        pw0 = (u32x4){PKW(p0, 0), PKW(p0, 2), PKW(p0, 4), PKW(p0, 6)}; pw1 = (u32x4){PKW(p0, 8), PKW(p0, 10), PKW(p0, 12), PKW(p0, 14)};
        pw2 = (u32x4){PKW(p1, 0), PKW(p1, 2), PKW(p1, 4), PKW(p1, 6)}; pw3 = (u32x4){PKW(p1, 8), PKW(p1, 10), PKW(p1, 12), PKW(p1, 14)};
#undef PKW
        if (n + 1 < 17) asm volatile("s_waitcnt vmcnt(8)" ::: "memory"); else asm volatile("s_waitcnt vmcnt(0)" ::: "memory");
        pv(o, vb0, __builtin_bit_cast(bf16x8, pw0), __builtin_bit_cast(bf16x8, pw1), __builtin_bit_cast(bf16x8, pw2), __builtin_bit_cast(bf16x8, pw3));
        if (n + 1 < 17) DIL_ISSUE_V(n + 1);
    }
#undef DIL_DESC
#undef DIL_ISSUE_K
#undef DIL_ISSUE_V
    { auto rr = __builtin_amdgcn_permlane32_swap(__float_as_uint(l_reg), __float_as_uint(l_reg), false, false); l_reg = __uint_as_float(rr[0]) + __uint_as_float(rr[1]); }
    if (hi == 0) wsf[32 + r32] = l_reg; asm volatile("s_waitcnt lgkmcnt(0)" ::: "memory");
    float rli[16];
#pragma unroll
    for (int r = 0; r < 16; ++r) rli[r] = __builtin_amdgcn_rcpf(wsf[32 + crow(r, hi)]);
    {   LAS bf16_t* stg = (LAS bf16_t*)(ldsbase + area_off);
#pragma unroll
        for (int r = 0; r < 16; ++r) { const int orow = crow(r, hi);
#pragma unroll
            for (int d0 = 0; d0 < 2; ++d0) stg[orow * 64 + d0 * 32 + r32] = (bf16_t)f2bf(o[d0][r] * rli[r]); }
        asm volatile("s_waitcnt lgkmcnt(0)" ::: "memory");
#pragma unroll
        for (int i = 0; i < 4; ++i) { const int row = i * 8 + (lane >> 3), ch = lane & 7; const u32x4 v = *(const LAS u32x4*)(stg + row * 64 + ch * 8);
            *(u32x4*)(Ob + (brow + pos0 + 16 * row) * KVW + 64 * j + ch * 8) = v; }
        asm volatile("s_waitcnt lgkmcnt(0)" ::: "memory");
    }
}
}

#define XB_TMO      128
#define XB_XCNT(j)  (256  + 64 * (j))
#define XB_XSUB(j)  (1280 + 64 * (j))
#define XB_XGEN(j)  (2304 + 64 * (j))
#define XB_TOP      3328
#define XB_TOPGEN   3392
#define XCD_BAR_WORDS 3456
#define XB_SPIN_CAP (1u << 18)
__device__ __forceinline__ unsigned xb_ld(unsigned* p)              { return __hip_atomic_load(p, __ATOMIC_RELAXED, __HIP_MEMORY_SCOPE_AGENT); }
__device__ __forceinline__ unsigned xb_add(unsigned* p, unsigned v) { return __hip_atomic_fetch_add(p, v, __ATOMIC_RELAXED, __HIP_MEMORY_SCOPE_AGENT); }
__device__ __forceinline__ unsigned xb_xcc_id() { return (unsigned)__builtin_amdgcn_s_getreg((3 << 11) | 20) & 0xFu; }
#define XB_SPIN(cond, bar) do { unsigned _sp = 0; while (cond) { __builtin_amdgcn_s_sleep(1); \
    if ((++_sp & 255u) == 0u) { if (xb_ld(&(bar)[XB_TMO])) break; if (_sp > XB_SPIN_CAP) { atomicAdd(&(bar)[XB_TMO], 1u); break; } } } } while (0)
struct XcdBarrier { unsigned* bar; unsigned x; volatile LAS unsigned* st; };
__device__ __forceinline__ XcdBarrier xcd_barrier_post(unsigned* bar, volatile LAS unsigned* st) {
    XcdBarrier b; b.bar = bar; b.x = xb_xcc_id(); b.st = st;
    if (threadIdx.x == 0) (void)xb_add(&bar[XB_XCNT(b.x)], 1u);
    return b;
}
__device__ __forceinline__ void xcd_barrier_complete(unsigned* bar, unsigned x, unsigned& nloc, unsigned& nx) {
    const unsigned G = gridDim.x * gridDim.y * gridDim.z;
    unsigned sum, cnt, mine, sp = 0u;
    for (;;) {
        sum = 0u; cnt = 0u; mine = 0u;
#pragma unroll
        for (unsigned j = 0; j < 16; ++j) { const unsigned c = xb_ld(&bar[XB_XCNT(j)]); sum += c; cnt += (c > 0u) ? 1u : 0u; mine = (j == x) ? c : mine; }
        if (sum == G) break;
        __builtin_amdgcn_s_sleep(1);
        if ((++sp & 255u) == 0u) { if (xb_ld(&bar[XB_TMO])) break; if (sp > XB_SPIN_CAP) { atomicAdd(&bar[XB_TMO], 1u); break; } }
    }
    nloc = mine > 0u ? mine : 1u; nx = cnt > 0u ? cnt : 1u;
}
__device__ __forceinline__ void xcd_barrier(const XcdBarrier& b) {
    asm volatile("s_waitcnt vmcnt(0)" ::: "memory");
    __syncthreads();
    if (threadIdx.x == 0) {
        unsigned* bar = b.bar;
        __builtin_amdgcn_s_waitcnt(0);
        unsigned nloc = b.st[0], nx = b.st[1];
        if (nloc == 0u) { xcd_barrier_complete(bar, b.x, nloc, nx); b.st[0] = nloc; b.st[1] = nx; }
        const unsigned old = xb_add(&bar[XB_XSUB(b.x)], 1u);
        const unsigned gen = old / nloc;
        if (old + 1u == (gen + 1u) * nloc) {
            __builtin_amdgcn_fence(__ATOMIC_RELEASE, "agent");
            asm volatile("s_waitcnt vmcnt(0)" ::: "memory");
            const unsigned og = xb_add(&bar[XB_TOP], 1u);
            const unsigned tg = og / nx;
            if (og + 1u == (tg + 1u) * nx) xb_add(&bar[XB_TOPGEN], 1u);
            else XB_SPIN(xb_ld(&bar[XB_TOPGEN]) == tg, bar);
            __builtin_amdgcn_fence(__ATOMIC_ACQUIRE, "agent");
            xb_add(&bar[XB_XGEN(b.x)], 1u);
            asm volatile("s_waitcnt vmcnt(0)" ::: "memory");
        } else {
            XB_SPIN(xb_ld(&bar[XB_XGEN(b.x)]) == gen, bar);
            __builtin_amdgcn_fence(__ATOMIC_ACQUIRE, "agent");
            asm volatile("s_waitcnt vmcnt(0)" ::: "memory");
        }
    }
    __syncthreads();
}

__device__ __forceinline__ const float* inptr(int k) {
    asm volatile("" : "+s"(k));
    return ((const float* const __attribute__((address_space(4)))*)__builtin_amdgcn_kernarg_segment_ptr())[k];
}
#define INP(k) inptr(k)
__device__ __forceinline__ int otid() { int t = threadIdx.x; asm volatile("" : "+v"(t)); return t; }
struct Frame {
    LAS unsigned char* lds;
    volatile LAS unsigned* MISC;
    gu32* ctl;
    int wave;
    int vcu, G;
    float* out;
    unsigned char* ws;
};
__device__ __forceinline__ float wave_sum(float v) {
#pragma unroll
    for (int o = 1; o < 64; o <<= 1) v += __shfl_xor(v, o);
    return v;
}

__device__ __forceinline__ void p0_item(const float* W, int ldw, int K, bf16_t* WT, const float* gain, LAS float* scr, int kb, int nb, int lane) {
    const int k0 = 64 * kb, n0 = 32 * nb;
#pragma unroll 8
    for (int i = 0; i < 32; ++i) { const int kk = 2 * i + (lane >> 5); float v = W[(size_t)(k0 + kk) * ldw + n0 + (lane & 31)]; if (gain) v *= gain[k0 + kk]; scr[kk * 33 + (lane & 31)] = v; }
    LDS_WAIT(); asm volatile("" ::: "memory");
    const int c = lane & 7;
#pragma unroll
    for (int j = 0; j < 4; ++j) { const int n = (lane >> 3) + 8 * j; const LAS float* s = scr + (8 * c) * 33 + n;
        u32x4 o; o.x = pk2(s[0 * 33], s[1 * 33]); o.y = pk2(s[2 * 33], s[3 * 33]); o.z = pk2(s[4 * 33], s[5 * 33]); o.w = pk2(s[6 * 33], s[7 * 33]);
        *(GAS u32x4*)(WT + (size_t)(n0 + n) * K + k0 + 8 * c) = o; }
    LDS_WAIT(); asm volatile("" ::: "memory");
}
__device__ __forceinline__ void p0_prologue(Frame& F) {
    const int tid_ = otid(), lane_ = tid_ & 63;
    LAS float* scr = (LAS float*)(F.lds + F.wave * 16384);
    const int gw = F.vcu * 8 + F.wave, NGW = F.G * 8;
    unsigned char* ws = F.ws;
    constexpr int I0 = 16 * 96, I1 = 16 * 32, I2 = 16 * 96, I3 = 16 * 48, I4 = 8 * 32, I5 = 32 * 256, I6 = 32 * 256, I7 = 32 * 256;
    constexpr int NITEMS = I0 + I1 + I2 + I3 + I4 + I5 + I6 + I7;
    for (int it = gw; it < NITEMS; it += NGW) {
        int r = it;
        if (r < I0) { p0_item(INP(2), 3088, 1024, (bf16_t*)(ws + WS_WQKVA), INP(1), scr, r / 96, r % 96, lane_); continue; } r -= I0;
        if (r < I1) { p0_item(INP(6), 1024, 1024, (bf16_t*)(ws + WS_WOA), nullptr, scr, r / 32, r % 32, lane_); continue; } r -= I1;
        if (r < I2) { p0_item(INP(8), 3072, 1024, (bf16_t*)(ws + WS_WKVQ), INP(7), scr, r / 96, r % 96, lane_); continue; } r -= I2;
        if (r < I3) { p0_item(INP(12), 1536, 1024, (bf16_t*)(ws + WS_WKVQ) + (size_t)3072 * 1024, INP(11), scr, r / 48, r % 48, lane_); continue; } r -= I3;
        if (r < I4) { p0_item(INP(14), 1024, 512, (bf16_t*)(ws + WS_WOB), nullptr, scr, r / 32, r % 32, lane_); continue; } r -= I4;
        if (r < I5) { const int le = r / 256, q = r % 256;
            p0_item(INP(20) + (size_t)le * 1024 * 512, 512, 1024, (bf16_t*)(ws + WS_WGU) + (size_t)le * 1024 * 1024, INP(15) + (le >> 4) * 1024, scr, q / 16, q % 16, lane_); continue; } r -= I5;
        if (r < I6) { const int le = r / 256, q = r % 256;
            p0_item(INP(21) + (size_t)le * 1024 * 512, 512, 1024, (bf16_t*)(ws + WS_WGU) + (size_t)le * 1024 * 1024 + (size_t)512 * 1024, INP(15) + (le >> 4) * 1024, scr, q / 16, q % 16, lane_); continue; } r -= I6;
        { const int le = r / 256, q = r % 256;
            p0_item(INP(22) + (size_t)le * 512 * 1024, 1024, 512, (bf16_t*)(ws + WS_WD) + (size_t)le * 1024 * 512, nullptr, scr, q / 32, q % 32, lane_); }
    }
    const int gt = gw * 64 + lane_, NGT = NGW * 64;
    { const float* an = INP(1); const float* awin = INP(2);
    for (int e = gt; e < 16 * 1024; e += NGT) { const int n = e >> 10, k = e & 1023; ((bf16_t*)(ws + WS_WF))[e] = (bf16_t)f2bf(an[k] * awin[(size_t)k * 3088 + 3072 + n]); } }
    const float* fn_ = INP(15); const float* wexp_ = INP(18); const float* wgrp_ = INP(16);
    for (int e = gt; e < 2 * 32 * 1024; e += NGT) { const int l = e >> 15, n = (e >> 10) & 31, k = e & 1023;
        float v = 0.f;
        if (n < 16) v = fn_[l * 1024 + k] * wexp_[((size_t)l * 1024 + k) * 16 + n];
        else if (n < 20) v = fn_[l * 1024 + k] * wgrp_[((size_t)l * 1024 + k) * 4 + (n - 16)];
        const unsigned hb = f2bf(v); const float lo = v - bf2f(hb);
        bf16_t* wr = (bf16_t*)(ws + WS_WR) + (size_t)l * 2 * 32 * 1024;
        wr[n * 1024 + k] = (bf16_t)hb; wr[32 * 1024 + n * 1024 + k] = (bf16_t)f2bf(lo); }
    if (gt < 6 * 64) { const int sgi = gt >> 6, d = gt & 63; float v = 1.0f;
        if (sgi == 0) v = INP(4)[d] * C2; else if (sgi == 1) v = INP(5)[d]; else if (sgi == 3) v = INP(9)[d]; else if (sgi == 5) v = INP(13)[d] * C2;
        ((float*)(ws + WS_GTAB))[gt] = v; }
    const float* x_ = INP(0);
    for (int m = gw; m < NTOK; m += NGW) {
        const GAS f32x4* xr = (const GAS f32x4*)(x_ + (size_t)m * DM) + lane_;
        f32x4 v[4]; float s = 0.f;
#pragma unroll
        for (int jj = 0; jj < 4; ++jj) { v[jj] = xr[64 * jj]; s += (v[jj].x * v[jj].x + v[jj].y * v[jj].y) + (v[jj].z * v[jj].z + v[jj].w * v[jj].w); }
        const float rstd = 1.f / sqrtf(wave_sum(s) * (1.f / DM) + EPS);
        GAS unsigned long long* o8 = (GAS unsigned long long*)((bf16_t*)(ws + WS_XB) + (size_t)m * DM) + lane_;
#pragma unroll
        for (int jj = 0; jj < 4; ++jj) o8[64 * jj] = (unsigned long long)pk2(v[jj].x, v[jj].y) | ((unsigned long long)pk2(v[jj].z, v[jj].w) << 32);
        if (lane_ == 0) ((float*)(ws + WS_RSTD0))[m] = rstd;
    }
}

__device__ __forceinline__ void forget_phase(Frame& F) {
    const int tid_ = otid(), lane_ = tid_ & 63;
    const bf16_t* XB = (const bf16_t*)(F.ws + WS_XB); const bf16_t* WF = (const bf16_t*)(F.ws + WS_WF);
    const float* RSTD0 = (const float*)(F.ws + WS_RSTD0); const float* b_f = INP(3);
    float* LC = (float*)(F.ws + WS_LC); float* CT = (float*)(F.ws + WS_CT);
    LAS float* wt = (LAS float*)(F.lds + AUX_OFF);
    const int fr = lane_ & 15, fq = lane_ >> 4;
    for (int chunk = blockIdx.x; chunk < NTOK / 128; chunk += F.G) {
        const int row = chunk * 128 + F.wave * 16 + fr;
        const bf16_t* xa = XB + (size_t)row * DM + 8 * fq; const bf16_t* wb = WF + (size_t)fr * DM + 8 * fq;
        f32x4 acc = {0.f, 0.f, 0.f, 0.f};
#pragma unroll 8
        for (int kb = 0; kb < 32; ++kb) { const bf16x8 a = *(const bf16x8*)(xa + 32 * kb), w = *(const bf16x8*)(wb + 32 * kb); acc = __builtin_amdgcn_mfma_f32_16x16x32_bf16(w, a, acc, 0, 0, 0); }
        const float rs = RSTD0[row];
        float lf[4];
#pragma unroll
        for (int i = 0; i < 4; ++i) { const float z = acc[i] * rs + b_f[4 * fq + i]; lf[i] = fminf(z, 0.f) - log1pf(expf(-fabsf(z))); }
#pragma unroll
        for (int off = 1; off < 16; off <<= 1)
#pragma unroll
            for (int i = 0; i < 4; ++i) { const float t = __shfl_up(lf[i], off, 16); if (fr >= off) lf[i] += t; }
        if (fr == 15) {
#pragma unroll
            for (int i = 0; i < 4; ++i) wt[F.wave * 16 + 4 * fq + i] = lf[i]; }
        __syncthreads();
#pragma unroll
        for (int i = 0; i < 4; ++i) { float p = 0.f; for (int w = 0; w < F.wave; ++w) p += wt[w * 16 + 4 * fq + i]; lf[i] += p; }
        const int b = row >> 13, s = row & (SEQ - 1);
#pragma unroll
        for (int i = 0; i < 4; ++i) LC[(size_t)(b * 16 + 4 * fq + i) * SEQ + s] = lf[i];
        if (F.wave == 7 && fr == 15) {
#pragma unroll
            for (int i = 0; i < 4; ++i) CT[(b * 16 + 4 * fq + i) * 64 + ((chunk * 128) & (SEQ - 1)) / 128] = lf[i]; }
        __syncthreads();
    }
}

__device__ __forceinline__ void attnA_phase(Frame& F, unsigned char* ldsg) {
    const int tid_ = otid(), lane_ = tid_ & 63;
    LAS float* NCK = (LAS float*)(F.lds + attn_body::LDS_NCK);
    LAS float* CPs = (LAS float*)(F.lds + AUX_OFF);
    volatile LAS int* ctl = (volatile LAS int*)(F.lds + AUX_OFF + 256);
    const float* LC = (const float*)(F.ws + WS_LC); const float* CT = (const float*)(F.ws + WS_CT);
    float mq = 0.f, mk = 0.f;
    { const float* gq_ = INP(4); const float* gk_ = INP(5);
      for (int d = 0; d < 64; ++d) { mq = fmaxf(mq, fabsf(gq_[d])); mk = fmaxf(mk, fabsf(gk_[d])); } }
    const float thr2 = (110.f + 2.f * 8.f * mq * mk * 1.03f) * LOG2E;
    unsigned* queue = (unsigned*)(F.ctl + CW_QUEUE);
    for (;;) {
        if (tid_ == 0) ctl[0] = (int)__hip_atomic_fetch_add(queue, 1u, RLX_AGENT);
        __syncthreads();
        const int u = ctl[0];
        if (u >= NBATCH * 16 * 32) break;
        const int qb = 31 - (u >> 6), bh = u & 63, b = bh >> 4, h = bh & 15, q0 = qb * 256, NTf = 4 * qb + 4, nkeys = q0 + 256;
        if (F.wave == 0) { const float c = CT[bh * 64 + lane_]; float v = c;
#pragma unroll
            for (int off = 1; off < 64; off <<= 1) { const float t = __shfl_up(v, off, 64); if (lane_ >= off) v += t; }
            CPs[lane_] = v - c; }
        if (tid_ == 0) ctl[1] = NTf - 4;
        __syncthreads();
        const float* lcp = LC + (size_t)bh * SEQ;
        const float cpq = CPs[q0 >> 7], lcq = lcp[q0];
        for (int s = tid_; s < nkeys; s += 512) NCK[s] = ((cpq - CPs[s >> 7]) + (lcq - lcp[s])) * LOG2E;
        __syncthreads();
        if (tid_ < NTf - 4) { if (NCK[64 * tid_ + 63] >= -thr2) __hip_atomic_fetch_min((LAS int*)&ctl[1], tid_, __ATOMIC_RELAXED, __HIP_MEMORY_SCOPE_WORKGROUP); }
        __syncthreads();
        const int T0 = ctl[1] & ~1;
        attn_body::attn_unit<8>(b, h, qb, T0, (const attn_body::bf16*)(F.ws + WS_QA), (const attn_body::bf16*)(F.ws + WS_KA), (const attn_body::bf16*)(F.ws + WS_VA), (attn_body::bf16*)(F.ws + WS_QA), (char*)ldsg);
    }
}

__device__ __forceinline__ void router_phase(Frame& F, int layer, const float* stats, float* rstd_out) {
    const int tid_ = otid(), lane_ = tid_ & 63;
    const float* H = F.out; const bf16_t* WR = (const bf16_t*)(F.ws + WS_WR) + (size_t)layer * 2 * 32 * 1024;
    const float* b_group = INP(17) + layer * 4; const float* b_expert = INP(19) + layer * 16;
    float* GATES = (float*)(F.ws + WS_GATES); int* PERM = (int*)(F.ws + WS_PERM);
    unsigned* CNT = (unsigned*)(F.ctl + (layer == 0 ? CW_CNT0 : CW_CNT1));
    volatile LAS int* lcnt = (volatile LAS int*)(F.lds + AUX_OFF);
    const int fr = lane_ & 15, fq = lane_ >> 4;
    for (int chunk = blockIdx.x; chunk < NTOK / 128; chunk += F.G) {
        if (tid_ < 64) lcnt[tid_] = 0;
        __syncthreads();
        const int row = chunk * 128 + F.wave * 16 + fr;
        const float* hp = H + (size_t)row * DM + 8 * fq;
        const bf16_t* w0 = WR + (size_t)fr * 1024 + 8 * fq; const bf16_t* w1 = WR + (size_t)(16 + fr) * 1024 + 8 * fq;
        f32x4 a0 = {0.f, 0.f, 0.f, 0.f}, a1 = {0.f, 0.f, 0.f, 0.f};
#pragma unroll 4
        for (int kb = 0; kb < 32; ++kb) {
            const f32x4 x0 = *(const f32x4*)(hp + 32 * kb), x1 = *(const f32x4*)(hp + 32 * kb + 4);
            float xs[8] = {x0[0], x0[1], x0[2], x0[3], x1[0], x1[1], x1[2], x1[3]};
            bf16x8 xh, xl;
#pragma unroll
            for (int e = 0; e < 8; ++e) { const unsigned hb = f2bf(xs[e]); xh[e] = (short)hb; xl[e] = (short)f2bf(xs[e] - bf2f(hb)); }
            const bf16x8 wh0 = *(const bf16x8*)(w0 + 32 * kb), wl0 = *(const bf16x8*)(w0 + 32 * 1024 + 32 * kb);
            const bf16x8 wh1 = *(const bf16x8*)(w1 + 32 * kb), wl1 = *(const bf16x8*)(w1 + 32 * 1024 + 32 * kb);
            a0 = __builtin_amdgcn_mfma_f32_16x16x32_bf16(wh0, xh, a0, 0, 0, 0); a0 = __builtin_amdgcn_mfma_f32_16x16x32_bf16(wh0, xl, a0, 0, 0, 0); a0 = __builtin_amdgcn_mfma_f32_16x16x32_bf16(wl0, xh, a0, 0, 0, 0);
            a1 = __builtin_amdgcn_mfma_f32_16x16x32_bf16(wh1, xh, a1, 0, 0, 0); a1 = __builtin_amdgcn_mfma_f32_16x16x32_bf16(wh1, xl, a1, 0, 0, 0); a1 = __builtin_amdgcn_mfma_f32_16x16x32_bf16(wl1, xh, a1, 0, 0, 0);
        }
        float ss; { const f32x4 p = *(const f32x4*)(stats + (size_t)row * 16 + 4 * fq); ss = (p[0] + p[1]) + (p[2] + p[3]); ss += __shfl_xor(ss, 16); ss += __shfl_xor(ss, 32); }
        const float rs = 1.0f / sqrtf(ss * (1.0f / 1024.0f) + EPS);
        if (fq == 0) rstd_out[row] = rs;
        float gl[4]; int gidx = 0; float gval = 0.f;
        {
#pragma unroll
            for (int i = 0; i < 4; ++i) gl[i] = a1[i] * rs + b_group[i];
            const float mx = fmaxf(fmaxf(gl[0], gl[1]), fmaxf(gl[2], gl[3]));
            float ex[4], sum = 0.f;
#pragma unroll
            for (int i = 0; i < 4; ++i) { ex[i] = expf(gl[i] - mx); sum += ex[i]; }
            float best = -1.f;
#pragma unroll
            for (int i = 0; i < 4; ++i) { const float p = ex[i] / sum; if (p > best) { best = p; gidx = i; } }
            gval = best;
        }
        gidx = __shfl(gidx, fr); gval = __shfl(gval, fr);
        int cls = -1, rank = 0;
        if (fq == gidx) {
            float el[4];
#pragma unroll
            for (int i = 0; i < 4; ++i) el[i] = a0[i] * rs + b_expert[4 * fq + i];
            const float mx = fmaxf(fmaxf(el[0], el[1]), fmaxf(el[2], el[3]));
            float pr[4], sum = 0.f;
#pragma unroll
            for (int i = 0; i < 4; ++i) { pr[i] = expf(el[i] - mx); sum += pr[i]; }
#pragma unroll
            for (int i = 0; i < 4; ++i) pr[i] = pr[i] / sum;
            int i1 = 0; float p1 = -1.f;
#pragma unroll
            for (int i = 0; i < 4; ++i) if (pr[i] > p1) { p1 = pr[i]; i1 = i; }
            int i2 = 0; float p2 = -1.f;
#pragma unroll
            for (int i = 0; i < 4; ++i) if (i != i1 && pr[i] > p2) { p2 = pr[i]; i2 = i; }
            const float den = p1 + p2; const float w1g = gval * (p1 / den), w2g = gval * (p2 / den);
            const int lo = i1 < i2 ? i1 : i2, hi = i1 < i2 ? i2 : i1;
            const float wlo = i1 < i2 ? w1g : w2g, whi = i1 < i2 ? w2g : w1g;
            const int pidx = (lo == 0) ? hi - 1 : (lo == 1) ? hi + 1 : 5;
            cls = 6 * gidx + pidx;
            GATES[2 * row] = wlo; GATES[2 * row + 1] = whi;
            rank = __hip_atomic_fetch_add((LAS int*)&lcnt[cls], 1, __ATOMIC_RELAXED, __HIP_MEMORY_SCOPE_WORKGROUP);
        }
        __syncthreads();
        if (tid_ < NCLASS) lcnt[32 + tid_] = (int)__hip_atomic_fetch_add(CNT + tid_, (unsigned)lcnt[tid_], RLX_AGENT);
        __syncthreads();
        if (cls >= 0) PERM[(size_t)cls * CAP + lcnt[32 + cls] + rank] = row;
        __syncthreads();
    }
}
__device__ __forceinline__ void moe_tile_prefix(Frame& F, const int* cnt, volatile LAS int* TP) {
    const int tid_ = otid(), lane_ = tid_ & 63;
    __syncthreads();
    if (tid_ == 0) { int acc = 0; for (int c = 0; c < NCLASS; ++c) { TP[c] = acc; acc += (cnt[c] + 255) >> 8; } TP[NCLASS] = acc; }
    __syncthreads();
}

__device__ __forceinline__ void dilated_phase(Frame& F) {
    const int tid_ = otid(), lane_ = tid_ & 63;
    LAS float* tb = (LAS float*)(F.lds + AUX_OFF);
    LAS float* wsf = (LAS float*)(F.lds + AUX_OFF + dil::WSCR_OFF) + F.wave * 64;
    const bf16_t* Qb = (const bf16_t*)(F.ws + WS_QB); const bf16_t* Kb = (const bf16_t*)(F.ws + WS_KB); const bf16_t* Vb = (const bf16_t*)(F.ws + WS_VB);
    bf16_t* Ob = (bf16_t*)(F.ws + WS_QB);
    int jprev = -1;
    for (int U = blockIdx.x; U < NBATCH * 8 * 16; U += F.G) {
        const int chunk = U & 15, j = (U >> 4) & 7, b = U >> 7;
        if (j != jprev) { __syncthreads(); dil::build_tables(tb, INP(10), j, tid_); __syncthreads(); jprev = j; }
#pragma unroll 1
        for (int half = 0; half < 2; ++half)
            dil::wave_unit<8>(b, j, chunk * 512, 8 * half + F.wave, Qb, Kb, Vb, Ob, F.lds, F.wave * 16384, tb, wsf, lane_);
    }
}

struct Args { const float* in[23]; float* out; unsigned char* ws; };
__global__ void __launch_bounds__(512, 2) fwd_kernel(Args args) {
    extern __shared__ __attribute__((aligned(16))) unsigned char lds[];
    Frame F;
    F.lds = (LAS unsigned char*)lds;
    F.MISC = (volatile LAS unsigned*)(F.lds + MISC_OFF);
    F.wave = __builtin_amdgcn_readfirstlane((int)threadIdx.x >> 6);
    F.G = gridDim.x; { const int bx = blockIdx.x; F.vcu = (F.G % 8 == 0) ? (bx % 8) * (F.G / 8) + bx / 8 : bx; }
    F.out = args.out; F.ws = args.ws;
    unsigned char* ws = args.ws;
    F.ctl = (gu32*)(ws + WS_CTL);
    for (int u = threadIdx.x; u < 128; u += 512) ((LAS unsigned*)(F.lds + MISC_OFF))[u] = 0u;
    __syncthreads();
    XcdBarrier bar = xcd_barrier_post((unsigned*)(F.ctl + CW_BAR), F.MISC + 8);
#define GRID_BAR() xcd_barrier(bar)
#ifndef RUN_FROM
#define RUN_FROM 0
#endif
#define RUN(k) ((k) <= RUN_UPTO && (k) >= RUN_FROM)

    bf16_t* XB = (bf16_t*)(ws + WS_XB);
    float* H = F.out;
    volatile LAS int* TP = (volatile LAS int*)(F.lds + AUX_OFF + 1024);

    if (RUN(0)) { p0_prologue(F); GRID_BAR(); }

    if (RUN(1)) {
        pg8::GemmP g{XB, 1024, 1024, 1024, 1 << 20, 32, 2};
        pg8::DenseSched S; S.so.init(NTOK, 3072, F.G, (int)blockIdx.x); S.Bt = (const bf16_t*)(ws + WS_WQKVA); S.lda = 1024; S.ldb = 1024;
        pg8::EpiHead E{(bf16_t*)(ws + WS_QA), (size_t)(WS_KA - WS_QA) / 2, (const float*)(ws + WS_GTAB), 2, 4, 8, 1024, (const float*)(ws + WS_RSTD0), nullptr};
        pg8::gemm_phase<pg8::EpiHead, pg8::DenseSched>(F.lds, g, S, E);
        forget_phase(F);
        GRID_BAR();
    }
    if (RUN(2)) { attnA_phase(F, lds); GRID_BAR(); }
    if (RUN(3)) {
        pg8::GemmP g{(const bf16_t*)(ws + WS_QA), 1024, 1024, 1024, 1 << 20, 128, 0};
        pg8::DenseSched S; S.so.init(NTOK, 1024, F.G, (int)blockIdx.x); S.Bt = (const bf16_t*)(ws + WS_WOA); S.lda = 1024; S.ldb = 1024;
        pg8::EpiResid E{INP(0), H, XB, (float*)(ws + WS_STATS1)};
        pg8::gemm_phase<pg8::EpiResid, pg8::DenseSched>(F.lds, g, S, E);
        GRID_BAR();
    }
#define MOE_LAYER(PH, layer, STATS_IN, RSTD_BUF, CW_CNT, XB_OUT, STATS_OUT) \
    if (RUN(PH)) { router_phase(F, layer, (const float*)(ws + STATS_IN), (float*)(ws + RSTD_BUF)); GRID_BAR(); } \
    if (RUN(PH + 1)) { \
        const int* cnt = (const int*)(F.ctl + CW_CNT); moe_tile_prefix(F, cnt, TP); \
        pg8::GemmP g{XB, 1024, 1024, 1024, 1 << 20, 512, 1}; \
        pg8::Moe1Sched S{TP, cnt, (const int*)(ws + WS_PERM), (const bf16_t*)(ws + WS_WGU) + (size_t)layer * 16 * 1024 * 1024, F.G, (int)blockIdx.x}; \
        pg8::EpiSwiglu E{(bf16_t*)(ws + WS_HID), (const int*)(ws + WS_PERM), (const float*)(ws + RSTD_BUF), (const float*)(ws + WS_GATES)}; \
        pg8::gemm_phase<pg8::EpiSwiglu, pg8::Moe1Sched>(F.lds, g, S, E); \
        GRID_BAR(); } \
    if (RUN(PH + 2)) { \
        const int* cnt = (const int*)(F.ctl + CW_CNT); moe_tile_prefix(F, cnt, TP); \
        pg8::GemmP g{(const bf16_t*)(ws + WS_HID), 1024, 512, 1024, 8, 128, 0}; \
        pg8::Moe2Sched S{TP, cnt, (const bf16_t*)(ws + WS_WD) + (size_t)layer * 16 * 1024 * 512, F.G, (int)blockIdx.x}; \
        pg8::EpiScatter E{H, H, XB_OUT, STATS_OUT, (const int*)(ws + WS_PERM)}; \
        pg8::gemm_phase<pg8::EpiScatter, pg8::Moe2Sched>(F.lds, g, S, E); \
        GRID_BAR(); }
    MOE_LAYER(4, 0, WS_STATS1, WS_RSTD1, CW_CNT0, XB, (float*)(ws + WS_STATS2))
    if (RUN(7)) {
        pg8::GemmP g{XB, 1024, 1024, 1024, 1 << 20, 32, 2};
        pg8::DenseSched S; S.so.init(NTOK, 4608, F.G, (int)blockIdx.x); S.Bt = (const bf16_t*)(ws + WS_WKVQ); S.lda = 1024; S.ldb = 1024;
        pg8::EpiHead E{(bf16_t*)(ws + WS_KB), (size_t)(WS_VB - WS_KB) / 2, (const float*)(ws + WS_GTAB) + 3 * 64, 1, 6, 12, KVW, nullptr, (const float*)(ws + WS_STATS2)};
        pg8::gemm_phase<pg8::EpiHead, pg8::DenseSched>(F.lds, g, S, E);
        GRID_BAR();
    }
    if (RUN(8)) { dilated_phase(F); GRID_BAR(); }
    if (RUN(9)) {
        pg8::GemmP g{(const bf16_t*)(ws + WS_QB), KVW, 512, 512, 1 << 20, 128, 0};
        pg8::DenseSched S; S.so.init(NTOK, 1024, F.G, (int)blockIdx.x); S.Bt = (const bf16_t*)(ws + WS_WOB); S.lda = KVW; S.ldb = 512;
        pg8::EpiResid E{H, H, XB, (float*)(ws + WS_STATS3)};
        pg8::gemm_phase<pg8::EpiResid, pg8::DenseSched>(F.lds, g, S, E);
        GRID_BAR();
    }
    MOE_LAYER(10, 1, WS_STATS3, WS_RSTD3, CW_CNT1, (bf16_t*)nullptr, (float*)nullptr)

#if RUN_UPTO < 3
    { const int gt = (blockIdx.x * 512 + otid()); const f32x4* xs = (const f32x4*)INP(0); f32x4* od = (f32x4*)F.out;
      for (size_t e = gt; e < (size_t)NTOK * DM / 4; e += (size_t)F.G * 512) od[e] = xs[e]; }
#endif
    if (__hip_atomic_load((unsigned*)(F.ctl + CW_BAR) + XB_TMO, RLX_AGENT) != 0u) {
        const int gt = (blockIdx.x * 512 + otid()); const float q = __builtin_nanf("");
        for (size_t e = gt; e < (size_t)NTOK * DM; e += (size_t)F.G * 512) F.out[e] = q;
    }
}

extern "C" void kernel_launch(void* const* d_in, const int* in_sizes, int n_in, void* d_out, int out_size, void* d_ws, size_t ws_size, hipStream_t stream) {
    static int grid = 0;
    if (grid == 0) {
        if (n_in != 23 || in_sizes[0] != NTOK * DM || out_size != NTOK * DM || ws_size < WS_END) { fprintf(stderr, "kernel_launch: unexpected shapes (n_in %d, in0 %d, out %d, ws %zu)\n", n_in, n_in > 0 ? in_sizes[0] : -1, out_size, ws_size); grid = -1; return; }
        int dev = 0, cus = 0, per_cu = 0;
        if (hipGetDevice(&dev) != hipSuccess || hipDeviceGetAttribute(&cus, hipDeviceAttributeMultiprocessorCount, dev) != hipSuccess) { grid = -1; return; }
        if (hipFuncSetAttribute((const void*)fwd_kernel, hipFuncAttributeMaxDynamicSharedMemorySize, LDS_BYTES) != hipSuccess) { fprintf(stderr, "kernel_launch: hipFuncSetAttribute failed\n"); grid = -1; return; }
        if (hipOccupancyMaxActiveBlocksPerMultiprocessor(&per_cu, (const void*)fwd_kernel, 512, LDS_BYTES) != hipSuccess || per_cu < 1) fprintf(stderr, "kernel_launch: occupancy query reports %d\n", per_cu);
        (void)hipGetLastError();
        grid = cus;
    }
    if (grid < 0) return;
    if (hipMemsetAsync((char*)d_ws + WS_CTL, 0, CTL_ZERO_BYTES, stream) != hipSuccess) return;
    Args a{};
    for (int i = 0; i < 23; ++i) a.in[i] = (const float*)d_in[i];
    a.out = (float*)d_out; a.ws = (unsigned char*)d_ws;
    hipLaunchKernelGGL(fwd_kernel, dim3(grid), dim3(512), LDS_BYTES, stream, a);
}
```

```cpp
#include <hip/hip_runtime.h>
#include <hip/hip_bf16.h>
#include <cstdio>
#include <cstdint>
#include <cmath>

#ifndef RUN_UPTO
#define RUN_UPTO 99
#endif

#define GAS __attribute__((address_space(1)))
#define LAS __attribute__((address_space(3)))
typedef unsigned short bf16_t;
typedef short bf16x8 __attribute__((ext_vector_type(8)));
typedef float f32x2 __attribute__((ext_vector_type(2)));
typedef float f32x4 __attribute__((ext_vector_type(4)));
typedef float f32x16 __attribute__((ext_vector_type(16)));
typedef unsigned u32x2 __attribute__((ext_vector_type(2)));
typedef unsigned u32x4 __attribute__((ext_vector_type(4)));
typedef short s16x4 __attribute__((ext_vector_type(4)));
typedef int i32x4 __attribute__((ext_vector_type(4)));
typedef int i32x8 __attribute__((ext_vector_type(8)));
typedef GAS unsigned gu32;

constexpr int NTOK = 32768, DM = 1024, SEQ = 8192, NBATCH = 4;
constexpr int KVW = 1536;
constexpr float EPS = 1e-6f;
constexpr float LOG2E = 1.4426950408889634f;
constexpr float C2 = 0.125f * LOG2E;
constexpr int NCLASS = 24, CAP = 32768;

constexpr size_t MiB = 1u << 20;
constexpr size_t WS_CTL = 0, CTL_ZERO_BYTES = 1 * MiB;
constexpr size_t WS_RSTD0 = 2 * MiB, WS_RSTD1 = 2 * MiB + 128 * 1024, WS_RSTD3 = 2 * MiB + 256 * 1024;
constexpr size_t WS_STATS1 = 3 * MiB, WS_STATS2 = 5 * MiB, WS_STATS3 = 7 * MiB;
constexpr size_t WS_GATES = 9 * MiB;
constexpr size_t WS_LC = 10 * MiB;
constexpr size_t WS_CT = 12 * MiB;
constexpr size_t WS_WF = 12 * MiB + 64 * 1024;
constexpr size_t WS_WR = 12 * MiB + 128 * 1024;
constexpr size_t WS_GTAB = 12 * MiB + 32 * 1024;
constexpr size_t WS_PERM = 13 * MiB;
constexpr size_t WS_WQKVA = 16 * MiB, WS_WOA = 22 * MiB, WS_WKVQ = 24 * MiB, WS_WOB = 33 * MiB;
constexpr size_t WS_WGU = 34 * MiB;
constexpr size_t WS_XB8 = 66 * MiB;
constexpr size_t WS_DPML = 114 * MiB;
constexpr size_t WS_WD = 98 * MiB;
constexpr size_t WS_GSORT = 120 * MiB;
constexpr size_t WS_XB = 132 * MiB;
constexpr size_t WS_R = 196 * MiB;
constexpr size_t WS_QA = WS_R, WS_KA = WS_R + 64 * MiB, WS_VA = WS_R + 128 * MiB;
constexpr size_t WS_HID = WS_R;
constexpr size_t WS_XN8 = WS_R + 44 * MiB;
constexpr size_t WS_KB = WS_R, WS_VB = WS_R + 96 * MiB, WS_QB = WS_R + 192 * MiB;
constexpr size_t WS_END = WS_R + 288 * MiB;
constexpr int CW_BAR = 4096, CW_QUEUE = 8192, CW_CNT0 = 9216, CW_CNT1 = 9216 + 64, CW_DONE = 32768;

constexpr int RING_BYTES = 131072;
constexpr int MISC_OFF = RING_BYTES;
constexpr int AUX_OFF = RING_BYTES + 512;
constexpr int LDS_BYTES = 155648;
constexpr int AUX_BYTES = LDS_BYTES - AUX_OFF;

#define LDS_WAIT() asm volatile("s_waitcnt lgkmcnt(0)" ::: "memory")
#define VM_WAIT() asm volatile("s_waitcnt vmcnt(0)" ::: "memory")
#define RLX_AGENT __ATOMIC_RELAXED, __HIP_MEMORY_SCOPE_AGENT

__device__ __forceinline__ int lane_id() { int l; asm volatile("v_mbcnt_lo_u32_b32 %0, -1, 0\n\tv_mbcnt_hi_u32_b32 %0, -1, %0" : "=v"(l)); return l; }
__device__ __forceinline__ float shfl_from(float v, int srclane) { return __int_as_float(__builtin_amdgcn_ds_bpermute(srclane << 2, __float_as_int(v))); }
__device__ __forceinline__ int shfl_from(int v, int srclane) { return __builtin_amdgcn_ds_bpermute(srclane << 2, v); }
__device__ __forceinline__ float shfl_x(float v, int lane, int mask) { return shfl_from(v, lane ^ mask); }
__device__ __forceinline__ unsigned f2bf(float f) { unsigned u = __builtin_bit_cast(unsigned, f); return (u + 0x7fffu + ((u >> 16) & 1u)) >> 16; }
__device__ __forceinline__ float bf2f(unsigned b) { return __builtin_bit_cast(float, b << 16); }
__device__ __forceinline__ unsigned pk2(float lo, float hi) { return f2bf(lo) | (f2bf(hi) << 16); }
__device__ __forceinline__ unsigned pk4_fp8(float a, float b, float c, float d) { int v = 0; v = __builtin_amdgcn_cvt_pk_fp8_f32(a, b, v, false); v = __builtin_amdgcn_cvt_pk_fp8_f32(c, d, v, true); return (unsigned)v; }
constexpr float W8SCALE = 32.0f, H8SCALE = 16.0f;
__device__ __forceinline__ unsigned cvt_pk_bf16(float lo, float hi) { unsigned r; asm volatile("v_cvt_pk_bf16_f32 %0, %1, %2" : "=v"(r) : "v"(lo), "v"(hi)); return r; }

namespace pg8 {
constexpr int BM = 256, BK = 64, HALF = 128, HTB = HALF * BK * 2, STAGE_BYTES = 8 * HTB, NXCD = 8, WGM = 8;
__host__ __device__ __forceinline__ int lds_byte(int r, int c) { const int st = (r >> 4) * 2 + (c >> 5), rr = r & 15, cc = c & 31, ob = rr * 64 + cc * 2; return st * 1024 + (ob ^ (((ob >> 9) & 1) << 5)); }
__host__ __device__ __forceinline__ void stage_rc(int b, int& R, int& C) { const int st = b / 1024, sb = b % 1024, swz = sb ^ (((sb >> 9) & 1) << 5); R = (st >> 1) * 16 + swz / 64; C = (st & 1) * 32 + (swz % 64) / 2; }
__host__ __device__ __forceinline__ int perm32(int rho) { const int n = rho >> 4, i = rho & 15; return 8 * (i >> 2) + 4 * n + (i & 3); }

struct Unit { int rowbase; int pn; int permoff; int nvalid; int e1; int e2; int type; };
struct GemmP { const void* A; int ldbB; int Kbytes; int nsplit; int hstepB; int pk = 0; };

struct StaticOrder {
    int nM, nN, nwg, G, c;
    __device__ void init(int M, int N, int G_, int c_) { nM = M / BM; nN = N / BM; nwg = nM * nN; G = G_; c = c_; }
    __device__ bool next(int i, int& pm, int& pn) const {
        const long L = (long)i * G + c; if (L >= nwg) return false;
        int wgid = (int)L; { const int q = nwg / NXCD, r = nwg % NXCD, xcd = wgid % NXCD, off = wgid / NXCD; wgid = (xcd < r ? xcd * (q + 1) : r * (q + 1) + (xcd - r) * q) + off; }
        const int nig = WGM * nN, gid = wgid / nig, fm = gid * WGM, gsz = (nM - fm) < WGM ? (nM - fm) : WGM;
        pm = fm + ((wgid % nig) % gsz); pn = (wgid % nig) / gsz; return true;
    }
};
struct DenseSched {
    static constexpr bool MIX = false;
    StaticOrder so; const bf16_t* Bt; int lda, ldb;
    __device__ __forceinline__ bool next(int i, Unit& u) const { int pm, pn; if (!so.next(i, pm, pn)) return false; u.rowbase = pm * BM; u.pn = pn; u.permoff = 0; u.nvalid = 256; u.e1 = 0; u.e2 = 0; u.type = 0; return true; }
    __device__ __forceinline__ void aoff(const Unit& u, const int (&R)[2], const int (&C)[2], unsigned (&v)[2][2]) const {
#pragma unroll
        for (int h = 0; h < 2; ++h)
#pragma unroll
            for (int i = 0; i < 2; ++i) v[h][i] = (unsigned)((u.rowbase + 128 * h + R[i]) * lda + C[i]) * 2u; }
    __device__ __forceinline__ const char* blo(const Unit& u) const { return (const char*)Bt + (size_t)u.pn * 256 * ldb * 2; }
    __device__ __forceinline__ const char* bhi(const Unit& u) const { return blo(u); }
};
__device__ __forceinline__ bool moe_unit(int L, int npn, int TT, const volatile LAS int* TP, const int* cnt, Unit& u) {
    if (L >= TT * npn) return false;
    const int tau = L / npn; u.pn = L % npn;
    int c = 0;
#pragma unroll 1
    for (int k = 1; k < NCLASS; ++k) if (TP[k] <= tau) c = k;
    const int rt = tau - TP[c]; const int n = cnt[c] - 256 * rt;
    u.rowbase = tau * 256; u.permoff = c * CAP + rt * 256; u.nvalid = n < 256 ? n : 256;
    const int g = c / 6, p = c % 6; const int a = (p < 3) ? 0 : (p < 5) ? 1 : 2; const int b = (p < 3) ? p + 1 : (p < 5) ? p - 1 : 3;
    u.e1 = 4 * g + a; u.e2 = 4 * g + b;
    u.rowbase = __builtin_amdgcn_readfirstlane(u.rowbase); u.pn = __builtin_amdgcn_readfirstlane(u.pn); u.permoff = __builtin_amdgcn_readfirstlane(u.permoff);
    u.nvalid = __builtin_amdgcn_readfirstlane(u.nvalid); u.e1 = __builtin_amdgcn_readfirstlane(u.e1); u.e2 = __builtin_amdgcn_readfirstlane(u.e2);
    return true;
}
struct Moe1Sched {      static constexpr bool MIX = false;
    const volatile LAS int* TP; const int* cnt; const int* perm; const unsigned char* Wgu; int G, c, TT;
    __device__ __forceinline__ bool next(int i, Unit& u) const { return moe_unit(i * G + c, 8, TT, TP, cnt, u); }
    __device__ __forceinline__ void aoff(const Unit& u, const int (&R)[2], const int (&C)[2], unsigned (&v)[2][2]) const {
#pragma unroll
        for (int h = 0; h < 2; ++h)
#pragma unroll
            for (int i = 0; i < 2; ++i) { const int r = 128 * h + R[i]; const int tok = (r < u.nvalid) ? ((const GAS int*)perm)[u.permoff + r] : 0; v[h][i] = (unsigned)(tok * 1024 + 2 * C[i]); } }
    __device__ __forceinline__ const char* blo(const Unit& u) const { const int e = (u.pn < 4) ? u.e1 : u.e2; return (const char*)Wgu + ((size_t)e * 1024 + 128 * (u.pn & 3)) * 1024; }
    __device__ __forceinline__ const char* bhi(const Unit& u) const { return blo(u); }
};
struct Moe2Sched {      static constexpr bool MIX = false;
    const volatile LAS int* TP; const int* cnt; const unsigned char* Wd; int G, c, TT;
    __device__ __forceinline__ bool next(int i, Unit& u) const { return moe_unit(i * G + c, 4, TT, TP, cnt, u); }
    __device__ __forceinline__ void aoff(const Unit& u, const int (&R)[2], const int (&C)[2], unsigned (&v)[2][2]) const {
#pragma unroll
        for (int h = 0; h < 2; ++h)
#pragma unroll
            for (int i = 0; i < 2; ++i) v[h][i] = (unsigned)((u.rowbase + 128 * h + R[i]) * 1024 + 2 * C[i]); }
    __device__ __forceinline__ const char* blo(const Unit& u) const { return (const char*)Wd + ((size_t)u.e1 * 1024 + 256 * u.pn) * 512; }
    __device__ __forceinline__ const char* bhi(const Unit& u) const { return (const char*)Wd + ((size_t)u.e2 * 1024 + 256 * u.pn) * 512 - 4 * 128; }
};

struct MoeMixSched {
    static constexpr bool MIX = true;
    const volatile LAS int* TP; const int* cnt; const int* perm; const unsigned char* Wgu; const unsigned char* Wd; int G, c, TT; unsigned* done; unsigned* tmo;
    __device__ __forceinline__ bool next(int i, Unit& u) const {
        const int cc = (G == 256) ? ((c & 7) * 32 + (c >> 3)) : c;
        const int L = i * G + cc, n1 = TT * 8;
        if (L < n1) { moe_unit(L, 8, TT, TP, cnt, u); u.type = 0; return true; }
        if (!moe_unit(L - n1, 4, TT, TP, cnt, u)) return false; u.type = 1; return true; }
    __device__ __forceinline__ void aoff(const Unit& u, const int (&R)[2], const int (&C)[2], unsigned (&v)[2][2]) const {
#pragma unroll
        for (int h = 0; h < 2; ++h)
#pragma unroll
            for (int i = 0; i < 2; ++i) { const int r = 128 * h + R[i];
                if (u.type == 0) { const int tok = (r < u.nvalid) ? ((const GAS int*)perm)[u.permoff + r] : 0; v[h][i] = (unsigned)WS_XN8 + (unsigned)(tok * 1024 + 2 * C[i]); }
                else v[h][i] = (unsigned)WS_HID + (unsigned)((u.rowbase + r) * 1024 + 2 * C[i]); } }
    __device__ __forceinline__ const char* blo(const Unit& u) const {
        if (u.type == 0) { const int e = (u.pn < 4) ? u.e1 : u.e2; return (const char*)Wgu + ((size_t)e * 1024 + 128 * (u.pn & 3)) * 1024; }
        return (const char*)Wd + ((size_t)u.e1 * 1024 + 256 * u.pn) * 512; }
    __device__ __forceinline__ const char* bhi(const Unit& u) const {
        if (u.type == 0) return blo(u);
        return (const char*)Wd + ((size_t)u.e2 * 1024 + 256 * u.pn) * 512 - 4 * 128; }
    __device__ __forceinline__ int ldbB(const Unit& u) const { return u.type == 0 ? 1024 : 512; }
    __device__ __forceinline__ int hstepB(const Unit& u) const { return u.type == 0 ? 512 : 128; }
    __device__ __forceinline__ int nsplit(const Unit& u) const { return u.type == 0 ? (1 << 20) : 4; }
    __device__ __forceinline__ void a_ready(const Unit& u) const {
        if (u.type == 1) { unsigned* w = done + 64 * (u.rowbase >> 8); unsigned sp = 0;
            while (__hip_atomic_load(w, __ATOMIC_RELAXED, __HIP_MEMORY_SCOPE_AGENT) < 64u) { __builtin_amdgcn_s_sleep(2); if (++sp > (1u << 20)) { __hip_atomic_store(tmo, 1u, __ATOMIC_RELAXED, __HIP_MEMORY_SCOPE_AGENT); break; } }
              } }
    __device__ __forceinline__ int done_tile(const Unit& u) const { return (u.type == 0) ? (u.rowbase >> 8) : -1; }
    __device__ __forceinline__ void signal(int tile, int lane) const { if (lane == 0) __hip_atomic_fetch_add(done + 64 * tile, 1u, __ATOMIC_RELAXED, __HIP_MEMORY_SCOPE_AGENT); }
};

__device__ __forceinline__ int dil_row(int tok, int D4) { const int s = tok & (SEQ - 1); return (tok & ~(SEQ - 1)) + ((s & ((1 << D4) - 1)) << (13 - D4)) + (s >> D4); }
__device__ __forceinline__ float row_rstd16(const float* stats, int row) {
    const f32x4* p = (const f32x4*)(stats + (size_t)row * 16); const f32x4 a = p[0], b = p[1], c = p[2], d = p[3];
    const float s = ((a[0] + a[1]) + (a[2] + a[3])) + ((b[0] + b[1]) + (b[2] + b[3])) + ((c[0] + c[1]) + (c[2] + c[3])) + ((d[0] + d[1]) + (d[2] + d[3]));
    return 1.0f / sqrtf(s * (1.0f / 1024.0f) + EPS);
}
struct EpiHead {
    static constexpr int BMODE = 2; static constexpr int NPF = 0;
    bf16_t* dbase; size_t dstride; const float* gtab; int plain_seg; int e0, e1;
    int ldc; const float* rstd; const float* stats; float ascale;
    int dil = 0;
    __device__ __forceinline__ void operator()(const f32x4 (&acc)[2][2][4][2], const Unit& u, int wr, int wc, int fr, int fq) const {
        asm volatile("" : "+v"(fr), "+v"(fq));
        const int pn = u.pn; const int seg = (pn < e0) ? 0 : (pn < e1) ? 1 : 2;
        bf16_t* dst = dbase + (size_t)seg * dstride; const float* gain = gtab + 64 * seg; const bool norm = (seg != plain_seg);
        const int pnl = pn - (seg == 0 ? 0 : seg == 1 ? e0 : e1);
        const int col0 = 64 * (4 * pnl + wc) + 8 * fq;
        f32x4 gv[2][2];
#pragma unroll
        for (int bj = 0; bj < 2; ++bj)
#pragma unroll
            for (int n = 0; n < 2; ++n) gv[bj][n] = *(const f32x4*)(gain + 32 * bj + 8 * fq + 4 * n);
        float rsv[2][4];
        if (rstd) {
#pragma unroll
            for (int ai = 0; ai < 2; ++ai)
#pragma unroll
                for (int m = 0; m < 4; ++m) rsv[ai][m] = ((const GAS float*)rstd)[u.rowbase + ai * HALF + wr * 64 + m * 16 + fr] * ascale;
        } else {
            f32x4 pq[2][4];
#pragma unroll
            for (int ai = 0; ai < 2; ++ai)
#pragma unroll
                for (int m = 0; m < 4; ++m) pq[ai][m] = *(const GAS f32x4*)(stats + (size_t)(u.rowbase + ai * HALF + wr * 64 + m * 16 + fr) * 16 + 4 * fq);
#pragma unroll
            for (int ai = 0; ai < 2; ++ai)
#pragma unroll
                for (int m = 0; m < 4; ++m) { float sq = (pq[ai][m][0] + pq[ai][m][1]) + (pq[ai][m][2] + pq[ai][m][3]); sq += shfl_x(sq, 16 * fq + fr, 16); sq += shfl_x(sq, 16 * fq + fr, 32);
                    rsv[ai][m] = ascale / sqrtf(sq * (1.0f / 1024.0f) + EPS); }
        }
#pragma unroll
        for (int ai = 0; ai < 2; ++ai)
#pragma unroll
            for (int m = 0; m < 4; ++m) {
                const int row = u.rowbase + ai * HALF + wr * 64 + m * 16 + fr;
                const float rs = rsv[ai][m];
                float hr = rs;
                if (norm) {
                    float ss = 0.f;
#pragma unroll
                    for (int bj = 0; bj < 2; ++bj)
#pragma unroll
                        for (int n = 0; n < 2; ++n) { const f32x4 x = acc[ai][bj][m][n]; ss += (x[0] * x[0] + x[1] * x[1]) + (x[2] * x[2] + x[3] * x[3]); }
                    ss += shfl_x(ss, 16 * fq + fr, 16); ss += shfl_x(ss, 16 * fq + fr, 32);
                    hr = rs / sqrtf(ss * rs * rs * (1.0f / 64.0f) + EPS);
                }
                bf16_t* rowp = dil ? dst + ((size_t)(4 * pnl + wc) * NTOK + dil_row(row, 2 * ((4 * pnl + wc) >> 3))) * 64 + 8 * fq : dst + (size_t)row * ldc + col0;
#pragma unroll
                for (int bj = 0; bj < 2; ++bj) {
                    const f32x4 v0 = acc[ai][bj][m][0] * hr * gv[bj][0], v1 = acc[ai][bj][m][1] * hr * gv[bj][1];
                    u32x4 w; w.x = cvt_pk_bf16(v0[0], v0[1]); w.y = cvt_pk_bf16(v0[2], v0[3]); w.z = cvt_pk_bf16(v1[0], v1[1]); w.w = cvt_pk_bf16(v1[2], v1[3]);
                    *(u32x4*)(rowp + 32 * bj) = w; }
                if (m & 1) asm volatile("" ::: "memory");
            }
    }
};
__device__ __forceinline__ void unpack8(const u32x4 b, f32x4& lo, f32x4& hi) {
    lo = (f32x4){bf2f(b.x & 0xffffu), bf2f(b.x >> 16), bf2f(b.y & 0xffffu), bf2f(b.y >> 16)}; hi = (f32x4){bf2f(b.z & 0xffffu), bf2f(b.z >> 16), bf2f(b.w & 0xffffu), bf2f(b.w >> 16)}; }
struct EpiResid {
    static constexpr int BMODE = 1; static constexpr int NPF = 0;
    bf16_t* xb; float* stats; float ascale;
    __device__ __forceinline__ void operator()(const f32x4 (&acc)[2][2][4][2], const Unit& u, int wr, int wc, int fr, int fq) const {
        asm volatile("" : "+v"(fr), "+v"(fq));
        const int col0 = u.pn * BM + wc * 32 + 8 * fq;
#pragma unroll
        for (int ai = 0; ai < 2; ++ai) {
        u32x4 bb[2][4][2];
#pragma unroll
            for (int m = 0; m < 4; ++m)
#pragma unroll
                for (int bj = 0; bj < 2; ++bj) bb[ai][m][bj] = *(const GAS u32x4*)(xb + (size_t)(u.rowbase + ai * HALF + wr * 64 + m * 16 + fr) * 1024 + col0 + bj * HALF);
#pragma unroll
            for (int m = 0; m < 4; ++m) {
                const int row = u.rowbase + ai * HALF + wr * 64 + m * 16 + fr; const size_t off = (size_t)row * 1024 + col0; float ss = 0.f;
#pragma unroll
                for (int bj = 0; bj < 2; ++bj) { const size_t o = off + bj * HALF; f32x4 b0, b1; unpack8(bb[ai][m][bj], b0, b1);
                    const f32x4 v0 = b0 + acc[ai][bj][m][0] * ascale, v1 = b1 + acc[ai][bj][m][1] * ascale;
                    ss += ((v0[0] * v0[0] + v0[1] * v0[1]) + (v0[2] * v0[2] + v0[3] * v0[3])) + ((v1[0] * v1[0] + v1[1] * v1[1]) + (v1[2] * v1[2] + v1[3] * v1[3]));
                    u32x4 w; w.x = cvt_pk_bf16(v0[0], v0[1]); w.y = cvt_pk_bf16(v0[2], v0[3]); w.z = cvt_pk_bf16(v1[0], v1[1]); w.w = cvt_pk_bf16(v1[2], v1[3]); *(GAS u32x4*)(xb + o) = w; }
                ss += shfl_x(ss, 16 * fq + fr, 16); ss += shfl_x(ss, 16 * fq + fr, 32);
                if (fq == 0) ((GAS float*)stats)[(size_t)row * 16 + u.pn * 4 + wc] = ss;
            }
        asm volatile("" ::: "memory"); }
    }
};
struct EpiSwiglu {
    static constexpr int BMODE = 1;
    unsigned char* hid; const float* gsort;
    __device__ __forceinline__ void operator()(const f32x4 (&acc)[2][2][4][2], const Unit& u, int wr, int wc, int fr, int fq, int pf0, int pf1) const {
        asm volatile("" : "+v"(fr), "+v"(fq));
        const int col0 = 512 * (u.pn >> 2) + 128 * (u.pn & 3) + 32 * wc + 8 * fq;
#pragma unroll
        for (int ai = 0; ai < 2; ++ai)
#pragma unroll
            for (int m = 0; m < 4; ++m) {
                const int r = ai * HALF + wr * 64 + m * 16 + fr;
                const float gq = __int_as_float(shfl_from(ai == 0 ? pf0 : pf1, m * 16 + fr)); const float gw = (r < u.nvalid) ? gq * H8SCALE : 0.f;
                float h[8];
#pragma unroll
                for (int n = 0; n < 2; ++n)
#pragma unroll
                    for (int i = 0; i < 4; ++i) { const float g = acc[ai][0][m][n][i] * (1.0f / W8SCALE), up = acc[ai][1][m][n][i] * (1.0f / W8SCALE); const float sg = g * __builtin_amdgcn_rcpf(1.0f + __builtin_amdgcn_exp2f(-g * LOG2E)); h[4 * n + i] = __builtin_fminf(__builtin_fmaxf(sg * up * gw, -440.f), 440.f); }
                u32x2 w; w.x = pk4_fp8(h[0], h[1], h[2], h[3]); w.y = pk4_fp8(h[4], h[5], h[6], h[7]);
                { GAS u32x2* hp_ = (GAS u32x2*)(hid + (size_t)(u.rowbase + r) * 1024 + col0); asm volatile("global_store_dwordx2 %0, %1, off sc1" :: "v"(hp_), "v"(w) : "memory"); }
            }
    }
};
template <bool LAST> struct EpiScatter {
    static constexpr int BMODE = 1;
    bf16_t* xb; float* out; float* stats; const int* perm; float ascale;
    __device__ __forceinline__ void operator()(const f32x4 (&acc)[2][2][4][2], const Unit& u, int wr, int wc, int fr, int fq, int pf0, int pf1) const {
        asm volatile("" : "+v"(fr), "+v"(fq));
        const int col0 = u.pn * BM + wc * 32 + 8 * fq;
        int tokv[2][4];
#pragma unroll
        for (int ai = 0; ai < 2; ++ai)
#pragma unroll
            for (int m = 0; m < 4; ++m) { const int r = ai * HALF + wr * 64 + m * 16 + fr; const int tq = shfl_from(ai == 0 ? pf0 : pf1, m * 16 + fr); tokv[ai][m] = (r < u.nvalid) ? tq : -1; }
#pragma unroll
        for (int ai = 0; ai < 2; ++ai) {
        u32x4 bb[2][4][2];
#pragma unroll
            for (int m = 0; m < 4; ++m)
#pragma unroll
                for (int bj = 0; bj < 2; ++bj) bb[ai][m][bj] = *(const GAS u32x4*)(xb + (size_t)(tokv[ai][m] >= 0 ? tokv[ai][m] : 0) * 1024 + col0 + bj * HALF);
#pragma unroll
            for (int m = 0; m < 4; ++m) {
                const bool valid = tokv[ai][m] >= 0; const int tok = valid ? tokv[ai][m] : 0;
                const size_t off = (size_t)tok * 1024 + col0; float ss = 0.f;
#pragma unroll
                for (int bj = 0; bj < 2; ++bj) { const size_t o = off + bj * HALF; f32x4 b0, b1; unpack8(bb[ai][m][bj], b0, b1);
                    const f32x4 v0 = b0 + acc[ai][bj][m][0] * ascale, v1 = b1 + acc[ai][bj][m][1] * ascale;
                    ss += ((v0[0] * v0[0] + v0[1] * v0[1]) + (v0[2] * v0[2] + v0[3] * v0[3])) + ((v1[0] * v1[0] + v1[1] * v1[1]) + (v1[2] * v1[2] + v1[3] * v1[3]));
                    if (valid) {
                        if constexpr (LAST) { *(GAS f32x4*)(out + o) = v0; *(GAS f32x4*)(out + o + 4) = v1; }
                        else { u32x4 w; w.x = cvt_pk_bf16(v0[0], v0[1]); w.y = cvt_pk_bf16(v0[2], v0[3]); w.z = cvt_pk_bf16(v1[0], v1[1]); w.w = cvt_pk_bf16(v1[2], v1[3]); *(GAS u32x4*)(xb + o) = w;
                               u32x2 q8; q8.x = pk4_fp8(v0[0], v0[1], v0[2], v0[3]); q8.y = pk4_fp8(v1[0], v1[1], v1[2], v1[3]); *(GAS u32x2*)((unsigned char*)xb - (WS_XB - WS_XB8) + o) = q8; } } }
                if (!LAST) { ss += shfl_x(ss, 16 * fq + fr, 16); ss += shfl_x(ss, 16 * fq + fr, 32);
                    if (valid && fq == 0) ((GAS float*)stats)[(size_t)tok * 16 + u.pn * 4 + wc] = ss; }
            }
        asm volatile("" ::: "memory"); }
    }
};

template <bool LAST> struct EpiMoe {
    static constexpr int BMODE = 1;
    static constexpr int NPF = 2;
    EpiSwiglu sw; EpiScatter<LAST> sc;
    __device__ __forceinline__ void prefetch(const Unit& u, int wr, int lane, int& pf0, int& pf1) const {
        const int r0 = wr * 64 + lane;
        const GAS int* p0 = (u.type == 0) ? (const GAS int*)sw.gsort + 2 * (size_t)(u.permoff + r0) + (u.pn >> 2) : (const GAS int*)sc.perm + (u.permoff + r0);
        const GAS int* p1 = p0 + ((u.type == 0) ? 2 * HALF : HALF);
        asm volatile("global_load_dword %0, %2, off\n\tglobal_load_dword %1, %3, off" : "=&v"(pf0), "=&v"(pf1) : "v"(p0), "v"(p1) : "memory"); }
    __device__ __forceinline__ void operator()(const f32x4 (&acc)[2][2][4][2], const Unit& u, int wr, int wc, int fr, int fq, int pf0, int pf1) const {
        if (u.type == 0) sw(acc, u, wr, wc, fr, fq, pf0, pf1); else sc(acc, u, wr, wc, fr, fq, pf0, pf1); }
};

template <class Epi, class Sched, bool F8 = false>
__device__ __forceinline__ void gemm_phase(LAS unsigned char* lds, const GemmP g, const Sched& S, const Epi& E, int wave) {
    int tid = wave * 64 + lane_id(); asm volatile("" : "+v"(tid));
    const int wid = __builtin_amdgcn_readfirstlane(tid >> 6), lane = tid & 63, wr = wid >> 2, wc = wid & 3, fr = lane & 15, fq = lane >> 4;
    const int nt = g.Kbytes / 128;
    unsigned voffB[2]; int RbB[2], CbB[2];
#pragma unroll
    for (int i = 0; i < 2; ++i) { int R[2], C[2]; stage_rc(tid * 16 + i * 8192, R[i], C[i]);
        RbB[i] = (Epi::BMODE == 0) ? R[i] : (Epi::BMODE == 1) ? ((R[i] & ~31) + perm32(R[i] & 31)) : (64 * (R[i] >> 5) + perm32(R[i] & 31)); CbB[i] = 2 * C[i];
        voffB[i] = (unsigned)(RbB[i] * g.ldbB + CbB[i]); }
    const size_t kstep = (size_t)(BK * 2);
    size_t hstepB = (size_t)g.hstepB * g.ldbB; int nsplit = g.nsplit;
    const unsigned ldsw = (unsigned)wid * 1024u;
    const int aoff = lds_byte(wr * 64 + fr, fq * 8), boff = lds_byte(wc * 32 + fr, fq * 8);
    const char* const Ab = (const char*)g.A;
#define PG8_SA(b, h) (((b) * 2 + (h)) * HTB)
#define PG8_SB(b, h) ((4 + (b) * 2 + (h)) * HTB)
#define PG8_STAGE(bufoff, gbase, voff) do { _Pragma("unroll") for (int _i = 0; _i < 2; ++_i) \
        __builtin_amdgcn_global_load_lds((const unsigned*)((const char*)(gbase) + (voff)[_i]), (LAS unsigned*)(lds + (bufoff) + ldsw + _i * 8192), 16, 0, 0); } while (0)
#define PG8_LD8(p) __builtin_shufflevector(*(const LAS i32x4*)(p), *(const LAS i32x4*)((p) + 1024), 0, 1, 2, 3, 4, 5, 6, 7)
#define PG8_LDA(dst, b, h) do { if constexpr (F8) { _Pragma("unroll") for (int m = 0; m < 4; ++m) dst##8[m] = PG8_LD8(lds + PG8_SA(b, h) + aoff + m * 2048); } \
        else { _Pragma("unroll") for (int m = 0; m < 4; ++m) _Pragma("unroll") for (int k = 0; k < 2; ++k) dst[m][k] = *(const LAS bf16x8*)(lds + PG8_SA(b, h) + aoff + m * 2048 + k * 1024); } } while (0)
#define PG8_LDB(dst, b, h) do { if constexpr (F8) { _Pragma("unroll") for (int n = 0; n < 2; ++n) dst##8[n] = PG8_LD8(lds + PG8_SB(b, h) + boff + n * 2048); } \
        else { _Pragma("unroll") for (int n = 0; n < 2; ++n) _Pragma("unroll") for (int k = 0; k < 2; ++k) dst[n][k] = *(const LAS bf16x8*)(lds + PG8_SB(b, h) + boff + n * 2048 + k * 1024); } } while (0)
#define PG8_MMA(ai, bj, At, Bt) do { __builtin_amdgcn_s_setprio(1); \
        if constexpr (F8) { _Pragma("unroll") for (int m = 0; m < 4; ++m) _Pragma("unroll") for (int n = 0; n < 2; ++n) \
            acc[ai][bj][m][n] = __builtin_amdgcn_mfma_scale_f32_16x16x128_f8f6f4(Bt##8[n], At##8[m], acc[ai][bj][m][n], 0, 0, 0, 0, 0, 0); } \
        else { _Pragma("unroll") for (int m = 0; m < 4; ++m) _Pragma("unroll") for (int n = 0; n < 2; ++n) _Pragma("unroll") for (int k = 0; k < 2; ++k) \
            acc[ai][bj][m][n] = __builtin_amdgcn_mfma_f32_16x16x32_bf16(Bt[n][k], At[m][k], acc[ai][bj][m][n], 0, 0, 0); } \
        __builtin_amdgcn_s_setprio(0); } while (0)
#define PG8_WAIT_V(n) asm volatile("s_waitcnt vmcnt(" #n ")" ::: "memory")
#define PG8_WAIT_L(n) asm volatile("s_waitcnt lgkmcnt(" #n ")" ::: "memory")
#define PG8_BAR __builtin_amdgcn_s_barrier()
#define PG8_SCHED __builtin_amdgcn_sched_barrier(0)
#ifndef PROBE_K
#define PROBE_K 0
#endif
#ifndef PROBE_KSEL
#define PROBE_KSEL 0
#endif
    unsigned long long pk_acc = 0ull, pk_t0 = 0ull;
    int pf0 = 0, pf1 = 0, pend = -1;
    Unit cur, nxt; int ui = 0;
    if (!S.next(0, cur)) return;
    unsigned vc[2][2];
    LAS u32x4* const vnl = (LAS u32x4*)(lds + AUX_OFF + 2048) + tid;
    { int R[2], C[2]; int t_ = tid; asm volatile("" : "+v"(t_)); stage_rc(t_ * 16, R[0], C[0]); stage_rc(t_ * 16 + 8192, R[1], C[1]); S.aoff(cur, R, C, vc); }
    f32x4 acc[2][2][4][2];
#pragma unroll
    for (int a = 0; a < 2; ++a)
#pragma unroll
        for (int b = 0; b < 2; ++b)
#pragma unroll
            for (int m = 0; m < 4; ++m)
#pragma unroll
                for (int n = 0; n < 2; ++n) acc[a][b][m][n] = (f32x4){0.f, 0.f, 0.f, 0.f};
    bf16x8 At[4][2], B0[2][2], B1[2][2]; i32x8 At8[4], B08[2], B18[2];
    const char* cBl = S.blo(cur); const char* cBh = S.bhi(cur);
    if constexpr (Sched::MIX) { const int lb_ = S.ldbB(cur); voffB[0] = (unsigned)(RbB[0] * lb_ + CbB[0]); voffB[1] = (unsigned)(RbB[1] * lb_ + CbB[1]); hstepB = (size_t)S.hstepB(cur) * lb_; nsplit = S.nsplit(cur); S.a_ready(cur); }
    PG8_STAGE(PG8_SB(0, 0), cBl, voffB); PG8_STAGE(PG8_SB(0, 1), cBl + hstepB, voffB); PG8_STAGE(PG8_SA(0, 0), Ab, vc[0]); PG8_STAGE(PG8_SA(0, 1), Ab, vc[1]);
    if (wr == 1) PG8_BAR;
    PG8_WAIT_V(2); PG8_BAR;
    PG8_STAGE(PG8_SB(1, 0), cBl + kstep, voffB); PG8_STAGE(PG8_SA(1, 0), Ab + kstep, vc[0]); PG8_STAGE(PG8_SB(1, 1), cBl + hstepB + kstep, voffB);
    PG8_WAIT_V(6); PG8_BAR;
    for (;;) {
        const bool has_next = S.next(ui + 1, nxt);
        { unsigned vn[2][2];
          if (has_next) { int R[2], C[2]; int t_ = tid; asm volatile("" : "+v"(t_)); stage_rc(t_ * 16, R[0], C[0]); stage_rc(t_ * 16 + 8192, R[1], C[1]); S.aoff(nxt, R, C, vn); } else {
#pragma unroll
            for (int h = 0; h < 2; ++h)
#pragma unroll
                for (int i = 0; i < 2; ++i) vn[h][i] = vc[h][i]; }
          *vnl = (u32x4){vn[0][0], vn[0][1], vn[1][0], vn[1][1]}; }
        const char* nBl = has_next ? S.blo(nxt) : cBl; const char* nBh = has_next ? S.bhi(nxt) : cBh;
        if (PROBE_K == 1 || PROBE_K == 3) pk_t0 = __builtin_amdgcn_s_memrealtime();
#pragma unroll 1
        for (int t = 0; t < nt; t += 2) {
            const bool last = (t == nt - 2);
            const char* a1 = Ab + (size_t)(t + 1) * kstep;
            const char* a2 = last ? Ab : Ab + (size_t)(t + 2) * kstep;
            const char* b2 = last ? nBl : (((t + 2) < nsplit) ? cBl : cBh) + (size_t)(t + 2) * kstep;
            const char* a3 = a2 + kstep; const char* b3 = b2 + kstep;
            PG8_LDB(B0, 0, 0); PG8_LDB(B1, 0, 1); PG8_SCHED; PG8_LDA(At, 0, 0); PG8_STAGE(PG8_SA(1, 1), a1, vc[1]);
            PG8_WAIT_V(8); PG8_WAIT_L(0); PG8_BAR; PG8_MMA(0, 0, At, B0); PG8_MMA(0, 1, At, B1); PG8_BAR; PG8_SCHED;
            if (last) { if constexpr (Epi::NPF > 0) E.prefetch(cur, wr, lane, pf0, pf1);
                const u32x4 v_ = *vnl; vc[0][0] = v_[0]; vc[0][1] = v_[1]; vc[1][0] = v_[2]; vc[1][1] = v_[3];
                if constexpr (Sched::MIX) { if (has_next) { const int lb_ = S.ldbB(nxt); voffB[0] = (unsigned)(RbB[0] * lb_ + CbB[0]); voffB[1] = (unsigned)(RbB[1] * lb_ + CbB[1]); hstepB = (size_t)S.hstepB(nxt) * lb_; S.a_ready(nxt); } } }
            PG8_LDA(At, 0, 1); PG8_STAGE(PG8_SB(0, 0), b2, voffB); PG8_STAGE(PG8_SB(0, 1), b2 + hstepB, voffB); PG8_STAGE(PG8_SA(0, 0), a2, vc[0]);
            if (Epi::NPF > 0 && last) PG8_WAIT_V(10); else PG8_WAIT_V(8);
            PG8_WAIT_L(0); PG8_BAR; PG8_MMA(1, 0, At, B0); PG8_MMA(1, 1, At, B1); PG8_BAR; PG8_SCHED;
            PG8_LDB(B0, 1, 0); PG8_LDB(B1, 1, 1); PG8_SCHED; PG8_LDA(At, 1, 0); PG8_STAGE(PG8_SA(0, 1), a2, vc[1]);
            PG8_WAIT_V(8); PG8_WAIT_L(0); PG8_BAR; PG8_MMA(0, 0, At, B0); PG8_MMA(0, 1, At, B1); PG8_BAR; PG8_SCHED;
            if constexpr (Sched::MIX) { if (t == 0 && pend >= 0) { S.signal(pend, lane); pend = -1; } }
            PG8_LDA(At, 1, 1); PG8_STAGE(PG8_SB(1, 0), b3, voffB); PG8_STAGE(PG8_SB(1, 1), b3 + hstepB, voffB); PG8_STAGE(PG8_SA(1, 0), a3, vc[0]);
            PG8_WAIT_V(8); PG8_WAIT_L(0); PG8_BAR; PG8_MMA(1, 0, At, B0); PG8_MMA(1, 1, At, B1); PG8_BAR; PG8_SCHED;
        }
        if (PROBE_K == 1) pk_acc += __builtin_amdgcn_s_memrealtime() - pk_t0;
        if (PROBE_K == 2) pk_t0 = __builtin_amdgcn_s_memrealtime();
        if (wr == 0) PG8_BAR;
        if constexpr (Epi::NPF > 0) { asm volatile("s_waitcnt vmcnt(14)" : "+v"(pf0), "+v"(pf1) :: "memory"); E(acc, cur, wr, wc, fr, fq, pf0, pf1); }
        else E(acc, cur, wr, wc, fr, fq);
        if constexpr (Sched::MIX) pend = S.done_tile(cur);
        if (PROBE_K == 2) { asm volatile("s_waitcnt vmcnt(0)" ::: "memory"); pk_acc += __builtin_amdgcn_s_memrealtime() - pk_t0; }
        if (PROBE_K == 3) pk_acc += __builtin_amdgcn_s_memrealtime() - pk_t0;
        if (!has_next) break;
#pragma unroll
        for (int a = 0; a < 2; ++a)
#pragma unroll
            for (int b = 0; b < 2; ++b)
#pragma unroll
                for (int m = 0; m < 4; ++m)
#pragma unroll
                    for (int n = 0; n < 2; ++n) acc[a][b][m][n] = (f32x4){0.f, 0.f, 0.f, 0.f};
        cur = nxt; cBl = nBl; cBh = nBh; ++ui;
        if constexpr (Sched::MIX) nsplit = S.nsplit(cur);
        if (wr == 1) PG8_BAR;
    }
    PG8_WAIT_V(0);
    if constexpr (Sched::MIX) { if (pend >= 0) S.signal(pend, lane); }
    PG8_BAR;
    if (PROBE_K != 0 && g.pk && tid == 0) { LAS unsigned* pw_ = (LAS unsigned*)(lds + MISC_OFF) + 120; *pw_ += (unsigned)pk_acc; }
#undef PG8_SA
#undef PG8_SB
#undef PG8_STAGE
#undef PG8_LDA
#undef PG8_LDB
#undef PG8_MMA
#undef PG8_LD8
#undef PG8_WAIT_V
#undef PG8_WAIT_L
#undef PG8_BAR
#undef PG8_SCHED
}
}

namespace attn_body {
using bf16 = __hip_bfloat16;
constexpr int NHEAD = 16, D = 64, DMQ = NHEAD * D;
constexpr int NW = 8, QBLK = 32, QB = QBLK * NW, KVBLK = 64;
__device__ __forceinline__ int crow(int r, int hi) { return (r & 3) + 8 * (r >> 2) + 4 * hi; }
#define SBAR() __builtin_amdgcn_sched_barrier(0)
__device__ __forceinline__ void cmask(f32x16& p0, f32x16& p1, int jb, int qrel, int hi) {
  const float NEG = -INFINITY; int kb = 64 * jb + 4 * hi;
  #pragma unroll
  for (int r = 0; r < 16; ++r) { int kv = kb + (r & 3) + 8 * (r >> 2); if (kv > qrel) p0[r] = NEG; if (kv + 32 > qrel) p1[r] = NEG; }
}
constexpr int NSLOT = 3, SLOTB = 8192;
constexpr int LDS_K = 0, LDS_V = NSLOT * SLOTB, LDS_WS = 2 * NSLOT * SLOTB, LDS_OST = LDS_WS + NW * 64 * 4, ATT_LDS_BYTES = LDS_OST + NW * 4096;
constexpr int LDS_NCK = 86016;
__device__ __forceinline__ void glds16(const void* gsrc, unsigned lds_dst) { unsigned keep;
  asm volatile("s_mov_b32 %0, m0\n\ts_mov_b32 m0, %2\n\ts_nop 0\n\tglobal_load_lds_dwordx4 %1, off\n\ts_mov_b32 m0, %0" : "=&s"(keep) : "v"(gsrc), "s"(lds_dst) : "memory"); }
__device__ __forceinline__ float max3f(float a, float b, float c) { float r; asm("v_max3_f32 %0, %1, %2, %3" : "=v"(r) : "v"(a), "v"(b), "v"(c)); return r; }
__device__ __forceinline__ float max2f(float a, float b) { float r; asm("v_max_f32_e32 %0, %1, %2" : "=v"(r) : "v"(a), "v"(b)); return r; }
__device__ __forceinline__ float fadd_s(float a, float b) { float r; asm("v_add_f32_e32 %0, %1, %2" : "=v"(r) : "v"(a), "v"(b)); return r; }
__device__ __forceinline__ float fsub_s(float a, float b) { float r; asm("v_sub_f32_e32 %0, %1, %2" : "=v"(r) : "v"(a), "v"(b)); return r; }
typedef __bf16 bf16x2_t __attribute__((ext_vector_type(2)));
__device__ __forceinline__ unsigned cvtpk_s(float lo, float hi) { f32x2 v = {lo, hi}; bf16x2_t b = __builtin_convertvector(v, bf16x2_t); return __builtin_bit_cast(unsigned, b); }
#define WAIT_BAR(N) asm volatile("s_waitcnt vmcnt(" #N ") lgkmcnt(0)\n\ts_barrier" ::: "memory")
typedef LAS const char* lds_cptr;
typedef short v4i16_t __attribute__((ext_vector_type(4)));
__device__ __forceinline__ void qkt(f32x16& p0, f32x16& p1, lds_cptr Kslot, const bf16x8* qr, const f32x16& negm, int r32, int hi) {
  lds_cptr kb = Kslot + hi * 1024 + r32 * 16;
  #pragma unroll
  for (int d0 = 0; d0 < 4; ++d0) {
    const bf16x8 b0 = *(const LAS bf16x8*)(kb + d0 * 2048);
    const bf16x8 b1 = *(const LAS bf16x8*)(kb + d0 * 2048 + 512);
    if (d0 == 0) { p0 = __builtin_amdgcn_mfma_f32_32x32x16_bf16(b0, qr[0], negm, 0, 0, 0); p1 = __builtin_amdgcn_mfma_f32_32x32x16_bf16(b1, qr[0], negm, 0, 0, 0); }
    else { p0 = __builtin_amdgcn_mfma_f32_32x32x16_bf16(b0, qr[d0], p0, 0, 0, 0); p1 = __builtin_amdgcn_mfma_f32_32x32x16_bf16(b1, qr[d0], p1, 0, 0, 0); } }
}
__device__ __forceinline__ void kload8(bf16x8* kf, lds_cptr kp) {
  kf[0] = *(const LAS bf16x8*)(kp);        kf[1] = *(const LAS bf16x8*)(kp + 512);
  kf[2] = *(const LAS bf16x8*)(kp + 2048); kf[3] = *(const LAS bf16x8*)(kp + 2560);
  kf[4] = *(const LAS bf16x8*)(kp + 4096); kf[5] = *(const LAS bf16x8*)(kp + 4608);
  kf[6] = *(const LAS bf16x8*)(kp + 6144); kf[7] = *(const LAS bf16x8*)(kp + 6656);
}
__device__ __forceinline__ void kload2(bf16x8* kf, lds_cptr kp, int j) { kf[2 * j] = *(const LAS bf16x8*)(kp + j * 2048); kf[2 * j + 1] = *(const LAS bf16x8*)(kp + j * 2048 + 512); }
__device__ __forceinline__ s16x4 vtr(lds_cptr p) { return __builtin_bit_cast(s16x4, __builtin_amdgcn_ds_read_tr16_b64_v4i16((LAS v4i16_t*)p)); }
__device__ __forceinline__ float rowmax(const f32x16& p0, const f32x16& p1) {
  float a = max3f(p0[0], p0[1], p1[0]), b = max3f(p0[2], p0[3], p1[1]); a = max3f(a, p1[2], p1[3]);
  #pragma unroll
  for (int r = 4; r < 16; r += 4) { a = max3f(a, p0[r], p0[r + 1]); b = max3f(b, p0[r + 2], p0[r + 3]); a = max3f(a, p1[r], p1[r + 1]); b = max3f(b, p1[r + 2], p1[r + 3]); }
  const float m = max2f(a, b);
  auto rr = __builtin_amdgcn_permlane32_swap(__float_as_uint(m), __float_as_uint(m), false, false);
  return max2f(__uint_as_float(rr[0]), __uint_as_float(rr[1]));
}
__device__ __forceinline__ void pv(f32x16* o, int vb, bf16x8 pa0, bf16x8 pa1, bf16x8 pa2, bf16x8 pa3) {
  #pragma unroll
  for (int d0 = 0; d0 < 2; ++d0) { s16x4 lo[4], hi[4];
    #pragma unroll
    for (int ks = 0; ks < 4; ++ks) {
      asm volatile("ds_read_b64_tr_b16 %0,%1 offset:%c2" : "=&v"(lo[ks]) : "v"(vb), "i"(d0 * 4096 + ks * 1024) : "memory");
      asm volatile("ds_read_b64_tr_b16 %0,%1 offset:%c2" : "=&v"(hi[ks]) : "v"(vb), "i"(d0 * 4096 + ks * 1024 + 512) : "memory"); }
    asm volatile("s_waitcnt lgkmcnt(0)" ::: "memory"); SBAR();
    #define PK(k) (bf16x8){lo[k][0], lo[k][1], lo[k][2], lo[k][3], hi[k][0], hi[k][1], hi[k][2], hi[k][3]}
    o[d0] = __builtin_amdgcn_mfma_f32_32x32x16_bf16(pa0, PK(0), o[d0], 0, 0, 0);
    o[d0] = __builtin_amdgcn_mfma_f32_32x32x16_bf16(pa1, PK(1), o[d0], 0, 0, 0);
    o[d0] = __builtin_amdgcn_mfma_f32_32x32x16_bf16(pa2, PK(2), o[d0], 0, 0, 0);
    o[d0] = __builtin_amdgcn_mfma_f32_32x32x16_bf16(pa3, PK(3), o[d0], 0, 0, 0);
    #undef PK
  }
}

struct Xpf { bool primed, has_next; long Pn; const bf16* Qn; const bf16* Kn; const bf16* Vn; };
template<int THRL, bool WIN, bool XP> __device__ __forceinline__ void attn_unit_x(int qb, int T0, long P, const bf16* Q, const bf16* __restrict__ K, const bf16* __restrict__ V, bf16* O, char* shm, int wave,
                                                                        float* PML, long wtok0, int wtstride, const Xpf xp, bf16x8 (&qn)[4], int& rho) {
#ifndef PROBE_A
#define PROBE_A 0
#endif
  unsigned long long pa_t = 0ull;
#define PA_T0(k) do { if (WIN && PROBE_A == (k)) pa_t = __builtin_amdgcn_s_memrealtime(); } while (0)
#define PA_T1(k) do { if (WIN && PROBE_A == (k)) { const unsigned d_ = (unsigned)(__builtin_amdgcn_s_memrealtime() - pa_t); if (tid == 0) *(unsigned*)(shm + MISC_OFF + 4 * 121) += d_; } } while (0)
  int tid = wave * 64 + lane_id(); asm volatile("" : "+v"(tid));
  const int lane = tid & 63, r32 = lane & 31, hi = lane >> 5; const int wid = __builtin_amdgcn_readfirstlane(tid >> 6);
  PA_T0(1);
  const int q0 = qb * QB;
  const bf16* Qw = Q + (long)(q0 + wid * QBLK) * P;
  const bf16* Kh = K + (long)T0 * KVBLK * P, *Vh = V + (long)T0 * KVBLK * P;
  const unsigned lds0 = (unsigned)(uintptr_t)shm; const lds_cptr shm3 = (lds_cptr)shm;
  float* wsf = (float*)(shm + LDS_WS) + wid * 64;
  const int wbj = 383 - (q0 + wid * QBLK + r32 - T0 * KVBLK) + 4 * hi;
  const LAS float* nck0 = WIN ? (const LAS float*)((lds_cptr)shm + LDS_NCK) + (wbj & 3) * 640 + (wbj & ~3)
                              : (const LAS float*)((lds_cptr)shm + LDS_NCK) + T0 * KVBLK + 4 * hi;
  const float cq2 = WIN ? 0.f : -((const LAS float*)((lds_cptr)shm + LDS_NCK))[q0 + wid * QBLK + r32];
  const bf16* ksrc = Kh + (long)lane * P + wid * 8;
  const bf16* vsrc = Vh + (long)(16 * (wid & 3) + (lane >> 2)) * P + (wid >> 2) * 32 + (lane & 3) * 8;
  const unsigned kdst = lds0 + LDS_K + wid * 1024, vdst = lds0 + LDS_V + wid * 1024;
  #define DMA_K(t, slot) glds16(ksrc + (long)(t) * KVBLK * P, (unsigned)__builtin_amdgcn_readfirstlane(kdst + (slot)))
  #define DMA_V(t, slot) glds16(vsrc + (long)(t) * KVBLK * P, (unsigned)__builtin_amdgcn_readfirstlane(vdst + (slot)))
  const int vb0 = (int)(lds0 + LDS_V) + ((lane >> 4) & 1) * 32 + (lane & 3) * 8 + (4 * hi + ((lane & 15) >> 2)) * 64;
  bf16x8 kf[8];
  const lds_cptr kp0 = shm3 + LDS_K + hi * 1024 + r32 * 16; const lds_cptr vp0 = shm3 + LDS_V + ((lane >> 4) & 1) * 32 + (lane & 3) * 8 + (4 * hi + ((lane & 15) >> 2)) * 64;
  const int NT = (q0 + QB) / KVBLK - T0;
  #define NXS(s) (((s) == (NSLOT - 1) * SLOTB) ? 0 : (s) + SLOTB)
  const int s0 = XP ? __builtin_amdgcn_readfirstlane(rho) * SLOTB : 0, s1 = NXS(s0), s2 = NXS(s1);
  const bool primed = XP && xp.primed;
  if (!primed) { DMA_K(0, s0); DMA_V(0, s0); DMA_K(1, s1); }
  bf16x8 qr[4];
  const lds_cptr qp = shm3 + LDS_OST + wid * 4096 + lane * 16;
  if (!primed) {
  #pragma unroll
  for (int d0 = 0; d0 < 4; ++d0) qr[d0] = *reinterpret_cast<const bf16x8*>(&Qw[(long)r32 * P + d0 * 16 + hi * 8]);
  #pragma unroll
  for (int d0 = 0; d0 < 4; ++d0) *(LAS bf16x8*)(qp + d0 * 1024) = qr[d0];
  } else {
  #pragma unroll
  for (int d0 = 0; d0 < 4; ++d0) qr[d0] = qn[d0];
  }
  #define QLD(d) (*(const LAS bf16x8*)(qp + (d) * 1024))
  float nm = cq2, l_reg = 0.f; f32x16 o[2]; o[0] = f32x16{}; o[1] = f32x16{};
  const int qrel = wid * QBLK + r32;
  #define CMASK(P0, P1, t) do { if (!WIN) { int jb_ = (t) - (NT - 4); if (jb_ >= 0) cmask(P0, P1, jb_, qrel, hi); } } while (0)
  #define DECAY(P0, P1, t) do { const LAS float* nk_ = nck0 + ((t) << 6); \
    _Pragma("unroll") for (int g_ = 0; g_ < 4; ++g_) { const f32x4 a_ = *(const LAS f32x4*)(nk_ + 8 * g_); const f32x4 b_ = *(const LAS f32x4*)(nk_ + 32 + 8 * g_); \
      P0[4 * g_] += a_[0]; P0[4 * g_ + 1] += a_[1]; P0[4 * g_ + 2] += a_[2]; P0[4 * g_ + 3] += a_[3]; P1[4 * g_] += b_[0]; P1[4 * g_ + 1] += b_[1]; P1[4 * g_ + 2] += b_[2]; P1[4 * g_ + 3] += b_[3]; SBAR(); } } while (0)
  bool resc = false;
  #define START(P0, P1) do { const float rm = rowmax(P0, P1); resc = false; \
    { const float dl = max2f(rm, -1000.f); nm = fsub_s(nm, dl); \
      _Pragma("unroll") for (int r = 0; r < 16; ++r) { P0[r] = fsub_s(P0[r], dl); P1[r] = fsub_s(P1[r], dl); } } \
    _Pragma("unroll") for (int r = 0; r < 16; ++r) P0[r] = __builtin_amdgcn_exp2f(P0[r]); } while (0)
  #define RESC() do { if (resc) { asm volatile("s_waitcnt lgkmcnt(0)" ::: "memory"); \
      _Pragma("unroll") for (int d_ = 0; d_ < 2; ++d_) _Pragma("unroll") for (int r = 0; r < 16; ++r) o[d_][r] *= wsf[crow(r, hi)]; } } while (0)
  f32x16 pA0, pA1, pB0, pB1;
  int sl_prev = s0, sl_cur = s0, sl_next = s1;
  #define ROT() do { sl_prev = sl_cur; sl_cur = sl_next; sl_next = (sl_next == (NSLOT - 1) * SLOTB) ? 0 : sl_next + SLOTB; } while (0)
  if (!primed) { DMA_K(2, s2); WAIT_BAR(3); }
  PA_T1(1); PA_T0(2);
  { f32x16 negm;
    #pragma unroll
    for (int r = 0; r < 16; ++r) negm[r] = nm;
    qkt(pA0, pA1, shm3 + LDS_K + s0, qr, negm, r32, hi); }
  asm volatile("s_nop 15\n\ts_nop 7" : "+v"(pA0), "+v"(pA1)); DECAY(pA0, pA1, 0); CMASK(pA0, pA1, 0);
  asm volatile("s_nop 1" : "+v"(pA0), "+v"(pA1));
  START(pA0, pA1);
  _Pragma("unroll") for (int r = 0; r < 16; ++r) pA1[r] = __builtin_amdgcn_exp2f(pA1[r]);
  WAIT_BAR(0);
  DMA_K(3, s0); DMA_V(1, s1);
  ROT();
  kload8(kf, kp0 + sl_cur);
  WAIT_BAR(2);
  PA_T1(2); PA_T0(3);
  s16x4 vlo[8], vhi[8]; u32x4 pw0, pw1, pw2, pw3; bf16x8 qfa = QLD(0), qfb = QLD(1);
  #define PKW(P, B) cvtpk_s(P[B], P[B + 1])
  #define PAF(k) __builtin_bit_cast(bf16x8, pw##k)
  #define VFR(i) (bf16x8){vlo[i][0], vlo[i][1], vlo[i][2], vlo[i][3], vhi[i][0], vhi[i][1], vhi[i][2], vhi[i][3]}
  #define PIN(x) asm volatile("" : "+v"(x))
  #define MX3(a, b, c) __builtin_fmaxf(__builtin_fmaxf((a), (b)), (c))
  #define SPLAT(X) do { _Pragma("unroll") for (int r_ = 0; r_ < 16; ++r_) X[r_] = nm; PIN(X); } while (0)
  #define GAPA(MF, A0, A1, A2, A3, W0, W1, PW) do { MF; sacc += A0; sacc += A1; sacc += A2; sacc += A3; PIN(sacc); W0; W1; PIN(PW); SBAR(); } while (0)
  #define EX(v) __builtin_amdgcn_exp2f(v)
  #define GAPB(MF, X, B) do { MF; X[B] = EX(X[B]); X[B + 1] = EX(X[B + 1]); X[B + 2] = EX(X[B + 2]); X[B + 3] = EX(X[B + 3]); PIN(X); SBAR(); } while (0)
  #define VRD(i) do { vlo[i] = vtr(vp_ + (((i) >> 2) * 4096 + ((i) & 3) * 1024)); vhi[i] = vtr(vp_ + (((i) >> 2) * 4096 + ((i) & 3) * 1024 + 512)); } while (0)
  #define KRD(G, j) do { if (G) { kload2(kf, kp0 + sl_next, j); SBAR(); } } while (0)
  #define STEP(C0, C1, P0, P1, t, GK, GV, GL) do { SBAR(); \
    const lds_cptr vp_ = vp0 + sl_prev; \
    SPLAT(C0); VRD(0); SBAR(); float sacc = (P0[0] + P0[1]); \
    GAPA(C0 = __builtin_amdgcn_mfma_f32_32x32x16_bf16(kf[0], qfa, C0, 0, 0, 0), P0[2], P0[3], P0[4], P0[5],     pw0[0] = PKW(P0, 0), pw0[1] = PKW(P0, 2), pw0); \
    SPLAT(C1); VRD(4); SBAR(); GAPA(C1 = __builtin_amdgcn_mfma_f32_32x32x16_bf16(kf[1], qfa, C1, 0, 0, 0), P0[6], P0[7], P0[8], P0[9],     pw0[2] = PKW(P0, 4), pw0[3] = PKW(P0, 6), pw0); \
    qfa = QLD(2); VRD(1); SBAR(); GAPA(C0 = __builtin_amdgcn_mfma_f32_32x32x16_bf16(kf[2], qfb, C0, 0, 0, 0),   P0[10], P0[11], P0[12], P0[13], pw1[0] = PKW(P0, 8), pw1[1] = PKW(P0, 10), pw1); \
    VRD(5); SBAR(); GAPA(C1 = __builtin_amdgcn_mfma_f32_32x32x16_bf16(kf[3], qfb, C1, 0, 0, 0),   P0[14], P0[15], P1[0], P1[1],   pw1[2] = PKW(P0, 12), pw1[3] = PKW(P0, 14), pw1); \
    qfb = QLD(3); VRD(2); SBAR(); GAPA(C0 = __builtin_amdgcn_mfma_f32_32x32x16_bf16(kf[4], qfa, C0, 0, 0, 0),   P1[2], P1[3], P1[4], P1[5],     pw2[0] = PKW(P1, 0), pw2[1] = PKW(P1, 2), pw2); \
    VRD(6); SBAR(); GAPA(C1 = __builtin_amdgcn_mfma_f32_32x32x16_bf16(kf[5], qfa, C1, 0, 0, 0),   P1[6], P1[7], P1[8], P1[9],     pw2[2] = PKW(P1, 4), pw2[3] = PKW(P1, 6), pw2); \
    VRD(3); SBAR(); GAPA(C0 = __builtin_amdgcn_mfma_f32_32x32x16_bf16(kf[6], qfb, C0, 0, 0, 0),   P1[10], P1[11], P1[12], P1[13], pw3[0] = PKW(P1, 8), pw3[1] = PKW(P1, 10), pw3); \
    VRD(7); SBAR(); GAPA(C1 = __builtin_amdgcn_mfma_f32_32x32x16_bf16(kf[7], qfb, C1, 0, 0, 0),   P1[14], P1[15], 0.f, 0.f,       pw3[2] = PKW(P1, 12), pw3[3] = PKW(P1, 14), pw3); \
    l_reg += sacc; \
    if (GK) { DMA_K((t) + 3, sl_cur); } if (GV) { DMA_V((t) + 1, sl_next); } \
    DECAY(C0, C1, t); \
    CMASK(C0, C1, t); \
    { float a = MX3(C0[0], C0[1], C1[0]), b = MX3(C0[2], C0[3], C1[1]); a = MX3(a, C1[2], C1[3]); \
      _Pragma("unroll") for (int r = 4; r < 16; r += 4) { a = MX3(a, C0[r], C0[r + 1]); b = MX3(b, C0[r + 2], C0[r + 3]); a = MX3(a, C1[r], C1[r + 1]); b = MX3(b, C1[r + 2], C1[r + 3]); } \
      float rm = __builtin_fmaxf(a, b); { auto rr = __builtin_amdgcn_permlane32_swap(__float_as_uint(rm), __float_as_uint(rm), false, false); rm = __builtin_fmaxf(__uint_as_float(rr[0]), __uint_as_float(rr[1])); } \
      resc = false; \
      if (__builtin_expect(__any(rm > (float)THRL), 0)) { const float dl = __builtin_fmaxf(rm, 0.f); nm -= dl; \
        _Pragma("unroll") for (int r = 0; r < 16; ++r) { C0[r] -= dl; C1[r] -= dl; } \
        const float f = __builtin_amdgcn_exp2f(-dl); l_reg *= f; if (hi == 0) wsf[r32] = f; resc = true; } } \
    SBAR(); \
    GAPB(o[0] = __builtin_amdgcn_mfma_f32_32x32x16_bf16(PAF(0), VFR(0), o[0], 0, 0, 0), C0, 0); \
    GAPB(o[1] = __builtin_amdgcn_mfma_f32_32x32x16_bf16(PAF(0), VFR(4), o[1], 0, 0, 0), C0, 4); \
    KRD(GL, 0); GAPB(o[0] = __builtin_amdgcn_mfma_f32_32x32x16_bf16(PAF(1), VFR(1), o[0], 0, 0, 0), C0, 8); \
    KRD(GL, 1); GAPB(o[1] = __builtin_amdgcn_mfma_f32_32x32x16_bf16(PAF(1), VFR(5), o[1], 0, 0, 0), C0, 12); \
    KRD(GL, 2); GAPB(o[0] = __builtin_amdgcn_mfma_f32_32x32x16_bf16(PAF(2), VFR(2), o[0], 0, 0, 0), C1, 0); \
    KRD(GL, 3); GAPB(o[1] = __builtin_amdgcn_mfma_f32_32x32x16_bf16(PAF(2), VFR(6), o[1], 0, 0, 0), C1, 4); \
    GAPB(o[0] = __builtin_amdgcn_mfma_f32_32x32x16_bf16(PAF(3), VFR(3), o[0], 0, 0, 0), C1, 8); \
    qfa = QLD(0); qfb = QLD(1); SBAR(); \
    GAPB(o[1] = __builtin_amdgcn_mfma_f32_32x32x16_bf16(PAF(3), VFR(7), o[1], 0, 0, 0), C1, 12); \
    } while (0)
  int t = 1;
  #undef CMASK
  #define CMASK(P0, P1, t) do {} while (0)
  for (; t + 5 < NT; t += 2) {
    STEP(pB0, pB1, pA0, pA1, t, true, true, true);     WAIT_BAR(2); RESC(); ROT();
    STEP(pA0, pA1, pB0, pB1, t + 1, true, true, true); WAIT_BAR(2); RESC(); ROT();
  }
  #undef CMASK
  #define CMASK(P0, P1, t) do { if (!WIN) { int jb_ = (t) - (NT - 4); if (jb_ >= 0) cmask(P0, P1, jb_, qrel, hi); } } while (0)
  #define ENDW(tt) do { if ((tt) + 3 < NT) { WAIT_BAR(2); } else if ((tt) + 2 < NT) { WAIT_BAR(1); } else { WAIT_BAR(0); } } while (0)
  for (; t + 1 < NT; t += 2) {
    STEP(pB0, pB1, pA0, pA1, t, (t + 3 < NT), (t + 1 < NT), (t + 1 < NT));       ENDW(t);     RESC(); ROT();
    STEP(pA0, pA1, pB0, pB1, t + 1, (t + 4 < NT), (t + 2 < NT), (t + 2 < NT));   ENDW(t + 1); RESC(); ROT();
  }
  bool pf_next = false;
  if constexpr (XP) { pf_next = xp.has_next; if (pf_next) {
    const int n0 = sl_next, n1 = NXS(n0), n2 = NXS(n1);
    const bf16* ksn = xp.Kn + (long)lane * xp.Pn + wid * 8;
    const bf16* vsn = xp.Vn + (long)(16 * (wid & 3) + (lane >> 2)) * xp.Pn + (wid >> 2) * 32 + (lane & 3) * 8;
    glds16(ksn, (unsigned)__builtin_amdgcn_readfirstlane(kdst + n0));
    const bf16* Qwn = xp.Qn + (long)(wid * QBLK) * xp.Pn;
    #pragma unroll
    for (int d0 = 0; d0 < 4; ++d0) qn[d0] = *reinterpret_cast<const bf16x8*>(&Qwn[(long)r32 * xp.Pn + d0 * 16 + hi * 8]);
    glds16(vsn, (unsigned)__builtin_amdgcn_readfirstlane(vdst + n0));
    glds16(ksn + (long)KVBLK * xp.Pn, (unsigned)__builtin_amdgcn_readfirstlane(kdst + n1));
    glds16(ksn + (long)2 * KVBLK * xp.Pn, (unsigned)__builtin_amdgcn_readfirstlane(kdst + n2));
    rho = n0 / SLOTB; } }
  STEP(pB0, pB1, pA0, pA1, NT - 1, false, false, false); RESC();
  { float sacc = pB0[0] + pB0[1]; _Pragma("unroll") for (int r = 2; r < 16; ++r) sacc += pB0[r]; _Pragma("unroll") for (int r = 0; r < 16; ++r) sacc += pB1[r]; l_reg += sacc;
    pw0 = (u32x4){PKW(pB0, 0), PKW(pB0, 2), PKW(pB0, 4), PKW(pB0, 6)}; pw1 = (u32x4){PKW(pB0, 8), PKW(pB0, 10), PKW(pB0, 12), PKW(pB0, 14)}; pw2 = (u32x4){PKW(pB1, 0), PKW(pB1, 2), PKW(pB1, 4), PKW(pB1, 6)}; pw3 = (u32x4){PKW(pB1, 8), PKW(pB1, 10), PKW(pB1, 12), PKW(pB1, 14)};
    SBAR(); pv(o, vb0 + sl_cur, PAF(0), PAF(1), PAF(2), PAF(3)); }
  PA_T1(3); PA_T0(4);
  #undef PKW
  #undef PAF
  #undef VFR
  #undef PIN
  #undef MX3
  #undef GAPA
  #undef SPLAT
  #undef GAPB
  #undef EX
  #undef VRD
  #undef KRD
  #undef STEP
  #undef ENDW
  { auto rr = __builtin_amdgcn_permlane32_swap(__float_as_uint(l_reg), __float_as_uint(l_reg), false, false); l_reg = __uint_as_float(rr[0]) + __uint_as_float(rr[1]); }
  if (hi == 0) wsf[32 + r32] = l_reg; asm volatile("s_waitcnt lgkmcnt(0)" ::: "memory");
  float rli[16];
  #pragma unroll
  for (int r = 0; r < 16; ++r) rli[r] = WIN ? 1.0f : __builtin_amdgcn_rcpf(wsf[32 + crow(r, hi)]);
  if (WIN) { if (hi == 0) *(f32x2*)(PML + 2 * (wtok0 + (long)wtstride * (q0 + wid * QBLK + r32))) = (f32x2){-nm, l_reg}; }
  bf16* Ow = O + (long)(q0 + wid * QBLK) * P;
  { bf16* stg = (bf16*)(shm + LDS_OST) + wid * 2048;
    #pragma unroll
    for (int r = 0; r < 16; ++r) { const int orow = crow(r, hi);
      #pragma unroll
      for (int d0 = 0; d0 < 2; ++d0) stg[orow * 64 + d0 * 32 + r32] = __float2bfloat16(o[d0][r] * rli[r]); }
    asm volatile("s_waitcnt lgkmcnt(0)" ::: "memory");
    #pragma unroll
    for (int i = 0; i < 4; ++i) { const int row = i * 8 + (lane >> 3), ch = lane & 7; const u32x4 v = *(const u32x4*)(stg + row * 64 + ch * 8); *(u32x4*)(Ow + (long)row * P + ch * 8) = v; } }
  if constexpr (XP) { if (pf_next) {
    asm volatile("s_waitcnt vmcnt(5)" ::: "memory");
    #pragma unroll
    for (int d0 = 0; d0 < 4; ++d0) *(LAS bf16x8*)(qp + d0 * 1024) = qn[d0]; } }
  asm volatile("s_waitcnt lgkmcnt(0)\n\ts_barrier" ::: "memory");
  PA_T1(4);
  #undef DMA_K
  #undef DMA_V
  #undef NXS
  #undef CMASK
  #undef DECAY
  #undef START
  #undef RESC
  #undef ROT
  #undef QLD
}
template<int THRL, bool WIN> __device__ __forceinline__ void attn_unit(int qb, int T0, long P, const bf16* Q, const bf16* __restrict__ K, const bf16* __restrict__ V, bf16* O, char* shm, int wave,
                                                                        float* PML = nullptr, long wtok0 = 0, int wtstride = 0) {
  Xpf xp{}; bf16x8 qn[4]; int rho = 0;
  attn_unit_x<THRL, WIN, false>(qb, T0, P, Q, K, V, O, shm, wave, PML, wtok0, wtstride, xp, qn, rho);
}
#undef WAIT_BAR
}

namespace dil {
constexpr float NEGBIG = -1.0e30f;
__device__ __forceinline__ int t5_bucket(int dist) {
    if (dist < 16) return dist;
    const float v = logf((float)dist / 16.0f) / 4.852030263919617f * 16.0f;
    const int l = 16 + (int)v; return l < 31 ? l : 31;
}
__device__ __forceinline__ void build_table(LAS float* tb, const float* rel_bias, int g, int d, int j, int tid) {
    asm volatile("" : "+v"(tid));
    for (int e = tid; e < 640; e += 512) { const int n = e - 256; const float v = (n >= 0 && n <= 128) ? rel_bias[t5_bucket(n * d) * 24 + 8 * g + j] * LOG2E : NEGBIG; const int m = 639 - e;
#pragma unroll
        for (int sft = 0; sft < 4; ++sft) if (m - sft >= 0) tb[640 * sft + m - sft] = v; }
}
}

#define XB_TMO      128
#define XB_XCNT(j)  (256  + 64 * (j))
#define XB_XSUB(j)  (1280 + 64 * (j))
#define XB_XGEN(j)  (2304 + 64 * (j))
#define XB_TOP      3328
#define XB_TOPGEN   3392
#define XCD_BAR_WORDS 3456
#define XB_SPIN_CAP (1u << 18)
__device__ __forceinline__ unsigned xb_ld(unsigned* p)              { return __hip_atomic_load(p, __ATOMIC_RELAXED, __HIP_MEMORY_SCOPE_AGENT); }
__device__ __forceinline__ unsigned xb_add(unsigned* p, unsigned v) { return __hip_atomic_fetch_add(p, v, __ATOMIC_RELAXED, __HIP_MEMORY_SCOPE_AGENT); }
__device__ __forceinline__ unsigned xb_xcc_id() { return (unsigned)__builtin_amdgcn_s_getreg((3 << 11) | 20) & 0xFu; }
#define XB_SPIN(cond, bar) do { unsigned _sp = 0; while (cond) { __builtin_amdgcn_s_sleep(1); \
    if ((++_sp & 255u) == 0u) { if (xb_ld(&(bar)[XB_TMO])) break; if (_sp > XB_SPIN_CAP) { atomicAdd(&(bar)[XB_TMO], 1u); break; } } } } while (0)
struct XcdBarrier { unsigned* bar; unsigned x; volatile LAS unsigned* st; };
__device__ __forceinline__ XcdBarrier xcd_barrier_post(unsigned* bar, volatile LAS unsigned* st, bool leader) {
    XcdBarrier b; b.bar = bar; b.x = xb_xcc_id(); b.st = st;
    if (leader) (void)xb_add(&bar[XB_XCNT(b.x)], 1u);
    return b;
}
__device__ __forceinline__ void xcd_barrier_complete(unsigned* bar, unsigned x, unsigned& nloc, unsigned& nx) {
    const unsigned G = gridDim.x * gridDim.y * gridDim.z;
    unsigned sum, cnt, mine, sp = 0u;
    for (;;) {
        sum = 0u; cnt = 0u; mine = 0u;
#pragma unroll
        for (unsigned j = 0; j < 16; ++j) { const unsigned c = xb_ld(&bar[XB_XCNT(j)]); sum += c; cnt += (c > 0u) ? 1u : 0u; mine = (j == x) ? c : mine; }
        if (sum == G) break;
        __builtin_amdgcn_s_sleep(1);
        if ((++sp & 255u) == 0u) { if (xb_ld(&bar[XB_TMO])) break; if (sp > XB_SPIN_CAP) { atomicAdd(&bar[XB_TMO], 1u); break; } }
    }
    nloc = mine > 0u ? mine : 1u; nx = cnt > 0u ? cnt : 1u;
}
__device__ __forceinline__ void xcd_barrier(const XcdBarrier& b, bool leader) {
    asm volatile("s_waitcnt vmcnt(0)" ::: "memory");
    __syncthreads();
    if (leader) {
        unsigned* bar = b.bar;
        __builtin_amdgcn_s_waitcnt(0);
        unsigned nloc = b.st[0], nx = b.st[1];
        if (nloc == 0u) { xcd_barrier_complete(bar, b.x, nloc, nx); b.st[0] = nloc; b.st[1] = nx; }
        const unsigned old = xb_add(&bar[XB_XSUB(b.x)], 1u);
        const unsigned gen = old / nloc;
        if (old + 1u == (gen + 1u) * nloc) {
            __builtin_amdgcn_fence(__ATOMIC_RELEASE, "agent");
            asm volatile("s_waitcnt vmcnt(0)" ::: "memory");
            const unsigned og = xb_add(&bar[XB_TOP], 1u);
            const unsigned tg = og / nx;
            if (og + 1u == (tg + 1u) * nx) xb_add(&bar[XB_TOPGEN], 1u);
            else XB_SPIN(xb_ld(&bar[XB_TOPGEN]) == tg, bar);
            __builtin_amdgcn_fence(__ATOMIC_ACQUIRE, "agent");
            xb_add(&bar[XB_XGEN(b.x)], 1u);
            asm volatile("s_waitcnt vmcnt(0)" ::: "memory");
        } else {
            XB_SPIN(xb_ld(&bar[XB_XGEN(b.x)]) == gen, bar);
            __builtin_amdgcn_fence(__ATOMIC_ACQUIRE, "agent");
            asm volatile("s_waitcnt vmcnt(0)" ::: "memory");
        }
    }
    __syncthreads();
}

__device__ __forceinline__ const float* inptr(int k) {
    asm volatile("" : "+s"(k));
    return ((const float* const __attribute__((address_space(4)))*)__builtin_amdgcn_kernarg_segment_ptr())[k];
}
#define INP(k) inptr(k)
__device__ __forceinline__ int otid(int wave) { int t = wave * 64 + lane_id(); asm volatile("" : "+v"(t)); return t; }
__device__ __forceinline__ unsigned char* opq_ptr(unsigned char* p) { asm volatile("" : "+s"(p)); return p; }
struct Frame {
    LAS unsigned char* lds;
    volatile LAS unsigned* MISC;
    gu32* ctl;
    int wave;
    int vcu, G;
    float* out;
    unsigned char* ws;
};
__device__ __forceinline__ float wave_sum(float v, int lane) {
#pragma unroll
    for (int o = 1; o < 64; o <<= 1) v += shfl_x(v, lane, o);
    return v;
}

struct P0D { const float* W; int ldw; int K; bf16_t* WT; const float* gain; int kb, nb; int f8; };
__device__ __forceinline__ P0D p0_decode(int it, unsigned char* ws) {
    constexpr int I0 = 16 * 96, I1 = 16 * 32, I2 = 16 * 96, I3 = 16 * 48, I4 = 8 * 32, I5 = 32 * 256, I6 = 32 * 256;
    P0D d; int r = it;
    if (r < I0) { d.f8 = 1; d.W = INP(2); d.ldw = 3088; d.K = 1024; d.WT = (bf16_t*)(ws + WS_WQKVA); d.gain = INP(1); d.kb = r / 96; d.nb = r % 96; return d; } r -= I0;
    if (r < I1) { d.f8 = 0; d.W = INP(6); d.ldw = 1024; d.K = 1024; d.WT = (bf16_t*)(ws + WS_WOA); d.gain = nullptr; d.kb = r / 32; d.nb = r % 32; return d; } r -= I1;
    if (r < I2) { d.f8 = 1; d.W = INP(8); d.ldw = 3072; d.K = 1024; d.WT = (bf16_t*)(ws + WS_WKVQ); d.gain = INP(7); d.kb = r / 96; d.nb = r % 96; return d; } r -= I2;
    if (r < I3) { d.f8 = 1; d.W = INP(12); d.ldw = 1536; d.K = 1024; d.WT = (bf16_t*)(ws + WS_WKVQ + (size_t)3072 * 1024); d.gain = INP(11); d.kb = r / 48; d.nb = r % 48; return d; } r -= I3;
    if (r < I4) { d.f8 = 1; d.W = INP(14); d.ldw = 1024; d.K = 512; d.WT = (bf16_t*)(ws + WS_WOB); d.gain = nullptr; d.kb = r / 32; d.nb = r % 32; return d; } r -= I4;
    if (r < I5) { const int le = r / 256, q = r % 256;
        d.f8 = 1; d.W = INP(20) + (size_t)le * 1024 * 512; d.ldw = 512; d.K = 1024; d.WT = (bf16_t*)(ws + WS_WGU + (size_t)le * 1024 * 1024); d.gain = INP(15) + (le >> 4) * 1024; d.kb = q / 16; d.nb = q % 16; return d; } r -= I5;
    if (r < I6) { const int le = r / 256, q = r % 256;
        d.f8 = 1; d.W = INP(21) + (size_t)le * 1024 * 512; d.ldw = 512; d.K = 1024; d.WT = (bf16_t*)(ws + WS_WGU + (size_t)le * 1024 * 1024 + (size_t)512 * 1024); d.gain = INP(15) + (le >> 4) * 1024; d.kb = q / 16; d.nb = q % 16; return d; } r -= I6;
    { const int le = r / 256, q = r % 256;
        d.f8 = 1; d.W = INP(22) + (size_t)le * 512 * 1024; d.ldw = 1024; d.K = 512; d.WT = (bf16_t*)(ws + WS_WD + (size_t)le * 1024 * 512); d.gain = nullptr; d.kb = q / 32; d.nb = q % 32; return d; }
}
__device__ __forceinline__ void p0_load(const P0D& d, int lane, f32x4 (&v)[8], float (&gv)[8]) {
    const float* src = d.W + (size_t)(64 * d.kb + (lane >> 3)) * d.ldw + 32 * d.nb + 4 * (lane & 7);
#pragma unroll
    for (int i = 0; i < 8; ++i) { v[i] = *(const GAS f32x4*)(src + (size_t)(8 * i) * d.ldw); gv[i] = d.gain ? d.gain[64 * d.kb + (lane >> 3) + 8 * i] : 1.0f; }
}
__device__ __forceinline__ void p0_store(const P0D& d, int lane, const f32x4 (&v)[8], const float (&gv)[8], LAS float* scr) {
#pragma unroll
    for (int i = 0; i < 8; ++i) { LAS float* p = scr + ((lane >> 3) + 8 * i) * 33 + 4 * (lane & 7); const f32x4 x = v[i] * gv[i]; p[0] = x[0]; p[1] = x[1]; p[2] = x[2]; p[3] = x[3]; }
    LDS_WAIT(); asm volatile("" ::: "memory");
    const int c = lane & 7, k0 = 64 * d.kb, n0 = 32 * d.nb;
#pragma unroll
    for (int j = 0; j < 4; ++j) { const int n = (lane >> 3) + 8 * j; const LAS float* s = scr + (8 * c) * 33 + n;
        if (d.f8) { u32x2 o; o.x = pk4_fp8(s[0 * 33] * W8SCALE, s[1 * 33] * W8SCALE, s[2 * 33] * W8SCALE, s[3 * 33] * W8SCALE); o.y = pk4_fp8(s[4 * 33] * W8SCALE, s[5 * 33] * W8SCALE, s[6 * 33] * W8SCALE, s[7 * 33] * W8SCALE);
            *(GAS u32x2*)((unsigned char*)d.WT + (size_t)(n0 + n) * d.K + k0 + 8 * c) = o; }
        else { u32x4 o; o.x = pk2(s[0 * 33], s[1 * 33]); o.y = pk2(s[2 * 33], s[3 * 33]); o.z = pk2(s[4 * 33], s[5 * 33]); o.w = pk2(s[6 * 33], s[7 * 33]);
            *(GAS u32x4*)(d.WT + (size_t)(n0 + n) * d.K + k0 + 8 * c) = o; } }
    LDS_WAIT(); asm volatile("" ::: "memory");
}
struct P0H { const float* W; unsigned char* WT; int kb, nb; };
__device__ __forceinline__ P0H p0h_decode(int idx, unsigned char* ws) { const int le = idx >> 9, hq = idx & 511; P0H d; d.W = INP(22) + (size_t)le * 512 * 1024; d.WT = ws + WS_WD + (size_t)le * 1024 * 512; d.kb = hq >> 6; d.nb = hq & 63; return d; }
__device__ __forceinline__ void p0h_load(const P0H& d, int lane, f32x4 (&v)[4]) {
    const float* src = d.W + (size_t)(64 * d.kb + (lane >> 2)) * 1024 + 16 * d.nb + 4 * (lane & 3);
#pragma unroll
    for (int i = 0; i < 4; ++i) v[i] = *(const GAS f32x4*)(src + (size_t)(16 * i) * 1024);
}
__device__ __forceinline__ void p0h_store(const P0H& d, int lane, const f32x4 (&v)[4], LAS float* scr) {
#pragma unroll
    for (int i = 0; i < 4; ++i) { LAS float* p = scr + ((lane >> 2) + 16 * i) * 17 + 4 * (lane & 3); p[0] = v[i][0]; p[1] = v[i][1]; p[2] = v[i][2]; p[3] = v[i][3]; }
    LDS_WAIT(); asm volatile("" ::: "memory");
    const int n = lane >> 2, c = lane & 3; const LAS float* s = scr + (16 * c) * 17 + n;
    u32x4 o;
    o.x = pk4_fp8(s[0 * 17] * W8SCALE, s[1 * 17] * W8SCALE, s[2 * 17] * W8SCALE, s[3 * 17] * W8SCALE);     o.y = pk4_fp8(s[4 * 17] * W8SCALE, s[5 * 17] * W8SCALE, s[6 * 17] * W8SCALE, s[7 * 17] * W8SCALE);
    o.z = pk4_fp8(s[8 * 17] * W8SCALE, s[9 * 17] * W8SCALE, s[10 * 17] * W8SCALE, s[11 * 17] * W8SCALE); o.w = pk4_fp8(s[12 * 17] * W8SCALE, s[13 * 17] * W8SCALE, s[14 * 17] * W8SCALE, s[15 * 17] * W8SCALE);
    *(GAS u32x4*)(d.WT + (size_t)(16 * d.nb + n) * 512 + 64 * d.kb + 16 * c) = o;
    LDS_WAIT(); asm volatile("" ::: "memory");
}
__device__ __forceinline__ void p0_prologue(Frame& F) {
    const int tid_ = otid(F.wave), lane_ = tid_ & 63;
    LAS float* scr = (LAS float*)(F.lds + F.wave * 16384);
    const int gw = F.vcu * 8 + F.wave, NGW = F.G * 8;
    unsigned char* ws = F.ws;
    constexpr int NITEMS = 16 * 96 + 16 * 32 + 16 * 96 + 16 * 48 + 8 * 32 + 2 * 32 * 256;
    {
        f32x4 va[8], vb[8], vc_[8]; float ga[8], gb[8], gc[8]; P0D da, db, dc;
        int it = gw;
        if (it < NITEMS) { da = p0_decode(it, ws); p0_load(da, lane_, va, ga); }
        if (it + NGW < NITEMS) { db = p0_decode(it + NGW, ws); p0_load(db, lane_, vb, gb); }
        while (it < NITEMS) {
            if (it + 2 * NGW < NITEMS) { dc = p0_decode(it + 2 * NGW, ws); p0_load(dc, lane_, vc_, gc); }
            p0_store(da, lane_, va, ga, scr);
            if (it + NGW >= NITEMS) break;
            if (it + 3 * NGW < NITEMS) { da = p0_decode(it + 3 * NGW, ws); p0_load(da, lane_, va, ga); }
            p0_store(db, lane_, vb, gb, scr);
            if (it + 2 * NGW >= NITEMS) break;
            if (it + 4 * NGW < NITEMS) { db = p0_decode(it + 4 * NGW, ws); p0_load(db, lane_, vb, gb); }
            p0_store(dc, lane_, vc_, gc, scr);
            it += 3 * NGW;
        }
    }
    const int gt = gw * 64 + lane_, NGT = NGW * 64;
    { const float* an = INP(1); const float* awin = INP(2);
    for (int e = gt; e < 16 * 1024; e += NGT) { const int n = e >> 10, k = e & 1023; ((bf16_t*)(ws + WS_WF))[e] = (bf16_t)f2bf(an[k] * awin[(size_t)k * 3088 + 3072 + n]); } }
    const float* fn_ = INP(15); const float* wexp_ = INP(18); const float* wgrp_ = INP(16);
    for (int e = gt; e < 2 * 32 * 1024; e += NGT) { const int l = e >> 15, n = (e >> 10) & 31, k = e & 1023;
        float v = 0.f;
        if (n < 16) v = fn_[l * 1024 + k] * wexp_[((size_t)l * 1024 + k) * 16 + n];
        else if (n < 20) v = fn_[l * 1024 + k] * wgrp_[((size_t)l * 1024 + k) * 4 + (n - 16)];
        const unsigned hb = f2bf(v); const float lo = v - bf2f(hb);
        bf16_t* wr = (bf16_t*)(ws + WS_WR) + (size_t)l * 2 * 32 * 1024;
        wr[n * 1024 + k] = (bf16_t)hb; wr[32 * 1024 + n * 1024 + k] = (bf16_t)f2bf(lo); }
    if (gt < 6 * 64) { const int sgi = gt >> 6, d = gt & 63; float v = 1.0f;
        if (sgi == 0) v = INP(4)[d] * C2; else if (sgi == 1) v = INP(5)[d]; else if (sgi == 3) v = INP(9)[d]; else if (sgi == 5) v = INP(13)[d] * C2;
        ((float*)(ws + WS_GTAB))[gt] = v; }
    const float* x_ = INP(0);
    {
        f32x4 v[4], vn[4], vm[4];
        int m = gw;
        if (m < NTOK) { const GAS f32x4* xr = (const GAS f32x4*)(x_ + (size_t)m * DM) + lane_;
#pragma unroll
            for (int jj = 0; jj < 4; ++jj) v[jj] = xr[64 * jj]; }
        if (m + NGW < NTOK) { const GAS f32x4* xr = (const GAS f32x4*)(x_ + (size_t)(m + NGW) * DM) + lane_;
#pragma unroll
            for (int jj = 0; jj < 4; ++jj) vn[jj] = xr[64 * jj]; }
        while (m < NTOK) {
            if (m + 2 * NGW < NTOK) { const GAS f32x4* xr = (const GAS f32x4*)(x_ + (size_t)(m + 2 * NGW) * DM) + lane_;
#pragma unroll
                for (int jj = 0; jj < 4; ++jj) vm[jj] = xr[64 * jj]; }
            float sq = 0.f;
#pragma unroll
            for (int jj = 0; jj < 4; ++jj) sq += (v[jj].x * v[jj].x + v[jj].y * v[jj].y) + (v[jj].z * v[jj].z + v[jj].w * v[jj].w);
            const float rstd = 1.f / sqrtf(wave_sum(sq, lane_) * (1.f / DM) + EPS);
            GAS unsigned long long* o8 = (GAS unsigned long long*)((bf16_t*)(ws + WS_XB) + (size_t)m * DM) + lane_;
#pragma unroll
            for (int jj = 0; jj < 4; ++jj) o8[64 * jj] = (unsigned long long)pk2(v[jj].x, v[jj].y) | ((unsigned long long)pk2(v[jj].z, v[jj].w) << 32);
            GAS unsigned* q8 = (GAS unsigned*)(ws + WS_XB8 + (size_t)m * DM) + lane_;
#pragma unroll
            for (int jj = 0; jj < 4; ++jj) q8[64 * jj] = pk4_fp8(v[jj].x, v[jj].y, v[jj].z, v[jj].w);
            if (lane_ == 0) ((float*)(ws + WS_RSTD0))[m] = rstd;
#pragma unroll
            for (int jj = 0; jj < 4; ++jj) { v[jj] = vn[jj]; vn[jj] = vm[jj]; }
            m += NGW;
        }
    }
}

__device__ __forceinline__ void forget_phase(Frame& F) {
    const int tid_ = otid(F.wave), lane_ = tid_ & 63;
    const bf16_t* XB = (const bf16_t*)(F.ws + WS_XB); const bf16_t* WF = (const bf16_t*)(F.ws + WS_WF);
    const float* RSTD0 = (const float*)(F.ws + WS_RSTD0); const float* b_f = INP(3);
    float* LC = (float*)(F.ws + WS_LC); float* CT = (float*)(F.ws + WS_CT);
    LAS float* wt = (LAS float*)(F.lds + AUX_OFF);
    const int fr = lane_ & 15, fq = lane_ >> 4;
    for (int chunk = blockIdx.x; chunk < NTOK / 128; chunk += F.G) {
        const int row = chunk * 128 + F.wave * 16 + fr;
        const bf16_t* xa = XB + (size_t)row * DM + 8 * fq; const bf16_t* wb = WF + (size_t)fr * DM + 8 * fq;
        f32x4 acc = {0.f, 0.f, 0.f, 0.f};
#pragma unroll 8
        for (int kb = 0; kb < 32; ++kb) { const bf16x8 a = *(const bf16x8*)(xa + 32 * kb), w = *(const bf16x8*)(wb + 32 * kb); acc = __builtin_amdgcn_mfma_f32_16x16x32_bf16(w, a, acc, 0, 0, 0); }
        const float rs = RSTD0[row];
        float lf[4];
#pragma unroll
        for (int i = 0; i < 4; ++i) { const float z = acc[i] * rs + b_f[4 * fq + i]; lf[i] = fminf(z, 0.f) - log1pf(expf(-fabsf(z))); }
#pragma unroll
        for (int off = 1; off < 16; off <<= 1)
#pragma unroll
            for (int i = 0; i < 4; ++i) { const float t = shfl_from(lf[i], lane_ - off); if (fr >= off) lf[i] += t; }
        if (fr == 15) {
#pragma unroll
            for (int i = 0; i < 4; ++i) wt[F.wave * 16 + 4 * fq + i] = lf[i]; }
        __syncthreads();
#pragma unroll
        for (int i = 0; i < 4; ++i) { float p = 0.f; for (int w = 0; w < F.wave; ++w) p += wt[w * 16 + 4 * fq + i]; lf[i] += p; }
        const int b = row >> 13, s = row & (SEQ - 1);
#pragma unroll
        for (int i = 0; i < 4; ++i) LC[(size_t)(b * 16 + 4 * fq + i) * SEQ + s] = lf[i];
        if (F.wave == 7 && fr == 15) {
#pragma unroll
            for (int i = 0; i < 4; ++i) CT[(b * 16 + 4 * fq + i) * 64 + ((chunk * 128) & (SEQ - 1)) / 128] = lf[i]; }
        __syncthreads();
    }
}

__device__ __forceinline__ void attnA_phase(Frame& F, unsigned char* ldsg) {
    const int tid_ = otid(F.wave), lane_ = tid_ & 63;
    LAS float* NCK = (LAS float*)(F.lds + attn_body::LDS_NCK);
    LAS float* CPs = (LAS float*)(F.lds + AUX_OFF);
    volatile LAS int* ctl = (volatile LAS int*)(F.lds + AUX_OFF + 256);
    const float* LC = (const float*)(F.ws + WS_LC); const float* CT = (const float*)(F.ws + WS_CT);
    float mqk = 0.f;
    { const float* gq_ = INP(4); const float* gk_ = INP(5);
      for (int d = 0; d < 64; ++d) mqk = fmaxf(mqk, fabsf(gq_[d] * gk_[d])); }
    const float thr2 = (40.f + 2.f * 8.f * mqk * 1.03f) * LOG2E;
    unsigned* queue = (unsigned*)(F.ctl + CW_QUEUE);
    for (;;) {
        if (tid_ == 0) ctl[0] = (int)__hip_atomic_fetch_add(queue, 1u, RLX_AGENT);
        __syncthreads();
        const int u = ctl[0];
        if (u >= NBATCH * 16 * 32) break;
        const int qb = 31 - (u >> 6), bh = u & 63, b = bh >> 4, h = bh & 15, q0 = qb * 256, NTf = 4 * qb + 4, nkeys = q0 + 256;
        const float* lcp = LC + (size_t)bh * SEQ;
        f32x4 dva[4]; const P0H ddi = p0h_decode(8 * u + F.wave, F.ws); p0h_load(ddi, lane_, dva);
        if (F.wave == 0) { const float c = CT[bh * 64 + lane_]; float v = c;
#pragma unroll
            for (int off = 1; off < 64; off <<= 1) { const float t = shfl_from(v, lane_ - off); if (lane_ >= off) v += t; }
            const float excl = v - c; CPs[lane_] = excl;
            const float cumq = shfl_from(excl, q0 >> 7) + lcp[q0];
            const bool need = (lane_ <= (q0 >> 7)) && ((cumq - v) * LOG2E >= -thr2);
            const unsigned long long bm = __builtin_amdgcn_ballot_w64(need);
            int t0 = 2 * (int)__builtin_ctzll(bm | (1ull << 63)); t0 = t0 < NTf - 4 ? t0 : NTf - 4;
            if (lane_ == 0) ctl[1] = t0; }
        __syncthreads();
        const int T0 = ctl[1];
        const float cpq = CPs[q0 >> 7], lcq = lcp[q0];
        for (int s = 64 * T0 + tid_; s < nkeys; s += 512) NCK[s] = ((cpq - CPs[s >> 7]) + (lcq - lcp[s])) * LOG2E;
        __syncthreads();
        { const size_t ho = ((size_t)b * SEQ * 1024 + h * 64) * 2;
          attn_body::attn_unit<8, false>(qb, T0, 1024, (const attn_body::bf16*)(F.ws + WS_QA + ho), (const attn_body::bf16*)(F.ws + WS_KA + ho), (const attn_body::bf16*)(F.ws + WS_VA + ho), (attn_body::bf16*)(F.ws + WS_QA + ho), (char*)ldsg, F.wave); }
        p0h_store(ddi, lane_, dva, (LAS float*)(F.lds + F.wave * 8192));
    }
}

__device__ __forceinline__ void router_phase(Frame& F, int layer, const float* stats, float* rstd_out) {
    const int tid_ = otid(F.wave), lane_ = tid_ & 63;
    const bf16_t* XBr = (const bf16_t*)(F.ws + WS_XB); unsigned char* XN8 = (unsigned char*)(F.ws + WS_XN8); const bf16_t* WR = (const bf16_t*)(F.ws + WS_WR) + (size_t)layer * 2 * 32 * 1024;
    const float* b_group = INP(17) + layer * 4; const float* b_expert = INP(19) + layer * 16;
    float* GSORT = (float*)(F.ws + WS_GSORT); int* PERM = (int*)(F.ws + WS_PERM);
    unsigned* CNT = (unsigned*)(F.ctl + (layer == 0 ? CW_CNT0 : CW_CNT1));
    volatile LAS int* lcnt = (volatile LAS int*)(F.lds + AUX_OFF);
    const int fr = lane_ & 15, fq = lane_ >> 4;
#pragma unroll
    for (int p = 0; p < 16; ++p) { const int off = p * 8192 + tid_ * 16, n = off >> 11, pc = (off >> 4) & 127;
        __builtin_amdgcn_global_load_lds((const unsigned*)((const char*)WR + n * 2048 + ((pc ^ (n & 15)) << 4)), (LAS unsigned*)(F.lds + p * 8192 + F.wave * 1024), 16, 0, 0); }
    for (int chunk = blockIdx.x; chunk < NTOK / 128; chunk += F.G) {
        if (tid_ < 64) lcnt[tid_] = 0;
        VM_WAIT();
        __syncthreads();
        const int row = chunk * 128 + F.wave * 16 + fr;
        float ss; { const f32x4 p = *(const f32x4*)(stats + (size_t)row * 16 + 4 * fq); ss = (p[0] + p[1]) + (p[2] + p[3]); ss += shfl_x(ss, 16 * fq + fr, 16); ss += shfl_x(ss, 16 * fq + fr, 32); }
        const float rs = 1.0f / sqrtf(ss * (1.0f / 1024.0f) + EPS);
        const bf16_t* hp = XBr + (size_t)row * DM + 8 * fq;
        unsigned char* x8 = XN8 + (size_t)row * DM + 8 * fq;
        const LAS unsigned char* wl = F.lds + fr * 2048;
        f32x4 a0 = {0.f, 0.f, 0.f, 0.f}, a1 = {0.f, 0.f, 0.f, 0.f};
#pragma unroll 4
        for (int kb = 0; kb < 32; ++kb) {
            const bf16x8 xh = *(const bf16x8*)(hp + 32 * kb);
            const int wc_ = ((4 * kb + fq) ^ fr) << 4;
            const bf16x8 wh0 = *(const LAS bf16x8*)(wl + wc_), wl0 = *(const LAS bf16x8*)(wl + 32 * 2048 + wc_);
            const bf16x8 wh1 = *(const LAS bf16x8*)(wl + 16 * 2048 + wc_), wl1 = *(const LAS bf16x8*)(wl + 48 * 2048 + wc_);
            a0 = __builtin_amdgcn_mfma_f32_16x16x32_bf16(wh0, xh, a0, 0, 0, 0); a0 = __builtin_amdgcn_mfma_f32_16x16x32_bf16(wl0, xh, a0, 0, 0, 0);
            a1 = __builtin_amdgcn_mfma_f32_16x16x32_bf16(wh1, xh, a1, 0, 0, 0); a1 = __builtin_amdgcn_mfma_f32_16x16x32_bf16(wl1, xh, a1, 0, 0, 0);
            u32x2 q8; q8.x = pk4_fp8(bf2f((unsigned short)xh[0]) * rs, bf2f((unsigned short)xh[1]) * rs, bf2f((unsigned short)xh[2]) * rs, bf2f((unsigned short)xh[3]) * rs);
            q8.y = pk4_fp8(bf2f((unsigned short)xh[4]) * rs, bf2f((unsigned short)xh[5]) * rs, bf2f((unsigned short)xh[6]) * rs, bf2f((unsigned short)xh[7]) * rs);
            *(u32x2*)(x8 + 32 * kb) = q8;
        }
        if (fq == 0) rstd_out[row] = rs;
        float gl[4]; int gidx = 0; float gval = 0.f;
        {
#pragma unroll
            for (int i = 0; i < 4; ++i) gl[i] = a1[i] * rs + b_group[i];
            const float mx = fmaxf(fmaxf(gl[0], gl[1]), fmaxf(gl[2], gl[3]));
            float ex[4], sum = 0.f;
#pragma unroll
            for (int i = 0; i < 4; ++i) { ex[i] = expf(gl[i] - mx); sum += ex[i]; }
            float best = -1.f;
#pragma unroll
            for (int i = 0; i < 4; ++i) { const float p = ex[i] / sum; if (p > best) { best = p; gidx = i; } }
            gval = best;
        }
        gidx = shfl_from(gidx, fr); gval = shfl_from(gval, fr);
        int cls = -1, rank = 0; float gwlo = 0.f, gwhi = 0.f;
        if (fq == gidx) {
            float el[4];
#pragma unroll
            for (int i = 0; i < 4; ++i) el[i] = a0[i] * rs + b_expert[4 * fq + i];
            const float mx = fmaxf(fmaxf(el[0], el[1]), fmaxf(el[2], el[3]));
            float pr[4], sum = 0.f;
#pragma unroll
            for (int i = 0; i < 4; ++i) { pr[i] = expf(el[i] - mx); sum += pr[i]; }
#pragma unroll
            for (int i = 0; i < 4; ++i) pr[i] = pr[i] / sum;
            int i1 = 0; float p1 = -1.f;
#pragma unroll
            for (int i = 0; i < 4; ++i) if (pr[i] > p1) { p1 = pr[i]; i1 = i; }
            int i2 = 0; float p2 = -1.f;
#pragma unroll
            for (int i = 0; i < 4; ++i) if (i != i1 && pr[i] > p2) { p2 = pr[i]; i2 = i; }
            const float den = p1 + p2; const float w1g = gval * (p1 / den), w2g = gval * (p2 / den);
            const int lo = i1 < i2 ? i1 : i2, hi = i1 < i2 ? i2 : i1;
            const float wlo = i1 < i2 ? w1g : w2g, whi = i1 < i2 ? w2g : w1g;
            const int pidx = (lo == 0) ? hi - 1 : (lo == 1) ? hi + 1 : 5;
            cls = 6 * gidx + pidx;
            gwlo = wlo; gwhi = whi;
            rank = __hip_atomic_fetch_add((LAS int*)&lcnt[cls], 1, __ATOMIC_RELAXED, __HIP_MEMORY_SCOPE_WORKGROUP);
        }
        __syncthreads();
        if (tid_ < NCLASS) lcnt[32 + tid_] = (int)__hip_atomic_fetch_add(CNT + tid_, (unsigned)lcnt[tid_], RLX_AGENT);
        __syncthreads();
        if (cls >= 0) { const size_t p_ = (size_t)cls * CAP + lcnt[32 + cls] + rank; PERM[p_] = row; *(f32x2*)(GSORT + 2 * p_) = (f32x2){gwlo, gwhi}; }
        __syncthreads();
    }
}
__device__ __forceinline__ void moe_tile_prefix(Frame& F, const int* cnt, volatile LAS int* TP) {
    const int tid_ = otid(F.wave), lane_ = tid_ & 63;
    __syncthreads();
    if (tid_ == 0) { int acc = 0; for (int c = 0; c < NCLASS; ++c) { TP[c] = acc; acc += (cnt[c] + 255) >> 8; } TP[NCLASS] = acc; }
    __syncthreads();
}

__device__ __forceinline__ void dilated_phase(Frame& F, unsigned char* ldsg) {
    const int tid_ = otid(F.wave);
    LAS float* tb = (LAS float*)(F.lds + attn_body::LDS_NCK);
    const int per = (3072 + F.G - 1) / F.G;
    int gjprev = -1, rho = 0; bool primed = false; bf16x8 qn[4];
    for (int i = 0; i < per; ++i) {
        const int u = blockIdx.x * per + i; if (u >= 3072) break;
        const int g = u >> 10, v = u & 1023, j = v >> 7, b = (v >> 5) & 3, x = v & 31;
        const int D4 = 2 * g, d = 1 << D4, r = x & (d - 1), qb = x >> D4;
        unsigned long long pl_t = 0ull; if (PROBE_A == 5) pl_t = __builtin_amdgcn_s_memrealtime();
        if (g * 8 + j != gjprev) { __syncthreads(); dil::build_table(tb, INP(10), g, d, j, tid_); __syncthreads(); gjprev = g * 8 + j; }
        if (!primed) VM_WAIT();
        __syncthreads();
        if (PROBE_A == 5) { const unsigned d_ = (unsigned)(__builtin_amdgcn_s_memrealtime() - pl_t); if (tid_ == 0) ((LAS unsigned*)(F.lds + MISC_OFF))[121] += d_; }
        const size_t ho = (((size_t)(8 * g + j) * NTOK + (size_t)b * SEQ + (size_t)r * (SEQ >> D4)) * 64) * 2;
        const int T0 = qb == 0 ? 0 : 4 * qb - 2;
        attn_body::Xpf xp{}; xp.primed = primed; xp.has_next = (i + 1 < per) && (u + 1 < 3072);
        if (xp.has_next) { const int u2 = u + 1, g2 = u2 >> 10, v2 = u2 & 1023, j2 = v2 >> 7, b2 = (v2 >> 5) & 3, x2 = v2 & 31;
            const int D42 = 2 * g2, d2 = 1 << D42, r2 = x2 & (d2 - 1), qb2 = x2 >> D42, T02 = qb2 == 0 ? 0 : 4 * qb2 - 2;
            const size_t ho2 = (((size_t)(8 * g2 + j2) * NTOK + (size_t)b2 * SEQ + (size_t)r2 * (SEQ >> D42)) * 64) * 2; xp.Pn = 64;
            xp.Qn = (const attn_body::bf16*)(F.ws + WS_QB + ho2) + (long)qb2 * 256 * xp.Pn;
            xp.Kn = (const attn_body::bf16*)(F.ws + WS_KB + ho2) + (long)T02 * 64 * xp.Pn; xp.Vn = (const attn_body::bf16*)(F.ws + WS_VB + ho2) + (long)T02 * 64 * xp.Pn; }
        attn_body::attn_unit_x<8, true, true>(qb, T0, 64, (const attn_body::bf16*)(F.ws + WS_QB + ho), (const attn_body::bf16*)(F.ws + WS_KB + ho), (const attn_body::bf16*)(F.ws + WS_VB + ho),
                                      (attn_body::bf16*)(F.ws + WS_QB + ho), (char*)ldsg, F.wave, (float*)(F.ws + WS_DPML) + (size_t)(g * 8 + j) * NTOK * 2, (long)b * SEQ + r, d, xp, qn, rho);
        primed = xp.has_next;
    }
}
__device__ __forceinline__ void dilated_merge(Frame& F) {
    const int tid_ = otid(F.wave);
    bf16_t* QB = (bf16_t*)(F.ws + WS_QB); const float* PML = (const float*)(F.ws + WS_DPML);
    for (size_t it = (size_t)blockIdx.x * 512 + tid_; it < (size_t)NTOK * 64; it += (size_t)F.G * 512) {
        const int ch = (int)(it & 7), j = (int)((it >> 3) & 7); const size_t tok = it >> 6;
        f32x2 ml[3]; u32x4 o[3];
#pragma unroll
        for (int g = 0; g < 3; ++g) { ml[g] = *(const f32x2*)(PML + ((size_t)(g * 8 + j) * NTOK + tok) * 2); o[g] = *(const u32x4*)(QB + ((size_t)(8 * g + j) * NTOK + pg8::dil_row((int)tok, 2 * g)) * 64 + 8 * ch); }
        const float M = fmaxf(fmaxf(ml[0][0], ml[1][0]), ml[2][0]);
        float f[3], L = 0.f;
#pragma unroll
        for (int g = 0; g < 3; ++g) { f[g] = __builtin_amdgcn_exp2f(ml[g][0] - M); L += f[g] * ml[g][1]; }
        const float rl = 1.0f / L;
        float r8[8];
#pragma unroll
        for (int e = 0; e < 4; ++e) { float lo = 0.f, hh = 0.f;
#pragma unroll
            for (int g = 0; g < 3; ++g) { lo += bf2f(o[g][e] & 0xffffu) * f[g]; hh += bf2f(o[g][e] >> 16) * f[g]; }
            r8[2 * e] = lo * rl; r8[2 * e + 1] = hh * rl; }
        u32x2 q8; q8.x = pk4_fp8(r8[0], r8[1], r8[2], r8[3]); q8.y = pk4_fp8(r8[4], r8[5], r8[6], r8[7]);
        *(GAS u32x2*)(F.ws + WS_XB8 + tok * 512 + 64 * j + 8 * ch) = q8;
    }
}

struct Args { const float* in[23]; float* out; unsigned char* ws; };
__global__ void __launch_bounds__(512, 2) fwd_kernel(Args args) {
    extern __shared__ __attribute__((aligned(16))) unsigned char lds[];
    Frame F;
    F.lds = (LAS unsigned char*)lds;
    F.MISC = (volatile LAS unsigned*)(F.lds + MISC_OFF);
    F.wave = __builtin_amdgcn_readfirstlane((int)threadIdx.x >> 6);
    F.G = gridDim.x; { const int bx = blockIdx.x; F.vcu = (F.G % 8 == 0) ? (bx % 8) * (F.G / 8) + bx / 8 : bx; }
    F.out = args.out; F.ws = args.ws;
    F.ctl = (gu32*)(args.ws + WS_CTL);
    for (int u = otid(F.wave); u < 128; u += 512) ((LAS unsigned*)(F.lds + MISC_OFF))[u] = 0u;
    __syncthreads();
    XcdBarrier bar = xcd_barrier_post((unsigned*)(F.ctl + CW_BAR), F.MISC + 8, F.wave == 0 && lane_id() == 0);
#define GRID_BAR() xcd_barrier(bar, F.wave == 0 && lane_id() == 0)
#ifndef RUN_FROM
#define RUN_FROM 0
#endif
#define RUN(k) ((k) <= RUN_UPTO && (k) >= RUN_FROM)
#ifndef PROBE_MASK
#define PROBE_MASK 0
#endif
    unsigned long long pr_acc = 0ull, pr_t0 = 0ull;
#define PR_BEGIN(k) do { if ((PROBE_MASK >> (k)) & 1) pr_t0 = __builtin_amdgcn_s_memrealtime(); } while (0)
#define PR_END(k) do { if ((PROBE_MASK >> (k)) & 1) pr_acc += __builtin_amdgcn_s_memrealtime() - pr_t0; } while (0)

#define ws opq_ptr(F.ws)
#define XB ((bf16_t*)(ws + WS_XB))
#define H (F.out)
#define TP ((volatile LAS int*)(F.lds + AUX_OFF + 1024))

    PR_BEGIN(0); if (RUN(0)) { p0_prologue(F); GRID_BAR(); } PR_END(0);

    PR_BEGIN(1);
    if (RUN(1)) {
        pg8::GemmP g{(const void*)(ws + WS_XB8), 1024, 1024, 1 << 20, 32, (PROBE_KSEL >> 1) & 1};
        pg8::DenseSched S; S.so.init(NTOK, 3072, F.G, (int)blockIdx.x); S.Bt = (const bf16_t*)(ws + WS_WQKVA); S.lda = 512; S.ldb = 512;
        pg8::EpiHead E{(bf16_t*)(ws + WS_QA), (size_t)(WS_KA - WS_QA) / 2, (const float*)(ws + WS_GTAB), 2, 4, 8, 1024, (const float*)(ws + WS_RSTD0), nullptr, 1.0f / W8SCALE};
        pg8::gemm_phase<pg8::EpiHead, pg8::DenseSched, true>(F.lds, g, S, E, F.wave);
        forget_phase(F);
        GRID_BAR();
    }
    PR_END(1); PR_BEGIN(2);
    if (RUN(2)) { attnA_phase(F, lds); GRID_BAR(); }
    PR_END(2); PR_BEGIN(3);
    if (RUN(3)) {
        pg8::GemmP g{(const bf16_t*)(ws + WS_QA), 2048, 2048, 1 << 20, 128, (PROBE_KSEL >> 3) & 1};
        pg8::DenseSched S; S.so.init(NTOK, 1024, F.G, (int)blockIdx.x); S.Bt = (const bf16_t*)(ws + WS_WOA); S.lda = 1024; S.ldb = 1024;
        pg8::EpiResid E{XB, (float*)(ws + WS_STATS1), 1.0f};
        pg8::gemm_phase<pg8::EpiResid, pg8::DenseSched>(F.lds, g, S, E, F.wave);
        GRID_BAR();
    }
    PR_END(3);
#define MOE_LAYER(PH, layer, STATS_IN, RSTD_BUF, CW_CNT, LASTL, STATS_OUT) \
    PR_BEGIN(PH); if (RUN(PH)) { router_phase(F, layer, (const float*)(ws + STATS_IN), (float*)(ws + RSTD_BUF)); GRID_BAR(); } PR_END(PH); PR_BEGIN(PH + 1); \
    if (RUN(PH + 1)) { \
        const int* cnt = (const int*)(F.ctl + CW_CNT); moe_tile_prefix(F, cnt, TP); \
        pg8::GemmP g{(const void*)ws, 1024, 1024, 1 << 20, 512, (PROBE_KSEL >> (PH + 1)) & 1}; \
        pg8::MoeMixSched S{TP, cnt, (const int*)(ws + WS_PERM), (const unsigned char*)(ws + WS_WGU) + (size_t)layer * 16 * 1024 * 1024, (const unsigned char*)(ws + WS_WD) + (size_t)layer * 16 * 1024 * 512, \
                           F.G, (int)blockIdx.x, __builtin_amdgcn_readfirstlane(TP[NCLASS]), (unsigned*)(F.ctl + CW_DONE + layer * 16384), (unsigned*)(F.ctl + CW_BAR) + XB_TMO}; \
        pg8::EpiMoe<LASTL> E{pg8::EpiSwiglu{(unsigned char*)(ws + WS_HID), (const float*)(ws + WS_GSORT)}, \
                             pg8::EpiScatter<LASTL>{XB, H, STATS_OUT, (const int*)(ws + WS_PERM), 1.0f / (W8SCALE * H8SCALE)}}; \
        pg8::gemm_phase<pg8::EpiMoe<LASTL>, pg8::MoeMixSched, true>(F.lds, g, S, E, F.wave); \
        if (!(LASTL)) GRID_BAR(); } PR_END(PH + 1);
    MOE_LAYER(4, 0, WS_STATS1, WS_RSTD1, CW_CNT0, false, (float*)(ws + WS_STATS2))
    PR_BEGIN(7);
    if (RUN(7)) {
        pg8::GemmP g{(const void*)(ws + WS_XB8), 1024, 1024, 1 << 20, 32, (PROBE_KSEL >> 7) & 1};
        pg8::DenseSched S; S.so.init(NTOK, 4608, F.G, (int)blockIdx.x); S.Bt = (const bf16_t*)(ws + WS_WKVQ); S.lda = 512; S.ldb = 512;
        pg8::EpiHead E{(bf16_t*)(ws + WS_KB), (size_t)(WS_VB - WS_KB) / 2, (const float*)(ws + WS_GTAB) + 3 * 64, 1, 6, 12, KVW, nullptr, (const float*)(ws + WS_STATS2), 1.0f / W8SCALE, 1};
        pg8::gemm_phase<pg8::EpiHead, pg8::DenseSched, true>(F.lds, g, S, E, F.wave);
        GRID_BAR();
    }
    PR_END(7); PR_BEGIN(8);
    if (RUN(8)) { dilated_phase(F, lds); GRID_BAR(); dilated_merge(F); GRID_BAR(); }
    PR_END(8); PR_BEGIN(9);
    if (RUN(9)) {
        pg8::GemmP g{(const void*)(ws + WS_XB8), 512, 512, 1 << 20, 128, (PROBE_KSEL >> 9) & 1};
        pg8::DenseSched S; S.so.init(NTOK, 1024, F.G, (int)blockIdx.x); S.Bt = (const bf16_t*)(ws + WS_WOB); S.lda = 256; S.ldb = 256;
        pg8::EpiResid E{XB, (float*)(ws + WS_STATS3), 1.0f / W8SCALE};
        pg8::gemm_phase<pg8::EpiResid, pg8::DenseSched, true>(F.lds, g, S, E, F.wave);
        GRID_BAR();
    }
    PR_END(9);
    MOE_LAYER(10, 1, WS_STATS3, WS_RSTD3, CW_CNT1, true, (float*)nullptr)

#if RUN_UPTO < 12
    { const int gt = (blockIdx.x * 512 + otid(F.wave)); const f32x4* xs = (const f32x4*)INP(0); f32x4* od = (f32x4*)F.out;
      for (size_t e = gt; e < (size_t)NTOK * DM / 4; e += (size_t)F.G * 512) od[e] = xs[e]; }
#endif
    if (PROBE_K != 0) pr_acc += ((LAS unsigned*)(F.lds + MISC_OFF))[120];
    if (PROBE_A != 0) pr_acc += ((LAS unsigned*)(F.lds + MISC_OFF))[121];
    if (PROBE_MASK != 0 && blockIdx.x == 0 && otid(F.wave) == 0) { const unsigned long long t1 = __builtin_amdgcn_s_memrealtime(); while (__builtin_amdgcn_s_memrealtime() - t1 < pr_acc) __builtin_amdgcn_s_sleep(8); }
    if (__hip_atomic_load((unsigned*)(F.ctl + CW_BAR) + XB_TMO, RLX_AGENT) != 0u) {
        const int gt = (blockIdx.x * 512 + otid(F.wave)); const float q = __builtin_nanf("");
        for (size_t e = gt; e < (size_t)NTOK * DM; e += (size_t)F.G * 512) F.out[e] = q;
    }
}

#undef ws
#undef XB
#undef H
#undef TP
extern "C" void kernel_launch(void* const* d_in, const int* in_sizes, int n_in, void* d_out, int out_size, void* d_ws, size_t ws_size, hipStream_t stream) {
    static int grid = 0;
    if (grid == 0) {
        if (n_in != 23 || in_sizes[0] != NTOK * DM || out_size != NTOK * DM || ws_size < WS_END) { fprintf(stderr, "kernel_launch: unexpected shapes (n_in %d, in0 %d, out %d, ws %zu)\n", n_in, n_in > 0 ? in_sizes[0] : -1, out_size, ws_size); grid = -1; return; }
        int dev = 0, cus = 0, per_cu = 0;
        if (hipGetDevice(&dev) != hipSuccess || hipDeviceGetAttribute(&cus, hipDeviceAttributeMultiprocessorCount, dev) != hipSuccess) { grid = -1; return; }
        if (hipFuncSetAttribute((const void*)fwd_kernel, hipFuncAttributeMaxDynamicSharedMemorySize, LDS_BYTES) != hipSuccess) { fprintf(stderr, "kernel_launch: hipFuncSetAttribute failed\n"); grid = -1; return; }
        if (hipOccupancyMaxActiveBlocksPerMultiprocessor(&per_cu, (const void*)fwd_kernel, 512, LDS_BYTES) != hipSuccess || per_cu < 1) fprintf(stderr, "kernel_launch: occupancy query reports %d\n", per_cu);
        (void)hipGetLastError();
        grid = cus;
    }
    if (grid < 0) return;
    if (hipMemsetAsync((char*)d_ws + WS_CTL, 0, CTL_ZERO_BYTES, stream) != hipSuccess) return;
    Args a{};
    for (int i = 0; i < 23; ++i) a.in[i] = (const float*)d_in[i];
    a.out = (float*)d_out; a.ws = (unsigned char*)d_ws;
    hipLaunchKernelGGL(fwd_kernel, dim3(grid), dim3(512), LDS_BYTES, stream, a);
}
```

```cpp
#include <hip/hip_runtime.h>
#include <hip/hip_bf16.h>
#include <cstdio>
#include <cstdint>
#include <cmath>

#ifndef RUN_UPTO
#define RUN_UPTO 99
#endif

#define GAS __attribute__((address_space(1)))
#define LAS __attribute__((address_space(3)))
typedef unsigned short bf16_t;
typedef short bf16x8 __attribute__((ext_vector_type(8)));
typedef float f32x2 __attribute__((ext_vector_type(2)));
typedef float f32x4 __attribute__((ext_vector_type(4)));
typedef float f32x16 __attribute__((ext_vector_type(16)));
typedef unsigned u32x2 __attribute__((ext_vector_type(2)));
typedef unsigned u32x4 __attribute__((ext_vector_type(4)));
typedef short s16x4 __attribute__((ext_vector_type(4)));
typedef int i32x4 __attribute__((ext_vector_type(4)));
typedef int i32x8 __attribute__((ext_vector_type(8)));
typedef GAS unsigned gu32;

constexpr int NTOK = 32768, DM = 1024, SEQ = 8192, NBATCH = 4;
constexpr int KVW = 1536;
constexpr float EPS = 1e-6f;
constexpr float LOG2E = 1.4426950408889634f;
constexpr float C2 = 0.125f * LOG2E;
constexpr int NCLASS = 24, CAP = 32768;

constexpr size_t MiB = 1u << 20;
constexpr size_t WS_CTL = 0, CTL_ZERO_BYTES = 256 * 1024;
constexpr size_t WS_RSTD0 = 2 * MiB, WS_RSTD1 = 2 * MiB + 128 * 1024, WS_RSTD3 = 2 * MiB + 256 * 1024;
constexpr size_t WS_STATS1 = 3 * MiB, WS_STATS2 = 5 * MiB, WS_STATS3 = 7 * MiB;
constexpr size_t WS_GATES = 9 * MiB;
constexpr size_t WS_LC = 10 * MiB;
constexpr size_t WS_CT = 12 * MiB;
constexpr size_t WS_WF = 12 * MiB + 64 * 1024;
constexpr size_t WS_WR = 12 * MiB + 128 * 1024;
constexpr size_t WS_GTAB = 12 * MiB + 32 * 1024;
constexpr size_t WS_PERM = 13 * MiB;
constexpr size_t WS_WQKVA = 16 * MiB, WS_WOA = 22 * MiB, WS_WKVQ = 24 * MiB, WS_WOB = 33 * MiB;
constexpr size_t WS_WGU = 34 * MiB;
constexpr size_t WS_XB8 = 66 * MiB;
constexpr size_t WS_DPML = 114 * MiB;
constexpr size_t WS_WD = 98 * MiB;
constexpr size_t WS_GSORT = 120 * MiB;
constexpr size_t WS_XB = 132 * MiB;
constexpr size_t WS_R = 196 * MiB;
constexpr size_t WS_QA = WS_R, WS_KA = WS_R + 64 * MiB, WS_VA = WS_R + 128 * MiB;
constexpr size_t WS_HID = WS_R;
constexpr size_t WS_XN8 = WS_R + 44 * MiB;
constexpr size_t WS_KB = WS_R, WS_VB = WS_R + 96 * MiB, WS_QB = WS_R + 192 * MiB;
constexpr size_t WS_END = WS_R + 288 * MiB;
constexpr int CW_BAR = 4096, CW_QUEUE = 8192, CW_CNT0 = 9216, CW_CNT1 = 9216 + 64, CW_DONE = 32768;

constexpr int RING_BYTES = 131072;
constexpr int MISC_OFF = RING_BYTES;
constexpr int AUX_OFF = RING_BYTES + 512;
constexpr int LDS_BYTES = 155648;
constexpr int AUX_BYTES = LDS_BYTES - AUX_OFF;

#define LDS_WAIT() asm volatile("s_waitcnt lgkmcnt(0)" ::: "memory")
#define VM_WAIT() asm volatile("s_waitcnt vmcnt(0)" ::: "memory")
#define RLX_AGENT __ATOMIC_RELAXED, __HIP_MEMORY_SCOPE_AGENT

__device__ __forceinline__ int lane_id() { int l; asm volatile("v_mbcnt_lo_u32_b32 %0, -1, 0\n\tv_mbcnt_hi_u32_b32 %0, -1, %0" : "=v"(l)); return l; }
__device__ __forceinline__ float shfl_from(float v, int srclane) { return __int_as_float(__builtin_amdgcn_ds_bpermute(srclane << 2, __float_as_int(v))); }
__device__ __forceinline__ int shfl_from(int v, int srclane) { return __builtin_amdgcn_ds_bpermute(srclane << 2, v); }
__device__ __forceinline__ float shfl_x(float v, int lane, int mask) { return shfl_from(v, lane ^ mask); }
__device__ __forceinline__ unsigned f2bf(float f) { unsigned u = __builtin_bit_cast(unsigned, f); return (u + 0x7fffu + ((u >> 16) & 1u)) >> 16; }
__device__ __forceinline__ float bf2f(unsigned b) { return __builtin_bit_cast(float, b << 16); }
__device__ __forceinline__ unsigned pk2(float lo, float hi) { return f2bf(lo) | (f2bf(hi) << 16); }
__device__ __forceinline__ unsigned pk4_fp8(float a, float b, float c, float d) { int v = 0; v = __builtin_amdgcn_cvt_pk_fp8_f32(a, b, v, false); v = __builtin_amdgcn_cvt_pk_fp8_f32(c, d, v, true); return (unsigned)v; }
constexpr float W8SCALE = 32.0f, H8SCALE = 16.0f;
__device__ __forceinline__ unsigned cvt_pk_bf16(float lo, float hi) { unsigned r; asm volatile("v_cvt_pk_bf16_f32 %0, %1, %2" : "=v"(r) : "v"(lo), "v"(hi)); return r; }

namespace pg8 {
constexpr int BM = 256, BK = 64, HALF = 128, HTB = HALF * BK * 2, STAGE_BYTES = 8 * HTB, NXCD = 8, WGM = 8;
__host__ __device__ __forceinline__ int lds_byte(int r, int c) { const int st = (r >> 4) * 2 + (c >> 5), rr = r & 15, cc = c & 31, ob = rr * 64 + cc * 2; return st * 1024 + (ob ^ (((ob >> 9) & 1) << 5)); }
__host__ __device__ __forceinline__ void stage_rc(int b, int& R, int& C) { const int st = b / 1024, sb = b % 1024, swz = sb ^ (((sb >> 9) & 1) << 5); R = (st >> 1) * 16 + swz / 64; C = (st & 1) * 32 + (swz % 64) / 2; }
__host__ __device__ __forceinline__ int perm32(int rho) { const int n = rho >> 4, i = rho & 15; return 8 * (i >> 2) + 4 * n + (i & 3); }

struct Unit { int rowbase; int pn; int permoff; int nvalid; int e1; int e2; int type; };
struct GemmP { const void* A; int ldbB; int Kbytes; int nsplit; int hstepB; int pk = 0; };

struct StaticOrder {
    int nM, nN, nwg, G, c;
    __device__ void init(int M, int N, int G_, int c_) { nM = M / BM; nN = N / BM; nwg = nM * nN; G = G_; c = c_; }
    __device__ bool next(int i, int& pm, int& pn) const {
        const long L = (long)i * G + c; if (L >= nwg) return false;
        int wgid = (int)L; { const int q = nwg / NXCD, r = nwg % NXCD, xcd = wgid % NXCD, off = wgid / NXCD; wgid = (xcd < r ? xcd * (q + 1) : r * (q + 1) + (xcd - r) * q) + off; }
        const int nig = WGM * nN, gid = wgid / nig, fm = gid * WGM, gsz = (nM - fm) < WGM ? (nM - fm) : WGM;
        pm = fm + ((wgid % nig) % gsz); pn = (wgid % nig) / gsz; return true;
    }
};
struct DenseSched {
    static constexpr bool MIX = false;
    StaticOrder so; const bf16_t* Bt; int lda, ldb;
    __device__ __forceinline__ bool next(int i, Unit& u) const { int pm, pn; if (!so.next(i, pm, pn)) return false; u.rowbase = pm * BM; u.pn = pn; u.permoff = 0; u.nvalid = 256; u.e1 = 0; u.e2 = 0; u.type = 0; return true; }
    __device__ __forceinline__ void aoff(const Unit& u, const int (&R)[2], const int (&C)[2], unsigned (&v)[2][2]) const {
#pragma unroll
        for (int h = 0; h < 2; ++h)
#pragma unroll
            for (int i = 0; i < 2; ++i) v[h][i] = (unsigned)((u.rowbase + 128 * h + R[i]) * lda + C[i]) * 2u; }
    __device__ __forceinline__ const char* blo(const Unit& u) const { return (const char*)Bt + (size_t)u.pn * 256 * ldb * 2; }
    __device__ __forceinline__ const char* bhi(const Unit& u) const { return blo(u); }
};
__device__ __forceinline__ bool moe_unit(int L, int npn, int TT, const volatile LAS int* TP, const int* cnt, Unit& u) {
    if (L >= TT * npn) return false;
    const int tau = L / npn; u.pn = L % npn;
    int c = 0;
#pragma unroll 1
    for (int k = 1; k < NCLASS; ++k) if (TP[k] <= tau) c = k;
    const int rt = tau - TP[c]; const int n = cnt[c] - 256 * rt;
    u.rowbase = tau * 256; u.permoff = c * CAP + rt * 256; u.nvalid = n < 256 ? n : 256;
    const int g = c / 6, p = c % 6; const int a = (p < 3) ? 0 : (p < 5) ? 1 : 2; const int b = (p < 3) ? p + 1 : (p < 5) ? p - 1 : 3;
    u.e1 = 4 * g + a; u.e2 = 4 * g + b;
    u.rowbase = __builtin_amdgcn_readfirstlane(u.rowbase); u.pn = __builtin_amdgcn_readfirstlane(u.pn); u.permoff = __builtin_amdgcn_readfirstlane(u.permoff);
    u.nvalid = __builtin_amdgcn_readfirstlane(u.nvalid); u.e1 = __builtin_amdgcn_readfirstlane(u.e1); u.e2 = __builtin_amdgcn_readfirstlane(u.e2);
    return true;
}
struct Moe1Sched {      static constexpr bool MIX = false;
    const volatile LAS int* TP; const int* cnt; const int* perm; const unsigned char* Wgu; int G, c, TT;
    __device__ __forceinline__ bool next(int i, Unit& u) const { return moe_unit(i * G + c, 8, TT, TP, cnt, u); }
    __device__ __forceinline__ void aoff(const Unit& u, const int (&R)[2], const int (&C)[2], unsigned (&v)[2][2]) const {
#pragma unroll
        for (int h = 0; h < 2; ++h)
#pragma unroll
            for (int i = 0; i < 2; ++i) { const int r = 128 * h + R[i]; const int tok = (r < u.nvalid) ? ((const GAS int*)perm)[u.permoff + r] : 0; v[h][i] = (unsigned)(tok * 1024 + 2 * C[i]); } }
    __device__ __forceinline__ const char* blo(const Unit& u) const { const int e = (u.pn < 4) ? u.e1 : u.e2; return (const char*)Wgu + ((size_t)e * 1024 + 128 * (u.pn & 3)) * 1024; }
    __device__ __forceinline__ const char* bhi(const Unit& u) const { return blo(u); }
};
struct Moe2Sched {      static constexpr bool MIX = false;
    const volatile LAS int* TP; const int* cnt; const unsigned char* Wd; int G, c, TT;
    __device__ __forceinline__ bool next(int i, Unit& u) const { return moe_unit(i * G + c, 4, TT, TP, cnt, u); }
    __device__ __forceinline__ void aoff(const Unit& u, const int (&R)[2], const int (&C)[2], unsigned (&v)[2][2]) const {
#pragma unroll
        for (int h = 0; h < 2; ++h)
#pragma unroll
            for (int i = 0; i < 2; ++i) v[h][i] = (unsigned)((u.rowbase + 128 * h + R[i]) * 1024 + 2 * C[i]); }
    __device__ __forceinline__ const char* blo(const Unit& u) const { return (const char*)Wd + ((size_t)u.e1 * 1024 + 256 * u.pn) * 512; }
    __device__ __forceinline__ const char* bhi(const Unit& u) const { return (const char*)Wd + ((size_t)u.e2 * 1024 + 256 * u.pn) * 512 - 4 * 128; }
};

struct MoeMixSched {
    static constexpr bool MIX = true;
    const volatile LAS int* TP; const int* cnt; const int* perm; const unsigned char* Wgu; const unsigned char* Wd; int G, c, TT; unsigned* done; unsigned* tmo;
    __device__ __forceinline__ bool next(int i, Unit& u) const {
        const int cc = (G == 256) ? ((c & 7) * 32 + (c >> 3)) : c;
        const int L = i * G + cc, n1 = TT * 8;
        if (L < n1) { moe_unit(L, 8, TT, TP, cnt, u); u.type = 0; return true; }
        if (!moe_unit(L - n1, 4, TT, TP, cnt, u)) return false; u.type = 1; return true; }
    __device__ __forceinline__ void aoff(const Unit& u, const int (&R)[2], const int (&C)[2], unsigned (&v)[2][2]) const {
#pragma unroll
        for (int h = 0; h < 2; ++h)
#pragma unroll
            for (int i = 0; i < 2; ++i) { const int r = 128 * h + R[i];
                if (u.type == 0) { const int tok = (r < u.nvalid) ? ((const GAS int*)perm)[u.permoff + r] : 0; v[h][i] = (unsigned)WS_XN8 + (unsigned)(tok * 1024 + 2 * C[i]); }
                else v[h][i] = (unsigned)WS_HID + (unsigned)((u.rowbase + r) * 1024 + 2 * C[i]); } }
    __device__ __forceinline__ const char* blo(const Unit& u) const {
        if (u.type == 0) { const int e = (u.pn < 4) ? u.e1 : u.e2; return (const char*)Wgu + ((size_t)e * 1024 + 128 * (u.pn & 3)) * 1024; }
        return (const char*)Wd + ((size_t)u.e1 * 1024 + 256 * u.pn) * 512; }
    __device__ __forceinline__ const char* bhi(const Unit& u) const {
        if (u.type == 0) return blo(u);
        return (const char*)Wd + ((size_t)u.e2 * 1024 + 256 * u.pn) * 512 - 4 * 128; }
    __device__ __forceinline__ int ldbB(const Unit& u) const { return u.type == 0 ? 1024 : 512; }
    __device__ __forceinline__ int hstepB(const Unit& u) const { return u.type == 0 ? 512 : 128; }
    __device__ __forceinline__ int nsplit(const Unit& u) const { return u.type == 0 ? (1 << 20) : 4; }
    __device__ __forceinline__ void a_ready(const Unit& u) const {
        if (u.type == 1) { unsigned* w = done + 64 * (u.rowbase >> 8); unsigned sp = 0;
            while (__hip_atomic_load(w, __ATOMIC_RELAXED, __HIP_MEMORY_SCOPE_AGENT) < 64u) { __builtin_amdgcn_s_sleep(2); if (++sp > (1u << 20)) { __hip_atomic_store(tmo, 1u, __ATOMIC_RELAXED, __HIP_MEMORY_SCOPE_AGENT); break; } }
              } }
    __device__ __forceinline__ int done_tile(const Unit& u) const { return (u.type == 0) ? (u.rowbase >> 8) : -1; }
    __device__ __forceinline__ void signal(int tile, int lane) const { if (lane == 0) __hip_atomic_fetch_add(done + 64 * tile, 1u, __ATOMIC_RELAXED, __HIP_MEMORY_SCOPE_AGENT); }
};

__device__ __forceinline__ int dil_row(int tok, int D4) { const int s = tok & (SEQ - 1); return (tok & ~(SEQ - 1)) + ((s & ((1 << D4) - 1)) << (13 - D4)) + (s >> D4); }
__device__ __forceinline__ float row_rstd16(const float* stats, int row) {
    const f32x4* p = (const f32x4*)(stats + (size_t)row * 16); const f32x4 a = p[0], b = p[1], c = p[2], d = p[3];
    const float s = ((a[0] + a[1]) + (a[2] + a[3])) + ((b[0] + b[1]) + (b[2] + b[3])) + ((c[0] + c[1]) + (c[2] + c[3])) + ((d[0] + d[1]) + (d[2] + d[3]));
    return 1.0f / sqrtf(s * (1.0f / 1024.0f) + EPS);
}
struct EpiHead {
    static constexpr int BMODE = 2; static constexpr int NPF = 0;
    bf16_t* dbase; size_t dstride; const float* gtab; int plain_seg; int e0, e1;
    int ldc; const float* rstd; const float* stats; float ascale;
    int dil = 0;
    __device__ __forceinline__ void operator()(const f32x4 (&acc)[2][2][4][2], const Unit& u, int wr, int wc, int fr, int fq) const {
        asm volatile("" : "+v"(fr), "+v"(fq));
        const int pn = u.pn; const int seg = (pn < e0) ? 0 : (pn < e1) ? 1 : 2;
        bf16_t* dst = dbase + (size_t)seg * dstride; const float* gain = gtab + 64 * seg; const bool norm = (seg != plain_seg);
        const int pnl = pn - (seg == 0 ? 0 : seg == 1 ? e0 : e1);
        const int col0 = 64 * (4 * pnl + wc) + 8 * fq;
        f32x4 gv[2][2];
#pragma unroll
        for (int bj = 0; bj < 2; ++bj)
#pragma unroll
            for (int n = 0; n < 2; ++n) gv[bj][n] = *(const f32x4*)(gain + 32 * bj + 8 * fq + 4 * n);
        float rsv[2][4];
        if (rstd) {
#pragma unroll
            for (int ai = 0; ai < 2; ++ai)
#pragma unroll
                for (int m = 0; m < 4; ++m) rsv[ai][m] = ((const GAS float*)rstd)[u.rowbase + ai * HALF + wr * 64 + m * 16 + fr] * ascale;
        } else {
            f32x4 pq[2][4];
#pragma unroll
            for (int ai = 0; ai < 2; ++ai)
#pragma unroll
                for (int m = 0; m < 4; ++m) pq[ai][m] = *(const GAS f32x4*)(stats + (size_t)(u.rowbase + ai * HALF + wr * 64 + m * 16 + fr) * 16 + 4 * fq);
#pragma unroll
            for (int ai = 0; ai < 2; ++ai)
#pragma unroll
                for (int m = 0; m < 4; ++m) { float sq = (pq[ai][m][0] + pq[ai][m][1]) + (pq[ai][m][2] + pq[ai][m][3]); sq += shfl_x(sq, 16 * fq + fr, 16); sq += shfl_x(sq, 16 * fq + fr, 32);
                    rsv[ai][m] = ascale / sqrtf(sq * (1.0f / 1024.0f) + EPS); }
        }
#pragma unroll
        for (int ai = 0; ai < 2; ++ai)
#pragma unroll
            for (int m = 0; m < 4; ++m) {
                const int row = u.rowbase + ai * HALF + wr * 64 + m * 16 + fr;
                const float rs = rsv[ai][m];
                float hr = rs;
                if (norm) {
                    float ss = 0.f;
#pragma unroll
                    for (int bj = 0; bj < 2; ++bj)
#pragma unroll
                        for (int n = 0; n < 2; ++n) { const f32x4 x = acc[ai][bj][m][n]; ss += (x[0] * x[0] + x[1] * x[1]) + (x[2] * x[2] + x[3] * x[3]); }
                    ss += shfl_x(ss, 16 * fq + fr, 16); ss += shfl_x(ss, 16 * fq + fr, 32);
                    hr = rs / sqrtf(ss * rs * rs * (1.0f / 64.0f) + EPS);
                }
                bf16_t* rowp = dil ? dst + ((size_t)(4 * pnl + wc) * NTOK + dil_row(row, 2 * ((4 * pnl + wc) >> 3))) * 64 + 8 * fq : dst + (size_t)row * ldc + col0;
#pragma unroll
                for (int bj = 0; bj < 2; ++bj) {
                    const f32x4 v0 = acc[ai][bj][m][0] * hr * gv[bj][0], v1 = acc[ai][bj][m][1] * hr * gv[bj][1];
                    u32x4 w; w.x = cvt_pk_bf16(v0[0], v0[1]); w.y = cvt_pk_bf16(v0[2], v0[3]); w.z = cvt_pk_bf16(v1[0], v1[1]); w.w = cvt_pk_bf16(v1[2], v1[3]);
                    *(u32x4*)(rowp + 32 * bj) = w; }
                if (m & 1) asm volatile("" ::: "memory");
            }
    }
};
__device__ __forceinline__ void unpack8(const u32x4 b, f32x4& lo, f32x4& hi) {
    lo = (f32x4){bf2f(b.x & 0xffffu), bf2f(b.x >> 16), bf2f(b.y & 0xffffu), bf2f(b.y >> 16)}; hi = (f32x4){bf2f(b.z & 0xffffu), bf2f(b.z >> 16), bf2f(b.w & 0xffffu), bf2f(b.w >> 16)}; }
struct EpiResid {
    static constexpr int BMODE = 1; static constexpr int NPF = 0;
    bf16_t* xb; float* stats; float ascale;
    __device__ __forceinline__ void operator()(const f32x4 (&acc)[2][2][4][2], const Unit& u, int wr, int wc, int fr, int fq) const {
        asm volatile("" : "+v"(fr), "+v"(fq));
        const int col0 = u.pn * BM + wc * 32 + 8 * fq;
#pragma unroll
        for (int ai = 0; ai < 2; ++ai) {
        u32x4 bb[2][4][2];
#pragma unroll
            for (int m = 0; m < 4; ++m)
#pragma unroll
                for (int bj = 0; bj < 2; ++bj) bb[ai][m][bj] = *(const GAS u32x4*)(xb + (size_t)(u.rowbase + ai * HALF + wr * 64 + m * 16 + fr) * 1024 + col0 + bj * HALF);
#pragma unroll
            for (int m = 0; m < 4; ++m) {
                const int row = u.rowbase + ai * HALF + wr * 64 + m * 16 + fr; const size_t off = (size_t)row * 1024 + col0; float ss = 0.f;
#pragma unroll
                for (int bj = 0; bj < 2; ++bj) { const size_t o = off + bj * HALF; f32x4 b0, b1; unpack8(bb[ai][m][bj], b0, b1);
                    const f32x4 v0 = b0 + acc[ai][bj][m][0] * ascale, v1 = b1 + acc[ai][bj][m][1] * ascale;
                    ss += ((v0[0] * v0[0] + v0[1] * v0[1]) + (v0[2] * v0[2] + v0[3] * v0[3])) + ((v1[0] * v1[0] + v1[1] * v1[1]) + (v1[2] * v1[2] + v1[3] * v1[3]));
                    u32x4 w; w.x = cvt_pk_bf16(v0[0], v0[1]); w.y = cvt_pk_bf16(v0[2], v0[3]); w.z = cvt_pk_bf16(v1[0], v1[1]); w.w = cvt_pk_bf16(v1[2], v1[3]); *(GAS u32x4*)(xb + o) = w; }
                ss += shfl_x(ss, 16 * fq + fr, 16); ss += shfl_x(ss, 16 * fq + fr, 32);
                if (fq == 0) ((GAS float*)stats)[(size_t)row * 16 + u.pn * 4 + wc] = ss;
            }
        asm volatile("" ::: "memory"); }
    }
};
struct EpiSwiglu {
    static constexpr int BMODE = 1;
    unsigned char* hid; const float* gsort;
    __device__ __forceinline__ void operator()(const f32x4 (&acc)[2][2][4][2], const Unit& u, int wr, int wc, int fr, int fq, int pf0, int pf1) const {
        asm volatile("" : "+v"(fr), "+v"(fq));
        const int col0 = 512 * (u.pn >> 2) + 128 * (u.pn & 3) + 32 * wc + 8 * fq;
#pragma unroll
        for (int ai = 0; ai < 2; ++ai)
#pragma unroll
            for (int m = 0; m < 4; ++m) {
                const int r = ai * HALF + wr * 64 + m * 16 + fr;
                const float gq = __int_as_float(shfl_from(ai == 0 ? pf0 : pf1, m * 16 + fr)); const float gw = (r < u.nvalid) ? gq * H8SCALE : 0.f;
                float h[8];
#pragma unroll
                for (int n = 0; n < 2; ++n)
#pragma unroll
                    for (int i = 0; i < 4; ++i) { const float g = acc[ai][0][m][n][i] * (1.0f / W8SCALE), up = acc[ai][1][m][n][i] * (1.0f / W8SCALE); const float sg = g * __builtin_amdgcn_rcpf(1.0f + __builtin_amdgcn_exp2f(-g * LOG2E)); h[4 * n + i] = __builtin_fminf(__builtin_fmaxf(sg * up * gw, -440.f), 440.f); }
                u32x2 w; w.x = pk4_fp8(h[0], h[1], h[2], h[3]); w.y = pk4_fp8(h[4], h[5], h[6], h[7]);
                { GAS u32x2* hp_ = (GAS u32x2*)(hid + (size_t)(u.rowbase + r) * 1024 + col0); asm volatile("global_store_dwordx2 %0, %1, off sc1" :: "v"(hp_), "v"(w) : "memory"); }
            }
    }
};
template <bool LAST> struct EpiScatter {
    static constexpr int BMODE = 1;
    bf16_t* xb; float* out; float* stats; const int* perm; float ascale;
    __device__ __forceinline__ void operator()(const f32x4 (&acc)[2][2][4][2], const Unit& u, int wr, int wc, int fr, int fq, int pf0, int pf1) const {
        asm volatile("" : "+v"(fr), "+v"(fq));
        const int col0 = u.pn * BM + wc * 32 + 8 * fq;
        int tokv[2][4];
#pragma unroll
        for (int ai = 0; ai < 2; ++ai)
#pragma unroll
            for (int m = 0; m < 4; ++m) { const int r = ai * HALF + wr * 64 + m * 16 + fr; const int tq = shfl_from(ai == 0 ? pf0 : pf1, m * 16 + fr); tokv[ai][m] = (r < u.nvalid) ? tq : -1; }
#pragma unroll
        for (int ai = 0; ai < 2; ++ai) {
        u32x4 bb[2][4][2];
#pragma unroll
            for (int m = 0; m < 4; ++m)
#pragma unroll
                for (int bj = 0; bj < 2; ++bj) bb[ai][m][bj] = *(const GAS u32x4*)(xb + (size_t)(tokv[ai][m] >= 0 ? tokv[ai][m] : 0) * 1024 + col0 + bj * HALF);
#pragma unroll
            for (int m = 0; m < 4; ++m) {
                const bool valid = tokv[ai][m] >= 0; const int tok = valid ? tokv[ai][m] : 0;
                const size_t off = (size_t)tok * 1024 + col0; float ss = 0.f;
#pragma unroll
                for (int bj = 0; bj < 2; ++bj) { const size_t o = off + bj * HALF; f32x4 b0, b1; unpack8(bb[ai][m][bj], b0, b1);
                    const f32x4 v0 = b0 + acc[ai][bj][m][0] * ascale, v1 = b1 + acc[ai][bj][m][1] * ascale;
                    ss += ((v0[0] * v0[0] + v0[1] * v0[1]) + (v0[2] * v0[2] + v0[3] * v0[3])) + ((v1[0] * v1[0] + v1[1] * v1[1]) + (v1[2] * v1[2] + v1[3] * v1[3]));
                    if (valid) {
                        if constexpr (LAST) { *(GAS f32x4*)(out + o) = v0; *(GAS f32x4*)(out + o + 4) = v1; }
                        else { u32x4 w; w.x = cvt_pk_bf16(v0[0], v0[1]); w.y = cvt_pk_bf16(v0[2], v0[3]); w.z = cvt_pk_bf16(v1[0], v1[1]); w.w = cvt_pk_bf16(v1[2], v1[3]); *(GAS u32x4*)(xb + o) = w;
                               u32x2 q8; q8.x = pk4_fp8(v0[0], v0[1], v0[2], v0[3]); q8.y = pk4_fp8(v1[0], v1[1], v1[2], v1[3]); *(GAS u32x2*)((unsigned char*)xb - (WS_XB - WS_XB8) + o) = q8; } } }
                if (!LAST) { ss += shfl_x(ss, 16 * fq + fr, 16); ss += shfl_x(ss, 16 * fq + fr, 32);
                    if (valid && fq == 0) ((GAS float*)stats)[(size_t)tok * 16 + u.pn * 4 + wc] = ss; }
            }
        asm volatile("" ::: "memory"); }
    }
};

template <bool LAST> struct EpiMoe {
    static constexpr int BMODE = 1;
    static constexpr int NPF = 2;
    EpiSwiglu sw; EpiScatter<LAST> sc;
    __device__ __forceinline__ void prefetch(const Unit& u, int wr, int lane, int& pf0, int& pf1) const {
        const int r0 = wr * 64 + lane;
        const GAS int* p0 = (u.type == 0) ? (const GAS int*)sw.gsort + 2 * (size_t)(u.permoff + r0) + (u.pn >> 2) : (const GAS int*)sc.perm + (u.permoff + r0);
        const GAS int* p1 = p0 + ((u.type == 0) ? 2 * HALF : HALF);
        asm volatile("global_load_dword %0, %2, off\n\tglobal_load_dword %1, %3, off" : "=&v"(pf0), "=&v"(pf1) : "v"(p0), "v"(p1) : "memory"); }
    __device__ __forceinline__ void operator()(const f32x4 (&acc)[2][2][4][2], const Unit& u, int wr, int wc, int fr, int fq, int pf0, int pf1) const {
        if (u.type == 0) sw(acc, u, wr, wc, fr, fq, pf0, pf1); else sc(acc, u, wr, wc, fr, fq, pf0, pf1); }
};

template <class Epi, class Sched, bool F8 = false>
__device__ __forceinline__ void gemm_phase(LAS unsigned char* lds, const GemmP g, const Sched& S, const Epi& E, int wave) {
    int tid = wave * 64 + lane_id(); asm volatile("" : "+v"(tid));
    const int wid = __builtin_amdgcn_readfirstlane(tid >> 6), lane = tid & 63, wr = wid >> 2, wc = wid & 3, fr = lane & 15, fq = lane >> 4;
    const int nt = g.Kbytes / 128;
    unsigned voffB[2]; int RbB[2], CbB[2];
#pragma unroll
    for (int i = 0; i < 2; ++i) { int R[2], C[2]; stage_rc(tid * 16 + i * 8192, R[i], C[i]);
        RbB[i] = (Epi::BMODE == 0) ? R[i] : (Epi::BMODE == 1) ? ((R[i] & ~31) + perm32(R[i] & 31)) : (64 * (R[i] >> 5) + perm32(R[i] & 31)); CbB[i] = 2 * C[i];
        voffB[i] = (unsigned)(RbB[i] * g.ldbB + CbB[i]); }
    const size_t kstep = (size_t)(BK * 2);
    size_t hstepB = (size_t)g.hstepB * g.ldbB; int nsplit = g.nsplit;
    const unsigned ldsw = (unsigned)wid * 1024u;
    const int aoff = lds_byte(wr * 64 + fr, fq * 8), boff = lds_byte(wc * 32 + fr, fq * 8);
    const char* const Ab = (const char*)g.A;
#define PG8_SA(b, h) (((b) * 2 + (h)) * HTB)
#define PG8_SB(b, h) ((4 + (b) * 2 + (h)) * HTB)
#define PG8_STAGE(bufoff, gbase, voff) do { _Pragma("unroll") for (int _i = 0; _i < 2; ++_i) \
        __builtin_amdgcn_global_load_lds((const unsigned*)((const char*)(gbase) + (voff)[_i]), (LAS unsigned*)(lds + (bufoff) + ldsw + _i * 8192), 16, 0, 0); } while (0)
#define PG8_LD8(p) __builtin_shufflevector(*(const LAS i32x4*)(p), *(const LAS i32x4*)((p) + 1024), 0, 1, 2, 3, 4, 5, 6, 7)
#define PG8_LDA(dst, b, h) do { if constexpr (F8) { _Pragma("unroll") for (int m = 0; m < 4; ++m) dst##8[m] = PG8_LD8(lds + PG8_SA(b, h) + aoff + m * 2048); } \
        else { _Pragma("unroll") for (int m = 0; m < 4; ++m) _Pragma("unroll") for (int k = 0; k < 2; ++k) dst[m][k] = *(const LAS bf16x8*)(lds + PG8_SA(b, h) + aoff + m * 2048 + k * 1024); } } while (0)
#define PG8_LDB(dst, b, h) do { if constexpr (F8) { _Pragma("unroll") for (int n = 0; n < 2; ++n) dst##8[n] = PG8_LD8(lds + PG8_SB(b, h) + boff + n * 2048); } \
        else { _Pragma("unroll") for (int n = 0; n < 2; ++n) _Pragma("unroll") for (int k = 0; k < 2; ++k) dst[n][k] = *(const LAS bf16x8*)(lds + PG8_SB(b, h) + boff + n * 2048 + k * 1024); } } while (0)
#define PG8_MMA(ai, bj, At, Bt) do { __builtin_amdgcn_s_setprio(1); \
        if constexpr (F8) { _Pragma("unroll") for (int m = 0; m < 4; ++m) _Pragma("unroll") for (int n = 0; n < 2; ++n) \
            acc[ai][bj][m][n] = __builtin_amdgcn_mfma_scale_f32_16x16x128_f8f6f4(Bt##8[n], At##8[m], acc[ai][bj][m][n], 0, 0, 0, 0, 0, 0); } \
        else { _Pragma("unroll") for (int m = 0; m < 4; ++m) _Pragma("unroll") for (int n = 0; n < 2; ++n) _Pragma("unroll") for (int k = 0; k < 2; ++k) \
            acc[ai][bj][m][n] = __builtin_amdgcn_mfma_f32_16x16x32_bf16(Bt[n][k], At[m][k], acc[ai][bj][m][n], 0, 0, 0); } \
        __builtin_amdgcn_s_setprio(0); } while (0)
#define PG8_WAIT_V(n) asm volatile("s_waitcnt vmcnt(" #n ")" ::: "memory")
#define PG8_WAIT_L(n) asm volatile("s_waitcnt lgkmcnt(" #n ")" ::: "memory")
#define PG8_BAR __builtin_amdgcn_s_barrier()
#define PG8_SCHED __builtin_amdgcn_sched_barrier(0)
#ifndef PROBE_K
#define PROBE_K 0
#endif
#ifndef PROBE_KSEL
#define PROBE_KSEL 0
#endif
    unsigned long long pk_acc = 0ull, pk_t0 = 0ull;
    int pf0 = 0, pf1 = 0, pend = -1;
    Unit cur, nxt; int ui = 0;
    if (!S.next(0, cur)) return;
    unsigned vc[2][2];
    LAS u32x4* const vnl = (LAS u32x4*)(lds + AUX_OFF + 2048) + tid;
    { int R[2], C[2]; int t_ = tid; asm volatile("" : "+v"(t_)); stage_rc(t_ * 16, R[0], C[0]); stage_rc(t_ * 16 + 8192, R[1], C[1]); S.aoff(cur, R, C, vc); }
    f32x4 acc[2][2][4][2];
#pragma unroll
    for (int a = 0; a < 2; ++a)
#pragma unroll
        for (int b = 0; b < 2; ++b)
#pragma unroll
            for (int m = 0; m < 4; ++m)
#pragma unroll
                for (int n = 0; n < 2; ++n) acc[a][b][m][n] = (f32x4){0.f, 0.f, 0.f, 0.f};
    bf16x8 At[4][2], B0[2][2], B1[2][2]; i32x8 At8[4], B08[2], B18[2];
    const char* cBl = S.blo(cur); const char* cBh = S.bhi(cur);
    if constexpr (Sched::MIX) { const int lb_ = S.ldbB(cur); voffB[0] = (unsigned)(RbB[0] * lb_ + CbB[0]); voffB[1] = (unsigned)(RbB[1] * lb_ + CbB[1]); hstepB = (size_t)S.hstepB(cur) * lb_; nsplit = S.nsplit(cur); S.a_ready(cur); }
    PG8_STAGE(PG8_SB(0, 0), cBl, voffB); PG8_STAGE(PG8_SB(0, 1), cBl + hstepB, voffB); PG8_STAGE(PG8_SA(0, 0), Ab, vc[0]); PG8_STAGE(PG8_SA(0, 1), Ab, vc[1]);
    if (wr == 1) PG8_BAR;
    PG8_WAIT_V(2); PG8_BAR;
    PG8_STAGE(PG8_SB(1, 0), cBl + kstep, voffB); PG8_STAGE(PG8_SA(1, 0), Ab + kstep, vc[0]); PG8_STAGE(PG8_SB(1, 1), cBl + hstepB + kstep, voffB);
    PG8_WAIT_V(6); PG8_BAR;
    for (;;) {
        const bool has_next = S.next(ui + 1, nxt);
        { unsigned vn[2][2];
          if (has_next) { int R[2], C[2]; int t_ = tid; asm volatile("" : "+v"(t_)); stage_rc(t_ * 16, R[0], C[0]); stage_rc(t_ * 16 + 8192, R[1], C[1]); S.aoff(nxt, R, C, vn); } else {
#pragma unroll
            for (int h = 0; h < 2; ++h)
#pragma unroll
                for (int i = 0; i < 2; ++i) vn[h][i] = vc[h][i]; }
          *vnl = (u32x4){vn[0][0], vn[0][1], vn[1][0], vn[1][1]}; }
        const char* nBl = has_next ? S.blo(nxt) : cBl; const char* nBh = has_next ? S.bhi(nxt) : cBh;
        if (PROBE_K == 1 || PROBE_K == 3) pk_t0 = __builtin_amdgcn_s_memrealtime();
#pragma unroll 1
        for (int t = 0; t < nt; t += 2) {
            const bool last = (t == nt - 2);
            const char* a1 = Ab + (size_t)(t + 1) * kstep;
            const char* a2 = last ? Ab : Ab + (size_t)(t + 2) * kstep;
            const char* b2 = last ? nBl : (((t + 2) < nsplit) ? cBl : cBh) + (size_t)(t + 2) * kstep;
            const char* a3 = a2 + kstep; const char* b3 = b2 + kstep;
            PG8_LDB(B0, 0, 0); PG8_LDB(B1, 0, 1); PG8_SCHED; PG8_LDA(At, 0, 0); PG8_STAGE(PG8_SA(1, 1), a1, vc[1]);
            PG8_WAIT_V(8); PG8_WAIT_L(0); PG8_BAR; PG8_MMA(0, 0, At, B0); PG8_MMA(0, 1, At, B1); PG8_BAR; PG8_SCHED;
            if (last) { if constexpr (Epi::NPF > 0) E.prefetch(cur, wr, lane, pf0, pf1);
                const u32x4 v_ = *vnl; vc[0][0] = v_[0]; vc[0][1] = v_[1]; vc[1][0] = v_[2]; vc[1][1] = v_[3];
                if constexpr (Sched::MIX) { if (has_next) { const int lb_ = S.ldbB(nxt); voffB[0] = (unsigned)(RbB[0] * lb_ + CbB[0]); voffB[1] = (unsigned)(RbB[1] * lb_ + CbB[1]); hstepB = (size_t)S.hstepB(nxt) * lb_; S.a_ready(nxt); } } }
            PG8_LDA(At, 0, 1); PG8_STAGE(PG8_SB(0, 0), b2, voffB); PG8_STAGE(PG8_SB(0, 1), b2 + hstepB, voffB); PG8_STAGE(PG8_SA(0, 0), a2, vc[0]);
            if (Epi::NPF > 0 && last) PG8_WAIT_V(10); else PG8_WAIT_V(8);
            PG8_WAIT_L(0); PG8_BAR; PG8_MMA(1, 0, At, B0); PG8_MMA(1, 1, At, B1); PG8_BAR; PG8_SCHED;
            PG8_LDB(B0, 1, 0); PG8_LDB(B1, 1, 1); PG8_SCHED; PG8_LDA(At, 1, 0); PG8_STAGE(PG8_SA(0, 1), a2, vc[1]);
            PG8_WAIT_V(8); PG8_WAIT_L(0); PG8_BAR; PG8_MMA(0, 0, At, B0); PG8_MMA(0, 1, At, B1); PG8_BAR; PG8_SCHED;
            if constexpr (Sched::MIX) { if (t == 0 && pend >= 0) { S.signal(pend, lane); pend = -1; } }
            PG8_LDA(At, 1, 1); PG8_STAGE(PG8_SB(1, 0), b3, voffB); PG8_STAGE(PG8_SB(1, 1), b3 + hstepB, voffB); PG8_STAGE(PG8_SA(1, 0), a3, vc[0]);
            PG8_WAIT_V(8); PG8_WAIT_L(0); PG8_BAR; PG8_MMA(1, 0, At, B0); PG8_MMA(1, 1, At, B1); PG8_BAR; PG8_SCHED;
        }
        if (PROBE_K == 1) pk_acc += __builtin_amdgcn_s_memrealtime() - pk_t0;
        if (PROBE_K == 2) pk_t0 = __builtin_amdgcn_s_memrealtime();
        if (wr == 0) PG8_BAR;
        if constexpr (Epi::NPF > 0) { asm volatile("s_waitcnt vmcnt(14)" : "+v"(pf0), "+v"(pf1) :: "memory"); E(acc, cur, wr, wc, fr, fq, pf0, pf1); }
        else E(acc, cur, wr, wc, fr, fq);
        if constexpr (Sched::MIX) pend = S.done_tile(cur);
        if (PROBE_K == 2) { asm volatile("s_waitcnt vmcnt(0)" ::: "memory"); pk_acc += __builtin_amdgcn_s_memrealtime() - pk_t0; }
        if (PROBE_K == 3) pk_acc += __builtin_amdgcn_s_memrealtime() - pk_t0;
        if (!has_next) break;
#pragma unroll
        for (int a = 0; a < 2; ++a)
#pragma unroll
            for (int b = 0; b < 2; ++b)
#pragma unroll
                for (int m = 0; m < 4; ++m)
#pragma unroll
                    for (int n = 0; n < 2; ++n) acc[a][b][m][n] = (f32x4){0.f, 0.f, 0.f, 0.f};
        cur = nxt; cBl = nBl; cBh = nBh; ++ui;
        if constexpr (Sched::MIX) nsplit = S.nsplit(cur);
        if (wr == 1) PG8_BAR;
    }
    PG8_WAIT_V(0);
    if constexpr (Sched::MIX) { if (pend >= 0) S.signal(pend, lane); }
    PG8_BAR;
    if (PROBE_K != 0 && g.pk && tid == 0) { LAS unsigned* pw_ = (LAS unsigned*)(lds + MISC_OFF) + 120; *pw_ += (unsigned)pk_acc; }
#undef PG8_SA
#undef PG8_SB
#undef PG8_STAGE
#undef PG8_LDA
#undef PG8_LDB
#undef PG8_MMA
#undef PG8_LD8
#undef PG8_WAIT_V
#undef PG8_WAIT_L
#undef PG8_BAR
#undef PG8_SCHED
}
}

namespace attn_body {
using bf16 = __hip_bfloat16;
constexpr int NHEAD = 16, D = 64, DMQ = NHEAD * D;
constexpr int NW = 8, QBLK = 32, QB = QBLK * NW, KVBLK = 64;
__device__ __forceinline__ int crow(int r, int hi) { return (r & 3) + 8 * (r >> 2) + 4 * hi; }
#define SBAR() __builtin_amdgcn_sched_barrier(0)
__device__ __forceinline__ void cmask(f32x16& p0, f32x16& p1, int jb, int qrel, int hi) {
  const float NEG = -INFINITY; int kb = 64 * jb + 4 * hi;
  #pragma unroll
  for (int r = 0; r < 16; ++r) { int kv = kb + (r & 3) + 8 * (r >> 2); if (kv > qrel) p0[r] = NEG; if (kv + 32 > qrel) p1[r] = NEG; }
}
constexpr int NSLOT = 3, SLOTB = 8192;
constexpr int LDS_K = 0, LDS_V = NSLOT * SLOTB, LDS_WS = 2 * NSLOT * SLOTB, LDS_OST = LDS_WS + NW * 64 * 4, ATT_LDS_BYTES = LDS_OST + NW * 4096;
constexpr int LDS_NCK = 86016;
__device__ __forceinline__ void glds16(const void* gsrc, unsigned lds_dst) { unsigned keep;
  asm volatile("s_mov_b32 %0, m0\n\ts_mov_b32 m0, %2\n\ts_nop 0\n\tglobal_load_lds_dwordx4 %1, off\n\ts_mov_b32 m0, %0" : "=&s"(keep) : "v"(gsrc), "s"(lds_dst) : "memory"); }
__device__ __forceinline__ float max3f(float a, float b, float c) { float r; asm("v_max3_f32 %0, %1, %2, %3" : "=v"(r) : "v"(a), "v"(b), "v"(c)); return r; }
__device__ __forceinline__ float max2f(float a, float b) { float r; asm("v_max_f32_e32 %0, %1, %2" : "=v"(r) : "v"(a), "v"(b)); return r; }
__device__ __forceinline__ float fadd_s(float a, float b) { float r; asm("v_add_f32_e32 %0, %1, %2" : "=v"(r) : "v"(a), "v"(b)); return r; }
__device__ __forceinline__ float fsub_s(float a, float b) { float r; asm("v_sub_f32_e32 %0, %1, %2" : "=v"(r) : "v"(a), "v"(b)); return r; }
typedef __bf16 bf16x2_t __attribute__((ext_vector_type(2)));
__device__ __forceinline__ unsigned cvtpk_s(float lo, float hi) { f32x2 v = {lo, hi}; bf16x2_t b = __builtin_convertvector(v, bf16x2_t); return __builtin_bit_cast(unsigned, b); }
#define WAIT_BAR(N) asm volatile("s_waitcnt vmcnt(" #N ") lgkmcnt(0)\n\ts_barrier" ::: "memory")
typedef LAS const char* lds_cptr;
typedef short v4i16_t __attribute__((ext_vector_type(4)));
__device__ __forceinline__ void qkt(f32x16& p0, f32x16& p1, lds_cptr Kslot, const bf16x8* qr, const f32x16& negm, int r32, int hi) {
  lds_cptr kb = Kslot + hi * 1024 + r32 * 16;
  #pragma unroll
  for (int d0 = 0; d0 < 4; ++d0) {
    const bf16x8 b0 = *(const LAS bf16x8*)(kb + d0 * 2048);
    const bf16x8 b1 = *(const LAS bf16x8*)(kb + d0 * 2048 + 512);
    if (d0 == 0) { p0 = __builtin_amdgcn_mfma_f32_32x32x16_bf16(b0, qr[0], negm, 0, 0, 0); p1 = __builtin_amdgcn_mfma_f32_32x32x16_bf16(b1, qr[0], negm, 0, 0, 0); }
    else { p0 = __builtin_amdgcn_mfma_f32_32x32x16_bf16(b0, qr[d0], p0, 0, 0, 0); p1 = __builtin_amdgcn_mfma_f32_32x32x16_bf16(b1, qr[d0], p1, 0, 0, 0); } }
}
__device__ __forceinline__ void kload8(bf16x8* kf, lds_cptr kp) {
  kf[0] = *(const LAS bf16x8*)(kp);        kf[1] = *(const LAS bf16x8*)(kp + 512);
  kf[2] = *(const LAS bf16x8*)(kp + 2048); kf[3] = *(const LAS bf16x8*)(kp + 2560);
  kf[4] = *(const LAS bf16x8*)(kp + 4096); kf[5] = *(const LAS bf16x8*)(kp + 4608);
  kf[6] = *(const LAS bf16x8*)(kp + 6144); kf[7] = *(const LAS bf16x8*)(kp + 6656);
}
__device__ __forceinline__ void kload2(bf16x8* kf, lds_cptr kp, int j) { kf[2 * j] = *(const LAS bf16x8*)(kp + j * 2048); kf[2 * j + 1] = *(const LAS bf16x8*)(kp + j * 2048 + 512); }
__device__ __forceinline__ s16x4 vtr(lds_cptr p) { return __builtin_bit_cast(s16x4, __builtin_amdgcn_ds_read_tr16_b64_v4i16((LAS v4i16_t*)p)); }
__device__ __forceinline__ float rowmax(const f32x16& p0, const f32x16& p1) {
  float a = max3f(p0[0], p0[1], p1[0]), b = max3f(p0[2], p0[3], p1[1]); a = max3f(a, p1[2], p1[3]);
  #pragma unroll
  for (int r = 4; r < 16; r += 4) { a = max3f(a, p0[r], p0[r + 1]); b = max3f(b, p0[r + 2], p0[r + 3]); a = max3f(a, p1[r], p1[r + 1]); b = max3f(b, p1[r + 2], p1[r + 3]); }
  const float m = max2f(a, b);
  auto rr = __builtin_amdgcn_permlane32_swap(__float_as_uint(m), __float_as_uint(m), false, false);
  return max2f(__uint_as_float(rr[0]), __uint_as_float(rr[1]));
}
__device__ __forceinline__ void pv(f32x16* o, int vb, bf16x8 pa0, bf16x8 pa1, bf16x8 pa2, bf16x8 pa3) {
  #pragma unroll
  for (int d0 = 0; d0 < 2; ++d0) { s16x4 lo[4], hi[4];
    #pragma unroll
    for (int ks = 0; ks < 4; ++ks) {
      asm volatile("ds_read_b64_tr_b16 %0,%1 offset:%c2" : "=&v"(lo[ks]) : "v"(vb), "i"(d0 * 4096 + ks * 1024) : "memory");
      asm volatile("ds_read_b64_tr_b16 %0,%1 offset:%c2" : "=&v"(hi[ks]) : "v"(vb), "i"(d0 * 4096 + ks * 1024 + 512) : "memory"); }
    asm volatile("s_waitcnt lgkmcnt(0)" ::: "memory"); SBAR();
    #define PK(k) (bf16x8){lo[k][0], lo[k][1], lo[k][2], lo[k][3], hi[k][0], hi[k][1], hi[k][2], hi[k][3]}
    o[d0] = __builtin_amdgcn_mfma_f32_32x32x16_bf16(pa0, PK(0), o[d0], 0, 0, 0);
    o[d0] = __builtin_amdgcn_mfma_f32_32x32x16_bf16(pa1, PK(1), o[d0], 0, 0, 0);
    o[d0] = __builtin_amdgcn_mfma_f32_32x32x16_bf16(pa2, PK(2), o[d0], 0, 0, 0);
    o[d0] = __builtin_amdgcn_mfma_f32_32x32x16_bf16(pa3, PK(3), o[d0], 0, 0, 0);
    #undef PK
  }
}

struct Xpf { bool primed, has_next; long Pn; const bf16* Qn; const bf16* Kn; const bf16* Vn; };
template<int THRL, bool WIN, bool XP> __device__ __forceinline__ void attn_unit_x(int qb, int T0, long P, const bf16* Q, const bf16* __restrict__ K, const bf16* __restrict__ V, bf16* O, char* shm, int wave,
                                                                        float* PML, long wtok0, int wtstride, const Xpf xp, bf16x8 (&qn)[4], int& rho) {
#ifndef PROBE_A
#define PROBE_A 0
#endif
  unsigned long long pa_t = 0ull;
#define PA_T0(k) do { if (WIN && PROBE_A == (k)) pa_t = __builtin_amdgcn_s_memrealtime(); } while (0)
#define PA_T1(k) do { if (WIN && PROBE_A == (k)) { const unsigned d_ = (unsigned)(__builtin_amdgcn_s_memrealtime() - pa_t); if (tid == 0) *(unsigned*)(shm + MISC_OFF + 4 * 121) += d_; } } while (0)
  int tid = wave * 64 + lane_id(); asm volatile("" : "+v"(tid));
  const int lane = tid & 63, r32 = lane & 31, hi = lane >> 5; const int wid = __builtin_amdgcn_readfirstlane(tid >> 6);
  PA_T0(1);
  const int q0 = qb * QB;
  const bf16* Qw = Q + (long)(q0 + wid * QBLK) * P;
  const bf16* Kh = K + (long)T0 * KVBLK * P, *Vh = V + (long)T0 * KVBLK * P;
  const unsigned lds0 = (unsigned)(uintptr_t)shm; const lds_cptr shm3 = (lds_cptr)shm;
  float* wsf = (float*)(shm + LDS_WS) + wid * 64;
  const int wbj = 383 - (q0 + wid * QBLK + r32 - T0 * KVBLK) + 4 * hi;
  const LAS float* nck0 = WIN ? (const LAS float*)((lds_cptr)shm + LDS_NCK) + (wbj & 3) * 640 + (wbj & ~3)
                              : (const LAS float*)((lds_cptr)shm + LDS_NCK) + T0 * KVBLK + 4 * hi;
  const float cq2 = WIN ? 0.f : -((const LAS float*)((lds_cptr)shm + LDS_NCK))[q0 + wid * QBLK + r32];
  const bf16* ksrc = Kh + (long)lane * P + wid * 8;
  const bf16* vsrc = Vh + (long)(16 * (wid & 3) + (lane >> 2)) * P + (wid >> 2) * 32 + (lane & 3) * 8;
  const unsigned kdst = lds0 + LDS_K + wid * 1024, vdst = lds0 + LDS_V + wid * 1024;
  #define DMA_K(t, slot) glds16(ksrc + (long)(t) * KVBLK * P, (unsigned)__builtin_amdgcn_readfirstlane(kdst + (slot)))
  #define DMA_V(t, slot) glds16(vsrc + (long)(t) * KVBLK * P, (unsigned)__builtin_amdgcn_readfirstlane(vdst + (slot)))
  const int vb0 = (int)(lds0 + LDS_V) + ((lane >> 4) & 1) * 32 + (lane & 3) * 8 + (4 * hi + ((lane & 15) >> 2)) * 64;
  bf16x8 kf[8];
  const lds_cptr kp0 = shm3 + LDS_K + hi * 1024 + r32 * 16; const lds_cptr vp0 = shm3 + LDS_V + ((lane >> 4) & 1) * 32 + (lane & 3) * 8 + (4 * hi + ((lane & 15) >> 2)) * 64;
  const int NT = (q0 + QB) / KVBLK - T0;
  #define NXS(s) (((s) == (NSLOT - 1) * SLOTB) ? 0 : (s) + SLOTB)
  const int s0 = XP ? __builtin_amdgcn_readfirstlane(rho) * SLOTB : 0, s1 = NXS(s0), s2 = NXS(s1);
  const bool primed = XP && xp.primed;
  if (!primed) { DMA_K(0, s0); DMA_V(0, s0); DMA_K(1, s1); }
  bf16x8 qr[4];
  const lds_cptr qp = shm3 + LDS_OST + wid * 4096 + lane * 16;
  if (!primed) {
  #pragma unroll
  for (int d0 = 0; d0 < 4; ++d0) qr[d0] = *reinterpret_cast<const bf16x8*>(&Qw[(long)r32 * P + d0 * 16 + hi * 8]);
  #pragma unroll
  for (int d0 = 0; d0 < 4; ++d0) *(LAS bf16x8*)(qp + d0 * 1024) = qr[d0];
  } else {
  #pragma unroll
  for (int d0 = 0; d0 < 4; ++d0) qr[d0] = qn[d0];
  }
  #define QLD(d) (*(const LAS bf16x8*)(qp + (d) * 1024))
  float nm = cq2, l_reg = 0.f; f32x16 o[2]; o[0] = f32x16{}; o[1] = f32x16{};
  const int qrel = wid * QBLK + r32;
  #define CMASK(P0, P1, t) do { if (!WIN) { int jb_ = (t) - (NT - 4); if (jb_ >= 0) cmask(P0, P1, jb_, qrel, hi); } } while (0)
  #define DECAY(P0, P1, t) do { const LAS float* nk_ = nck0 + ((t) << 6); \
    _Pragma("unroll") for (int g_ = 0; g_ < 4; ++g_) { const f32x4 a_ = *(const LAS f32x4*)(nk_ + 8 * g_); const f32x4 b_ = *(const LAS f32x4*)(nk_ + 32 + 8 * g_); \
      P0[4 * g_] += a_[0]; P0[4 * g_ + 1] += a_[1]; P0[4 * g_ + 2] += a_[2]; P0[4 * g_ + 3] += a_[3]; P1[4 * g_] += b_[0]; P1[4 * g_ + 1] += b_[1]; P1[4 * g_ + 2] += b_[2]; P1[4 * g_ + 3] += b_[3]; SBAR(); } } while (0)
  bool resc = false;
  #define START(P0, P1) do { const float rm = rowmax(P0, P1); resc = false; \
    { const float dl = max2f(rm, -1000.f); nm = fsub_s(nm, dl); \
      _Pragma("unroll") for (int r = 0; r < 16; ++r) { P0[r] = fsub_s(P0[r], dl); P1[r] = fsub_s(P1[r], dl); } } \
    _Pragma("unroll") for (int r = 0; r < 16; ++r) P0[r] = __builtin_amdgcn_exp2f(P0[r]); } while (0)
  #define RESC() do { if (resc) { asm volatile("s_waitcnt lgkmcnt(0)" ::: "memory"); \
      _Pragma("unroll") for (int d_ = 0; d_ < 2; ++d_) _Pragma("unroll") for (int r = 0; r < 16; ++r) o[d_][r] *= wsf[crow(r, hi)]; } } while (0)
  f32x16 pA0, pA1, pB0, pB1;
  int sl_prev = s0, sl_cur = s0, sl_next = s1;
  #define ROT() do { sl_prev = sl_cur; sl_cur = sl_next; sl_next = (sl_next == (NSLOT - 1) * SLOTB) ? 0 : sl_next + SLOTB; } while (0)
  if (!primed) { DMA_K(2, s2); WAIT_BAR(3); }
  PA_T1(1); PA_T0(2);
  { f32x16 negm;
    #pragma unroll
    for (int r = 0; r < 16; ++r) negm[r] = nm;
    qkt(pA0, pA1, shm3 + LDS_K + s0, qr, negm, r32, hi); }
  asm volatile("s_nop 15\n\ts_nop 7" : "+v"(pA0), "+v"(pA1)); DECAY(pA0, pA1, 0); CMASK(pA0, pA1, 0);
  asm volatile("s_nop 1" : "+v"(pA0), "+v"(pA1));
  START(pA0, pA1);
  _Pragma("unroll") for (int r = 0; r < 16; ++r) pA1[r] = __builtin_amdgcn_exp2f(pA1[r]);
  WAIT_BAR(0);
  DMA_K(3, s0); DMA_V(1, s1);
  ROT();
  kload8(kf, kp0 + sl_cur);
  WAIT_BAR(2);
  PA_T1(2); PA_T0(3);
  s16x4 vlo[8], vhi[8]; u32x4 pw0, pw1, pw2, pw3; bf16x8 qfa = QLD(0), qfb = QLD(1);
  #define PKW(P, B) cvtpk_s(P[B], P[B + 1])
  #define PAF(k) __builtin_bit_cast(bf16x8, pw##k)
  #define VFR(i) (bf16x8){vlo[i][0], vlo[i][1], vlo[i][2], vlo[i][3], vhi[i][0], vhi[i][1], vhi[i][2], vhi[i][3]}
  #define PIN(x) asm volatile("" : "+v"(x))
  #define MX3(a, b, c) __builtin_fmaxf(__builtin_fmaxf((a), (b)), (c))
  #define SPLAT(X) do { _Pragma("unroll") for (int r_ = 0; r_ < 16; ++r_) X[r_] = nm; PIN(X); } while (0)
  #define GAPA(MF, A0, A1, A2, A3, W0, W1, PW) do { MF; sacc += A0; sacc += A1; sacc += A2; sacc += A3; PIN(sacc); W0; W1; PIN(PW); SBAR(); } while (0)
  #define EX(v) __builtin_amdgcn_exp2f(v)
  #define GAPB(MF, X, B) do { MF; X[B] = EX(X[B]); X[B + 1] = EX(X[B + 1]); X[B + 2] = EX(X[B + 2]); X[B + 3] = EX(X[B + 3]); PIN(X); SBAR(); } while (0)
  #define VRD(i) do { vlo[i] = vtr(vp_ + (((i) >> 2) * 4096 + ((i) & 3) * 1024)); vhi[i] = vtr(vp_ + (((i) >> 2) * 4096 + ((i) & 3) * 1024 + 512)); } while (0)
  #define KRD(G, j) do { if (G) { kload2(kf, kp0 + sl_next, j); SBAR(); } } while (0)
  #define STEP(C0, C1, P0, P1, t, GK, GV, GL) do { SBAR(); \
    const lds_cptr vp_ = vp0 + sl_prev; \
    SPLAT(C0); VRD(0); SBAR(); float sacc = (P0[0] + P0[1]); \
    GAPA(C0 = __builtin_amdgcn_mfma_f32_32x32x16_bf16(kf[0], qfa, C0, 0, 0, 0), P0[2], P0[3], P0[4], P0[5],     pw0[0] = PKW(P0, 0), pw0[1] = PKW(P0, 2), pw0); \
    SPLAT(C1); VRD(4); SBAR(); GAPA(C1 = __builtin_amdgcn_mfma_f32_32x32x16_bf16(kf[1], qfa, C1, 0, 0, 0), P0[6], P0[7], P0[8], P0[9],     pw0[2] = PKW(P0, 4), pw0[3] = PKW(P0, 6), pw0); \
    qfa = QLD(2); VRD(1); SBAR(); GAPA(C0 = __builtin_amdgcn_mfma_f32_32x32x16_bf16(kf[2], qfb, C0, 0, 0, 0),   P0[10], P0[11], P0[12], P0[13], pw1[0] = PKW(P0, 8), pw1[1] = PKW(P0, 10), pw1); \
    VRD(5); SBAR(); GAPA(C1 = __builtin_amdgcn_mfma_f32_32x32x16_bf16(kf[3], qfb, C1, 0, 0, 0),   P0[14], P0[15], P1[0], P1[1],   pw1[2] = PKW(P0, 12), pw1[3] = PKW(P0, 14), pw1); \
    qfb = QLD(3); VRD(2); SBAR(); GAPA(C0 = __builtin_amdgcn_mfma_f32_32x32x16_bf16(kf[4], qfa, C0, 0, 0, 0),   P1[2], P1[3], P1[4], P1[5],     pw2[0] = PKW(P1, 0), pw2[1] = PKW(P1, 2), pw2); \
    VRD(6); SBAR(); GAPA(C1 = __builtin_amdgcn_mfma_f32_32x32x16_bf16(kf[5], qfa, C1, 0, 0, 0),   P1[6], P1[7], P1[8], P1[9],     pw2[2] = PKW(P1, 4), pw2[3] = PKW(P1, 6), pw2); \
    VRD(3); SBAR(); GAPA(C0 = __builtin_amdgcn_mfma_f32_32x32x16_bf16(kf[6], qfb, C0, 0, 0, 0),   P1[10], P1[11], P1[12], P1[13], pw3[0] = PKW(P1, 8), pw3[1] = PKW(P1, 10), pw3); \
    VRD(7); SBAR(); GAPA(C1 = __builtin_amdgcn_mfma_f32_32x32x16_bf16(kf[7], qfb, C1, 0, 0, 0),   P1[14], P1[15], 0.f, 0.f,       pw3[2] = PKW(P1, 12), pw3[3] = PKW(P1, 14), pw3); \
    l_reg += sacc; \
    if (GK) { DMA_K((t) + 3, sl_cur); } if (GV) { DMA_V((t) + 1, sl_next); } \
    DECAY(C0, C1, t); \
    CMASK(C0, C1, t); \
    { float a = MX3(C0[0], C0[1], C1[0]), b = MX3(C0[2], C0[3], C1[1]); a = MX3(a, C1[2], C1[3]); \
      _Pragma("unroll") for (int r = 4; r < 16; r += 4) { a = MX3(a, C0[r], C0[r + 1]); b = MX3(b, C0[r + 2], C0[r + 3]); a = MX3(a, C1[r], C1[r + 1]); b = MX3(b, C1[r + 2], C1[r + 3]); } \
      float rm = __builtin_fmaxf(a, b); { auto rr = __builtin_amdgcn_permlane32_swap(__float_as_uint(rm), __float_as_uint(rm), false, false); rm = __builtin_fmaxf(__uint_as_float(rr[0]), __uint_as_float(rr[1])); } \
      resc = false; \
      if (__builtin_expect(__any(rm > (float)THRL), 0)) { const float dl = __builtin_fmaxf(rm, 0.f); nm -= dl; \
        _Pragma("unroll") for (int r = 0; r < 16; ++r) { C0[r] -= dl; C1[r] -= dl; } \
        const float f = __builtin_amdgcn_exp2f(-dl); l_reg *= f; if (hi == 0) wsf[r32] = f; resc = true; } } \
    SBAR(); \
    GAPB(o[0] = __builtin_amdgcn_mfma_f32_32x32x16_bf16(PAF(0), VFR(0), o[0], 0, 0, 0), C0, 0); \
    GAPB(o[1] = __builtin_amdgcn_mfma_f32_32x32x16_bf16(PAF(0), VFR(4), o[1], 0, 0, 0), C0, 4); \
    KRD(GL, 0); GAPB(o[0] = __builtin_amdgcn_mfma_f32_32x32x16_bf16(PAF(1), VFR(1), o[0], 0, 0, 0), C0, 8); \
    KRD(GL, 1); GAPB(o[1] = __builtin_amdgcn_mfma_f32_32x32x16_bf16(PAF(1), VFR(5), o[1], 0, 0, 0), C0, 12); \
    KRD(GL, 2); GAPB(o[0] = __builtin_amdgcn_mfma_f32_32x32x16_bf16(PAF(2), VFR(2), o[0], 0, 0, 0), C1, 0); \
    KRD(GL, 3); GAPB(o[1] = __builtin_amdgcn_mfma_f32_32x32x16_bf16(PAF(2), VFR(6), o[1], 0, 0, 0), C1, 4); \
    GAPB(o[0] = __builtin_amdgcn_mfma_f32_32x32x16_bf16(PAF(3), VFR(3), o[0], 0, 0, 0), C1, 8); \
    qfa = QLD(0); qfb = QLD(1); SBAR(); \
    GAPB(o[1] = __builtin_amdgcn_mfma_f32_32x32x16_bf16(PAF(3), VFR(7), o[1], 0, 0, 0), C1, 12); \
    } while (0)
  int t = 1;
  #undef CMASK
  #define CMASK(P0, P1, t) do {} while (0)
  for (; t + 5 < NT; t += 2) {
    STEP(pB0, pB1, pA0, pA1, t, true, true, true);     WAIT_BAR(2); RESC(); ROT();
    STEP(pA0, pA1, pB0, pB1, t + 1, true, true, true); WAIT_BAR(2); RESC(); ROT();
  }
  #undef CMASK
  #define CMASK(P0, P1, t) do { if (!WIN) { int jb_ = (t) - (NT - 4); if (jb_ >= 0) cmask(P0, P1, jb_, qrel, hi); } } while (0)
  #define ENDW(tt) do { if ((tt) + 3 < NT) { WAIT_BAR(2); } else if ((tt) + 2 < NT) { WAIT_BAR(1); } else { WAIT_BAR(0); } } while (0)
  for (; t + 1 < NT; t += 2) {
    STEP(pB0, pB1, pA0, pA1, t, (t + 3 < NT), (t + 1 < NT), (t + 1 < NT));       ENDW(t);     RESC(); ROT();
    STEP(pA0, pA1, pB0, pB1, t + 1, (t + 4 < NT), (t + 2 < NT), (t + 2 < NT));   ENDW(t + 1); RESC(); ROT();
  }
  bool pf_next = false;
  if constexpr (XP) { pf_next = xp.has_next; if (pf_next) {
    const int n0 = sl_next, n1 = NXS(n0), n2 = NXS(n1);
    const bf16* ksn = xp.Kn + (long)lane * xp.Pn + wid * 8;
    const bf16* vsn = xp.Vn + (long)(16 * (wid & 3) + (lane >> 2)) * xp.Pn + (wid >> 2) * 32 + (lane & 3) * 8;
    glds16(ksn, (unsigned)__builtin_amdgcn_readfirstlane(kdst + n0));
    const bf16* Qwn = xp.Qn + (long)(wid * QBLK) * xp.Pn;
    #pragma unroll
    for (int d0 = 0; d0 < 4; ++d0) qn[d0] = *reinterpret_cast<const bf16x8*>(&Qwn[(long)r32 * xp.Pn + d0 * 16 + hi * 8]);
    glds16(vsn, (unsigned)__builtin_amdgcn_readfirstlane(vdst + n0));
    glds16(ksn + (long)KVBLK * xp.Pn, (unsigned)__builtin_amdgcn_readfirstlane(kdst + n1));
    glds16(ksn + (long)2 * KVBLK * xp.Pn, (unsigned)__builtin_amdgcn_readfirstlane(kdst + n2));
    rho = n0 / SLOTB; } }
  STEP(pB0, pB1, pA0, pA1, NT - 1, false, false, false); RESC();
  { float sacc = pB0[0] + pB0[1]; _Pragma("unroll") for (int r = 2; r < 16; ++r) sacc += pB0[r]; _Pragma("unroll") for (int r = 0; r < 16; ++r) sacc += pB1[r]; l_reg += sacc;
    pw0 = (u32x4){PKW(pB0, 0), PKW(pB0, 2), PKW(pB0, 4), PKW(pB0, 6)}; pw1 = (u32x4){PKW(pB0, 8), PKW(pB0, 10), PKW(pB0, 12), PKW(pB0, 14)}; pw2 = (u32x4){PKW(pB1, 0), PKW(pB1, 2), PKW(pB1, 4), PKW(pB1, 6)}; pw3 = (u32x4){PKW(pB1, 8), PKW(pB1, 10), PKW(pB1, 12), PKW(pB1, 14)};
    SBAR(); pv(o, vb0 + sl_cur, PAF(0), PAF(1), PAF(2), PAF(3)); }
  PA_T1(3); PA_T0(4);
  #undef PKW
  #undef PAF
  #undef VFR
  #undef PIN
  #undef MX3
  #undef GAPA
  #undef SPLAT
  #undef GAPB
  #undef EX
  #undef VRD
  #undef KRD
  #undef STEP
  #undef ENDW
  { auto rr = __builtin_amdgcn_permlane32_swap(__float_as_uint(l_reg), __float_as_uint(l_reg), false, false); l_reg = __uint_as_float(rr[0]) + __uint_as_float(rr[1]); }
  if (hi == 0) wsf[32 + r32] = l_reg; asm volatile("s_waitcnt lgkmcnt(0)" ::: "memory");
  float rli[16];
  #pragma unroll
  for (int r = 0; r < 16; ++r) rli[r] = WIN ? 1.0f : __builtin_amdgcn_rcpf(wsf[32 + crow(r, hi)]);
  if (WIN) { if (hi == 0) *(f32x2*)(PML + 2 * (wtok0 + (long)wtstride * (q0 + wid * QBLK + r32))) = (f32x2){-nm, l_reg}; }
  bf16* Ow = O + (long)(q0 + wid * QBLK) * P;
  { bf16* stg = (bf16*)(shm + LDS_OST) + wid * 2048;
    #pragma unroll
    for (int r = 0; r < 16; ++r) { const int orow = crow(r, hi);
      #pragma unroll
      for (int d0 = 0; d0 < 2; ++d0) stg[orow * 64 + d0 * 32 + r32] = __float2bfloat16(o[d0][r] * rli[r]); }
    asm volatile("s_waitcnt lgkmcnt(0)" ::: "memory");
    #pragma unroll
    for (int i = 0; i < 4; ++i) { const int row = i * 8 + (lane >> 3), ch = lane & 7; const u32x4 v = *(const u32x4*)(stg + row * 64 + ch * 8); *(u32x4*)(Ow + (long)row * P + ch * 8) = v; } }
  if constexpr (XP) { if (pf_next) {
    asm volatile("s_waitcnt vmcnt(5)" ::: "memory");
    #pragma unroll
    for (int d0 = 0; d0 < 4; ++d0) *(LAS bf16x8*)(qp + d0 * 1024) = qn[d0]; } }
  asm volatile("s_waitcnt lgkmcnt(0)\n\ts_barrier" ::: "memory");
  PA_T1(4);
  #undef DMA_K
  #undef DMA_V
  #undef NXS
  #undef CMASK
  #undef DECAY
  #undef START
  #undef RESC
  #undef ROT
  #undef QLD
}
template<int THRL, bool WIN> __device__ __forceinline__ void attn_unit(int qb, int T0, long P, const bf16* Q, const bf16* __restrict__ K, const bf16* __restrict__ V, bf16* O, char* shm, int wave,
                                                                        float* PML = nullptr, long wtok0 = 0, int wtstride = 0) {
  Xpf xp{}; bf16x8 qn[4]; int rho = 0;
  attn_unit_x<THRL, WIN, false>(qb, T0, P, Q, K, V, O, shm, wave, PML, wtok0, wtstride, xp, qn, rho);
}
#undef WAIT_BAR
}

namespace dil {
constexpr float NEGBIG = -1.0e30f;
__device__ __forceinline__ int t5_bucket(int dist) {
    if (dist < 16) return dist;
    const float v = logf((float)dist / 16.0f) / 4.852030263919617f * 16.0f;
    const int l = 16 + (int)v; return l < 31 ? l : 31;
}
__device__ __forceinline__ void build_table(LAS float* tb, const float* rel_bias, int g, int d, int j, int tid) {
    asm volatile("" : "+v"(tid));
    for (int e = tid; e < 640; e += 512) { const int n = e - 256; const float v = (n >= 0 && n <= 128) ? rel_bias[t5_bucket(n * d) * 24 + 8 * g + j] * LOG2E : NEGBIG; const int m = 639 - e;
#pragma unroll
        for (int sft = 0; sft < 4; ++sft) if (m - sft >= 0) tb[640 * sft + m - sft] = v; }
}
}

#define XB_TMO      128
#define XB_XCNT(j)  (256  + 64 * (j))
#define XB_XSUB(j)  (1280 + 64 * (j))
#define XB_XGEN(j)  (2304 + 64 * (j))
#define XB_TOP      3328
#define XB_TOPGEN   3392
#define XCD_BAR_WORDS 3456
#define XB_SPIN_CAP (1u << 18)
__device__ __forceinline__ unsigned xb_ld(unsigned* p)              { return __hip_atomic_load(p, __ATOMIC_RELAXED, __HIP_MEMORY_SCOPE_AGENT); }
__device__ __forceinline__ unsigned xb_add(unsigned* p, unsigned v) { return __hip_atomic_fetch_add(p, v, __ATOMIC_RELAXED, __HIP_MEMORY_SCOPE_AGENT); }
__device__ __forceinline__ unsigned xb_xcc_id() { return (unsigned)__builtin_amdgcn_s_getreg((3 << 11) | 20) & 0xFu; }
#define XB_SPIN(cond, bar) do { unsigned _sp = 0; while (cond) { __builtin_amdgcn_s_sleep(1); \
    if ((++_sp & 255u) == 0u) { if (xb_ld(&(bar)[XB_TMO])) break; if (_sp > XB_SPIN_CAP) { atomicAdd(&(bar)[XB_TMO], 1u); break; } } } } while (0)
struct XcdBarrier { unsigned* bar; unsigned x; volatile LAS unsigned* st; };
__device__ __forceinline__ XcdBarrier xcd_barrier_post(unsigned* bar, volatile LAS unsigned* st, bool leader) {
    XcdBarrier b; b.bar = bar; b.x = xb_xcc_id(); b.st = st;
    if (leader) (void)xb_add(&bar[XB_XCNT(b.x)], 1u);
    return b;
}
__device__ __forceinline__ void xcd_barrier_complete(unsigned* bar, unsigned x, unsigned& nloc, unsigned& nx) {
    const unsigned G = gridDim.x * gridDim.y * gridDim.z;
    unsigned sum, cnt, mine, sp = 0u;
    for (;;) {
        sum = 0u; cnt = 0u; mine = 0u;
#pragma unroll
        for (unsigned j = 0; j < 16; ++j) { const unsigned c = xb_ld(&bar[XB_XCNT(j)]); sum += c; cnt += (c > 0u) ? 1u : 0u; mine = (j == x) ? c : mine; }
        if (sum == G) break;
        __builtin_amdgcn_s_sleep(1);
        if ((++sp & 255u) == 0u) { if (xb_ld(&bar[XB_TMO])) break; if (sp > XB_SPIN_CAP) { atomicAdd(&bar[XB_TMO], 1u); break; } }
    }
    nloc = mine > 0u ? mine : 1u; nx = cnt > 0u ? cnt : 1u;
}
__device__ __forceinline__ void xcd_barrier(const XcdBarrier& b, bool leader) {
    asm volatile("s_waitcnt vmcnt(0)" ::: "memory");
    __syncthreads();
    if (leader) {
        unsigned* bar = b.bar;
        __builtin_amdgcn_s_waitcnt(0);
        unsigned nloc = b.st[0], nx = b.st[1];
        if (nloc == 0u) { xcd_barrier_complete(bar, b.x, nloc, nx); b.st[0] = nloc; b.st[1] = nx; }
        const unsigned old = xb_add(&bar[XB_XSUB(b.x)], 1u);
        const unsigned gen = old / nloc;
        if (old + 1u == (gen + 1u) * nloc) {
            __builtin_amdgcn_fence(__ATOMIC_RELEASE, "agent");
            asm volatile("s_waitcnt vmcnt(0)" ::: "memory");
            const unsigned og = xb_add(&bar[XB_TOP], 1u);
            const unsigned tg = og / nx;
            if (og + 1u == (tg + 1u) * nx) xb_add(&bar[XB_TOPGEN], 1u);
            else XB_SPIN(xb_ld(&bar[XB_TOPGEN]) == tg, bar);
            __builtin_amdgcn_fence(__ATOMIC_ACQUIRE, "agent");
            xb_add(&bar[XB_XGEN(b.x)], 1u);
            asm volatile("s_waitcnt vmcnt(0)" ::: "memory");
        } else {
            XB_SPIN(xb_ld(&bar[XB_XGEN(b.x)]) == gen, bar);
            __builtin_amdgcn_fence(__ATOMIC_ACQUIRE, "agent");
            asm volatile("s_waitcnt vmcnt(0)" ::: "memory");
        }
    }
    __syncthreads();
}

__device__ __forceinline__ const float* inptr(int k) {
    asm volatile("" : "+s"(k));
    return ((const float* const __attribute__((address_space(4)))*)__builtin_amdgcn_kernarg_segment_ptr())[k];
}
#define INP(k) inptr(k)
__device__ __forceinline__ int otid(int wave) { int t = wave * 64 + lane_id(); asm volatile("" : "+v"(t)); return t; }
__device__ __forceinline__ unsigned char* opq_ptr(unsigned char* p) { asm volatile("" : "+s"(p)); return p; }
struct Frame {
    LAS unsigned char* lds;
    volatile LAS unsigned* MISC;
    gu32* ctl;
    int wave;
    int vcu, G;
    float* out;
    unsigned char* ws;
};
__device__ __forceinline__ float wave_sum(float v, int lane) {
#pragma unroll
    for (int o = 1; o < 64; o <<= 1) v += shfl_x(v, lane, o);
    return v;
}

struct P0D { const float* W; int ldw; int K; bf16_t* WT; const float* gain; int kb, nb; int f8; };
__device__ __forceinline__ P0D p0_decode(int it, unsigned char* ws) {
    constexpr int I0 = 16 * 96, I1 = 16 * 32, I2 = 16 * 96, I3 = 16 * 48, I4 = 8 * 32, I5 = 32 * 256, I6 = 32 * 256;
    P0D d; int r = it;
    if (r < I0) { d.f8 = 1; d.W = INP(2); d.ldw = 3088; d.K = 1024; d.WT = (bf16_t*)(ws + WS_WQKVA); d.gain = INP(1); d.kb = r / 96; d.nb = r % 96; return d; } r -= I0;
    if (r < I1) { d.f8 = 0; d.W = INP(6); d.ldw = 1024; d.K = 1024; d.WT = (bf16_t*)(ws + WS_WOA); d.gain = nullptr; d.kb = r / 32; d.nb = r % 32; return d; } r -= I1;
    if (r < I2) { d.f8 = 1; d.W = INP(8); d.ldw = 3072; d.K = 1024; d.WT = (bf16_t*)(ws + WS_WKVQ); d.gain = INP(7); d.kb = r / 96; d.nb = r % 96; return d; } r -= I2;
    if (r < I3) { d.f8 = 1; d.W = INP(12); d.ldw = 1536; d.K = 1024; d.WT = (bf16_t*)(ws + WS_WKVQ + (size_t)3072 * 1024); d.gain = INP(11); d.kb = r / 48; d.nb = r % 48; return d; } r -= I3;
    if (r < I4) { d.f8 = 1; d.W = INP(14); d.ldw = 1024; d.K = 512; d.WT = (bf16_t*)(ws + WS_WOB); d.gain = nullptr; d.kb = r / 32; d.nb = r % 32; return d; } r -= I4;
    if (r < I5) { const int le = r / 256, q = r % 256;
        d.f8 = 1; d.W = INP(20) + (size_t)le * 1024 * 512; d.ldw = 512; d.K = 1024; d.WT = (bf16_t*)(ws + WS_WGU + (size_t)le * 1024 * 1024); d.gain = INP(15) + (le >> 4) * 1024; d.kb = q / 16; d.nb = q % 16; return d; } r -= I5;
    if (r < I6) { const int le = r / 256, q = r % 256;
        d.f8 = 1; d.W = INP(21) + (size_t)le * 1024 * 512; d.ldw = 512; d.K = 1024; d.WT = (bf16_t*)(ws + WS_WGU + (size_t)le * 1024 * 1024 + (size_t)512 * 1024); d.gain = INP(15) + (le >> 4) * 1024; d.kb = q / 16; d.nb = q % 16; return d; } r -= I6;
    { const int le = r / 256, q = r % 256;
        d.f8 = 1; d.W = INP(22) + (size_t)le * 512 * 1024; d.ldw = 1024; d.K = 512; d.WT = (bf16_t*)(ws + WS_WD + (size_t)le * 1024 * 512); d.gain = nullptr; d.kb = q / 32; d.nb = q % 32; return d; }
}
__device__ __forceinline__ void p0_load(const P0D& d, int lane, f32x4 (&v)[8], float (&gv)[8]) {
    const float* src = d.W + (size_t)(64 * d.kb + (lane >> 3)) * d.ldw + 32 * d.nb + 4 * (lane & 7);
#pragma unroll
    for (int i = 0; i < 8; ++i) { v[i] = *(const GAS f32x4*)(src + (size_t)(8 * i) * d.ldw); gv[i] = d.gain ? d.gain[64 * d.kb + (lane >> 3) + 8 * i] : 1.0f; }
}
__device__ __forceinline__ void p0_store(const P0D& d, int lane, const f32x4 (&v)[8], const float (&gv)[8], LAS float* scr) {
#pragma unroll
    for (int i = 0; i < 8; ++i) { LAS float* p = scr + ((lane >> 3) + 8 * i) * 33 + 4 * (lane & 7); const f32x4 x = v[i] * gv[i]; p[0] = x[0]; p[1] = x[1]; p[2] = x[2]; p[3] = x[3]; }
    LDS_WAIT(); asm volatile("" ::: "memory");
    const int c = lane & 7, k0 = 64 * d.kb, n0 = 32 * d.nb;
#pragma unroll
    for (int j = 0; j < 4; ++j) { const int n = (lane >> 3) + 8 * j; const LAS float* s = scr + (8 * c) * 33 + n;
        if (d.f8) { u32x2 o; o.x = pk4_fp8(s[0 * 33] * W8SCALE, s[1 * 33] * W8SCALE, s[2 * 33] * W8SCALE, s[3 * 33] * W8SCALE); o.y = pk4_fp8(s[4 * 33] * W8SCALE, s[5 * 33] * W8SCALE, s[6 * 33] * W8SCALE, s[7 * 33] * W8SCALE);
            *(GAS u32x2*)((unsigned char*)d.WT + (size_t)(n0 + n) * d.K + k0 + 8 * c) = o; }
        else { u32x4 o; o.x = pk2(s[0 * 33], s[1 * 33]); o.y = pk2(s[2 * 33], s[3 * 33]); o.z = pk2(s[4 * 33], s[5 * 33]); o.w = pk2(s[6 * 33], s[7 * 33]);
            *(GAS u32x4*)(d.WT + (size_t)(n0 + n) * d.K + k0 + 8 * c) = o; } }
    LDS_WAIT(); asm volatile("" ::: "memory");
}
struct P0H { const float* W; unsigned char* WT; int kb, nb; };
__device__ __forceinline__ P0H p0h_decode(int idx, unsigned char* ws) { const int le = idx >> 9, hq = idx & 511; P0H d; d.W = INP(22) + (size_t)le * 512 * 1024; d.WT = ws + WS_WD + (size_t)le * 1024 * 512; d.kb = hq >> 6; d.nb = hq & 63; return d; }
__device__ __forceinline__ void p0h_load(const P0H& d, int lane, f32x4 (&v)[4]) {
    const float* src = d.W + (size_t)(64 * d.kb + (lane >> 2)) * 1024 + 16 * d.nb + 4 * (lane & 3);
#pragma unroll
    for (int i = 0; i < 4; ++i) v[i] = *(const GAS f32x4*)(src + (size_t)(16 * i) * 1024);
}
__device__ __forceinline__ void p0h_store(const P0H& d, int lane, const f32x4 (&v)[4], LAS float* scr) {
#pragma unroll
    for (int i = 0; i < 4; ++i) { LAS float* p = scr + ((lane >> 2) + 16 * i) * 17 + 4 * (lane & 3); p[0] = v[i][0]; p[1] = v[i][1]; p[2] = v[i][2]; p[3] = v[i][3]; }
    LDS_WAIT(); asm volatile("" ::: "memory");
    const int n = lane >> 2, c = lane & 3; const LAS float* s = scr + (16 * c) * 17 + n;
    u32x4 o;
    o.x = pk4_fp8(s[0 * 17] * W8SCALE, s[1 * 17] * W8SCALE, s[2 * 17] * W8SCALE, s[3 * 17] * W8SCALE);     o.y = pk4_fp8(s[4 * 17] * W8SCALE, s[5 * 17] * W8SCALE, s[6 * 17] * W8SCALE, s[7 * 17] * W8SCALE);
    o.z = pk4_fp8(s[8 * 17] * W8SCALE, s[9 * 17] * W8SCALE, s[10 * 17] * W8SCALE, s[11 * 17] * W8SCALE); o.w = pk4_fp8(s[12 * 17] * W8SCALE, s[13 * 17] * W8SCALE, s[14 * 17] * W8SCALE, s[15 * 17] * W8SCALE);
    *(GAS u32x4*)(d.WT + (size_t)(16 * d.nb + n) * 512 + 64 * d.kb + 16 * c) = o;
    LDS_WAIT(); asm volatile("" ::: "memory");
}
__device__ __forceinline__ void p0_prologue(Frame& F) {
    const int tid_ = otid(F.wave), lane_ = tid_ & 63;
    LAS float* scr = (LAS float*)(F.lds + F.wave * 16384);
    const int gw = F.vcu * 8 + F.wave, NGW = F.G * 8;
    unsigned char* ws = F.ws;
    constexpr int NITEMS = 16 * 96 + 16 * 32 + 16 * 96 + 16 * 48 + 8 * 32 + 2 * 32 * 256;
    {
        f32x4 va[8], vb[8], vc_[8]; float ga[8], gb[8], gc[8]; P0D da, db, dc;
        int it = gw;
        if (it < NITEMS) { da = p0_decode(it, ws); p0_load(da, lane_, va, ga); }
        if (it + NGW < NITEMS) { db = p0_decode(it + NGW, ws); p0_load(db, lane_, vb, gb); }
        while (it < NITEMS) {
            if (it + 2 * NGW < NITEMS) { dc = p0_decode(it + 2 * NGW, ws); p0_load(dc, lane_, vc_, gc); }
            p0_store(da, lane_, va, ga, scr);
            if (it + NGW >= NITEMS) break;
            if (it + 3 * NGW < NITEMS) { da = p0_decode(it + 3 * NGW, ws); p0_load(da, lane_, va, ga); }
            p0_store(db, lane_, vb, gb, scr);
            if (it + 2 * NGW >= NITEMS) break;
            if (it + 4 * NGW < NITEMS) { db = p0_decode(it + 4 * NGW, ws); p0_load(db, lane_, vb, gb); }
            p0_store(dc, lane_, vc_, gc, scr);
            it += 3 * NGW;
        }
    }
    const int gt = gw * 64 + lane_, NGT = NGW * 64;
    { const float* an = INP(1); const float* awin = INP(2);
    for (int e = gt; e < 16 * 1024; e += NGT) { const int n = e >> 10, k = e & 1023; ((bf16_t*)(ws + WS_WF))[e] = (bf16_t)f2bf(an[k] * awin[(size_t)k * 3088 + 3072 + n]); } }
    const float* fn_ = INP(15); const float* wexp_ = INP(18); const float* wgrp_ = INP(16);
    for (int e = gt; e < 2 * 32 * 1024; e += NGT) { const int l = e >> 15, n = (e >> 10) & 31, k = e & 1023;
        float v = 0.f;
        if (n < 16) v = fn_[l * 1024 + k] * wexp_[((size_t)l * 1024 + k) * 16 + n];
        else if (n < 20) v = fn_[l * 1024 + k] * wgrp_[((size_t)l * 1024 + k) * 4 + (n - 16)];
        const unsigned hb = f2bf(v); const float lo = v - bf2f(hb);
        bf16_t* wr = (bf16_t*)(ws + WS_WR) + (size_t)l * 2 * 32 * 1024;
        wr[n * 1024 + k] = (bf16_t)hb; wr[32 * 1024 + n * 1024 + k] = (bf16_t)f2bf(lo); }
    if (gt < 6 * 64) { const int sgi = gt >> 6, d = gt & 63; float v = 1.0f;
        if (sgi == 0) v = INP(4)[d] * C2; else if (sgi == 1) v = INP(5)[d]; else if (sgi == 3) v = INP(9)[d]; else if (sgi == 5) v = INP(13)[d] * C2;
        ((float*)(ws + WS_GTAB))[gt] = v; }
    const float* x_ = INP(0);
    {
        f32x4 v[4], vn[4], vm[4];
        int m = gw;
        if (m < NTOK) { const GAS f32x4* xr = (const GAS f32x4*)(x_ + (size_t)m * DM) + lane_;
#pragma unroll
            for (int jj = 0; jj < 4; ++jj) v[jj] = xr[64 * jj]; }
        if (m + NGW < NTOK) { const GAS f32x4* xr = (const GAS f32x4*)(x_ + (size_t)(m + NGW) * DM) + lane_;
#pragma unroll
            for (int jj = 0; jj < 4; ++jj) vn[jj] = xr[64 * jj]; }
        while (m < NTOK) {
            if (m + 2 * NGW < NTOK) { const GAS f32x4* xr = (const GAS f32x4*)(x_ + (size_t)(m + 2 * NGW) * DM) + lane_;
#pragma unroll
                for (int jj = 0; jj < 4; ++jj) vm[jj] = xr[64 * jj]; }
            float sq = 0.f;
#pragma unroll
            for (int jj = 0; jj < 4; ++jj) sq += (v[jj].x * v[jj].x + v[jj].y * v[jj].y) + (v[jj].z * v[jj].z + v[jj].w * v[jj].w);
            const float rstd = 1.f / sqrtf(wave_sum(sq, lane_) * (1.f / DM) + EPS);
            GAS unsigned long long* o8 = (GAS unsigned long long*)((bf16_t*)(ws + WS_XB) + (size_t)m * DM) + lane_;
#pragma unroll
            for (int jj = 0; jj < 4; ++jj) o8[64 * jj] = (unsigned long long)pk2(v[jj].x, v[jj].y) | ((unsigned long long)pk2(v[jj].z, v[jj].w) << 32);
            GAS unsigned* q8 = (GAS unsigned*)(ws + WS_XB8 + (size_t)m * DM) + lane_;
#pragma unroll
            for (int jj = 0; jj < 4; ++jj) q8[64 * jj] = pk4_fp8(v[jj].x, v[jj].y, v[jj].z, v[jj].w);
            if (lane_ == 0) ((float*)(ws + WS_RSTD0))[m] = rstd;
#pragma unroll
            for (int jj = 0; jj < 4; ++jj) { v[jj] = vn[jj]; vn[jj] = vm[jj]; }
            m += NGW;
        }
    }
}

__device__ __forceinline__ void forget_phase(Frame& F) {
    const int tid_ = otid(F.wave), lane_ = tid_ & 63;
    const bf16_t* XB = (const bf16_t*)(F.ws + WS_XB); const bf16_t* WF = (const bf16_t*)(F.ws + WS_WF);
    const float* RSTD0 = (const float*)(F.ws + WS_RSTD0); const float* b_f = INP(3);
    float* LC = (float*)(F.ws + WS_LC); float* CT = (float*)(F.ws + WS_CT);
    LAS float* wt = (LAS float*)(F.lds + AUX_OFF);
    const int fr = lane_ & 15, fq = lane_ >> 4;
    for (int chunk = blockIdx.x; chunk < NTOK / 128; chunk += F.G) {
        const int row = chunk * 128 + F.wave * 16 + fr;
        const bf16_t* xa = XB + (size_t)row * DM + 8 * fq; const bf16_t* wb = WF + (size_t)fr * DM + 8 * fq;
        f32x4 acc = {0.f, 0.f, 0.f, 0.f};
#pragma unroll 8
        for (int kb = 0; kb < 32; ++kb) { const bf16x8 a = *(const bf16x8*)(xa + 32 * kb), w = *(const bf16x8*)(wb + 32 * kb); acc = __builtin_amdgcn_mfma_f32_16x16x32_bf16(w, a, acc, 0, 0, 0); }
        const float rs = RSTD0[row];
        float lf[4];
#pragma unroll
        for (int i = 0; i < 4; ++i) { const float z = acc[i] * rs + b_f[4 * fq + i]; lf[i] = fminf(z, 0.f) - log1pf(expf(-fabsf(z))); }
#pragma unroll
        for (int off = 1; off < 16; off <<= 1)
#pragma unroll
            for (int i = 0; i < 4; ++i) { const float t = shfl_from(lf[i], lane_ - off); if (fr >= off) lf[i] += t; }
        if (fr == 15) {
#pragma unroll
            for (int i = 0; i < 4; ++i) wt[F.wave * 16 + 4 * fq + i] = lf[i]; }
        __syncthreads();
#pragma unroll
        for (int i = 0; i < 4; ++i) { float p = 0.f; for (int w = 0; w < F.wave; ++w) p += wt[w * 16 + 4 * fq + i]; lf[i] += p; }
        const int b = row >> 13, s = row & (SEQ - 1);
#pragma unroll
        for (int i = 0; i < 4; ++i) LC[(size_t)(b * 16 + 4 * fq + i) * SEQ + s] = lf[i];
        if (F.wave == 7 && fr == 15) {
#pragma unroll
            for (int i = 0; i < 4; ++i) CT[(b * 16 + 4 * fq + i) * 64 + ((chunk * 128) & (SEQ - 1)) / 128] = lf[i]; }
        __syncthreads();
    }
}

__device__ __forceinline__ void attnA_phase(Frame& F, unsigned char* ldsg) {
    const int tid_ = otid(F.wave), lane_ = tid_ & 63;
    LAS float* NCK = (LAS float*)(F.lds + attn_body::LDS_NCK);
    LAS float* CPs = (LAS float*)(F.lds + AUX_OFF);
    volatile LAS int* ctl = (volatile LAS int*)(F.lds + AUX_OFF + 256);
    const float* LC = (const float*)(F.ws + WS_LC); const float* CT = (const float*)(F.ws + WS_CT);
    float mqk = 0.f;
    { const float* gq_ = INP(4); const float* gk_ = INP(5);
      for (int d = 0; d < 64; ++d) mqk = fmaxf(mqk, fabsf(gq_[d] * gk_[d])); }
    const float thr2 = (40.f + 2.f * 8.f * mqk * 1.03f) * LOG2E;
    unsigned* queue = (unsigned*)(F.ctl + CW_QUEUE);
    for (;;) {
        if (tid_ == 0) ctl[0] = (int)__hip_atomic_fetch_add(queue, 1u, RLX_AGENT);
        __syncthreads();
        const int u = ctl[0];
        if (u >= NBATCH * 16 * 32) break;
        const int qb = 31 - (u >> 6), bh = u & 63, b = bh >> 4, h = bh & 15, q0 = qb * 256, NTf = 4 * qb + 4, nkeys = q0 + 256;
        const float* lcp = LC + (size_t)bh * SEQ;
        f32x4 dva[4]; const P0H ddi = p0h_decode(8 * u + F.wave, F.ws); p0h_load(ddi, lane_, dva);
        if (F.wave == 0) { const float c = CT[bh * 64 + lane_]; float v = c;
#pragma unroll
            for (int off = 1; off < 64; off <<= 1) { const float t = shfl_from(v, lane_ - off); if (lane_ >= off) v += t; }
            const float excl = v - c; CPs[lane_] = excl;
            const float cumq = shfl_from(excl, q0 >> 7) + lcp[q0];
            const bool need = (lane_ <= (q0 >> 7)) && ((cumq - v) * LOG2E >= -thr2);
            const unsigned long long bm = __builtin_amdgcn_ballot_w64(need);
            int t0 = 2 * (int)__builtin_ctzll(bm | (1ull << 63)); t0 = t0 < NTf - 4 ? t0 : NTf - 4;
            if (lane_ == 0) ctl[1] = t0; }
        __syncthreads();
        const int T0 = ctl[1];
        const float cpq = CPs[q0 >> 7], lcq = lcp[q0];
        for (int s = 64 * T0 + tid_; s < nkeys; s += 512) NCK[s] = ((cpq - CPs[s >> 7]) + (lcq - lcp[s])) * LOG2E;
        __syncthreads();
        { const size_t ho = ((size_t)b * SEQ * 1024 + h * 64) * 2;
          attn_body::attn_unit<8, false>(qb, T0, 1024, (const attn_body::bf16*)(F.ws + WS_QA + ho), (const attn_body::bf16*)(F.ws + WS_KA + ho), (const attn_body::bf16*)(F.ws + WS_VA + ho), (attn_body::bf16*)(F.ws + WS_QA + ho), (char*)ldsg, F.wave); }
        p0h_store(ddi, lane_, dva, (LAS float*)(F.lds + F.wave * 8192));
    }
}

__device__ __forceinline__ void router_phase(Frame& F, int layer, const float* stats, float* rstd_out) {
    const int tid_ = otid(F.wave), lane_ = tid_ & 63;
    const bf16_t* XBr = (const bf16_t*)(F.ws + WS_XB); unsigned char* XN8 = (unsigned char*)(F.ws + WS_XN8); const bf16_t* WR = (const bf16_t*)(F.ws + WS_WR) + (size_t)layer * 2 * 32 * 1024;
    const float* b_group = INP(17) + layer * 4; const float* b_expert = INP(19) + layer * 16;
    float* GSORT = (float*)(F.ws + WS_GSORT); int* PERM = (int*)(F.ws + WS_PERM);
    unsigned* CNT = (unsigned*)(F.ctl + (layer == 0 ? CW_CNT0 : CW_CNT1));
    volatile LAS int* lcnt = (volatile LAS int*)(F.lds + AUX_OFF);
    const int fr = lane_ & 15, fq = lane_ >> 4;
#pragma unroll
    for (int p = 0; p < 16; ++p) { const int off = p * 8192 + tid_ * 16, n = off >> 11, pc = (off >> 4) & 127;
        __builtin_amdgcn_global_load_lds((const unsigned*)((const char*)WR + n * 2048 + ((pc ^ (n & 15)) << 4)), (LAS unsigned*)(F.lds + p * 8192 + F.wave * 1024), 16, 0, 0); }
    for (int chunk = blockIdx.x; chunk < NTOK / 128; chunk += F.G) {
        if (tid_ < 64) lcnt[tid_] = 0;
        VM_WAIT();
        __syncthreads();
        const int row = chunk * 128 + F.wave * 16 + fr;
        float ss; { const f32x4 p = *(const f32x4*)(stats + (size_t)row * 16 + 4 * fq); ss = (p[0] + p[1]) + (p[2] + p[3]); ss += shfl_x(ss, 16 * fq + fr, 16); ss += shfl_x(ss, 16 * fq + fr, 32); }
        const float rs = 1.0f / sqrtf(ss * (1.0f / 1024.0f) + EPS);
        const bf16_t* hp = XBr + (size_t)row * DM + 8 * fq;
        unsigned char* x8 = XN8 + (size_t)row * DM + 8 * fq;
        const LAS unsigned char* wl = F.lds + fr * 2048;
        f32x4 a0 = {0.f, 0.f, 0.f, 0.f}, a1 = {0.f, 0.f, 0.f, 0.f};
#pragma unroll 4
        for (int kb = 0; kb < 32; ++kb) {
            const bf16x8 xh = *(const bf16x8*)(hp + 32 * kb);
            const int wc_ = ((4 * kb + fq) ^ fr) << 4;
            const bf16x8 wh0 = *(const LAS bf16x8*)(wl + wc_), wl0 = *(const LAS bf16x8*)(wl + 32 * 2048 + wc_);
            const bf16x8 wh1 = *(const LAS bf16x8*)(wl + 16 * 2048 + wc_), wl1 = *(const LAS bf16x8*)(wl + 48 * 2048 + wc_);
            a0 = __builtin_amdgcn_mfma_f32_16x16x32_bf16(wh0, xh, a0, 0, 0, 0); a0 = __builtin_amdgcn_mfma_f32_16x16x32_bf16(wl0, xh, a0, 0, 0, 0);
            a1 = __builtin_amdgcn_mfma_f32_16x16x32_bf16(wh1, xh, a1, 0, 0, 0); a1 = __builtin_amdgcn_mfma_f32_16x16x32_bf16(wl1, xh, a1, 0, 0, 0);
            u32x2 q8; q8.x = pk4_fp8(bf2f((unsigned short)xh[0]) * rs, bf2f((unsigned short)xh[1]) * rs, bf2f((unsigned short)xh[2]) * rs, bf2f((unsigned short)xh[3]) * rs);
            q8.y = pk4_fp8(bf2f((unsigned short)xh[4]) * rs, bf2f((unsigned short)xh[5]) * rs, bf2f((unsigned short)xh[6]) * rs, bf2f((unsigned short)xh[7]) * rs);
            *(u32x2*)(x8 + 32 * kb) = q8;
        }
        if (fq == 0) rstd_out[row] = rs;
        float gl[4]; int gidx = 0; float gval = 0.f;
        {
#pragma unroll
            for (int i = 0; i < 4; ++i) gl[i] = a1[i] * rs + b_group[i];
            const float mx = fmaxf(fmaxf(gl[0], gl[1]), fmaxf(gl[2], gl[3]));
            float ex[4], sum = 0.f;
#pragma unroll
            for (int i = 0; i < 4; ++i) { ex[i] = expf(gl[i] - mx); sum += ex[i]; }
            float best = -1.f;
#pragma unroll
            for (int i = 0; i < 4; ++i) { const float p = ex[i] / sum; if (p > best) { best = p; gidx = i; } }
            gval = best;
        }
        gidx = shfl_from(gidx, fr); gval = shfl_from(gval, fr);
        int cls = -1, rank = 0; float gwlo = 0.f, gwhi = 0.f;
        if (fq == gidx) {
            float el[4];
#pragma unroll
            for (int i = 0; i < 4; ++i) el[i] = a0[i] * rs + b_expert[4 * fq + i];
            const float mx = fmaxf(fmaxf(el[0], el[1]), fmaxf(el[2], el[3]));
            float pr[4], sum = 0.f;
#pragma unroll
            for (int i = 0; i < 4; ++i) { pr[i] = expf(el[i] - mx); sum += pr[i]; }
#pragma unroll
            for (int i = 0; i < 4; ++i) pr[i] = pr[i] / sum;
            int i1 = 0; float p1 = -1.f;
#pragma unroll
            for (int i = 0; i < 4; ++i) if (pr[i] > p1) { p1 = pr[i]; i1 = i; }
            int i2 = 0; float p2 = -1.f;
#pragma unroll
            for (int i = 0; i < 4; ++i) if (i != i1 && pr[i] > p2) { p2 = pr[i]; i2 = i; }
            const float den = p1 + p2; const float w1g = gval * (p1 / den), w2g = gval * (p2 / den);
            const int lo = i1 < i2 ? i1 : i2, hi = i1 < i2 ? i2 : i1;
            const float wlo = i1 < i2 ? w1g : w2g, whi = i1 < i2 ? w2g : w1g;
            const int pidx = (lo == 0) ? hi - 1 : (lo == 1) ? hi + 1 : 5;
            cls = 6 * gidx + pidx;
            gwlo = wlo; gwhi = whi;
            rank = __hip_atomic_fetch_add((LAS int*)&lcnt[cls], 1, __ATOMIC_RELAXED, __HIP_MEMORY_SCOPE_WORKGROUP);
        }
        __syncthreads();
        if (tid_ < NCLASS) lcnt[32 + tid_] = (int)__hip_atomic_fetch_add(CNT + tid_, (unsigned)lcnt[tid_], RLX_AGENT);
        __syncthreads();
        if (cls >= 0) { const size_t p_ = (size_t)cls * CAP + lcnt[32 + cls] + rank; PERM[p_] = row; *(f32x2*)(GSORT + 2 * p_) = (f32x2){gwlo, gwhi}; }
        __syncthreads();
    }
}
__device__ __forceinline__ void moe_tile_prefix(Frame& F, const int* cnt, volatile LAS int* TP) {
    const int tid_ = otid(F.wave), lane_ = tid_ & 63;
    __syncthreads();
    if (tid_ == 0) { int acc = 0; for (int c = 0; c < NCLASS; ++c) { TP[c] = acc; acc += (cnt[c] + 255) >> 8; } TP[NCLASS] = acc; }
    __syncthreads();
}

__device__ __forceinline__ void dilated_phase(Frame& F, unsigned char* ldsg) {
    const int tid_ = otid(F.wave);
    LAS float* tb = (LAS float*)(F.lds + attn_body::LDS_NCK);
    const int per = (3072 + F.G - 1) / F.G;
    int gjprev = -1, rho = 0; bool primed = false; bf16x8 qn[4];
    for (int i = 0; i < per; ++i) {
        const int u = blockIdx.x * per + i; if (u >= 3072) break;
        const int g = u >> 10, v = u & 1023, j = v >> 7, b = (v >> 5) & 3, x = v & 31;
        const int D4 = 2 * g, d = 1 << D4, r = x & (d - 1), qb = x >> D4;
        unsigned long long pl_t = 0ull; if (PROBE_A == 5) pl_t = __builtin_amdgcn_s_memrealtime();
        if (g * 8 + j != gjprev) { __syncthreads(); dil::build_table(tb, INP(10), g, d, j, tid_); __syncthreads(); gjprev = g * 8 + j; }
        if (!primed) VM_WAIT();
        __syncthreads();
        if (PROBE_A == 5) { const unsigned d_ = (unsigned)(__builtin_amdgcn_s_memrealtime() - pl_t); if (tid_ == 0) ((LAS unsigned*)(F.lds + MISC_OFF))[121] += d_; }
        const size_t ho = (((size_t)(8 * g + j) * NTOK + (size_t)b * SEQ + (size_t)r * (SEQ >> D4)) * 64) * 2;
        const int T0 = qb == 0 ? 0 : 4 * qb - 2;
        attn_body::Xpf xp{}; xp.primed = primed; xp.has_next = (i + 1 < per) && (u + 1 < 3072);
        if (xp.has_next) { const int u2 = u + 1, g2 = u2 >> 10, v2 = u2 & 1023, j2 = v2 >> 7, b2 = (v2 >> 5) & 3, x2 = v2 & 31;
            const int D42 = 2 * g2, d2 = 1 << D42, r2 = x2 & (d2 - 1), qb2 = x2 >> D42, T02 = qb2 == 0 ? 0 : 4 * qb2 - 2;
            const size_t ho2 = (((size_t)(8 * g2 + j2) * NTOK + (size_t)b2 * SEQ + (size_t)r2 * (SEQ >> D42)) * 64) * 2; xp.Pn = 64;
            xp.Qn = (const attn_body::bf16*)(F.ws + WS_QB + ho2) + (long)qb2 * 256 * xp.Pn;
            xp.Kn = (const attn_body::bf16*)(F.ws + WS_KB + ho2) + (long)T02 * 64 * xp.Pn; xp.Vn = (const attn_body::bf16*)(F.ws + WS_VB + ho2) + (long)T02 * 64 * xp.Pn; }
        attn_body::attn_unit_x<8, true, true>(qb, T0, 64, (const attn_body::bf16*)(F.ws + WS_QB + ho), (const attn_body::bf16*)(F.ws + WS_KB + ho), (const attn_body::bf16*)(F.ws + WS_VB + ho),
                                      (attn_body::bf16*)(F.ws + WS_QB + ho), (char*)ldsg, F.wave, (float*)(F.ws + WS_DPML) + (size_t)(g * 8 + j) * NTOK * 2, (long)b * SEQ + r, d, xp, qn, rho);
        primed = xp.has_next;
    }
}
__device__ __forceinline__ void dilated_merge(Frame& F) {
    const int tid_ = otid(F.wave);
    bf16_t* QB = (bf16_t*)(F.ws + WS_QB); const float* PML = (const float*)(F.ws + WS_DPML);
    for (size_t it = (size_t)blockIdx.x * 512 + tid_; it < (size_t)NTOK * 64; it += (size_t)F.G * 512) {
        const int ch = (int)(it & 7), j = (int)((it >> 3) & 7); const size_t tok = it >> 6;
        f32x2 ml[3]; u32x4 o[3];
#pragma unroll
        for (int g = 0; g < 3; ++g) { ml[g] = *(const f32x2*)(PML + ((size_t)(g * 8 + j) * NTOK + tok) * 2); o[g] = *(const u32x4*)(QB + ((size_t)(8 * g + j) * NTOK + pg8::dil_row((int)tok, 2 * g)) * 64 + 8 * ch); }
        const float M = fmaxf(fmaxf(ml[0][0], ml[1][0]), ml[2][0]);
        float f[3], L = 0.f;
#pragma unroll
        for (int g = 0; g < 3; ++g) { f[g] = __builtin_amdgcn_exp2f(ml[g][0] - M); L += f[g] * ml[g][1]; }
        const float rl = 1.0f / L;
        float r8[8];
#pragma unroll
        for (int e = 0; e < 4; ++e) { float lo = 0.f, hh = 0.f;
#pragma unroll
            for (int g = 0; g < 3; ++g) { lo += bf2f(o[g][e] & 0xffffu) * f[g]; hh += bf2f(o[g][e] >> 16) * f[g]; }
            r8[2 * e] = lo * rl; r8[2 * e + 1] = hh * rl; }
        u32x2 q8; q8.x = pk4_fp8(r8[0], r8[1], r8[2], r8[3]); q8.y = pk4_fp8(r8[4], r8[5], r8[6], r8[7]);
        *(GAS u32x2*)(F.ws + WS_XB8 + tok * 512 + 64 * j + 8 * ch) = q8;
    }
}

struct Args { const float* in[23]; float* out; unsigned char* ws; };
__global__ void __launch_bounds__(512, 2) fwd_kernel(Args args) {
    extern __shared__ __attribute__((aligned(16))) unsigned char lds[];
    Frame F;
    F.lds = (LAS unsigned char*)lds;
    F.MISC = (volatile LAS unsigned*)(F.lds + MISC_OFF);
    F.wave = __builtin_amdgcn_readfirstlane((int)threadIdx.x >> 6);
    F.G = gridDim.x; { const int bx = blockIdx.x; F.vcu = (F.G % 8 == 0) ? (bx % 8) * (F.G / 8) + bx / 8 : bx; }
    F.out = args.out; F.ws = args.ws;
    F.ctl = (gu32*)(args.ws + WS_CTL);
    for (int u = otid(F.wave); u < 128; u += 512) ((LAS unsigned*)(F.lds + MISC_OFF))[u] = 0u;
    __syncthreads();
    XcdBarrier bar = xcd_barrier_post((unsigned*)(F.ctl + CW_BAR), F.MISC + 8, F.wave == 0 && lane_id() == 0);
#define GRID_BAR() xcd_barrier(bar, F.wave == 0 && lane_id() == 0)
#ifndef RUN_FROM
#define RUN_FROM 0
#endif
#define RUN(k) ((k) <= RUN_UPTO && (k) >= RUN_FROM)
#ifndef PROBE_MASK
#define PROBE_MASK 0
#endif
    unsigned long long pr_acc = 0ull, pr_t0 = 0ull;
#define PR_BEGIN(k) do { if ((PROBE_MASK >> (k)) & 1) pr_t0 = __builtin_amdgcn_s_memrealtime(); } while (0)
#define PR_END(k) do { if ((PROBE_MASK >> (k)) & 1) pr_acc += __builtin_amdgcn_s_memrealtime() - pr_t0; } while (0)

#define ws opq_ptr(F.ws)
#define XB ((bf16_t*)(ws + WS_XB))
#define H (F.out)
#define TP ((volatile LAS int*)(F.lds + AUX_OFF + 1024))

    PR_BEGIN(0); if (RUN(0)) { p0_prologue(F); GRID_BAR(); } PR_END(0);

    PR_BEGIN(1);
    if (RUN(1)) {
        pg8::GemmP g{(const void*)(ws + WS_XB8), 1024, 1024, 1 << 20, 32, (PROBE_KSEL >> 1) & 1};
        pg8::DenseSched S; S.so.init(NTOK, 3072, F.G, (int)blockIdx.x); S.Bt = (const bf16_t*)(ws + WS_WQKVA); S.lda = 512; S.ldb = 512;
        pg8::EpiHead E{(bf16_t*)(ws + WS_QA), (size_t)(WS_KA - WS_QA) / 2, (const float*)(ws + WS_GTAB), 2, 4, 8, 1024, (const float*)(ws + WS_RSTD0), nullptr, 1.0f / W8SCALE};
        pg8::gemm_phase<pg8::EpiHead, pg8::DenseSched, true>(F.lds, g, S, E, F.wave);
        forget_phase(F);
        GRID_BAR();
    }
    PR_END(1); PR_BEGIN(2);
    if (RUN(2)) { attnA_phase(F, lds); GRID_BAR(); }
    PR_END(2); PR_BEGIN(3);
    if (RUN(3)) {
        pg8::GemmP g{(const bf16_t*)(ws + WS_QA), 2048, 2048, 1 << 20, 128, (PROBE_KSEL >> 3) & 1};
        pg8::DenseSched S; S.so.init(NTOK, 1024, F.G, (int)blockIdx.x); S.Bt = (const bf16_t*)(ws + WS_WOA); S.lda = 1024; S.ldb = 1024;
        pg8::EpiResid E{XB, (float*)(ws + WS_STATS1), 1.0f};
        pg8::gemm_phase<pg8::EpiResid, pg8::DenseSched>(F.lds, g, S, E, F.wave);
        GRID_BAR();
    }
    PR_END(3);
#define MOE_LAYER(PH, layer, STATS_IN, RSTD_BUF, CW_CNT, LASTL, STATS_OUT) \
    PR_BEGIN(PH); if (RUN(PH)) { router_phase(F, layer, (const float*)(ws + STATS_IN), (float*)(ws + RSTD_BUF)); GRID_BAR(); } PR_END(PH); PR_BEGIN(PH + 1); \
    if (RUN(PH + 1)) { \
        const int* cnt = (const int*)(F.ctl + CW_CNT); moe_tile_prefix(F, cnt, TP); \
        pg8::GemmP g{(const void*)ws, 1024, 1024, 1 << 20, 512, (PROBE_KSEL >> (PH + 1)) & 1}; \
        pg8::MoeMixSched S{TP, cnt, (const int*)(ws + WS_PERM), (const unsigned char*)(ws + WS_WGU) + (size_t)layer * 16 * 1024 * 1024, (const unsigned char*)(ws + WS_WD) + (size_t)layer * 16 * 1024 * 512, \
                           F.G, (int)blockIdx.x, __builtin_amdgcn_readfirstlane(TP[NCLASS]), (unsigned*)(F.ctl + CW_DONE + layer * 16384), (unsigned*)(F.ctl + CW_BAR) + XB_TMO}; \
        pg8::EpiMoe<LASTL> E{pg8::EpiSwiglu{(unsigned char*)(ws + WS_HID), (const float*)(ws + WS_GSORT)}, \
                             pg8::EpiScatter<LASTL>{XB, H, STATS_OUT, (const int*)(ws + WS_PERM), 1.0f / (W8SCALE * H8SCALE)}}; \
        pg8::gemm_phase<pg8::EpiMoe<LASTL>, pg8::MoeMixSched, true>(F.lds, g, S, E, F.wave); \
        if (!(LASTL)) GRID_BAR(); } PR_END(PH + 1);
    MOE_LAYER(4, 0, WS_STATS1, WS_RSTD1, CW_CNT0, false, (float*)(ws + WS_STATS2))
    PR_BEGIN(7);
    if (RUN(7)) {
        pg8::GemmP g{(const void*)(ws + WS_XB8), 1024, 1024, 1 << 20, 32, (PROBE_KSEL >> 7) & 1};
        pg8::DenseSched S; S.so.init(NTOK, 4608, F.G, (int)blockIdx.x); S.Bt = (const bf16_t*)(ws + WS_WKVQ); S.lda = 512; S.ldb = 512;
        pg8::EpiHead E{(bf16_t*)(ws + WS_KB), (size_t)(WS_VB - WS_KB) / 2, (const float*)(ws + WS_GTAB) + 3 * 64, 1, 6, 12, KVW, nullptr, (const float*)(ws + WS_STATS2), 1.0f / W8SCALE, 1};
        pg8::gemm_phase<pg8::EpiHead, pg8::DenseSched, true>(F.lds, g, S, E, F.wave);
        GRID_BAR();
    }
    PR_END(7); PR_BEGIN(8);
    if (RUN(8)) { dilated_phase(F, lds); GRID_BAR(); dilated_merge(F); GRID_BAR(); }
    PR_END(8); PR_BEGIN(9);
    if (RUN(9)) {
        pg8::GemmP g{(const void*)(ws + WS_XB8), 512, 512, 1 << 20, 128, (PROBE_KSEL >> 9) & 1};
        pg8::DenseSched S; S.so.init(NTOK, 1024, F.G, (int)blockIdx.x); S.Bt = (const bf16_t*)(ws + WS_WOB); S.lda = 256; S.ldb = 256;
        pg8::EpiResid E{XB, (float*)(ws + WS_STATS3), 1.0f / W8SCALE};
        pg8::gemm_phase<pg8::EpiResid, pg8::DenseSched, true>(F.lds, g, S, E, F.wave);
        GRID_BAR();
    }
    PR_END(9);
    MOE_LAYER(10, 1, WS_STATS3, WS_RSTD3, CW_CNT1, true, (float*)nullptr)

#if RUN_UPTO < 12
    { const int gt = (blockIdx.x * 512 + otid(F.wave)); const f32x4* xs = (const f32x4*)INP(0); f32x4* od = (f32x4*)F.out;
      for (size_t e = gt; e < (size_t)NTOK * DM / 4; e += (size_t)F.G * 512) od[e] = xs[e]; }
#endif
    if (PROBE_K != 0) pr_acc += ((LAS unsigned*)(F.lds + MISC_OFF))[120];
    if (PROBE_A != 0) pr_acc += ((LAS unsigned*)(F.lds + MISC_OFF))[121];
    if (PROBE_MASK != 0 && blockIdx.x == 0 && otid(F.wave) == 0) { const unsigned long long t1 = __builtin_amdgcn_s_memrealtime(); while (__builtin_amdgcn_s_memrealtime() - t1 < pr_acc) __builtin_amdgcn_s_sleep(8); }
    if (__hip_atomic_load((unsigned*)(F.ctl + CW_BAR) + XB_TMO, RLX_AGENT) != 0u) {
        const int gt = (blockIdx.x * 512 + otid(F.wave)); const float q = __builtin_nanf("");
        for (size_t e = gt; e < (size_t)NTOK * DM; e += (size_t)F.G * 512) F.out[e] = q;
    }
}

#undef ws
#undef XB
#undef H
#undef TP
extern "C" void kernel_launch(void* const* d_in, const int* in_sizes, int n_in, void* d_out, int out_size, void* d_ws, size_t ws_size, hipStream_t stream) {
    static int grid = 0;
    if (grid == 0) {
        if (n_in != 23 || in_sizes[0] != NTOK * DM || out_size != NTOK * DM || ws_size < WS_END) { fprintf(stderr, "kernel_launch: unexpected shapes (n_in %d, in0 %d, out %d, ws %zu)\n", n_in, n_in > 0 ? in_sizes[0] : -1, out_size, ws_size); grid = -1; return; }
        int dev = 0, cus = 0, per_cu = 0;
        if (hipGetDevice(&dev) != hipSuccess || hipDeviceGetAttribute(&cus, hipDeviceAttributeMultiprocessorCount, dev) != hipSuccess) { grid = -1; return; }
        if (hipFuncSetAttribute((const void*)fwd_kernel, hipFuncAttributeMaxDynamicSharedMemorySize, LDS_BYTES) != hipSuccess) { fprintf(stderr, "kernel_launch: hipFuncSetAttribute failed\n"); grid = -1; return; }
        if (hipOccupancyMaxActiveBlocksPerMultiprocessor(&per_cu, (const void*)fwd_kernel, 512, LDS_BYTES) != hipSuccess || per_cu < 1) fprintf(stderr, "kernel_launch: occupancy query reports %d\n", per_cu);
        (void)hipGetLastError();
        grid = cus;
    }
    if (grid < 0) return;
    if (hipMemsetAsync((char*)d_ws + WS_CTL, 0, CTL_ZERO_BYTES, stream) != hipSuccess) return;
    Args a{};
    for (int i = 0; i < 23; ++i) a.in[i] = (const float*)d_in[i];
    a.out = (float*)d_out; a.ws = (unsigned char*)d_ws;
    hipLaunchKernelGGL(fwd_kernel, dim3(grid), dim3(512), LDS_BYTES, stream, a);
}
```

```cpp
#include <hip/hip_runtime.h>
#include <hip/hip_bf16.h>
#include <cstdio>
#include <cstdint>
#include <cmath>

#ifndef RUN_UPTO
#define RUN_UPTO 99
#endif

#define GAS __attribute__((address_space(1)))
#define LAS __attribute__((address_space(3)))
typedef unsigned short bf16_t;
typedef short bf16x8 __attribute__((ext_vector_type(8)));
typedef float f32x2 __attribute__((ext_vector_type(2)));
typedef float f32x4 __attribute__((ext_vector_type(4)));
typedef float f32x16 __attribute__((ext_vector_type(16)));
typedef unsigned u32x2 __attribute__((ext_vector_type(2)));
typedef unsigned u32x4 __attribute__((ext_vector_type(4)));
typedef short s16x4 __attribute__((ext_vector_type(4)));
typedef int i32x4 __attribute__((ext_vector_type(4)));
typedef int i32x8 __attribute__((ext_vector_type(8)));
typedef GAS unsigned gu32;

constexpr int NTOK = 32768, DM = 1024, SEQ = 8192, NBATCH = 4;
constexpr int KVW = 1536;
constexpr float EPS = 1e-6f;
constexpr float LOG2E = 1.4426950408889634f;
constexpr float C2 = 0.125f * LOG2E;
constexpr int NCLASS = 24, CAP = 32768;

constexpr size_t MiB = 1u << 20;
constexpr size_t WS_CTL = 0, CTL_ZERO_BYTES = 256 * 1024;
constexpr size_t WS_RSTD0 = 2 * MiB, WS_RSTD1 = 2 * MiB + 128 * 1024, WS_RSTD3 = 2 * MiB + 256 * 1024;
constexpr size_t WS_STATS1 = 3 * MiB, WS_STATS2 = 5 * MiB, WS_STATS3 = 7 * MiB;
constexpr size_t WS_GATES = 9 * MiB;
constexpr size_t WS_LC = 10 * MiB;
constexpr size_t WS_CT = 12 * MiB;
constexpr size_t WS_WF = 12 * MiB + 64 * 1024;
constexpr size_t WS_WR = 12 * MiB + 128 * 1024;
constexpr size_t WS_GTAB = 12 * MiB + 32 * 1024;
constexpr size_t WS_PERM = 13 * MiB;
constexpr size_t WS_WQKVA = 16 * MiB, WS_WOA = 22 * MiB, WS_WKVQ = 24 * MiB, WS_WOB = 33 * MiB;
constexpr size_t WS_WGU = 34 * MiB;
constexpr size_t WS_XB8 = 66 * MiB;
constexpr size_t WS_DPML = 114 * MiB;
constexpr size_t WS_WD = 98 * MiB;
constexpr size_t WS_GSORT = 120 * MiB;
constexpr size_t WS_XB = 132 * MiB;
constexpr size_t WS_R = 196 * MiB;
constexpr size_t WS_QA = WS_R, WS_KA = WS_R + 64 * MiB, WS_VA = WS_R + 128 * MiB;
constexpr size_t WS_HID = WS_R;
constexpr size_t WS_XN8 = WS_R + 44 * MiB;
constexpr size_t WS_KB = WS_R, WS_VB = WS_R + 96 * MiB, WS_QB = WS_R + 192 * MiB;
constexpr size_t WS_END = WS_R + 288 * MiB;
constexpr int CW_BAR = 4096, CW_QUEUE = 8192, CW_CNT0 = 9216, CW_CNT1 = 9216 + 64, CW_DONE = 32768;

constexpr int RING_BYTES = 131072;
constexpr int MISC_OFF = RING_BYTES;
constexpr int AUX_OFF = RING_BYTES + 512;
constexpr int LDS_BYTES = 155648;
constexpr int AUX_BYTES = LDS_BYTES - AUX_OFF;

#define LDS_WAIT() asm volatile("s_waitcnt lgkmcnt(0)" ::: "memory")
#define VM_WAIT() asm volatile("s_waitcnt vmcnt(0)" ::: "memory")
#define RLX_AGENT __ATOMIC_RELAXED, __HIP_MEMORY_SCOPE_AGENT

__device__ __forceinline__ int lane_id() { int l; asm volatile("v_mbcnt_lo_u32_b32 %0, -1, 0\n\tv_mbcnt_hi_u32_b32 %0, -1, %0" : "=v"(l)); return l; }
__device__ __forceinline__ float shfl_from(float v, int srclane) { return __int_as_float(__builtin_amdgcn_ds_bpermute(srclane << 2, __float_as_int(v))); }
__device__ __forceinline__ int shfl_from(int v, int srclane) { return __builtin_amdgcn_ds_bpermute(srclane << 2, v); }
__device__ __forceinline__ float shfl_x(float v, int lane, int mask) { return shfl_from(v, lane ^ mask); }
__device__ __forceinline__ unsigned f2bf(float f) { unsigned u = __builtin_bit_cast(unsigned, f); return (u + 0x7fffu + ((u >> 16) & 1u)) >> 16; }
__device__ __forceinline__ float bf2f(unsigned b) { return __builtin_bit_cast(float, b << 16); }
__device__ __forceinline__ unsigned pk2(float lo, float hi) { return f2bf(lo) | (f2bf(hi) << 16); }
__device__ __forceinline__ unsigned pk4_fp8(float a, float b, float c, float d) { int v = 0; v = __builtin_amdgcn_cvt_pk_fp8_f32(a, b, v, false); v = __builtin_amdgcn_cvt_pk_fp8_f32(c, d, v, true); return (unsigned)v; }
constexpr float W8SCALE = 32.0f, H8SCALE = 16.0f;
__device__ __forceinline__ unsigned cvt_pk_bf16(float lo, float hi) { unsigned r; asm volatile("v_cvt_pk_bf16_f32 %0, %1, %2" : "=v"(r) : "v"(lo), "v"(hi)); return r; }

namespace pg8 {
constexpr int BM = 256, BK = 64, HALF = 128, HTB = HALF * BK * 2, STAGE_BYTES = 8 * HTB, NXCD = 8, WGM = 8;
__host__ __device__ __forceinline__ int lds_byte(int r, int c) { const int st = (r >> 4) * 2 + (c >> 5), rr = r & 15, cc = c & 31, ob = rr * 64 + cc * 2; return st * 1024 + (ob ^ (((ob >> 9) & 1) << 5)); }
__host__ __device__ __forceinline__ void stage_rc(int b, int& R, int& C) { const int st = b / 1024, sb = b % 1024, swz = sb ^ (((sb >> 9) & 1) << 5); R = (st >> 1) * 16 + swz / 64; C = (st & 1) * 32 + (swz % 64) / 2; }
__host__ __device__ __forceinline__ int perm32(int rho) { const int n = rho >> 4, i = rho & 15; return 8 * (i >> 2) + 4 * n + (i & 3); }

struct Unit { int rowbase; int pn; int permoff; int nvalid; int e1; int e2; int type; };
struct GemmP { const void* A; int ldbB; int Kbytes; int nsplit; int hstepB; int pk = 0; };

struct StaticOrder {
    int nM, nN, nwg, G, c;
    __device__ void init(int M, int N, int G_, int c_) { nM = M / BM; nN = N / BM; nwg = nM * nN; G = G_; c = c_; }
    __device__ bool next(int i, int& pm, int& pn) const {
        const long L = (long)i * G + c; if (L >= nwg) return false;
        int wgid = (int)L; { const int q = nwg / NXCD, r = nwg % NXCD, xcd = wgid % NXCD, off = wgid / NXCD; wgid = (xcd < r ? xcd * (q + 1) : r * (q + 1) + (xcd - r) * q) + off; }
        const int nig = WGM * nN, gid = wgid / nig, fm = gid * WGM, gsz = (nM - fm) < WGM ? (nM - fm) : WGM;
        pm = fm + ((wgid % nig) % gsz); pn = (wgid % nig) / gsz; return true;
    }
};
struct DenseSched {
    static constexpr bool MIX = false;
    StaticOrder so; const bf16_t* Bt; int lda, ldb;
    __device__ __forceinline__ bool next(int i, Unit& u) const { int pm, pn; if (!so.next(i, pm, pn)) return false; u.rowbase = pm * BM; u.pn = pn; u.permoff = 0; u.nvalid = 256; u.e1 = 0; u.e2 = 0; u.type = 0; return true; }
    __device__ __forceinline__ void aoff(const Unit& u, const int (&R)[2], const int (&C)[2], unsigned (&v)[2][2]) const {
#pragma unroll
        for (int h = 0; h < 2; ++h)
#pragma unroll
            for (int i = 0; i < 2; ++i) v[h][i] = (unsigned)((u.rowbase + 128 * h + R[i]) * lda + C[i]) * 2u; }
    __device__ __forceinline__ const char* blo(const Unit& u) const { return (const char*)Bt + (size_t)u.pn * 256 * ldb * 2; }
    __device__ __forceinline__ const char* bhi(const Unit& u) const { return blo(u); }
};
__device__ __forceinline__ bool moe_unit(int L, int npn, int TT, const volatile LAS int* TP, const int* cnt, Unit& u) {
    if (L >= TT * npn) return false;
    const int tau = L / npn; u.pn = L % npn;
    int c = 0;
#pragma unroll 1
    for (int k = 1; k < NCLASS; ++k) if (TP[k] <= tau) c = k;
    const int rt = tau - TP[c]; const int n = cnt[c] - 256 * rt;
    u.rowbase = tau * 256; u.permoff = c * CAP + rt * 256; u.nvalid = n < 256 ? n : 256;
    const int g = c / 6, p = c % 6; const int a = (p < 3) ? 0 : (p < 5) ? 1 : 2; const int b = (p < 3) ? p + 1 : (p < 5) ? p - 1 : 3;
    u.e1 = 4 * g + a; u.e2 = 4 * g + b;
    u.rowbase = __builtin_amdgcn_readfirstlane(u.rowbase); u.pn = __builtin_amdgcn_readfirstlane(u.pn); u.permoff = __builtin_amdgcn_readfirstlane(u.permoff);
    u.nvalid = __builtin_amdgcn_readfirstlane(u.nvalid); u.e1 = __builtin_amdgcn_readfirstlane(u.e1); u.e2 = __builtin_amdgcn_readfirstlane(u.e2);
    return true;
}
struct Moe1Sched {      static constexpr bool MIX = false;
    const volatile LAS int* TP; const int* cnt; const int* perm; const unsigned char* Wgu; int G, c, TT;
    __device__ __forceinline__ bool next(int i, Unit& u) const { return moe_unit(i * G + c, 8, TT, TP, cnt, u); }
    __device__ __forceinline__ void aoff(const Unit& u, const int (&R)[2], const int (&C)[2], unsigned (&v)[2][2]) const {
#pragma unroll
        for (int h = 0; h < 2; ++h)
#pragma unroll
            for (int i = 0; i < 2; ++i) { const int r = 128 * h + R[i]; const int tok = (r < u.nvalid) ? ((const GAS int*)perm)[u.permoff + r] : 0; v[h][i] = (unsigned)(tok * 1024 + 2 * C[i]); } }
    __device__ __forceinline__ const char* blo(const Unit& u) const { const int e = (u.pn < 4) ? u.e1 : u.e2; return (const char*)Wgu + ((size_t)e * 1024 + 128 * (u.pn & 3)) * 1024; }
    __device__ __forceinline__ const char* bhi(const Unit& u) const { return blo(u); }
};
struct Moe2Sched {      static constexpr bool MIX = false;
    const volatile LAS int* TP; const int* cnt; const unsigned char* Wd; int G, c, TT;
    __device__ __forceinline__ bool next(int i, Unit& u) const { return moe_unit(i * G + c, 4, TT, TP, cnt, u); }
    __device__ __forceinline__ void aoff(const Unit& u, const int (&R)[2], const int (&C)[2], unsigned (&v)[2][2]) const {
#pragma unroll
        for (int h = 0; h < 2; ++h)
#pragma unroll
            for (int i = 0; i < 2; ++i) v[h][i] = (unsigned)((u.rowbase + 128 * h + R[i]) * 1024 + 2 * C[i]); }
    __device__ __forceinline__ const char* blo(const Unit& u) const { return (const char*)Wd + ((size_t)u.e1 * 1024 + 256 * u.pn) * 512; }
    __device__ __forceinline__ const char* bhi(const Unit& u) const { return (const char*)Wd + ((size_t)u.e2 * 1024 + 256 * u.pn) * 512 - 4 * 128; }
};

struct MoeMixSched {
    static constexpr bool MIX = true;
    const volatile LAS int* TP; const int* cnt; const int* perm; const unsigned char* Wgu; const unsigned char* Wd; int G, c, TT; unsigned* done; unsigned* tmo;
    __device__ __forceinline__ bool next(int i, Unit& u) const {
        const int cc = (G == 256) ? ((c & 7) * 32 + (c >> 3)) : c;
        const int L = i * G + cc, n1 = TT * 8;
        if (L < n1) { moe_unit(L, 8, TT, TP, cnt, u); u.type = 0; return true; }
        if (!moe_unit(L - n1, 4, TT, TP, cnt, u)) return false; u.type = 1; return true; }
    __device__ __forceinline__ void aoff(const Unit& u, const int (&R)[2], const int (&C)[2], unsigned (&v)[2][2]) const {
#pragma unroll
        for (int h = 0; h < 2; ++h)
#pragma unroll
            for (int i = 0; i < 2; ++i) { const int r = 128 * h + R[i];
                if (u.type == 0) { const int tok = (r < u.nvalid) ? ((const GAS int*)perm)[u.permoff + r] : 0; v[h][i] = (unsigned)WS_XN8 + (unsigned)(tok * 1024 + 2 * C[i]); }
                else v[h][i] = (unsigned)WS_HID + (unsigned)((u.rowbase + r) * 1024 + 2 * C[i]); } }
    __device__ __forceinline__ const char* blo(const Unit& u) const {
        if (u.type == 0) { const int e = (u.pn < 4) ? u.e1 : u.e2; return (const char*)Wgu + ((size_t)e * 1024 + 128 * (u.pn & 3)) * 1024; }
        return (const char*)Wd + ((size_t)u.e1 * 1024 + 256 * u.pn) * 512; }
    __device__ __forceinline__ const char* bhi(const Unit& u) const {
        if (u.type == 0) return blo(u);
        return (const char*)Wd + ((size_t)u.e2 * 1024 + 256 * u.pn) * 512 - 4 * 128; }
    __device__ __forceinline__ int ldbB(const Unit& u) const { return u.type == 0 ? 1024 : 512; }
    __device__ __forceinline__ int hstepB(const Unit& u) const { return u.type == 0 ? 512 : 128; }
    __device__ __forceinline__ int nsplit(const Unit& u) const { return u.type == 0 ? (1 << 20) : 4; }
    __device__ __forceinline__ void a_ready(const Unit& u) const {
        if (u.type == 1) { unsigned* w = done + 64 * (u.rowbase >> 8); unsigned sp = 0;
            while (__hip_atomic_load(w, __ATOMIC_RELAXED, __HIP_MEMORY_SCOPE_AGENT) < 64u) { __builtin_amdgcn_s_sleep(2); if (++sp > (1u << 20)) { __hip_atomic_store(tmo, 1u, __ATOMIC_RELAXED, __HIP_MEMORY_SCOPE_AGENT); break; } }
              } }
    __device__ __forceinline__ const unsigned* poll_addr(const Unit& u) const { return done + 64 * (u.rowbase >> 8); }
    __device__ __forceinline__ int done_tile(const Unit& u) const { return (u.type == 0) ? (u.rowbase >> 8) : -1; }
    __device__ __forceinline__ void signal(int tile, int lane) const { if (lane == 0) __hip_atomic_fetch_add(done + 64 * tile, 1u, __ATOMIC_RELAXED, __HIP_MEMORY_SCOPE_AGENT); }
};

__device__ __forceinline__ int dil_row(int tok, int D4) { const int s = tok & (SEQ - 1); return (tok & ~(SEQ - 1)) + ((s & ((1 << D4) - 1)) << (13 - D4)) + (s >> D4); }
__device__ __forceinline__ float row_rstd16(const float* stats, int row) {
    const f32x4* p = (const f32x4*)(stats + (size_t)row * 16); const f32x4 a = p[0], b = p[1], c = p[2], d = p[3];
    const float s = ((a[0] + a[1]) + (a[2] + a[3])) + ((b[0] + b[1]) + (b[2] + b[3])) + ((c[0] + c[1]) + (c[2] + c[3])) + ((d[0] + d[1]) + (d[2] + d[3]));
    return 1.0f / sqrtf(s * (1.0f / 1024.0f) + EPS);
}
struct EpiHead {
    static constexpr int BMODE = 2; static constexpr int NPF = 0;
    bf16_t* dbase; size_t dstride; const float* gtab; int plain_seg; int e0, e1;
    int ldc; const float* rstd; const float* stats; float ascale;
    int dil = 0;
    __device__ __forceinline__ void operator()(const f32x4 (&acc)[2][2][4][2], const Unit& u, int wr, int wc, int fr, int fq) const {
        asm volatile("" : "+v"(fr), "+v"(fq));
        const int pn = u.pn; const int seg = (pn < e0) ? 0 : (pn < e1) ? 1 : 2;
        bf16_t* dst = dbase + (size_t)seg * dstride; const float* gain = gtab + 64 * seg; const bool norm = (seg != plain_seg);
        const int pnl = pn - (seg == 0 ? 0 : seg == 1 ? e0 : e1);
        const int col0 = 64 * (4 * pnl + wc) + 8 * fq;
        f32x4 gv[2][2];
#pragma unroll
        for (int bj = 0; bj < 2; ++bj)
#pragma unroll
            for (int n = 0; n < 2; ++n) gv[bj][n] = *(const f32x4*)(gain + 32 * bj + 8 * fq + 4 * n);
        float rsv[2][4];
        if (rstd) {
#pragma unroll
            for (int ai = 0; ai < 2; ++ai)
#pragma unroll
                for (int m = 0; m < 4; ++m) rsv[ai][m] = ((const GAS float*)rstd)[u.rowbase + ai * HALF + wr * 64 + m * 16 + fr] * ascale;
        } else {
            f32x4 pq[2][4];
#pragma unroll
            for (int ai = 0; ai < 2; ++ai)
#pragma unroll
                for (int m = 0; m < 4; ++m) pq[ai][m] = *(const GAS f32x4*)(stats + (size_t)(u.rowbase + ai * HALF + wr * 64 + m * 16 + fr) * 16 + 4 * fq);
#pragma unroll
            for (int ai = 0; ai < 2; ++ai)
#pragma unroll
                for (int m = 0; m < 4; ++m) { float sq = (pq[ai][m][0] + pq[ai][m][1]) + (pq[ai][m][2] + pq[ai][m][3]); sq += shfl_x(sq, 16 * fq + fr, 16); sq += shfl_x(sq, 16 * fq + fr, 32);
                    rsv[ai][m] = ascale / sqrtf(sq * (1.0f / 1024.0f) + EPS); }
        }
#pragma unroll
        for (int ai = 0; ai < 2; ++ai)
#pragma unroll
            for (int m = 0; m < 4; ++m) {
                const int row = u.rowbase + ai * HALF + wr * 64 + m * 16 + fr;
                const float rs = rsv[ai][m];
                float hr = rs;
                if (norm) {
                    float ss = 0.f;
#pragma unroll
                    for (int bj = 0; bj < 2; ++bj)
#pragma unroll
                        for (int n = 0; n < 2; ++n) { const f32x4 x = acc[ai][bj][m][n]; ss += (x[0] * x[0] + x[1] * x[1]) + (x[2] * x[2] + x[3] * x[3]); }
                    ss += shfl_x(ss, 16 * fq + fr, 16); ss += shfl_x(ss, 16 * fq + fr, 32);
                    hr = rs / sqrtf(ss * rs * rs * (1.0f / 64.0f) + EPS);
                }
                bf16_t* rowp = dil ? dst + ((size_t)(4 * pnl + wc) * NTOK + dil_row(row, 2 * ((4 * pnl + wc) >> 3))) * 64 + 8 * fq : dst + (size_t)row * ldc + col0;
#pragma unroll
                for (int bj = 0; bj < 2; ++bj) {
                    const f32x4 v0 = acc[ai][bj][m][0] * hr * gv[bj][0], v1 = acc[ai][bj][m][1] * hr * gv[bj][1];
                    u32x4 w; w.x = cvt_pk_bf16(v0[0], v0[1]); w.y = cvt_pk_bf16(v0[2], v0[3]); w.z = cvt_pk_bf16(v1[0], v1[1]); w.w = cvt_pk_bf16(v1[2], v1[3]);
                    *(u32x4*)(rowp + 32 * bj) = w; }
                if (m & 1) asm volatile("" ::: "memory");
            }
    }
};
__device__ __forceinline__ void unpack8(const u32x4 b, f32x4& lo, f32x4& hi) {
    lo = (f32x4){bf2f(b.x & 0xffffu), bf2f(b.x >> 16), bf2f(b.y & 0xffffu), bf2f(b.y >> 16)}; hi = (f32x4){bf2f(b.z & 0xffffu), bf2f(b.z >> 16), bf2f(b.w & 0xffffu), bf2f(b.w >> 16)}; }
struct EpiResid {
    static constexpr int BMODE = 1; static constexpr int NPF = 0;
    bf16_t* xb; float* stats; float ascale;
    __device__ __forceinline__ void operator()(const f32x4 (&acc)[2][2][4][2], const Unit& u, int wr, int wc, int fr, int fq) const {
        asm volatile("" : "+v"(fr), "+v"(fq));
        const int col0 = u.pn * BM + wc * 32 + 8 * fq;
#pragma unroll
        for (int ai = 0; ai < 2; ++ai) {
        u32x4 bb[2][4][2];
#pragma unroll
            for (int m = 0; m < 4; ++m)
#pragma unroll
                for (int bj = 0; bj < 2; ++bj) bb[ai][m][bj] = *(const GAS u32x4*)(xb + (size_t)(u.rowbase + ai * HALF + wr * 64 + m * 16 + fr) * 1024 + col0 + bj * HALF);
#pragma unroll
            for (int m = 0; m < 4; ++m) {
                const int row = u.rowbase + ai * HALF + wr * 64 + m * 16 + fr; const size_t off = (size_t)row * 1024 + col0; float ss = 0.f;
#pragma unroll
                for (int bj = 0; bj < 2; ++bj) { const size_t o = off + bj * HALF; f32x4 b0, b1; unpack8(bb[ai][m][bj], b0, b1);
                    const f32x4 v0 = b0 + acc[ai][bj][m][0] * ascale, v1 = b1 + acc[ai][bj][m][1] * ascale;
                    ss += ((v0[0] * v0[0] + v0[1] * v0[1]) + (v0[2] * v0[2] + v0[3] * v0[3])) + ((v1[0] * v1[0] + v1[1] * v1[1]) + (v1[2] * v1[2] + v1[3] * v1[3]));
                    u32x4 w; w.x = cvt_pk_bf16(v0[0], v0[1]); w.y = cvt_pk_bf16(v0[2], v0[3]); w.z = cvt_pk_bf16(v1[0], v1[1]); w.w = cvt_pk_bf16(v1[2], v1[3]); *(GAS u32x4*)(xb + o) = w; }
                ss += shfl_x(ss, 16 * fq + fr, 16); ss += shfl_x(ss, 16 * fq + fr, 32);
                if (fq == 0) ((GAS float*)stats)[(size_t)row * 16 + u.pn * 4 + wc] = ss;
            }
        asm volatile("" ::: "memory"); }
    }
};
struct EpiSwiglu {
    static constexpr int BMODE = 1;
    unsigned char* hid; const float* gsort;
    __device__ __forceinline__ void operator()(const f32x4 (&acc)[2][2][4][2], const Unit& u, int wr, int wc, int fr, int fq, int pf0, int pf1) const {
        asm volatile("" : "+v"(fr), "+v"(fq));
        const int col0 = 512 * (u.pn >> 2) + 128 * (u.pn & 3) + 32 * wc + 8 * fq;
#pragma unroll
        for (int ai = 0; ai < 2; ++ai)
#pragma unroll
            for (int m = 0; m < 4; ++m) {
                const int r = ai * HALF + wr * 64 + m * 16 + fr;
                const float gq = __int_as_float(shfl_from(ai == 0 ? pf0 : pf1, m * 16 + fr)); const float gw = (r < u.nvalid) ? gq * H8SCALE : 0.f;
                float h[8];
#pragma unroll
                for (int n = 0; n < 2; ++n)
#pragma unroll
                    for (int i = 0; i < 4; ++i) { const float g = acc[ai][0][m][n][i] * (1.0f / W8SCALE), up = acc[ai][1][m][n][i] * (1.0f / W8SCALE); const float sg = g * __builtin_amdgcn_rcpf(1.0f + __builtin_amdgcn_exp2f(-g * LOG2E)); h[4 * n + i] = __builtin_fminf(__builtin_fmaxf(sg * up * gw, -440.f), 440.f); }
                u32x2 w; w.x = pk4_fp8(h[0], h[1], h[2], h[3]); w.y = pk4_fp8(h[4], h[5], h[6], h[7]);
                { GAS u32x2* hp_ = (GAS u32x2*)(hid + (size_t)(u.rowbase + r) * 1024 + col0); asm volatile("global_store_dwordx2 %0, %1, off sc1" :: "v"(hp_), "v"(w) : "memory"); }
            }
    }
};
template <bool LAST> struct EpiScatter {
    static constexpr int BMODE = 1;
    bf16_t* xb; float* out; float* stats; const int* perm; float ascale;
    __device__ __forceinline__ void operator()(const f32x4 (&acc)[2][2][4][2], const Unit& u, int wr, int wc, int fr, int fq, int pf0, int pf1) const {
        asm volatile("" : "+v"(fr), "+v"(fq));
        const int col0 = u.pn * BM + wc * 32 + 8 * fq;
        int tokv[2][4];
#pragma unroll
        for (int ai = 0; ai < 2; ++ai)
#pragma unroll
            for (int m = 0; m < 4; ++m) { const int r = ai * HALF + wr * 64 + m * 16 + fr; const int tq = shfl_from(ai == 0 ? pf0 : pf1, m * 16 + fr); tokv[ai][m] = (r < u.nvalid) ? tq : -1; }
#pragma unroll
        for (int ai = 0; ai < 2; ++ai) {
        u32x4 bb[2][4][2];
#pragma unroll
            for (int m = 0; m < 4; ++m)
#pragma unroll
                for (int bj = 0; bj < 2; ++bj) bb[ai][m][bj] = *(const GAS u32x4*)(xb + (size_t)(tokv[ai][m] >= 0 ? tokv[ai][m] : 0) * 1024 + col0 + bj * HALF);
#pragma unroll
            for (int m = 0; m < 4; ++m) {
                const bool valid = tokv[ai][m] >= 0; const int tok = valid ? tokv[ai][m] : 0;
                const size_t off = (size_t)tok * 1024 + col0; float ss = 0.f;
#pragma unroll
                for (int bj = 0; bj < 2; ++bj) { const size_t o = off + bj * HALF; f32x4 b0, b1; unpack8(bb[ai][m][bj], b0, b1);
                    const f32x4 v0 = b0 + acc[ai][bj][m][0] * ascale, v1 = b1 + acc[ai][bj][m][1] * ascale;
                    ss += ((v0[0] * v0[0] + v0[1] * v0[1]) + (v0[2] * v0[2] + v0[3] * v0[3])) + ((v1[0] * v1[0] + v1[1] * v1[1]) + (v1[2] * v1[2] + v1[3] * v1[3]));
                    if (valid) {
                        if constexpr (LAST) { *(GAS f32x4*)(out + o) = v0; *(GAS f32x4*)(out + o + 4) = v1; }
                        else { u32x4 w; w.x = cvt_pk_bf16(v0[0], v0[1]); w.y = cvt_pk_bf16(v0[2], v0[3]); w.z = cvt_pk_bf16(v1[0], v1[1]); w.w = cvt_pk_bf16(v1[2], v1[3]); *(GAS u32x4*)(xb + o) = w;
                               u32x2 q8; q8.x = pk4_fp8(v0[0], v0[1], v0[2], v0[3]); q8.y = pk4_fp8(v1[0], v1[1], v1[2], v1[3]); *(GAS u32x2*)((unsigned char*)xb - (WS_XB - WS_XB8) + o) = q8; } } }
                if (!LAST) { ss += shfl_x(ss, 16 * fq + fr, 16); ss += shfl_x(ss, 16 * fq + fr, 32);
                    if (valid && fq == 0) ((GAS float*)stats)[(size_t)tok * 16 + u.pn * 4 + wc] = ss; }
            }
        asm volatile("" ::: "memory"); }
    }
};

template <bool LAST> struct EpiMoe {
    static constexpr int BMODE = 1;
    static constexpr int NPF = 2;
    EpiSwiglu sw; EpiScatter<LAST> sc;
    __device__ __forceinline__ void prefetch(const Unit& u, int wr, int lane, int& pf0, int& pf1) const {
        const int r0 = wr * 64 + lane;
        const GAS int* p0 = (u.type == 0) ? (const GAS int*)sw.gsort + 2 * (size_t)(u.permoff + r0) + (u.pn >> 2) : (const GAS int*)sc.perm + (u.permoff + r0);
        const GAS int* p1 = p0 + ((u.type == 0) ? 2 * HALF : HALF);
        asm volatile("global_load_dword %0, %2, off\n\tglobal_load_dword %1, %3, off" : "=&v"(pf0), "=&v"(pf1) : "v"(p0), "v"(p1) : "memory"); }
    __device__ __forceinline__ void operator()(const f32x4 (&acc)[2][2][4][2], const Unit& u, int wr, int wc, int fr, int fq, int pf0, int pf1) const {
        if (u.type == 0) sw(acc, u, wr, wc, fr, fq, pf0, pf1); else sc(acc, u, wr, wc, fr, fq, pf0, pf1); }
};

template <class Epi, class Sched, bool F8 = false>
__device__ __forceinline__ void gemm_phase(LAS unsigned char* lds, const GemmP g, const Sched& S, const Epi& E, int wave) {
    int tid = wave * 64 + lane_id(); asm volatile("" : "+v"(tid));
    const int wid = __builtin_amdgcn_readfirstlane(tid >> 6), lane = tid & 63, wr = wid >> 2, wc = wid & 3, fr = lane & 15, fq = lane >> 4;
    const int nt = g.Kbytes / 128;
    unsigned voffB[2]; int RbB[2], CbB[2];
#pragma unroll
    for (int i = 0; i < 2; ++i) { int R[2], C[2]; stage_rc(tid * 16 + i * 8192, R[i], C[i]);
        RbB[i] = (Epi::BMODE == 0) ? R[i] : (Epi::BMODE == 1) ? ((R[i] & ~31) + perm32(R[i] & 31)) : (64 * (R[i] >> 5) + perm32(R[i] & 31)); CbB[i] = 2 * C[i];
        voffB[i] = (unsigned)(RbB[i] * g.ldbB + CbB[i]); }
    const size_t kstep = (size_t)(BK * 2);
    size_t hstepB = (size_t)g.hstepB * g.ldbB; int nsplit = g.nsplit;
    const unsigned ldsw = (unsigned)wid * 1024u;
    const int aoff = lds_byte(wr * 64 + fr, fq * 8), boff = lds_byte(wc * 32 + fr, fq * 8);
    const char* const Ab = (const char*)g.A;
#define PG8_SA(b, h) (((b) * 2 + (h)) * HTB)
#define PG8_SB(b, h) ((4 + (b) * 2 + (h)) * HTB)
#define PG8_STAGE(bufoff, gbase, voff) do { _Pragma("unroll") for (int _i = 0; _i < 2; ++_i) \
        __builtin_amdgcn_global_load_lds((const unsigned*)((const char*)(gbase) + (voff)[_i]), (LAS unsigned*)(lds + (bufoff) + ldsw + _i * 8192), 16, 0, 0); } while (0)
#define PG8_LD8(p) __builtin_shufflevector(*(const LAS i32x4*)(p), *(const LAS i32x4*)((p) + 1024), 0, 1, 2, 3, 4, 5, 6, 7)
#define PG8_LDA(dst, b, h) do { if constexpr (F8) { _Pragma("unroll") for (int m = 0; m < 4; ++m) dst##8[m] = PG8_LD8(lds + PG8_SA(b, h) + aoff + m * 2048); } \
        else { _Pragma("unroll") for (int m = 0; m < 4; ++m) _Pragma("unroll") for (int k = 0; k < 2; ++k) dst[m][k] = *(const LAS bf16x8*)(lds + PG8_SA(b, h) + aoff + m * 2048 + k * 1024); } } while (0)
#define PG8_LDB(dst, b, h) do { if constexpr (F8) { _Pragma("unroll") for (int n = 0; n < 2; ++n) dst##8[n] = PG8_LD8(lds + PG8_SB(b, h) + boff + n * 2048); } \
        else { _Pragma("unroll") for (int n = 0; n < 2; ++n) _Pragma("unroll") for (int k = 0; k < 2; ++k) dst[n][k] = *(const LAS bf16x8*)(lds + PG8_SB(b, h) + boff + n * 2048 + k * 1024); } } while (0)
#define PG8_MMA(ai, bj, At, Bt) do { __builtin_amdgcn_s_setprio(1); \
        if constexpr (F8) { _Pragma("unroll") for (int m = 0; m < 4; ++m) _Pragma("unroll") for (int n = 0; n < 2; ++n) \
            acc[ai][bj][m][n] = __builtin_amdgcn_mfma_scale_f32_16x16x128_f8f6f4(Bt##8[n], At##8[m], acc[ai][bj][m][n], 0, 0, 0, 0, 0, 0); } \
        else { _Pragma("unroll") for (int m = 0; m < 4; ++m) _Pragma("unroll") for (int n = 0; n < 2; ++n) _Pragma("unroll") for (int k = 0; k < 2; ++k) \
            acc[ai][bj][m][n] = __builtin_amdgcn_mfma_f32_16x16x32_bf16(Bt[n][k], At[m][k], acc[ai][bj][m][n], 0, 0, 0); } \
        __builtin_amdgcn_s_setprio(0); } while (0)
#define PG8_WAIT_V(n) asm volatile("s_waitcnt vmcnt(" #n ")" ::: "memory")
#define PG8_WAIT_L(n) asm volatile("s_waitcnt lgkmcnt(" #n ")" ::: "memory")
#define PG8_BAR __builtin_amdgcn_s_barrier()
#define PG8_SCHED __builtin_amdgcn_sched_barrier(0)
#ifndef PROBE_K
#define PROBE_K 0
#endif
#ifndef PROBE_KSEL
#define PROBE_KSEL 0
#endif
    unsigned long long pk_acc = 0ull, pk_t0 = 0ull;
    unsigned pollv = 64u;
    int pf0 = 0, pf1 = 0, pend = -1;
    Unit cur, nxt; int ui = 0;
    if (!S.next(0, cur)) return;
    unsigned vc[2][2];
    LAS u32x4* const vnl = (LAS u32x4*)(lds + AUX_OFF + 2048) + tid;
    { int R[2], C[2]; int t_ = tid; asm volatile("" : "+v"(t_)); stage_rc(t_ * 16, R[0], C[0]); stage_rc(t_ * 16 + 8192, R[1], C[1]); S.aoff(cur, R, C, vc); }
    f32x4 acc[2][2][4][2];
#pragma unroll
    for (int a = 0; a < 2; ++a)
#pragma unroll
        for (int b = 0; b < 2; ++b)
#pragma unroll
            for (int m = 0; m < 4; ++m)
#pragma unroll
                for (int n = 0; n < 2; ++n) acc[a][b][m][n] = (f32x4){0.f, 0.f, 0.f, 0.f};
    bf16x8 At[4][2], B0[2][2], B1[2][2]; i32x8 At8[4], B08[2], B18[2];
    const char* cBl = S.blo(cur); const char* cBh = S.bhi(cur);
    if constexpr (Sched::MIX) { const int lb_ = S.ldbB(cur); voffB[0] = (unsigned)(RbB[0] * lb_ + CbB[0]); voffB[1] = (unsigned)(RbB[1] * lb_ + CbB[1]); hstepB = (size_t)S.hstepB(cur) * lb_; nsplit = S.nsplit(cur); S.a_ready(cur); }
    PG8_STAGE(PG8_SB(0, 0), cBl, voffB); PG8_STAGE(PG8_SB(0, 1), cBl + hstepB, voffB); PG8_STAGE(PG8_SA(0, 0), Ab, vc[0]); PG8_STAGE(PG8_SA(0, 1), Ab, vc[1]);
    if (wr == 1) PG8_BAR;
    PG8_WAIT_V(2); PG8_BAR;
    PG8_STAGE(PG8_SB(1, 0), cBl + kstep, voffB); PG8_STAGE(PG8_SA(1, 0), Ab + kstep, vc[0]); PG8_STAGE(PG8_SB(1, 1), cBl + hstepB + kstep, voffB);
    PG8_WAIT_V(6); PG8_BAR;
    for (;;) {
        const bool has_next = S.next(ui + 1, nxt);
        { unsigned vn[2][2];
          if (has_next) { int R[2], C[2]; int t_ = tid; asm volatile("" : "+v"(t_)); stage_rc(t_ * 16, R[0], C[0]); stage_rc(t_ * 16 + 8192, R[1], C[1]); S.aoff(nxt, R, C, vn); } else {
#pragma unroll
            for (int h = 0; h < 2; ++h)
#pragma unroll
                for (int i = 0; i < 2; ++i) vn[h][i] = vc[h][i]; }
          *vnl = (u32x4){vn[0][0], vn[0][1], vn[1][0], vn[1][1]}; }
        const char* nBl = has_next ? S.blo(nxt) : cBl; const char* nBh = has_next ? S.bhi(nxt) : cBh;
        if (PROBE_K == 1 || PROBE_K == 3) pk_t0 = __builtin_amdgcn_s_memrealtime();
#pragma unroll 1
        for (int t = 0; t < nt; t += 2) {
            const bool last = (t == nt - 2);
            const char* a1 = Ab + (size_t)(t + 1) * kstep;
            const char* a2 = last ? Ab : Ab + (size_t)(t + 2) * kstep;
            const char* b2 = last ? nBl : (((t + 2) < nsplit) ? cBl : cBh) + (size_t)(t + 2) * kstep;
            const char* a3 = a2 + kstep; const char* b3 = b2 + kstep;
            PG8_LDB(B0, 0, 0); PG8_LDB(B1, 0, 1); PG8_SCHED; PG8_LDA(At, 0, 0); PG8_STAGE(PG8_SA(1, 1), a1, vc[1]);
            PG8_WAIT_V(8); PG8_WAIT_L(0); PG8_BAR; PG8_MMA(0, 0, At, B0); PG8_MMA(0, 1, At, B1); PG8_BAR; PG8_SCHED;
            if constexpr (Sched::MIX) { if (t == nt - 4 && !last && has_next && nxt.type == 1) { const GAS unsigned* pa_ = (const GAS unsigned*)S.poll_addr(nxt);
                asm volatile("global_load_dword %0, %1, off sc1" : "=v"(pollv) : "v"(pa_) : "memory"); } }
            if (last) { if constexpr (Epi::NPF > 0) E.prefetch(cur, wr, lane, pf0, pf1);
                const u32x4 v_ = *vnl; vc[0][0] = v_[0]; vc[0][1] = v_[1]; vc[1][0] = v_[2]; vc[1][1] = v_[3];
                if constexpr (Sched::MIX) { if (has_next) { const int lb_ = S.ldbB(nxt); voffB[0] = (unsigned)(RbB[0] * lb_ + CbB[0]); voffB[1] = (unsigned)(RbB[1] * lb_ + CbB[1]); hstepB = (size_t)S.hstepB(nxt) * lb_;
                    if (nxt.type == 1) {
                        bool ok_ = false;
                        if (nt >= 8) { asm volatile("s_waitcnt vmcnt(18)" : "+v"(pollv) :: "memory"); ok_ = (unsigned)__builtin_amdgcn_readfirstlane((int)pollv) >= 64u; }
                        if (!ok_) S.a_ready(nxt); } } } }
            PG8_LDA(At, 0, 1); PG8_STAGE(PG8_SB(0, 0), b2, voffB); PG8_STAGE(PG8_SB(0, 1), b2 + hstepB, voffB); PG8_STAGE(PG8_SA(0, 0), a2, vc[0]);
            if (Epi::NPF > 0 && last) PG8_WAIT_V(10); else PG8_WAIT_V(8);
            PG8_WAIT_L(0); PG8_BAR; PG8_MMA(1, 0, At, B0); PG8_MMA(1, 1, At, B1); PG8_BAR; PG8_SCHED;
            PG8_LDB(B0, 1, 0); PG8_LDB(B1, 1, 1); PG8_SCHED; PG8_LDA(At, 1, 0); PG8_STAGE(PG8_SA(0, 1), a2, vc[1]);
            PG8_WAIT_V(8); PG8_WAIT_L(0); PG8_BAR; PG8_MMA(0, 0, At, B0); PG8_MMA(0, 1, At, B1); PG8_BAR; PG8_SCHED;
            if constexpr (Sched::MIX) { if (t == 0 && pend >= 0) { S.signal(pend, lane); pend = -1; } }
            PG8_LDA(At, 1, 1); PG8_STAGE(PG8_SB(1, 0), b3, voffB); PG8_STAGE(PG8_SB(1, 1), b3 + hstepB, voffB); PG8_STAGE(PG8_SA(1, 0), a3, vc[0]);
            PG8_WAIT_V(8); PG8_WAIT_L(0); PG8_BAR; PG8_MMA(1, 0, At, B0); PG8_MMA(1, 1, At, B1); PG8_BAR; PG8_SCHED;
        }
        if (PROBE_K == 1) pk_acc += __builtin_amdgcn_s_memrealtime() - pk_t0;
        if (PROBE_K == 2) pk_t0 = __builtin_amdgcn_s_memrealtime();
        if (wr == 0) PG8_BAR;
        if constexpr (Epi::NPF > 0) { asm volatile("s_waitcnt vmcnt(14)" : "+v"(pf0), "+v"(pf1) :: "memory"); E(acc, cur, wr, wc, fr, fq, pf0, pf1); }
        else E(acc, cur, wr, wc, fr, fq);
        if constexpr (Sched::MIX) pend = S.done_tile(cur);
        if (PROBE_K == 2) { asm volatile("s_waitcnt vmcnt(0)" ::: "memory"); pk_acc += __builtin_amdgcn_s_memrealtime() - pk_t0; }
        if (PROBE_K == 3) pk_acc += __builtin_amdgcn_s_memrealtime() - pk_t0;
        if (!has_next) break;
#pragma unroll
        for (int a = 0; a < 2; ++a)
#pragma unroll
            for (int b = 0; b < 2; ++b)
#pragma unroll
                for (int m = 0; m < 4; ++m)
#pragma unroll
                    for (int n = 0; n < 2; ++n) acc[a][b][m][n] = (f32x4){0.f, 0.f, 0.f, 0.f};
        cur = nxt; cBl = nBl; cBh = nBh; ++ui;
        if constexpr (Sched::MIX) nsplit = S.nsplit(cur);
        if (wr == 1) PG8_BAR;
    }
    PG8_WAIT_V(0);
    if constexpr (Sched::MIX) { if (pend >= 0) S.signal(pend, lane); }
    PG8_BAR;
    if (PROBE_K != 0 && g.pk && tid == 0) { LAS unsigned* pw_ = (LAS unsigned*)(lds + MISC_OFF) + 120; *pw_ += (unsigned)pk_acc; }
#undef PG8_SA
#undef PG8_SB
#undef PG8_STAGE
#undef PG8_LDA
#undef PG8_LDB
#undef PG8_MMA
#undef PG8_LD8
#undef PG8_WAIT_V
#undef PG8_WAIT_L
#undef PG8_BAR
#undef PG8_SCHED
}
}

namespace attn_body {
using bf16 = __hip_bfloat16;
constexpr int NHEAD = 16, D = 64, DMQ = NHEAD * D;
constexpr int NW = 8, QBLK = 32, QB = QBLK * NW, KVBLK = 64;
__device__ __forceinline__ int crow(int r, int hi) { return (r & 3) + 8 * (r >> 2) + 4 * hi; }
#define SBAR() __builtin_amdgcn_sched_barrier(0)
__device__ __forceinline__ void cmask(f32x16& p0, f32x16& p1, int jb, int qrel, int hi) {
  const float NEG = -INFINITY; int kb = 64 * jb + 4 * hi;
  #pragma unroll
  for (int r = 0; r < 16; ++r) { int kv = kb + (r & 3) + 8 * (r >> 2); if (kv > qrel) p0[r] = NEG; if (kv + 32 > qrel) p1[r] = NEG; }
}
constexpr int NSLOT = 3, SLOTB = 8192;
constexpr int LDS_K = 0, LDS_V = NSLOT * SLOTB, LDS_WS = 2 * NSLOT * SLOTB, LDS_OST = LDS_WS + NW * 64 * 4, ATT_LDS_BYTES = LDS_OST + NW * 4096;
constexpr int LDS_NCK = 86016;
__device__ __forceinline__ void glds16(const void* gsrc, unsigned lds_dst) { unsigned keep;
  asm volatile("s_mov_b32 %0, m0\n\ts_mov_b32 m0, %2\n\ts_nop 0\n\tglobal_load_lds_dwordx4 %1, off\n\ts_mov_b32 m0, %0" : "=&s"(keep) : "v"(gsrc), "s"(lds_dst) : "memory"); }
__device__ __forceinline__ float max3f(float a, float b, float c) { float r; asm("v_max3_f32 %0, %1, %2, %3" : "=v"(r) : "v"(a), "v"(b), "v"(c)); return r; }
__device__ __forceinline__ float max2f(float a, float b) { float r; asm("v_max_f32_e32 %0, %1, %2" : "=v"(r) : "v"(a), "v"(b)); return r; }
__device__ __forceinline__ float fadd_s(float a, float b) { float r; asm("v_add_f32_e32 %0, %1, %2" : "=v"(r) : "v"(a), "v"(b)); return r; }
__device__ __forceinline__ float fsub_s(float a, float b) { float r; asm("v_sub_f32_e32 %0, %1, %2" : "=v"(r) : "v"(a), "v"(b)); return r; }
typedef __bf16 bf16x2_t __attribute__((ext_vector_type(2)));
__device__ __forceinline__ unsigned cvtpk_s(float lo, float hi) { f32x2 v = {lo, hi}; bf16x2_t b = __builtin_convertvector(v, bf16x2_t); return __builtin_bit_cast(unsigned, b); }
#define WAIT_BAR(N) asm volatile("s_waitcnt vmcnt(" #N ") lgkmcnt(0)\n\ts_barrier" ::: "memory")
typedef LAS const char* lds_cptr;
typedef short v4i16_t __attribute__((ext_vector_type(4)));
__device__ __forceinline__ void qkt(f32x16& p0, f32x16& p1, lds_cptr Kslot, const bf16x8* qr, const f32x16& negm, int r32, int hi) {
  lds_cptr kb = Kslot + hi * 1024 + r32 * 16;
  #pragma unroll
  for (int d0 = 0; d0 < 4; ++d0) {
    const bf16x8 b0 = *(const LAS bf16x8*)(kb + d0 * 2048);
    const bf16x8 b1 = *(const LAS bf16x8*)(kb + d0 * 2048 + 512);
    if (d0 == 0) { p0 = __builtin_amdgcn_mfma_f32_32x32x16_bf16(b0, qr[0], negm, 0, 0, 0); p1 = __builtin_amdgcn_mfma_f32_32x32x16_bf16(b1, qr[0], negm, 0, 0, 0); }
    else { p0 = __builtin_amdgcn_mfma_f32_32x32x16_bf16(b0, qr[d0], p0, 0, 0, 0); p1 = __builtin_amdgcn_mfma_f32_32x32x16_bf16(b1, qr[d0], p1, 0, 0, 0); } }
}
__device__ __forceinline__ void kload8(bf16x8* kf, lds_cptr kp) {
  kf[0] = *(const LAS bf16x8*)(kp);        kf[1] = *(const LAS bf16x8*)(kp + 512);
  kf[2] = *(const LAS bf16x8*)(kp + 2048); kf[3] = *(const LAS bf16x8*)(kp + 2560);
  kf[4] = *(const LAS bf16x8*)(kp + 4096); kf[5] = *(const LAS bf16x8*)(kp + 4608);
  kf[6] = *(const LAS bf16x8*)(kp + 6144); kf[7] = *(const LAS bf16x8*)(kp + 6656);
}
__device__ __forceinline__ void kload2(bf16x8* kf, lds_cptr kp, int j) { kf[2 * j] = *(const LAS bf16x8*)(kp + j * 2048); kf[2 * j + 1] = *(const LAS bf16x8*)(kp + j * 2048 + 512); }
__device__ __forceinline__ s16x4 vtr(lds_cptr p) { return __builtin_bit_cast(s16x4, __builtin_amdgcn_ds_read_tr16_b64_v4i16((LAS v4i16_t*)p)); }
__device__ __forceinline__ float rowmax(const f32x16& p0, const f32x16& p1) {
  float a = max3f(p0[0], p0[1], p1[0]), b = max3f(p0[2], p0[3], p1[1]); a = max3f(a, p1[2], p1[3]);
  #pragma unroll
  for (int r = 4; r < 16; r += 4) { a = max3f(a, p0[r], p0[r + 1]); b = max3f(b, p0[r + 2], p0[r + 3]); a = max3f(a, p1[r], p1[r + 1]); b = max3f(b, p1[r + 2], p1[r + 3]); }
  const float m = max2f(a, b);
  auto rr = __builtin_amdgcn_permlane32_swap(__float_as_uint(m), __float_as_uint(m), false, false);
  return max2f(__uint_as_float(rr[0]), __uint_as_float(rr[1]));
}
__device__ __forceinline__ void pv(f32x16* o, int vb, bf16x8 pa0, bf16x8 pa1, bf16x8 pa2, bf16x8 pa3) {
  #pragma unroll
  for (int d0 = 0; d0 < 2; ++d0) { s16x4 lo[4], hi[4];
    #pragma unroll
    for (int ks = 0; ks < 4; ++ks) {
      asm volatile("ds_read_b64_tr_b16 %0,%1 offset:%c2" : "=&v"(lo[ks]) : "v"(vb), "i"(d0 * 4096 + ks * 1024) : "memory");
      asm volatile("ds_read_b64_tr_b16 %0,%1 offset:%c2" : "=&v"(hi[ks]) : "v"(vb), "i"(d0 * 4096 + ks * 1024 + 512) : "memory"); }
    asm volatile("s_waitcnt lgkmcnt(0)" ::: "memory"); SBAR();
    #define PK(k) (bf16x8){lo[k][0], lo[k][1], lo[k][2], lo[k][3], hi[k][0], hi[k][1], hi[k][2], hi[k][3]}
    o[d0] = __builtin_amdgcn_mfma_f32_32x32x16_bf16(pa0, PK(0), o[d0], 0, 0, 0);
    o[d0] = __builtin_amdgcn_mfma_f32_32x32x16_bf16(pa1, PK(1), o[d0], 0, 0, 0);
    o[d0] = __builtin_amdgcn_mfma_f32_32x32x16_bf16(pa2, PK(2), o[d0], 0, 0, 0);
    o[d0] = __builtin_amdgcn_mfma_f32_32x32x16_bf16(pa3, PK(3), o[d0], 0, 0, 0);
    #undef PK
  }
}

struct Xpf { bool primed, has_next; long Pn; const bf16* Qn; const bf16* Kn; const bf16* Vn; };
template<int THRL, bool WIN, bool XP> __device__ __forceinline__ void attn_unit_x(int qb, int T0, long P, const bf16* Q, const bf16* __restrict__ K, const bf16* __restrict__ V, bf16* O, char* shm, int wave,
                                                                        float* PML, long wtok0, int wtstride, const Xpf xp, bf16x8 (&qn)[4], int& rho) {
#ifndef PROBE_A
#define PROBE_A 0
#endif
  unsigned long long pa_t = 0ull;
#define PA_T0(k) do { if (WIN && PROBE_A == (k)) pa_t = __builtin_amdgcn_s_memrealtime(); } while (0)
#define PA_T1(k) do { if (WIN && PROBE_A == (k)) { const unsigned d_ = (unsigned)(__builtin_amdgcn_s_memrealtime() - pa_t); if (tid == 0) *(unsigned*)(shm + MISC_OFF + 4 * 121) += d_; } } while (0)
  int tid = wave * 64 + lane_id(); asm volatile("" : "+v"(tid));
  const int lane = tid & 63, r32 = lane & 31, hi = lane >> 5; const int wid = __builtin_amdgcn_readfirstlane(tid >> 6);
  PA_T0(1);
  const int q0 = qb * QB;
  const bf16* Qw = Q + (long)(q0 + wid * QBLK) * P;
  const bf16* Kh = K + (long)T0 * KVBLK * P, *Vh = V + (long)T0 * KVBLK * P;
  const unsigned lds0 = (unsigned)(uintptr_t)shm; const lds_cptr shm3 = (lds_cptr)shm;
  float* wsf = (float*)(shm + LDS_WS) + wid * 64;
  const int wbj = 383 - (q0 + wid * QBLK + r32 - T0 * KVBLK) + 4 * hi;
  const LAS float* nck0 = WIN ? (const LAS float*)((lds_cptr)shm + LDS_NCK) + (wbj & 3) * 640 + (wbj & ~3)
                              : (const LAS float*)((lds_cptr)shm + LDS_NCK) + T0 * KVBLK + 4 * hi;
  const float cq2 = WIN ? 0.f : -((const LAS float*)((lds_cptr)shm + LDS_NCK))[q0 + wid * QBLK + r32];
  const bf16* ksrc = Kh + (long)lane * P + wid * 8;
  const bf16* vsrc = Vh + (long)(16 * (wid & 3) + (lane >> 2)) * P + (wid >> 2) * 32 + (lane & 3) * 8;
  const unsigned kdst = lds0 + LDS_K + wid * 1024, vdst = lds0 + LDS_V + wid * 1024;
  #define DMA_K(t, slot) glds16(ksrc + (long)(t) * KVBLK * P, (unsigned)__builtin_amdgcn_readfirstlane(kdst + (slot)))
  #define DMA_V(t, slot) glds16(vsrc + (long)(t) * KVBLK * P, (unsigned)__builtin_amdgcn_readfirstlane(vdst + (slot)))
  const int vb0 = (int)(lds0 + LDS_V) + ((lane >> 4) & 1) * 32 + (lane & 3) * 8 + (4 * hi + ((lane & 15) >> 2)) * 64;
  bf16x8 kf[8];
  const lds_cptr kp0 = shm3 + LDS_K + hi * 1024 + r32 * 16; const lds_cptr vp0 = shm3 + LDS_V + ((lane >> 4) & 1) * 32 + (lane & 3) * 8 + (4 * hi + ((lane & 15) >> 2)) * 64;
  const int NT = (q0 + QB) / KVBLK - T0;
  #define NXS(s) (((s) == (NSLOT - 1) * SLOTB) ? 0 : (s) + SLOTB)
  const int s0 = XP ? __builtin_amdgcn_readfirstlane(rho) * SLOTB : 0, s1 = NXS(s0), s2 = NXS(s1);
  const bool primed = XP && xp.primed;
  if (!primed) { DMA_K(0, s0); DMA_V(0, s0); DMA_K(1, s1); }
  bf16x8 qr[4];
  const lds_cptr qp = shm3 + LDS_OST + wid * 4096 + lane * 16;
  if (!primed) {
  #pragma unroll
  for (int d0 = 0; d0 < 4; ++d0) qr[d0] = *reinterpret_cast<const bf16x8*>(&Qw[(long)r32 * P + d0 * 16 + hi * 8]);
  #pragma unroll
  for (int d0 = 0; d0 < 4; ++d0) *(LAS bf16x8*)(qp + d0 * 1024) = qr[d0];
  } else {
  #pragma unroll
  for (int d0 = 0; d0 < 4; ++d0) qr[d0] = qn[d0];
  }
  #define QLD(d) (*(const LAS bf16x8*)(qp + (d) * 1024))
  float nm = cq2, l_reg = 0.f; f32x16 o[2]; o[0] = f32x16{}; o[1] = f32x16{};
  const int qrel = wid * QBLK + r32;
  #define CMASK(P0, P1, t) do { if (!WIN) { int jb_ = (t) - (NT - 4); if (jb_ >= 0) cmask(P0, P1, jb_, qrel, hi); } } while (0)
  #define DECAY(P0, P1, t) do { const LAS float* nk_ = nck0 + ((t) << 6); \
    _Pragma("unroll") for (int g_ = 0; g_ < 4; ++g_) { const f32x4 a_ = *(const LAS f32x4*)(nk_ + 8 * g_); const f32x4 b_ = *(const LAS f32x4*)(nk_ + 32 + 8 * g_); \
      P0[4 * g_] += a_[0]; P0[4 * g_ + 1] += a_[1]; P0[4 * g_ + 2] += a_[2]; P0[4 * g_ + 3] += a_[3]; P1[4 * g_] += b_[0]; P1[4 * g_ + 1] += b_[1]; P1[4 * g_ + 2] += b_[2]; P1[4 * g_ + 3] += b_[3]; SBAR(); } } while (0)
  bool resc = false;
  #define START(P0, P1) do { const float rm = rowmax(P0, P1); resc = false; \
    { const float dl = max2f(rm, -1000.f); nm = fsub_s(nm, dl); \
      _Pragma("unroll") for (int r = 0; r < 16; ++r) { P0[r] = fsub_s(P0[r], dl); P1[r] = fsub_s(P1[r], dl); } } \
    _Pragma("unroll") for (int r = 0; r < 16; ++r) P0[r] = __builtin_amdgcn_exp2f(P0[r]); } while (0)
  #define RESC() do { if (resc) { asm volatile("s_waitcnt lgkmcnt(0)" ::: "memory"); \
      _Pragma("unroll") for (int d_ = 0; d_ < 2; ++d_) _Pragma("unroll") for (int r = 0; r < 16; ++r) o[d_][r] *= wsf[crow(r, hi)]; } } while (0)
  f32x16 pA0, pA1, pB0, pB1;
  int sl_prev = s0, sl_cur = s0, sl_next = s1;
  #define ROT() do { sl_prev = sl_cur; sl_cur = sl_next; sl_next = (sl_next == (NSLOT - 1) * SLOTB) ? 0 : sl_next + SLOTB; } while (0)
  if (!primed) { DMA_K(2, s2); WAIT_BAR(3); }
  PA_T1(1); PA_T0(2);
  { f32x16 negm;
    #pragma unroll
    for (int r = 0; r < 16; ++r) negm[r] = nm;
    qkt(pA0, pA1, shm3 + LDS_K + s0, qr, negm, r32, hi); }
  asm volatile("s_nop 15\n\ts_nop 7" : "+v"(pA0), "+v"(pA1)); DECAY(pA0, pA1, 0); CMASK(pA0, pA1, 0);
  asm volatile("s_nop 1" : "+v"(pA0), "+v"(pA1));
  START(pA0, pA1);
  _Pragma("unroll") for (int r = 0; r < 16; ++r) pA1[r] = __builtin_amdgcn_exp2f(pA1[r]);
  WAIT_BAR(0);
  DMA_K(3, s0); DMA_V(1, s1);
  ROT();
  kload8(kf, kp0 + sl_cur);
  WAIT_BAR(2);
  PA_T1(2); PA_T0(3);
  s16x4 vlo[8], vhi[8]; u32x4 pw0, pw1, pw2, pw3; bf16x8 qfa = QLD(0), qfb = QLD(1);
  #define PKW(P, B) cvtpk_s(P[B], P[B + 1])
  #define PAF(k) __builtin_bit_cast(bf16x8, pw##k)
  #define VFR(i) (bf16x8){vlo[i][0], vlo[i][1], vlo[i][2], vlo[i][3], vhi[i][0], vhi[i][1], vhi[i][2], vhi[i][3]}
  #define PIN(x) asm volatile("" : "+v"(x))
  #define MX3(a, b, c) __builtin_fmaxf(__builtin_fmaxf((a), (b)), (c))
  #define SPLAT(X) do { _Pragma("unroll") for (int r_ = 0; r_ < 16; ++r_) X[r_] = nm; PIN(X); } while (0)
  #define GAPA(MF, A0, A1, A2, A3, W0, W1, PW) do { MF; sacc += A0; sacc += A1; sacc += A2; sacc += A3; PIN(sacc); W0; W1; PIN(PW); SBAR(); } while (0)
  #define EX(v) __builtin_amdgcn_exp2f(v)
  #define GAPB(MF, X, B) do { MF; X[B] = EX(X[B]); X[B + 1] = EX(X[B + 1]); X[B + 2] = EX(X[B + 2]); X[B + 3] = EX(X[B + 3]); PIN(X); SBAR(); } while (0)
  #define VRD(i) do { vlo[i] = vtr(vp_ + (((i) >> 2) * 4096 + ((i) & 3) * 1024)); vhi[i] = vtr(vp_ + (((i) >> 2) * 4096 + ((i) & 3) * 1024 + 512)); } while (0)
  #define KRD(G, j) do { if (G) { kload2(kf, kp0 + sl_next, j); SBAR(); } } while (0)
  #define STEP(C0, C1, P0, P1, t, GK, GV, GL) do { SBAR(); \
    const lds_cptr vp_ = vp0 + sl_prev; \
    SPLAT(C0); VRD(0); SBAR(); float sacc = (P0[0] + P0[1]); \
    GAPA(C0 = __builtin_amdgcn_mfma_f32_32x32x16_bf16(kf[0], qfa, C0, 0, 0, 0), P0[2], P0[3], P0[4], P0[5],     pw0[0] = PKW(P0, 0), pw0[1] = PKW(P0, 2), pw0); \
    SPLAT(C1); VRD(4); SBAR(); GAPA(C1 = __builtin_amdgcn_mfma_f32_32x32x16_bf16(kf[1], qfa, C1, 0, 0, 0), P0[6], P0[7], P0[8], P0[9],     pw0[2] = PKW(P0, 4), pw0[3] = PKW(P0, 6), pw0); \
    qfa = QLD(2); VRD(1); SBAR(); GAPA(C0 = __builtin_amdgcn_mfma_f32_32x32x16_bf16(kf[2], qfb, C0, 0, 0, 0),   P0[10], P0[11], P0[12], P0[13], pw1[0] = PKW(P0, 8), pw1[1] = PKW(P0, 10), pw1); \
    VRD(5); SBAR(); GAPA(C1 = __builtin_amdgcn_mfma_f32_32x32x16_bf16(kf[3], qfb, C1, 0, 0, 0),   P0[14], P0[15], P1[0], P1[1],   pw1[2] = PKW(P0, 12), pw1[3] = PKW(P0, 14), pw1); \
    qfb = QLD(3); VRD(2); SBAR(); GAPA(C0 = __builtin_amdgcn_mfma_f32_32x32x16_bf16(kf[4], qfa, C0, 0, 0, 0),   P1[2], P1[3], P1[4], P1[5],     pw2[0] = PKW(P1, 0), pw2[1] = PKW(P1, 2), pw2); \
    VRD(6); SBAR(); GAPA(C1 = __builtin_amdgcn_mfma_f32_32x32x16_bf16(kf[5], qfa, C1, 0, 0, 0),   P1[6], P1[7], P1[8], P1[9],     pw2[2] = PKW(P1, 4), pw2[3] = PKW(P1, 6), pw2); \
    VRD(3); SBAR(); GAPA(C0 = __builtin_amdgcn_mfma_f32_32x32x16_bf16(kf[6], qfb, C0, 0, 0, 0),   P1[10], P1[11], P1[12], P1[13], pw3[0] = PKW(P1, 8), pw3[1] = PKW(P1, 10), pw3); \
    VRD(7); SBAR(); GAPA(C1 = __builtin_amdgcn_mfma_f32_32x32x16_bf16(kf[7], qfb, C1, 0, 0, 0),   P1[14], P1[15], 0.f, 0.f,       pw3[2] = PKW(P1, 12), pw3[3] = PKW(P1, 14), pw3); \
    l_reg += sacc; \
    if (GK) { DMA_K((t) + 3, sl_cur); } if (GV) { DMA_V((t) + 1, sl_next); } \
    DECAY(C0, C1, t); \
    CMASK(C0, C1, t); \
    { float a = MX3(C0[0], C0[1], C1[0]), b = MX3(C0[2], C0[3], C1[1]); a = MX3(a, C1[2], C1[3]); \
      _Pragma("unroll") for (int r = 4; r < 16; r += 4) { a = MX3(a, C0[r], C0[r + 1]); b = MX3(b, C0[r + 2], C0[r + 3]); a = MX3(a, C1[r], C1[r + 1]); b = MX3(b, C1[r + 2], C1[r + 3]); } \
      float rm = __builtin_fmaxf(a, b); { auto rr = __builtin_amdgcn_permlane32_swap(__float_as_uint(rm), __float_as_uint(rm), false, false); rm = __builtin_fmaxf(__uint_as_float(rr[0]), __uint_as_float(rr[1])); } \
      resc = false; \
      if (__builtin_expect(__any(rm > (float)THRL), 0)) { const float dl = __builtin_fmaxf(rm, 0.f); nm -= dl; \
        _Pragma("unroll") for (int r = 0; r < 16; ++r) { C0[r] -= dl; C1[r] -= dl; } \
        const float f = __builtin_amdgcn_exp2f(-dl); l_reg *= f; if (hi == 0) wsf[r32] = f; resc = true; } } \
    SBAR(); \
    GAPB(o[0] = __builtin_amdgcn_mfma_f32_32x32x16_bf16(PAF(0), VFR(0), o[0], 0, 0, 0), C0, 0); \
    GAPB(o[1] = __builtin_amdgcn_mfma_f32_32x32x16_bf16(PAF(0), VFR(4), o[1], 0, 0, 0), C0, 4); \
    KRD(GL, 0); GAPB(o[0] = __builtin_amdgcn_mfma_f32_32x32x16_bf16(PAF(1), VFR(1), o[0], 0, 0, 0), C0, 8); \
    KRD(GL, 1); GAPB(o[1] = __builtin_amdgcn_mfma_f32_32x32x16_bf16(PAF(1), VFR(5), o[1], 0, 0, 0), C0, 12); \
    KRD(GL, 2); GAPB(o[0] = __builtin_amdgcn_mfma_f32_32x32x16_bf16(PAF(2), VFR(2), o[0], 0, 0, 0), C1, 0); \
    KRD(GL, 3); GAPB(o[1] = __builtin_amdgcn_mfma_f32_32x32x16_bf16(PAF(2), VFR(6), o[1], 0, 0, 0), C1, 4); \
    GAPB(o[0] = __builtin_amdgcn_mfma_f32_32x32x16_bf16(PAF(3), VFR(3), o[0], 0, 0, 0), C1, 8); \
    qfa = QLD(0); qfb = QLD(1); SBAR(); \
    GAPB(o[1] = __builtin_amdgcn_mfma_f32_32x32x16_bf16(PAF(3), VFR(7), o[1], 0, 0, 0), C1, 12); \
    } while (0)
  int t = 1;
  #undef CMASK
  #define CMASK(P0, P1, t) do {} while (0)
  for (; t + 5 < NT; t += 2) {
    STEP(pB0, pB1, pA0, pA1, t, true, true, true);     WAIT_BAR(2); RESC(); ROT();
    STEP(pA0, pA1, pB0, pB1, t + 1, true, true, true); WAIT_BAR(2); RESC(); ROT();
  }
  #undef CMASK
  #define CMASK(P0, P1, t) do { if (!WIN) { int jb_ = (t) - (NT - 4); if (jb_ >= 0) cmask(P0, P1, jb_, qrel, hi); } } while (0)
  #define ENDW(tt) do { if ((tt) + 3 < NT) { WAIT_BAR(2); } else if ((tt) + 2 < NT) { WAIT_BAR(1); } else { WAIT_BAR(0); } } while (0)
  for (; t + 1 < NT; t += 2) {
    STEP(pB0, pB1, pA0, pA1, t, (t + 3 < NT), (t + 1 < NT), (t + 1 < NT));       ENDW(t);     RESC(); ROT();
    STEP(pA0, pA1, pB0, pB1, t + 1, (t + 4 < NT), (t + 2 < NT), (t + 2 < NT));   ENDW(t + 1); RESC(); ROT();
  }
  bool pf_next = false;
  if constexpr (XP) { pf_next = xp.has_next; if (pf_next) {
    const int n0 = sl_next, n1 = NXS(n0), n2 = NXS(n1);
    const bf16* ksn = xp.Kn + (long)lane * xp.Pn + wid * 8;
    const bf16* vsn = xp.Vn + (long)(16 * (wid & 3) + (lane >> 2)) * xp.Pn + (wid >> 2) * 32 + (lane & 3) * 8;
    glds16(ksn, (unsigned)__builtin_amdgcn_readfirstlane(kdst + n0));
    const bf16* Qwn = xp.Qn + (long)(wid * QBLK) * xp.Pn;
    #pragma unroll
    for (int d0 = 0; d0 < 4; ++d0) qn[d0] = *reinterpret_cast<const bf16x8*>(&Qwn[(long)r32 * xp.Pn + d0 * 16 + hi * 8]);
    glds16(vsn, (unsigned)__builtin_amdgcn_readfirstlane(vdst + n0));
    glds16(ksn + (long)KVBLK * xp.Pn, (unsigned)__builtin_amdgcn_readfirstlane(kdst + n1));
    glds16(ksn + (long)2 * KVBLK * xp.Pn, (unsigned)__builtin_amdgcn_readfirstlane(kdst + n2));
    rho = n0 / SLOTB; } }
  STEP(pB0, pB1, pA0, pA1, NT - 1, false, false, false); RESC();
  { float sacc = pB0[0] + pB0[1]; _Pragma("unroll") for (int r = 2; r < 16; ++r) sacc += pB0[r]; _Pragma("unroll") for (int r = 0; r < 16; ++r) sacc += pB1[r]; l_reg += sacc;
    pw0 = (u32x4){PKW(pB0, 0), PKW(pB0, 2), PKW(pB0, 4), PKW(pB0, 6)}; pw1 = (u32x4){PKW(pB0, 8), PKW(pB0, 10), PKW(pB0, 12), PKW(pB0, 14)}; pw2 = (u32x4){PKW(pB1, 0), PKW(pB1, 2), PKW(pB1, 4), PKW(pB1, 6)}; pw3 = (u32x4){PKW(pB1, 8), PKW(pB1, 10), PKW(pB1, 12), PKW(pB1, 14)};
    SBAR(); pv(o, vb0 + sl_cur, PAF(0), PAF(1), PAF(2), PAF(3)); }
  PA_T1(3); PA_T0(4);
  #undef PKW
  #undef PAF
  #undef VFR
  #undef PIN
  #undef MX3
  #undef GAPA
  #undef SPLAT
  #undef GAPB
  #undef EX
  #undef VRD
  #undef KRD
  #undef STEP
  #undef ENDW
  { auto rr = __builtin_amdgcn_permlane32_swap(__float_as_uint(l_reg), __float_as_uint(l_reg), false, false); l_reg = __uint_as_float(rr[0]) + __uint_as_float(rr[1]); }
  if (hi == 0) wsf[32 + r32] = l_reg; asm volatile("s_waitcnt lgkmcnt(0)" ::: "memory");
  float rli[16];
  #pragma unroll
  for (int r = 0; r < 16; ++r) rli[r] = WIN ? 1.0f : __builtin_amdgcn_rcpf(wsf[32 + crow(r, hi)]);
  if (WIN) { if (hi == 0) *(f32x2*)(PML + 2 * (wtok0 + (long)wtstride * (q0 + wid * QBLK + r32))) = (f32x2){-nm, l_reg}; }
  bf16* Ow = O + (long)(q0 + wid * QBLK) * P;
  { bf16* stg = (bf16*)(shm + LDS_OST) + wid * 2048;
    #pragma unroll
    for (int r = 0; r < 16; ++r) { const int orow = crow(r, hi);
      #pragma unroll
      for (int d0 = 0; d0 < 2; ++d0) stg[orow * 64 + d0 * 32 + r32] = __float2bfloat16(o[d0][r] * rli[r]); }
    asm volatile("s_waitcnt lgkmcnt(0)" ::: "memory");
    #pragma unroll
    for (int i = 0; i < 4; ++i) { const int row = i * 8 + (lane >> 3), ch = lane & 7; const u32x4 v = *(const u32x4*)(stg + row * 64 + ch * 8); *(u32x4*)(Ow + (long)row * P + ch * 8) = v; } }
  if constexpr (XP) { if (pf_next) {
    asm volatile("s_waitcnt vmcnt(5)" ::: "memory");
    #pragma unroll
    for (int d0 = 0; d0 < 4; ++d0) *(LAS bf16x8*)(qp + d0 * 1024) = qn[d0]; } }
  asm volatile("s_waitcnt lgkmcnt(0)\n\ts_barrier" ::: "memory");
  PA_T1(4);
  #undef DMA_K
  #undef DMA_V
  #undef NXS
  #undef CMASK
  #undef DECAY
  #undef START
  #undef RESC
  #undef ROT
  #undef QLD
}
template<int THRL, bool WIN> __device__ __forceinline__ void attn_unit(int qb, int T0, long P, const bf16* Q, const bf16* __restrict__ K, const bf16* __restrict__ V, bf16* O, char* shm, int wave,
                                                                        float* PML = nullptr, long wtok0 = 0, int wtstride = 0) {
  Xpf xp{}; bf16x8 qn[4]; int rho = 0;
  attn_unit_x<THRL, WIN, false>(qb, T0, P, Q, K, V, O, shm, wave, PML, wtok0, wtstride, xp, qn, rho);
}
#undef WAIT_BAR
}

namespace dil {
constexpr float NEGBIG = -1.0e30f;
__device__ __forceinline__ int t5_bucket(int dist) {
    if (dist < 16) return dist;
    const float v = logf((float)dist / 16.0f) / 4.852030263919617f * 16.0f;
    const int l = 16 + (int)v; return l < 31 ? l : 31;
}
__device__ __forceinline__ void build_table(LAS float* tb, const float* rel_bias, int g, int d, int j, int tid) {
    asm volatile("" : "+v"(tid));
    for (int e = tid; e < 640; e += 512) { const int n = e - 256; const float v = (n >= 0 && n <= 128) ? rel_bias[t5_bucket(n * d) * 24 + 8 * g + j] * LOG2E : NEGBIG; const int m = 639 - e;
#pragma unroll
        for (int sft = 0; sft < 4; ++sft) if (m - sft >= 0) tb[640 * sft + m - sft] = v; }
}
}

#define XB_TMO      128
#define XB_XCNT(j)  (256  + 64 * (j))
#define XB_XSUB(j)  (1280 + 64 * (j))
#define XB_XGEN(j)  (2304 + 64 * (j))
#define XB_TOP      3328
#define XB_TOPGEN   3392
#define XCD_BAR_WORDS 3456
#define XB_SPIN_CAP (1u << 18)
__device__ __forceinline__ unsigned xb_ld(unsigned* p)              { return __hip_atomic_load(p, __ATOMIC_RELAXED, __HIP_MEMORY_SCOPE_AGENT); }
__device__ __forceinline__ unsigned xb_add(unsigned* p, unsigned v) { return __hip_atomic_fetch_add(p, v, __ATOMIC_RELAXED, __HIP_MEMORY_SCOPE_AGENT); }
__device__ __forceinline__ unsigned xb_xcc_id() { return (unsigned)__builtin_amdgcn_s_getreg((3 << 11) | 20) & 0xFu; }
#define XB_SPIN(cond, bar) do { unsigned _sp = 0; while (cond) { __builtin_amdgcn_s_sleep(1); \
    if ((++_sp & 255u) == 0u) { if (xb_ld(&(bar)[XB_TMO])) break; if (_sp > XB_SPIN_CAP) { atomicAdd(&(bar)[XB_TMO], 1u); break; } } } } while (0)
struct XcdBarrier { unsigned* bar; unsigned x; volatile LAS unsigned* st; };
__device__ __forceinline__ XcdBarrier xcd_barrier_post(unsigned* bar, volatile LAS unsigned* st, bool leader) {
    XcdBarrier b; b.bar = bar; b.x = xb_xcc_id(); b.st = st;
    if (leader) (void)xb_add(&bar[XB_XCNT(b.x)], 1u);
    return b;
}
__device__ __forceinline__ void xcd_barrier_complete(unsigned* bar, unsigned x, unsigned& nloc, unsigned& nx) {
    const unsigned G = gridDim.x * gridDim.y * gridDim.z;
    unsigned sum, cnt, mine, sp = 0u;
    for (;;) {
        sum = 0u; cnt = 0u; mine = 0u;
#pragma unroll
        for (unsigned j = 0; j < 16; ++j) { const unsigned c = xb_ld(&bar[XB_XCNT(j)]); sum += c; cnt += (c > 0u) ? 1u : 0u; mine = (j == x) ? c : mine; }
        if (sum == G) break;
        __builtin_amdgcn_s_sleep(1);
        if ((++sp & 255u) == 0u) { if (xb_ld(&bar[XB_TMO])) break; if (sp > XB_SPIN_CAP) { atomicAdd(&bar[XB_TMO], 1u); break; } }
    }
    nloc = mine > 0u ? mine : 1u; nx = cnt > 0u ? cnt : 1u;
}
__device__ __forceinline__ void xcd_barrier(const XcdBarrier& b, bool leader) {
    asm volatile("s_waitcnt vmcnt(0)" ::: "memory");
    __syncthreads();
    if (leader) {
        unsigned* bar = b.bar;
        __builtin_amdgcn_s_waitcnt(0);
        unsigned nloc = b.st[0], nx = b.st[1];
        if (nloc == 0u) { xcd_barrier_complete(bar, b.x, nloc, nx); b.st[0] = nloc; b.st[1] = nx; }
        const unsigned old = xb_add(&bar[XB_XSUB(b.x)], 1u);
        const unsigned gen = old / nloc;
        if (old + 1u == (gen + 1u) * nloc) {
            __builtin_amdgcn_fence(__ATOMIC_RELEASE, "agent");
            asm volatile("s_waitcnt vmcnt(0)" ::: "memory");
            const unsigned og = xb_add(&bar[XB_TOP], 1u);
            const unsigned tg = og / nx;
            if (og + 1u == (tg + 1u) * nx) xb_add(&bar[XB_TOPGEN], 1u);
            else XB_SPIN(xb_ld(&bar[XB_TOPGEN]) == tg, bar);
            __builtin_amdgcn_fence(__ATOMIC_ACQUIRE, "agent");
            xb_add(&bar[XB_XGEN(b.x)], 1u);
            asm volatile("s_waitcnt vmcnt(0)" ::: "memory");
        } else {
            XB_SPIN(xb_ld(&bar[XB_XGEN(b.x)]) == gen, bar);
            __builtin_amdgcn_fence(__ATOMIC_ACQUIRE, "agent");
            asm volatile("s_waitcnt vmcnt(0)" ::: "memory");
        }
    }
    __syncthreads();
}

__device__ __forceinline__ const float* inptr(int k) {
    asm volatile("" : "+s"(k));
    return ((const float* const __attribute__((address_space(4)))*)__builtin_amdgcn_kernarg_segment_ptr())[k];
}
#define INP(k) inptr(k)
__device__ __forceinline__ int otid(int wave) { int t = wave * 64 + lane_id(); asm volatile("" : "+v"(t)); return t; }
__device__ __forceinline__ unsigned char* opq_ptr(unsigned char* p) { asm volatile("" : "+s"(p)); return p; }
struct Frame {
    LAS unsigned char* lds;
    volatile LAS unsigned* MISC;
    gu32* ctl;
    int wave;
    int vcu, G;
    float* out;
    unsigned char* ws;
};
__device__ __forceinline__ float wave_sum(float v, int lane) {
#pragma unroll
    for (int o = 1; o < 64; o <<= 1) v += shfl_x(v, lane, o);
    return v;
}

struct P0D { const float* W; int ldw; int K; bf16_t* WT; const float* gain; int kb, nb; int f8; };
__device__ __forceinline__ P0D p0_decode(int it, unsigned char* ws) {
    constexpr int I0 = 16 * 96, I1 = 16 * 32, I2 = 16 * 96, I3 = 16 * 48, I4 = 8 * 32, I5 = 32 * 256, I6 = 32 * 256;
    P0D d; int r = it;
    if (r < I0) { d.f8 = 1; d.W = INP(2); d.ldw = 3088; d.K = 1024; d.WT = (bf16_t*)(ws + WS_WQKVA); d.gain = INP(1); d.kb = r / 96; d.nb = r % 96; return d; } r -= I0;
    if (r < I1) { d.f8 = 0; d.W = INP(6); d.ldw = 1024; d.K = 1024; d.WT = (bf16_t*)(ws + WS_WOA); d.gain = nullptr; d.kb = r / 32; d.nb = r % 32; return d; } r -= I1;
    if (r < I2) { d.f8 = 1; d.W = INP(8); d.ldw = 3072; d.K = 1024; d.WT = (bf16_t*)(ws + WS_WKVQ); d.gain = INP(7); d.kb = r / 96; d.nb = r % 96; return d; } r -= I2;
    if (r < I3) { d.f8 = 1; d.W = INP(12); d.ldw = 1536; d.K = 1024; d.WT = (bf16_t*)(ws + WS_WKVQ + (size_t)3072 * 1024); d.gain = INP(11); d.kb = r / 48; d.nb = r % 48; return d; } r -= I3;
    if (r < I4) { d.f8 = 1; d.W = INP(14); d.ldw = 1024; d.K = 512; d.WT = (bf16_t*)(ws + WS_WOB); d.gain = nullptr; d.kb = r / 32; d.nb = r % 32; return d; } r -= I4;
    if (r < I5) { const int le = r / 256, q = r % 256;
        d.f8 = 1; d.W = INP(20) + (size_t)le * 1024 * 512; d.ldw = 512; d.K = 1024; d.WT = (bf16_t*)(ws + WS_WGU + (size_t)le * 1024 * 1024); d.gain = INP(15) + (le >> 4) * 1024; d.kb = q / 16; d.nb = q % 16; return d; } r -= I5;
    if (r < I6) { const int le = r / 256, q = r % 256;
        d.f8 = 1; d.W = INP(21) + (size_t)le * 1024 * 512; d.ldw = 512; d.K = 1024; d.WT = (bf16_t*)(ws + WS_WGU + (size_t)le * 1024 * 1024 + (size_t)512 * 1024); d.gain = INP(15) + (le >> 4) * 1024; d.kb = q / 16; d.nb = q % 16; return d; } r -= I6;
    { const int le = r / 256, q = r % 256;
        d.f8 = 1; d.W = INP(22) + (size_t)le * 512 * 1024; d.ldw = 1024; d.K = 512; d.WT = (bf16_t*)(ws + WS_WD + (size_t)le * 1024 * 512); d.gain = nullptr; d.kb = q / 32; d.nb = q % 32; return d; }
}
__device__ __forceinline__ void p0_load(const P0D& d, int lane, f32x4 (&v)[8], float (&gv)[8]) {
    const float* src = d.W + (size_t)(64 * d.kb + (lane >> 3)) * d.ldw + 32 * d.nb + 4 * (lane & 7);
#pragma unroll
    for (int i = 0; i < 8; ++i) { v[i] = *(const GAS f32x4*)(src + (size_t)(8 * i) * d.ldw); gv[i] = d.gain ? d.gain[64 * d.kb + (lane >> 3) + 8 * i] : 1.0f; }
}
__device__ __forceinline__ void p0_store(const P0D& d, int lane, const f32x4 (&v)[8], const float (&gv)[8], LAS float* scr) {
#pragma unroll
    for (int i = 0; i < 8; ++i) { LAS float* p = scr + ((lane >> 3) + 8 * i) * 33 + 4 * (lane & 7); const f32x4 x = v[i] * gv[i]; p[0] = x[0]; p[1] = x[1]; p[2] = x[2]; p[3] = x[3]; }
    LDS_WAIT(); asm volatile("" ::: "memory");
    const int c = lane & 7, k0 = 64 * d.kb, n0 = 32 * d.nb;
#pragma unroll
    for (int j = 0; j < 4; ++j) { const int n = (lane >> 3) + 8 * j; const LAS float* s = scr + (8 * c) * 33 + n;
        if (d.f8) { u32x2 o; o.x = pk4_fp8(s[0 * 33] * W8SCALE, s[1 * 33] * W8SCALE, s[2 * 33] * W8SCALE, s[3 * 33] * W8SCALE); o.y = pk4_fp8(s[4 * 33] * W8SCALE, s[5 * 33] * W8SCALE, s[6 * 33] * W8SCALE, s[7 * 33] * W8SCALE);
            *(GAS u32x2*)((unsigned char*)d.WT + (size_t)(n0 + n) * d.K + k0 + 8 * c) = o; }
        else { u32x4 o; o.x = pk2(s[0 * 33], s[1 * 33]); o.y = pk2(s[2 * 33], s[3 * 33]); o.z = pk2(s[4 * 33], s[5 * 33]); o.w = pk2(s[6 * 33], s[7 * 33]);
            *(GAS u32x4*)(d.WT + (size_t)(n0 + n) * d.K + k0 + 8 * c) = o; } }
    LDS_WAIT(); asm volatile("" ::: "memory");
}
struct P0H { const float* W; unsigned char* WT; int kb, nb; };
__device__ __forceinline__ P0H p0h_decode(int idx, unsigned char* ws) { const int le = idx >> 9, hq = idx & 511; P0H d; d.W = INP(22) + (size_t)le * 512 * 1024; d.WT = ws + WS_WD + (size_t)le * 1024 * 512; d.kb = hq >> 6; d.nb = hq & 63; return d; }
__device__ __forceinline__ void p0h_load(const P0H& d, int lane, f32x4 (&v)[4]) {
    const float* src = d.W + (size_t)(64 * d.kb + (lane >> 2)) * 1024 + 16 * d.nb + 4 * (lane & 3);
#pragma unroll
    for (int i = 0; i < 4; ++i) v[i] = *(const GAS f32x4*)(src + (size_t)(16 * i) * 1024);
}
__device__ __forceinline__ void p0h_store(const P0H& d, int lane, const f32x4 (&v)[4], LAS float* scr) {
#pragma unroll
    for (int i = 0; i < 4; ++i) { LAS float* p = scr + ((lane >> 2) + 16 * i) * 17 + 4 * (lane & 3); p[0] = v[i][0]; p[1] = v[i][1]; p[2] = v[i][2]; p[3] = v[i][3]; }
    LDS_WAIT(); asm volatile("" ::: "memory");
    const int n = lane >> 2, c = lane & 3; const LAS float* s = scr + (16 * c) * 17 + n;
    u32x4 o;
    o.x = pk4_fp8(s[0 * 17] * W8SCALE, s[1 * 17] * W8SCALE, s[2 * 17] * W8SCALE, s[3 * 17] * W8SCALE);     o.y = pk4_fp8(s[4 * 17] * W8SCALE, s[5 * 17] * W8SCALE, s[6 * 17] * W8SCALE, s[7 * 17] * W8SCALE);
    o.z = pk4_fp8(s[8 * 17] * W8SCALE, s[9 * 17] * W8SCALE, s[10 * 17] * W8SCALE, s[11 * 17] * W8SCALE); o.w = pk4_fp8(s[12 * 17] * W8SCALE, s[13 * 17] * W8SCALE, s[14 * 17] * W8SCALE, s[15 * 17] * W8SCALE);
    *(GAS u32x4*)(d.WT + (size_t)(16 * d.nb + n) * 512 + 64 * d.kb + 16 * c) = o;
    LDS_WAIT(); asm volatile("" ::: "memory");
}
__device__ __forceinline__ void p0_prologue(Frame& F) {
    const int tid_ = otid(F.wave), lane_ = tid_ & 63;
    LAS float* scr = (LAS float*)(F.lds + F.wave * 16384);
    const int gw = F.vcu * 8 + F.wave, NGW = F.G * 8;
    unsigned char* ws = F.ws;
    constexpr int NITEMS = 16 * 96 + 16 * 32 + 16 * 96 + 16 * 48 + 8 * 32 + 2 * 32 * 256;
    {
        f32x4 va[8], vb[8], vc_[8]; float ga[8], gb[8], gc[8]; P0D da, db, dc;
        int it = gw;
        if (it < NITEMS) { da = p0_decode(it, ws); p0_load(da, lane_, va, ga); }
        if (it + NGW < NITEMS) { db = p0_decode(it + NGW, ws); p0_load(db, lane_, vb, gb); }
        while (it < NITEMS) {
            if (it + 2 * NGW < NITEMS) { dc = p0_decode(it + 2 * NGW, ws); p0_load(dc, lane_, vc_, gc); }
            p0_store(da, lane_, va, ga, scr);
            if (it + NGW >= NITEMS) break;
            if (it + 3 * NGW < NITEMS) { da = p0_decode(it + 3 * NGW, ws); p0_load(da, lane_, va, ga); }
            p0_store(db, lane_, vb, gb, scr);
            if (it + 2 * NGW >= NITEMS) break;
            if (it + 4 * NGW < NITEMS) { db = p0_decode(it + 4 * NGW, ws); p0_load(db, lane_, vb, gb); }
            p0_store(dc, lane_, vc_, gc, scr);
            it += 3 * NGW;
        }
    }
    const int gt = gw * 64 + lane_, NGT = NGW * 64;
    { const float* an = INP(1); const float* awin = INP(2);
    for (int e = gt; e < 16 * 1024; e += NGT) { const int n = e >> 10, k = e & 1023; ((bf16_t*)(ws + WS_WF))[e] = (bf16_t)f2bf(an[k] * awin[(size_t)k * 3088 + 3072 + n]); } }
    const float* fn_ = INP(15); const float* wexp_ = INP(18); const float* wgrp_ = INP(16);
    for (int e = gt; e < 2 * 32 * 1024; e += NGT) { const int l = e >> 15, n = (e >> 10) & 31, k = e & 1023;
        float v = 0.f;
        if (n < 16) v = fn_[l * 1024 + k] * wexp_[((size_t)l * 1024 + k) * 16 + n];
        else if (n < 20) v = fn_[l * 1024 + k] * wgrp_[((size_t)l * 1024 + k) * 4 + (n - 16)];
        const unsigned hb = f2bf(v); const float lo = v - bf2f(hb);
        bf16_t* wr = (bf16_t*)(ws + WS_WR) + (size_t)l * 2 * 32 * 1024;
        wr[n * 1024 + k] = (bf16_t)hb; wr[32 * 1024 + n * 1024 + k] = (bf16_t)f2bf(lo); }
    if (gt < 6 * 64) { const int sgi = gt >> 6, d = gt & 63; float v = 1.0f;
        if (sgi == 0) v = INP(4)[d] * C2; else if (sgi == 1) v = INP(5)[d]; else if (sgi == 3) v = INP(9)[d]; else if (sgi == 5) v = INP(13)[d] * C2;
        ((float*)(ws + WS_GTAB))[gt] = v; }
    const float* x_ = INP(0);
    {
        f32x4 v[4], vn[4], vm[4];
        int m = gw;
        if (m < NTOK) { const GAS f32x4* xr = (const GAS f32x4*)(x_ + (size_t)m * DM) + lane_;
#pragma unroll
            for (int jj = 0; jj < 4; ++jj) v[jj] = xr[64 * jj]; }
        if (m + NGW < NTOK) { const GAS f32x4* xr = (const GAS f32x4*)(x_ + (size_t)(m + NGW) * DM) + lane_;
#pragma unroll
            for (int jj = 0; jj < 4; ++jj) vn[jj] = xr[64 * jj]; }
        while (m < NTOK) {
            if (m + 2 * NGW < NTOK) { const GAS f32x4* xr = (const GAS f32x4*)(x_ + (size_t)(m + 2 * NGW) * DM) + lane_;
#pragma unroll
                for (int jj = 0; jj < 4; ++jj) vm[jj] = xr[64 * jj]; }
            float sq = 0.f;
#pragma unroll
            for (int jj = 0; jj < 4; ++jj) sq += (v[jj].x * v[jj].x + v[jj].y * v[jj].y) + (v[jj].z * v[jj].z + v[jj].w * v[jj].w);
            const float rstd = 1.f / sqrtf(wave_sum(sq, lane_) * (1.f / DM) + EPS);
            GAS unsigned long long* o8 = (GAS unsigned long long*)((bf16_t*)(ws + WS_XB) + (size_t)m * DM) + lane_;
#pragma unroll
            for (int jj = 0; jj < 4; ++jj) o8[64 * jj] = (unsigned long long)pk2(v[jj].x, v[jj].y) | ((unsigned long long)pk2(v[jj].z, v[jj].w) << 32);
            GAS unsigned* q8 = (GAS unsigned*)(ws + WS_XB8 + (size_t)m * DM) + lane_;
#pragma unroll
            for (int jj = 0; jj < 4; ++jj) q8[64 * jj] = pk4_fp8(v[jj].x, v[jj].y, v[jj].z, v[jj].w);
            if (lane_ == 0) ((float*)(ws + WS_RSTD0))[m] = rstd;
#pragma unroll
            for (int jj = 0; jj < 4; ++jj) { v[jj] = vn[jj]; vn[jj] = vm[jj]; }
            m += NGW;
        }
    }
}

__device__ __forceinline__ void forget_phase(Frame& F) {
    const int tid_ = otid(F.wave), lane_ = tid_ & 63;
    const bf16_t* XB = (const bf16_t*)(F.ws + WS_XB); const bf16_t* WF = (const bf16_t*)(F.ws + WS_WF);
    const float* RSTD0 = (const float*)(F.ws + WS_RSTD0); const float* b_f = INP(3);
    float* LC = (float*)(F.ws + WS_LC); float* CT = (float*)(F.ws + WS_CT);
    LAS float* wt = (LAS float*)(F.lds + AUX_OFF);
    const int fr = lane_ & 15, fq = lane_ >> 4;
    for (int chunk = blockIdx.x; chunk < NTOK / 128; chunk += F.G) {
        const int row = chunk * 128 + F.wave * 16 + fr;
        const bf16_t* xa = XB + (size_t)row * DM + 8 * fq; const bf16_t* wb = WF + (size_t)fr * DM + 8 * fq;
        f32x4 acc = {0.f, 0.f, 0.f, 0.f};
#pragma unroll 8
        for (int kb = 0; kb < 32; ++kb) { const bf16x8 a = *(const bf16x8*)(xa + 32 * kb), w = *(const bf16x8*)(wb + 32 * kb); acc = __builtin_amdgcn_mfma_f32_16x16x32_bf16(w, a, acc, 0, 0, 0); }
        const float rs = RSTD0[row];
        float lf[4];
#pragma unroll
        for (int i = 0; i < 4; ++i) { const float z = acc[i] * rs + b_f[4 * fq + i]; lf[i] = fminf(z, 0.f) - log1pf(expf(-fabsf(z))); }
#pragma unroll
        for (int off = 1; off < 16; off <<= 1)
#pragma unroll
            for (int i = 0; i < 4; ++i) { const float t = shfl_from(lf[i], lane_ - off); if (fr >= off) lf[i] += t; }
        if (fr == 15) {
#pragma unroll
            for (int i = 0; i < 4; ++i) wt[F.wave * 16 + 4 * fq + i] = lf[i]; }
        __syncthreads();
#pragma unroll
        for (int i = 0; i < 4; ++i) { float p = 0.f; for (int w = 0; w < F.wave; ++w) p += wt[w * 16 + 4 * fq + i]; lf[i] += p; }
        const int b = row >> 13, s = row & (SEQ - 1);
#pragma unroll
        for (int i = 0; i < 4; ++i) LC[(size_t)(b * 16 + 4 * fq + i) * SEQ + s] = lf[i];
        if (F.wave == 7 && fr == 15) {
#pragma unroll
            for (int i = 0; i < 4; ++i) CT[(b * 16 + 4 * fq + i) * 64 + ((chunk * 128) & (SEQ - 1)) / 128] = lf[i]; }
        __syncthreads();
    }
}

__device__ __forceinline__ void attnA_phase(Frame& F, unsigned char* ldsg) {
    const int tid_ = otid(F.wave), lane_ = tid_ & 63;
    LAS float* NCK = (LAS float*)(F.lds + attn_body::LDS_NCK);
    LAS float* CPs = (LAS float*)(F.lds + AUX_OFF);
    volatile LAS int* ctl = (volatile LAS int*)(F.lds + AUX_OFF + 256);
    const float* LC = (const float*)(F.ws + WS_LC); const float* CT = (const float*)(F.ws + WS_CT);
    float mqk = 0.f;
    { const float* gq_ = INP(4); const float* gk_ = INP(5);
      for (int d = 0; d < 64; ++d) mqk = fmaxf(mqk, fabsf(gq_[d] * gk_[d])); }
    const float thr2 = (40.f + 2.f * 8.f * mqk * 1.03f) * LOG2E;
    unsigned* queue = (unsigned*)(F.ctl + CW_QUEUE);
    for (;;) {
        if (tid_ == 0) ctl[0] = (int)__hip_atomic_fetch_add(queue, 1u, RLX_AGENT);
        __syncthreads();
        const int u = ctl[0];
        if (u >= NBATCH * 16 * 32) break;
        const int qb = 31 - (u >> 6), bh = u & 63, b = bh >> 4, h = bh & 15, q0 = qb * 256, NTf = 4 * qb + 4, nkeys = q0 + 256;
        const float* lcp = LC + (size_t)bh * SEQ;
        f32x4 dva[4]; const P0H ddi = p0h_decode(8 * u + F.wave, F.ws); p0h_load(ddi, lane_, dva);
        if (F.wave == 0) { const float c = CT[bh * 64 + lane_]; float v = c;
#pragma unroll
            for (int off = 1; off < 64; off <<= 1) { const float t = shfl_from(v, lane_ - off); if (lane_ >= off) v += t; }
            const float excl = v - c; CPs[lane_] = excl;
            const float cumq = shfl_from(excl, q0 >> 7) + lcp[q0];
            const bool need = (lane_ <= (q0 >> 7)) && ((cumq - v) * LOG2E >= -thr2);
            const unsigned long long bm = __builtin_amdgcn_ballot_w64(need);
            int t0 = 2 * (int)__builtin_ctzll(bm | (1ull << 63)); t0 = t0 < NTf - 4 ? t0 : NTf - 4;
            if (lane_ == 0) ctl[1] = t0; }
        __syncthreads();
        const int T0 = ctl[1];
        const float cpq = CPs[q0 >> 7], lcq = lcp[q0];
        for (int s = 64 * T0 + tid_; s < nkeys; s += 512) NCK[s] = ((cpq - CPs[s >> 7]) + (lcq - lcp[s])) * LOG2E;
        __syncthreads();
        { const size_t ho = ((size_t)b * SEQ * 1024 + h * 64) * 2;
          attn_body::attn_unit<8, false>(qb, T0, 1024, (const attn_body::bf16*)(F.ws + WS_QA + ho), (const attn_body::bf16*)(F.ws + WS_KA + ho), (const attn_body::bf16*)(F.ws + WS_VA + ho), (attn_body::bf16*)(F.ws + WS_QA + ho), (char*)ldsg, F.wave); }
        p0h_store(ddi, lane_, dva, (LAS float*)(F.lds + F.wave * 8192));
    }
}

__device__ __forceinline__ void router_phase(Frame& F, int layer, const float* stats, float* rstd_out) {
    const int tid_ = otid(F.wave), lane_ = tid_ & 63;
    const bf16_t* XBr = (const bf16_t*)(F.ws + WS_XB); unsigned char* XN8 = (unsigned char*)(F.ws + WS_XN8); const bf16_t* WR = (const bf16_t*)(F.ws + WS_WR) + (size_t)layer * 2 * 32 * 1024;
    const float* b_group = INP(17) + layer * 4; const float* b_expert = INP(19) + layer * 16;
    float* GSORT = (float*)(F.ws + WS_GSORT); int* PERM = (int*)(F.ws + WS_PERM);
    unsigned* CNT = (unsigned*)(F.ctl + (layer == 0 ? CW_CNT0 : CW_CNT1));
    volatile LAS int* lcnt = (volatile LAS int*)(F.lds + AUX_OFF);
    const int fr = lane_ & 15, fq = lane_ >> 4;
#pragma unroll
    for (int p = 0; p < 16; ++p) { const int off = p * 8192 + tid_ * 16, n = off >> 11, pc = (off >> 4) & 127;
        __builtin_amdgcn_global_load_lds((const unsigned*)((const char*)WR + n * 2048 + ((pc ^ (n & 15)) << 4)), (LAS unsigned*)(F.lds + p * 8192 + F.wave * 1024), 16, 0, 0); }
    for (int chunk = blockIdx.x; chunk < NTOK / 128; chunk += F.G) {
        if (tid_ < 64) lcnt[tid_] = 0;
        VM_WAIT();
        __syncthreads();
        const int row = chunk * 128 + F.wave * 16 + fr;
        float ss; { const f32x4 p = *(const f32x4*)(stats + (size_t)row * 16 + 4 * fq); ss = (p[0] + p[1]) + (p[2] + p[3]); ss += shfl_x(ss, 16 * fq + fr, 16); ss += shfl_x(ss, 16 * fq + fr, 32); }
        const float rs = 1.0f / sqrtf(ss * (1.0f / 1024.0f) + EPS);
        const bf16_t* hp = XBr + (size_t)row * DM + 8 * fq;
        unsigned char* x8 = XN8 + (size_t)row * DM + 8 * fq;
        const LAS unsigned char* wl = F.lds + fr * 2048;
        f32x4 a0 = {0.f, 0.f, 0.f, 0.f}, a1 = {0.f, 0.f, 0.f, 0.f};
#pragma unroll 4
        for (int kb = 0; kb < 32; ++kb) {
            const bf16x8 xh = *(const bf16x8*)(hp + 32 * kb);
            const int wc_ = ((4 * kb + fq) ^ fr) << 4;
            const bf16x8 wh0 = *(const LAS bf16x8*)(wl + wc_), wl0 = *(const LAS bf16x8*)(wl + 32 * 2048 + wc_);
            const bf16x8 wh1 = *(const LAS bf16x8*)(wl + 16 * 2048 + wc_), wl1 = *(const LAS bf16x8*)(wl + 48 * 2048 + wc_);
            a0 = __builtin_amdgcn_mfma_f32_16x16x32_bf16(wh0, xh, a0, 0, 0, 0); a0 = __builtin_amdgcn_mfma_f32_16x16x32_bf16(wl0, xh, a0, 0, 0, 0);
            a1 = __builtin_amdgcn_mfma_f32_16x16x32_bf16(wh1, xh, a1, 0, 0, 0); a1 = __builtin_amdgcn_mfma_f32_16x16x32_bf16(wl1, xh, a1, 0, 0, 0);
            u32x2 q8; q8.x = pk4_fp8(bf2f((unsigned short)xh[0]) * rs, bf2f((unsigned short)xh[1]) * rs, bf2f((unsigned short)xh[2]) * rs, bf2f((unsigned short)xh[3]) * rs);
            q8.y = pk4_fp8(bf2f((unsigned short)xh[4]) * rs, bf2f((unsigned short)xh[5]) * rs, bf2f((unsigned short)xh[6]) * rs, bf2f((unsigned short)xh[7]) * rs);
            *(u32x2*)(x8 + 32 * kb) = q8;
        }
        if (fq == 0) rstd_out[row] = rs;
        float gl[4]; int gidx = 0; float gval = 0.f;
        {
#pragma unroll
            for (int i = 0; i < 4; ++i) gl[i] = a1[i] * rs + b_group[i];
            const float mx = fmaxf(fmaxf(gl[0], gl[1]), fmaxf(gl[2], gl[3]));
            float ex[4], sum = 0.f;
#pragma unroll
            for (int i = 0; i < 4; ++i) { ex[i] = expf(gl[i] - mx); sum += ex[i]; }
            float best = -1.f;
#pragma unroll
            for (int i = 0; i < 4; ++i) { const float p = ex[i] / sum; if (p > best) { best = p; gidx = i; } }
            gval = best;
        }
        gidx = shfl_from(gidx, fr); gval = shfl_from(gval, fr);
        int cls = -1, rank = 0; float gwlo = 0.f, gwhi = 0.f;
        if (fq == gidx) {
            float el[4];
#pragma unroll
            for (int i = 0; i < 4; ++i) el[i] = a0[i] * rs + b_expert[4 * fq + i];
            const float mx = fmaxf(fmaxf(el[0], el[1]), fmaxf(el[2], el[3]));
            float pr[4], sum = 0.f;
#pragma unroll
            for (int i = 0; i < 4; ++i) { pr[i] = expf(el[i] - mx); sum += pr[i]; }
#pragma unroll
            for (int i = 0; i < 4; ++i) pr[i] = pr[i] / sum;
            int i1 = 0; float p1 = -1.f;
#pragma unroll
            for (int i = 0; i < 4; ++i) if (pr[i] > p1) { p1 = pr[i]; i1 = i; }
            int i2 = 0; float p2 = -1.f;
#pragma unroll
            for (int i = 0; i < 4; ++i) if (i != i1 && pr[i] > p2) { p2 = pr[i]; i2 = i; }
            const float den = p1 + p2; const float w1g = gval * (p1 / den), w2g = gval * (p2 / den);
            const int lo = i1 < i2 ? i1 : i2, hi = i1 < i2 ? i2 : i1;
            const float wlo = i1 < i2 ? w1g : w2g, whi = i1 < i2 ? w2g : w1g;
            const int pidx = (lo == 0) ? hi - 1 : (lo == 1) ? hi + 1 : 5;
            cls = 6 * gidx + pidx;
            gwlo = wlo; gwhi = whi;
            rank = __hip_atomic_fetch_add((LAS int*)&lcnt[cls], 1, __ATOMIC_RELAXED, __HIP_MEMORY_SCOPE_WORKGROUP);
        }
        __syncthreads();
        if (tid_ < NCLASS) lcnt[32 + tid_] = (int)__hip_atomic_fetch_add(CNT + tid_, (unsigned)lcnt[tid_], RLX_AGENT);
        __syncthreads();
        if (cls >= 0) { const size_t p_ = (size_t)cls * CAP + lcnt[32 + cls] + rank; PERM[p_] = row; *(f32x2*)(GSORT + 2 * p_) = (f32x2){gwlo, gwhi}; }
        __syncthreads();
    }
}
__device__ __forceinline__ void moe_tile_prefix(Frame& F, const int* cnt, volatile LAS int* TP) {
    const int tid_ = otid(F.wave), lane_ = tid_ & 63;
    __syncthreads();
    if (tid_ == 0) { int acc = 0; for (int c = 0; c < NCLASS; ++c) { TP[c] = acc; acc += (cnt[c] + 255) >> 8; } TP[NCLASS] = acc; }
    __syncthreads();
}

__device__ __forceinline__ void dilated_phase(Frame& F, unsigned char* ldsg) {
    const int tid_ = otid(F.wave);
    LAS float* tb = (LAS float*)(F.lds + attn_body::LDS_NCK);
    const int per = (3072 + F.G - 1) / F.G;
    int gjprev = -1, rho = 0; bool primed = false; bf16x8 qn[4];
    for (int i = 0; i < per; ++i) {
        const int u = blockIdx.x * per + i; if (u >= 3072) break;
        const int g = u >> 10, v = u & 1023, j = v >> 7, b = (v >> 5) & 3, x = v & 31;
        const int D4 = 2 * g, d = 1 << D4, r = x & (d - 1), qb = x >> D4;
        unsigned long long pl_t = 0ull; if (PROBE_A == 5) pl_t = __builtin_amdgcn_s_memrealtime();
        if (g * 8 + j != gjprev) { __syncthreads(); dil::build_table(tb, INP(10), g, d, j, tid_); __syncthreads(); gjprev = g * 8 + j; }
        if (!primed) VM_WAIT();
        __syncthreads();
        if (PROBE_A == 5) { const unsigned d_ = (unsigned)(__builtin_amdgcn_s_memrealtime() - pl_t); if (tid_ == 0) ((LAS unsigned*)(F.lds + MISC_OFF))[121] += d_; }
        const size_t ho = (((size_t)(8 * g + j) * NTOK + (size_t)b * SEQ + (size_t)r * (SEQ >> D4)) * 64) * 2;
        const int T0 = qb == 0 ? 0 : 4 * qb - 2;
        attn_body::Xpf xp{}; xp.primed = primed; xp.has_next = (i + 1 < per) && (u + 1 < 3072);
        if (xp.has_next) { const int u2 = u + 1, g2 = u2 >> 10, v2 = u2 & 1023, j2 = v2 >> 7, b2 = (v2 >> 5) & 3, x2 = v2 & 31;
            const int D42 = 2 * g2, d2 = 1 << D42, r2 = x2 & (d2 - 1), qb2 = x2 >> D42, T02 = qb2 == 0 ? 0 : 4 * qb2 - 2;
            const size_t ho2 = (((size_t)(8 * g2 + j2) * NTOK + (size_t)b2 * SEQ + (size_t)r2 * (SEQ >> D42)) * 64) * 2; xp.Pn = 64;
            xp.Qn = (const attn_body::bf16*)(F.ws + WS_QB + ho2) + (long)qb2 * 256 * xp.Pn;
            xp.Kn = (const attn_body::bf16*)(F.ws + WS_KB + ho2) + (long)T02 * 64 * xp.Pn; xp.Vn = (const attn_body::bf16*)(F.ws + WS_VB + ho2) + (long)T02 * 64 * xp.Pn; }
        attn_body::attn_unit_x<8, true, true>(qb, T0, 64, (const attn_body::bf16*)(F.ws + WS_QB + ho), (const attn_body::bf16*)(F.ws + WS_KB + ho), (const attn_body::bf16*)(F.ws + WS_VB + ho),
                                      (attn_body::bf16*)(F.ws + WS_QB + ho), (char*)ldsg, F.wave, (float*)(F.ws + WS_DPML) + (size_t)(g * 8 + j) * NTOK * 2, (long)b * SEQ + r, d, xp, qn, rho);
        primed = xp.has_next;
    }
}
__device__ __forceinline__ void dilated_merge(Frame& F) {
    const int tid_ = otid(F.wave);
    bf16_t* QB = (bf16_t*)(F.ws + WS_QB); const float* PML = (const float*)(F.ws + WS_DPML);
    for (size_t it = (size_t)blockIdx.x * 512 + tid_; it < (size_t)NTOK * 64; it += (size_t)F.G * 512) {
        const int ch = (int)(it & 7), j = (int)((it >> 3) & 7); const size_t tok = it >> 6;
        f32x2 ml[3]; u32x4 o[3];
#pragma unroll
        for (int g = 0; g < 3; ++g) { ml[g] = *(const f32x2*)(PML + ((size_t)(g * 8 + j) * NTOK + tok) * 2); o[g] = *(const u32x4*)(QB + ((size_t)(8 * g + j) * NTOK + pg8::dil_row((int)tok, 2 * g)) * 64 + 8 * ch); }
        const float M = fmaxf(fmaxf(ml[0][0], ml[1][0]), ml[2][0]);
        float f[3], L = 0.f;
#pragma unroll
        for (int g = 0; g < 3; ++g) { f[g] = __builtin_amdgcn_exp2f(ml[g][0] - M); L += f[g] * ml[g][1]; }
        const float rl = 1.0f / L;
        float r8[8];
#pragma unroll
        for (int e = 0; e < 4; ++e) { float lo = 0.f, hh = 0.f;
#pragma unroll
            for (int g = 0; g < 3; ++g) { lo += bf2f(o[g][e] & 0xffffu) * f[g]; hh += bf2f(o[g][e] >> 16) * f[g]; }
            r8[2 * e] = lo * rl; r8[2 * e + 1] = hh * rl; }
        u32x2 q8; q8.x = pk4_fp8(r8[0], r8[1], r8[2], r8[3]); q8.y = pk4_fp8(r8[4], r8[5], r8[6], r8[7]);
        *(GAS u32x2*)(F.ws + WS_XB8 + tok * 512 + 64 * j + 8 * ch) = q8;
    }
}

struct Args { const float* in[23]; float* out; unsigned char* ws; };
__global__ void __launch_bounds__(512, 2) fwd_kernel(Args args) {
    extern __shared__ __attribute__((aligned(16))) unsigned char lds[];
    Frame F;
    F.lds = (LAS unsigned char*)lds;
    F.MISC = (volatile LAS unsigned*)(F.lds + MISC_OFF);
    F.wave = __builtin_amdgcn_readfirstlane((int)threadIdx.x >> 6);
    F.G = gridDim.x; { const int bx = blockIdx.x; F.vcu = (F.G % 8 == 0) ? (bx % 8) * (F.G / 8) + bx / 8 : bx; }
    F.out = args.out; F.ws = args.ws;
    F.ctl = (gu32*)(args.ws + WS_CTL);
    for (int u = otid(F.wave); u < 128; u += 512) ((LAS unsigned*)(F.lds + MISC_OFF))[u] = 0u;
    __syncthreads();
    XcdBarrier bar = xcd_barrier_post((unsigned*)(F.ctl + CW_BAR), F.MISC + 8, F.wave == 0 && lane_id() == 0);
#define GRID_BAR() xcd_barrier(bar, F.wave == 0 && lane_id() == 0)
#ifndef RUN_FROM
#define RUN_FROM 0
#endif
#define RUN(k) ((k) <= RUN_UPTO && (k) >= RUN_FROM)
#ifndef PROBE_MASK
#define PROBE_MASK 0
#endif
    unsigned long long pr_acc = 0ull, pr_t0 = 0ull;
#define PR_BEGIN(k) do { if ((PROBE_MASK >> (k)) & 1) pr_t0 = __builtin_amdgcn_s_memrealtime(); } while (0)
#define PR_END(k) do { if ((PROBE_MASK >> (k)) & 1) pr_acc += __builtin_amdgcn_s_memrealtime() - pr_t0; } while (0)

#define ws opq_ptr(F.ws)
#define XB ((bf16_t*)(ws + WS_XB))
#define H (F.out)
#define TP ((volatile LAS int*)(F.lds + AUX_OFF + 1024))

    PR_BEGIN(0); if (RUN(0)) { p0_prologue(F); GRID_BAR(); } PR_END(0);

    PR_BEGIN(1);
    if (RUN(1)) {
        pg8::GemmP g{(const void*)(ws + WS_XB8), 1024, 1024, 1 << 20, 32, (PROBE_KSEL >> 1) & 1};
        pg8::DenseSched S; S.so.init(NTOK, 3072, F.G, (int)blockIdx.x); S.Bt = (const bf16_t*)(ws + WS_WQKVA); S.lda = 512; S.ldb = 512;
        pg8::EpiHead E{(bf16_t*)(ws + WS_QA), (size_t)(WS_KA - WS_QA) / 2, (const float*)(ws + WS_GTAB), 2, 4, 8, 1024, (const float*)(ws + WS_RSTD0), nullptr, 1.0f / W8SCALE};
        pg8::gemm_phase<pg8::EpiHead, pg8::DenseSched, true>(F.lds, g, S, E, F.wave);
        forget_phase(F);
        GRID_BAR();
    }
    PR_END(1); PR_BEGIN(2);
    if (RUN(2)) { attnA_phase(F, lds); GRID_BAR(); }
    PR_END(2); PR_BEGIN(3);
    if (RUN(3)) {
        pg8::GemmP g{(const bf16_t*)(ws + WS_QA), 2048, 2048, 1 << 20, 128, (PROBE_KSEL >> 3) & 1};
        pg8::DenseSched S; S.so.init(NTOK, 1024, F.G, (int)blockIdx.x); S.Bt = (const bf16_t*)(ws + WS_WOA); S.lda = 1024; S.ldb = 1024;
        pg8::EpiResid E{XB, (float*)(ws + WS_STATS1), 1.0f};
        pg8::gemm_phase<pg8::EpiResid, pg8::DenseSched>(F.lds, g, S, E, F.wave);
        GRID_BAR();
    }
    PR_END(3);
#define MOE_LAYER(PH, layer, STATS_IN, RSTD_BUF, CW_CNT, LASTL, STATS_OUT) \
    PR_BEGIN(PH); if (RUN(PH)) { router_phase(F, layer, (const float*)(ws + STATS_IN), (float*)(ws + RSTD_BUF)); GRID_BAR(); } PR_END(PH); PR_BEGIN(PH + 1); \
    if (RUN(PH + 1)) { \
        const int* cnt = (const int*)(F.ctl + CW_CNT); moe_tile_prefix(F, cnt, TP); \
        pg8::GemmP g{(const void*)ws, 1024, 1024, 1 << 20, 512, (PROBE_KSEL >> (PH + 1)) & 1}; \
        pg8::MoeMixSched S{TP, cnt, (const int*)(ws + WS_PERM), (const unsigned char*)(ws + WS_WGU) + (size_t)layer * 16 * 1024 * 1024, (const unsigned char*)(ws + WS_WD) + (size_t)layer * 16 * 1024 * 512, \
                           F.G, (int)blockIdx.x, __builtin_amdgcn_readfirstlane(TP[NCLASS]), (unsigned*)(F.ctl + CW_DONE + layer * 16384), (unsigned*)(F.ctl + CW_BAR) + XB_TMO}; \
        pg8::EpiMoe<LASTL> E{pg8::EpiSwiglu{(unsigned char*)(ws + WS_HID), (const float*)(ws + WS_GSORT)}, \
                             pg8::EpiScatter<LASTL>{XB, H, STATS_OUT, (const int*)(ws + WS_PERM), 1.0f / (W8SCALE * H8SCALE)}}; \
        pg8::gemm_phase<pg8::EpiMoe<LASTL>, pg8::MoeMixSched, true>(F.lds, g, S, E, F.wave); \
        if (!(LASTL)) GRID_BAR(); } PR_END(PH + 1);
    MOE_LAYER(4, 0, WS_STATS1, WS_RSTD1, CW_CNT0, false, (float*)(ws + WS_STATS2))
    PR_BEGIN(7);
    if (RUN(7)) {
        pg8::GemmP g{(const void*)(ws + WS_XB8), 1024, 1024, 1 << 20, 32, (PROBE_KSEL >> 7) & 1};
        pg8::DenseSched S; S.so.init(NTOK, 4608, F.G, (int)blockIdx.x); S.Bt = (const bf16_t*)(ws + WS_WKVQ); S.lda = 512; S.ldb = 512;
        pg8::EpiHead E{(bf16_t*)(ws + WS_KB), (size_t)(WS_VB - WS_KB) / 2, (const float*)(ws + WS_GTAB) + 3 * 64, 1, 6, 12, KVW, nullptr, (const float*)(ws + WS_STATS2), 1.0f / W8SCALE, 1};
        pg8::gemm_phase<pg8::EpiHead, pg8::DenseSched, true>(F.lds, g, S, E, F.wave);
        GRID_BAR();
    }
    PR_END(7); PR_BEGIN(8);
    if (RUN(8)) { dilated_phase(F, lds); GRID_BAR(); dilated_merge(F); GRID_BAR(); }
    PR_END(8); PR_BEGIN(9);
    if (RUN(9)) {
        pg8::GemmP g{(const void*)(ws + WS_XB8), 512, 512, 1 << 20, 128, (PROBE_KSEL >> 9) & 1};
        pg8::DenseSched S; S.so.init(NTOK, 1024, F.G, (int)blockIdx.x); S.Bt = (const bf16_t*)(ws + WS_WOB); S.lda = 256; S.ldb = 256;
        pg8::EpiResid E{XB, (float*)(ws + WS_STATS3), 1.0f / W8SCALE};
        pg8::gemm_phase<pg8::EpiResid, pg8::DenseSched, true>(F.lds, g, S, E, F.wave);
        GRID_BAR();
    }
    PR_END(9);
    MOE_LAYER(10, 1, WS_STATS3, WS_RSTD3, CW_CNT1, true, (float*)nullptr)

#if RUN_UPTO < 12
    { const int gt = (blockIdx.x * 512 + otid(F.wave)); const f32x4* xs = (const f32x4*)INP(0); f32x4* od = (f32x4*)F.out;
      for (size_t e = gt; e < (size_t)NTOK * DM / 4; e += (size_t)F.G * 512) od[e] = xs[e]; }
#endif
    if (PROBE_K != 0) pr_acc += ((LAS unsigned*)(F.lds + MISC_OFF))[120];
    if (PROBE_A != 0) pr_acc += ((LAS unsigned*)(F.lds + MISC_OFF))[121];
    if (PROBE_MASK != 0 && blockIdx.x == 0 && otid(F.wave) == 0) { const unsigned long long t1 = __builtin_amdgcn_s_memrealtime(); while (__builtin_amdgcn_s_memrealtime() - t1 < pr_acc) __builtin_amdgcn_s_sleep(8); }
    if (__hip_atomic_load((unsigned*)(F.ctl + CW_BAR) + XB_TMO, RLX_AGENT) != 0u) {
        const int gt = (blockIdx.x * 512 + otid(F.wave)); const float q = __builtin_nanf("");
        for (size_t e = gt; e < (size_t)NTOK * DM; e += (size_t)F.G * 512) F.out[e] = q;
    }
}

#undef ws
#undef XB
#undef H
#undef TP
extern "C" void kernel_launch(void* const* d_in, const int* in_sizes, int n_in, void* d_out, int out_size, void* d_ws, size_t ws_size, hipStream_t stream) {
    static int grid = 0;
    if (grid == 0) {
        if (n_in != 23 || in_sizes[0] != NTOK * DM || out_size != NTOK * DM || ws_size < WS_END) { fprintf(stderr, "kernel_launch: unexpected shapes (n_in %d, in0 %d, out %d, ws %zu)\n", n_in, n_in > 0 ? in_sizes[0] : -1, out_size, ws_size); grid = -1; return; }
        int dev = 0, cus = 0, per_cu = 0;
        if (hipGetDevice(&dev) != hipSuccess || hipDeviceGetAttribute(&cus, hipDeviceAttributeMultiprocessorCount, dev) != hipSuccess) { grid = -1; return; }
        if (hipFuncSetAttribute((const void*)fwd_kernel, hipFuncAttributeMaxDynamicSharedMemorySize, LDS_BYTES) != hipSuccess) { fprintf(stderr, "kernel_launch: hipFuncSetAttribute failed\n"); grid = -1; return; }
        if (hipOccupancyMaxActiveBlocksPerMultiprocessor(&per_cu, (const void*)fwd_kernel, 512, LDS_BYTES) != hipSuccess || per_cu < 1) fprintf(stderr, "kernel_launch: occupancy query reports %d\n", per_cu);
        (void)hipGetLastError();
        grid = cus;
    }
    if (grid < 0) return;
    if (hipMemsetAsync((char*)d_ws + WS_CTL, 0, CTL_ZERO_BYTES, stream) != hipSuccess) return;
    Args a{};
    for (int i = 0; i < 23; ++i) a.in[i] = (const float*)d_in[i];
    a.out = (float*)d_out; a.ws = (unsigned char*)d_ws;
    hipLaunchKernelGGL(fwd_kernel, dim3(grid), dim3(512), LDS_BYTES, stream, a);
}
```

```cpp
#include <hip/hip_runtime.h>
#include <hip/hip_bf16.h>
#include <cstdio>
#include <cstdint>
#include <cmath>

#ifndef RUN_UPTO
#define RUN_UPTO 99
#endif

#define GAS __attribute__((address_space(1)))
#define LAS __attribute__((address_space(3)))
typedef unsigned short bf16_t;
typedef short bf16x8 __attribute__((ext_vector_type(8)));
typedef float f32x2 __attribute__((ext_vector_type(2)));
typedef float f32x4 __attribute__((ext_vector_type(4)));
typedef float f32x16 __attribute__((ext_vector_type(16)));
typedef unsigned u32x2 __attribute__((ext_vector_type(2)));
typedef unsigned u32x4 __attribute__((ext_vector_type(4)));
typedef short s16x4 __attribute__((ext_vector_type(4)));
typedef int i32x4 __attribute__((ext_vector_type(4)));
typedef int i32x8 __attribute__((ext_vector_type(8)));
typedef GAS unsigned gu32;

constexpr int NTOK = 32768, DM = 1024, SEQ = 8192, NBATCH = 4;
constexpr int KVW = 1536;
constexpr float EPS = 1e-6f;
constexpr float LOG2E = 1.4426950408889634f;
constexpr float C2 = 0.125f * LOG2E;
constexpr int NCLASS = 24, CAP = 32768;

constexpr size_t MiB = 1u << 20;
constexpr size_t WS_CTL = 0, CTL_ZERO_BYTES = 256 * 1024;
constexpr size_t WS_RSTD0 = 2 * MiB, WS_RSTD1 = 2 * MiB + 128 * 1024, WS_RSTD3 = 2 * MiB + 256 * 1024;
constexpr size_t WS_STATS1 = 3 * MiB, WS_STATS2 = 5 * MiB, WS_STATS3 = 7 * MiB;
constexpr size_t WS_GATES = 9 * MiB;
constexpr size_t WS_LC = 10 * MiB;
constexpr size_t WS_CT = 12 * MiB;
constexpr size_t WS_WF = 12 * MiB + 64 * 1024;
constexpr size_t WS_WR = 12 * MiB + 128 * 1024;
constexpr size_t WS_GTAB = 12 * MiB + 32 * 1024;
constexpr size_t WS_PERM = 13 * MiB;
constexpr size_t WS_WQKVA = 16 * MiB, WS_WOA = 22 * MiB, WS_WKVQ = 24 * MiB, WS_WOB = 33 * MiB;
constexpr size_t WS_WGU = 34 * MiB;
constexpr size_t WS_XB8 = 66 * MiB;
constexpr size_t WS_DPML = 114 * MiB;
constexpr size_t WS_WD = 98 * MiB;
constexpr size_t WS_GSORT = 120 * MiB;
constexpr size_t WS_XB = 132 * MiB;
constexpr size_t WS_R = 196 * MiB;
constexpr size_t WS_QA = WS_R, WS_KA = WS_R + 64 * MiB, WS_VA = WS_R + 128 * MiB;
constexpr size_t WS_HID = WS_R;
constexpr size_t WS_XN8 = WS_R + 44 * MiB;
constexpr size_t WS_KB = WS_R, WS_VB = WS_R + 96 * MiB, WS_QB = WS_R + 192 * MiB;
constexpr size_t WS_END = WS_R + 288 * MiB;
constexpr int CW_BAR = 4096, CW_QUEUE = 8192, CW_CNT0 = 9216, CW_CNT1 = 9216 + 64, CW_DONE = 32768;

constexpr int RING_BYTES = 131072;
constexpr int MISC_OFF = RING_BYTES;
constexpr int AUX_OFF = RING_BYTES + 512;
constexpr int LDS_BYTES = 155648;
constexpr int AUX_BYTES = LDS_BYTES - AUX_OFF;

#define LDS_WAIT() asm volatile("s_waitcnt lgkmcnt(0)" ::: "memory")
#define VM_WAIT() asm volatile("s_waitcnt vmcnt(0)" ::: "memory")
#define RLX_AGENT __ATOMIC_RELAXED, __HIP_MEMORY_SCOPE_AGENT

__device__ __forceinline__ int lane_id() { int l; asm volatile("v_mbcnt_lo_u32_b32 %0, -1, 0\n\tv_mbcnt_hi_u32_b32 %0, -1, %0" : "=v"(l)); return l; }
__device__ __forceinline__ void st16_wt(void* p, u32x4 v) { asm volatile("global_store_dwordx4 %0, %1, off sc1\n\ts_nop 2" :: "v"((GAS void*)p), "v"(v) : "memory"); }
__device__ __forceinline__ void st8_wt(void* p, u32x2 v) { asm volatile("global_store_dwordx2 %0, %1, off sc1" :: "v"((GAS void*)p), "v"(v) : "memory"); }
__device__ __forceinline__ float shfl_from(float v, int srclane) { return __int_as_float(__builtin_amdgcn_ds_bpermute(srclane << 2, __float_as_int(v))); }
__device__ __forceinline__ int shfl_from(int v, int srclane) { return __builtin_amdgcn_ds_bpermute(srclane << 2, v); }
__device__ __forceinline__ float shfl_x(float v, int lane, int mask) { return shfl_from(v, lane ^ mask); }
__device__ __forceinline__ unsigned f2bf(float f) { unsigned u = __builtin_bit_cast(unsigned, f); return (u + 0x7fffu + ((u >> 16) & 1u)) >> 16; }
__device__ __forceinline__ float bf2f(unsigned b) { return __builtin_bit_cast(float, b << 16); }
__device__ __forceinline__ unsigned pk2(float lo, float hi) { return f2bf(lo) | (f2bf(hi) << 16); }
__device__ __forceinline__ unsigned pk4_fp8(float a, float b, float c, float d) { int v = 0; v = __builtin_amdgcn_cvt_pk_fp8_f32(a, b, v, false); v = __builtin_amdgcn_cvt_pk_fp8_f32(c, d, v, true); return (unsigned)v; }
constexpr float W8SCALE = 32.0f, H8SCALE = 16.0f;
__device__ __forceinline__ unsigned cvt_pk_bf16(float lo, float hi) { unsigned r; asm volatile("v_cvt_pk_bf16_f32 %0, %1, %2" : "=v"(r) : "v"(lo), "v"(hi)); return r; }

namespace pg8 {
constexpr int BM = 256, BK = 64, HALF = 128, HTB = HALF * BK * 2, STAGE_BYTES = 8 * HTB, NXCD = 8, WGM = 8;
__host__ __device__ __forceinline__ int lds_byte(int r, int c) { const int st = (r >> 4) * 2 + (c >> 5), rr = r & 15, cc = c & 31, ob = rr * 64 + cc * 2; return st * 1024 + (ob ^ (((ob >> 9) & 1) << 5)); }
__host__ __device__ __forceinline__ void stage_rc(int b, int& R, int& C) { const int st = b / 1024, sb = b % 1024, swz = sb ^ (((sb >> 9) & 1) << 5); R = (st >> 1) * 16 + swz / 64; C = (st & 1) * 32 + (swz % 64) / 2; }
__host__ __device__ __forceinline__ int perm32(int rho) { const int n = rho >> 4, i = rho & 15; return 8 * (i >> 2) + 4 * n + (i & 3); }

struct Unit { int rowbase; int pn; int permoff; int nvalid; int e1; int e2; int type; };
struct GemmP { const void* A; int ldbB; int Kbytes; int nsplit; int hstepB; int pk = 0; };

struct StaticOrder {
    int nM, nN, nwg, G, c;
    __device__ void init(int M, int N, int G_, int c_) { nM = M / BM; nN = N / BM; nwg = nM * nN; G = G_; c = c_; }
    __device__ bool next(int i, int& pm, int& pn) const {
        const long L = (long)i * G + c; if (L >= nwg) return false;
        int wgid = (int)L; { const int q = nwg / NXCD, r = nwg % NXCD, xcd = wgid % NXCD, off = wgid / NXCD; wgid = (xcd < r ? xcd * (q + 1) : r * (q + 1) + (xcd - r) * q) + off; }
        const int nig = WGM * nN, gid = wgid / nig, fm = gid * WGM, gsz = (nM - fm) < WGM ? (nM - fm) : WGM;
        pm = fm + ((wgid % nig) % gsz); pn = (wgid % nig) / gsz; return true;
    }
};
struct DenseSched {
    static constexpr bool MIX = false;
    StaticOrder so; const bf16_t* Bt; int lda, ldb;
    __device__ __forceinline__ bool next(int i, Unit& u) const { int pm, pn; if (!so.next(i, pm, pn)) return false; u.rowbase = pm * BM; u.pn = pn; u.permoff = 0; u.nvalid = 256; u.e1 = 0; u.e2 = 0; u.type = 0; return true; }
    __device__ __forceinline__ void aoff(const Unit& u, const int (&R)[2], const int (&C)[2], unsigned (&v)[2][2]) const {
#pragma unroll
        for (int h = 0; h < 2; ++h)
#pragma unroll
            for (int i = 0; i < 2; ++i) v[h][i] = (unsigned)((u.rowbase + 128 * h + R[i]) * lda + C[i]) * 2u; }
    __device__ __forceinline__ const char* blo(const Unit& u) const { return (const char*)Bt + (size_t)u.pn * 256 * ldb * 2; }
    __device__ __forceinline__ const char* bhi(const Unit& u) const { return blo(u); }
};
__device__ __forceinline__ bool moe_unit(int L, int npn, int TT, const volatile LAS int* TP, const int* cnt, Unit& u) {
    if (L >= TT * npn) return false;
    const int tau = L / npn; u.pn = L % npn;
    int c = 0;
#pragma unroll 1
    for (int k = 1; k < NCLASS; ++k) if (TP[k] <= tau) c = k;
    const int rt = tau - TP[c]; const int n = cnt[c] - 256 * rt;
    u.rowbase = tau * 256; u.permoff = c * CAP + rt * 256; u.nvalid = n < 256 ? n : 256;
    const int g = c / 6, p = c % 6; const int a = (p < 3) ? 0 : (p < 5) ? 1 : 2; const int b = (p < 3) ? p + 1 : (p < 5) ? p - 1 : 3;
    u.e1 = 4 * g + a; u.e2 = 4 * g + b;
    u.rowbase = __builtin_amdgcn_readfirstlane(u.rowbase); u.pn = __builtin_amdgcn_readfirstlane(u.pn); u.permoff = __builtin_amdgcn_readfirstlane(u.permoff);
    u.nvalid = __builtin_amdgcn_readfirstlane(u.nvalid); u.e1 = __builtin_amdgcn_readfirstlane(u.e1); u.e2 = __builtin_amdgcn_readfirstlane(u.e2);
    return true;
}
struct Moe1Sched {      static constexpr bool MIX = false;
    const volatile LAS int* TP; const int* cnt; const int* perm; const unsigned char* Wgu; int G, c, TT;
    __device__ __forceinline__ bool next(int i, Unit& u) const { return moe_unit(i * G + c, 8, TT, TP, cnt, u); }
    __device__ __forceinline__ void aoff(const Unit& u, const int (&R)[2], const int (&C)[2], unsigned (&v)[2][2]) const {
#pragma unroll
        for (int h = 0; h < 2; ++h)
#pragma unroll
            for (int i = 0; i < 2; ++i) { const int r = 128 * h + R[i]; const int tok = (r < u.nvalid) ? ((const GAS int*)perm)[u.permoff + r] : 0; v[h][i] = (unsigned)(tok * 1024 + 2 * C[i]); } }
    __device__ __forceinline__ const char* blo(const Unit& u) const { const int e = (u.pn < 4) ? u.e1 : u.e2; return (const char*)Wgu + ((size_t)e * 1024 + 128 * (u.pn & 3)) * 1024; }
    __device__ __forceinline__ const char* bhi(const Unit& u) const { return blo(u); }
};
struct Moe2Sched {      static constexpr bool MIX = false;
    const volatile LAS int* TP; const int* cnt; const unsigned char* Wd; int G, c, TT;
    __device__ __forceinline__ bool next(int i, Unit& u) const { return moe_unit(i * G + c, 4, TT, TP, cnt, u); }
    __device__ __forceinline__ void aoff(const Unit& u, const int (&R)[2], const int (&C)[2], unsigned (&v)[2][2]) const {
#pragma unroll
        for (int h = 0; h < 2; ++h)
#pragma unroll
            for (int i = 0; i < 2; ++i) v[h][i] = (unsigned)((u.rowbase + 128 * h + R[i]) * 1024 + 2 * C[i]); }
    __device__ __forceinline__ const char* blo(const Unit& u) const { return (const char*)Wd + ((size_t)u.e1 * 1024 + 256 * u.pn) * 512; }
    __device__ __forceinline__ const char* bhi(const Unit& u) const { return (const char*)Wd + ((size_t)u.e2 * 1024 + 256 * u.pn) * 512 - 4 * 128; }
};

struct MoeMixSched {
    static constexpr bool MIX = true;
    const volatile LAS int* TP; const int* cnt; const int* perm; const unsigned char* Wgu; const unsigned char* Wd; int G, c, TT; unsigned* done; unsigned* tmo;
    __device__ __forceinline__ bool next(int i, Unit& u) const {
        const int cc = (G == 256) ? ((c & 7) * 32 + (c >> 3)) : c;
        const int L = i * G + cc, n1 = TT * 8;
        if (L < n1) { moe_unit(L, 8, TT, TP, cnt, u); u.type = 0; return true; }
        if (!moe_unit(L - n1, 4, TT, TP, cnt, u)) return false; u.type = 1; return true; }
    __device__ __forceinline__ void aoff(const Unit& u, const int (&R)[2], const int (&C)[2], unsigned (&v)[2][2]) const {
#pragma unroll
        for (int h = 0; h < 2; ++h)
#pragma unroll
            for (int i = 0; i < 2; ++i) { const int r = 128 * h + R[i];
                if (u.type == 0) { const int tok = (r < u.nvalid) ? ((const GAS int*)perm)[u.permoff + r] : 0; v[h][i] = (unsigned)WS_XN8 + (unsigned)(tok * 1024 + 2 * C[i]); }
                else v[h][i] = (unsigned)WS_HID + (unsigned)((u.rowbase + r) * 1024 + 2 * C[i]); } }
    __device__ __forceinline__ const char* blo(const Unit& u) const {
        if (u.type == 0) { const int e = (u.pn < 4) ? u.e1 : u.e2; return (const char*)Wgu + ((size_t)e * 1024 + 128 * (u.pn & 3)) * 1024; }
        return (const char*)Wd + ((size_t)u.e1 * 1024 + 256 * u.pn) * 512; }
    __device__ __forceinline__ const char* bhi(const Unit& u) const {
        if (u.type == 0) return blo(u);
        return (const char*)Wd + ((size_t)u.e2 * 1024 + 256 * u.pn) * 512 - 4 * 128; }
    __device__ __forceinline__ int ldbB(const Unit& u) const { return u.type == 0 ? 1024 : 512; }
    __device__ __forceinline__ int hstepB(const Unit& u) const { return u.type == 0 ? 512 : 128; }
    __device__ __forceinline__ int nsplit(const Unit& u) const { return u.type == 0 ? (1 << 20) : 4; }
    __device__ __forceinline__ void a_ready(const Unit& u) const {
        if (u.type == 1) { unsigned* w = done + 64 * (u.rowbase >> 8); unsigned sp = 0;
            while (__hip_atomic_load(w, __ATOMIC_RELAXED, __HIP_MEMORY_SCOPE_AGENT) < 64u) { __builtin_amdgcn_s_sleep(2); if (++sp > (1u << 20)) { __hip_atomic_store(tmo, 1u, __ATOMIC_RELAXED, __HIP_MEMORY_SCOPE_AGENT); break; } }
              } }
    __device__ __forceinline__ const unsigned* poll_addr(const Unit& u) const { return done + 64 * (u.rowbase >> 8); }
    __device__ __forceinline__ int done_tile(const Unit& u) const { return (u.type == 0) ? (u.rowbase >> 8) : -1; }
    __device__ __forceinline__ void signal(int tile, int lane) const { if (lane == 0) __hip_atomic_fetch_add(done + 64 * tile, 1u, __ATOMIC_RELAXED, __HIP_MEMORY_SCOPE_AGENT); }
};

__device__ __forceinline__ int dil_row(int tok, int D4) { const int s = tok & (SEQ - 1); return (tok & ~(SEQ - 1)) + ((s & ((1 << D4) - 1)) << (13 - D4)) + (s >> D4); }
__device__ __forceinline__ float row_rstd16(const float* stats, int row) {
    const f32x4* p = (const f32x4*)(stats + (size_t)row * 16); const f32x4 a = p[0], b = p[1], c = p[2], d = p[3];
    const float s = ((a[0] + a[1]) + (a[2] + a[3])) + ((b[0] + b[1]) + (b[2] + b[3])) + ((c[0] + c[1]) + (c[2] + c[3])) + ((d[0] + d[1]) + (d[2] + d[3]));
    return 1.0f / sqrtf(s * (1.0f / 1024.0f) + EPS);
}
struct EpiHead {
    static constexpr int BMODE = 2; static constexpr int NPF = 0;
    bf16_t* dbase; size_t dstride; const float* gtab; int plain_seg; int e0, e1;
    int ldc; const float* rstd; const float* stats; float ascale;
    int dil = 0;
    __device__ __forceinline__ void operator()(const f32x4 (&acc)[2][2][4][2], const Unit& u, int wr, int wc, int fr, int fq) const {
        asm volatile("" : "+v"(fr), "+v"(fq));
        const int pn = u.pn; const int seg = (pn < e0) ? 0 : (pn < e1) ? 1 : 2;
        bf16_t* dst = dbase + (size_t)seg * dstride; const float* gain = gtab + 64 * seg; const bool norm = (seg != plain_seg);
        const int pnl = pn - (seg == 0 ? 0 : seg == 1 ? e0 : e1);
        const int col0 = 64 * (4 * pnl + wc) + 8 * fq;
        f32x4 gv[2][2];
#pragma unroll
        for (int bj = 0; bj < 2; ++bj)
#pragma unroll
            for (int n = 0; n < 2; ++n) gv[bj][n] = *(const f32x4*)(gain + 32 * bj + 8 * fq + 4 * n);
        float rsv[2][4];
        if (rstd) {
#pragma unroll
            for (int ai = 0; ai < 2; ++ai)
#pragma unroll
                for (int m = 0; m < 4; ++m) rsv[ai][m] = ((const GAS float*)rstd)[u.rowbase + ai * HALF + wr * 64 + m * 16 + fr] * ascale;
        } else {
            f32x4 pq[2][4];
#pragma unroll
            for (int ai = 0; ai < 2; ++ai)
#pragma unroll
                for (int m = 0; m < 4; ++m) pq[ai][m] = *(const GAS f32x4*)(stats + (size_t)(u.rowbase + ai * HALF + wr * 64 + m * 16 + fr) * 16 + 4 * fq);
#pragma unroll
            for (int ai = 0; ai < 2; ++ai)
#pragma unroll
                for (int m = 0; m < 4; ++m) { float sq = (pq[ai][m][0] + pq[ai][m][1]) + (pq[ai][m][2] + pq[ai][m][3]); sq += shfl_x(sq, 16 * fq + fr, 16); sq += shfl_x(sq, 16 * fq + fr, 32);
                    rsv[ai][m] = ascale / sqrtf(sq * (1.0f / 1024.0f) + EPS); }
        }
#pragma unroll
        for (int ai = 0; ai < 2; ++ai)
#pragma unroll
            for (int m = 0; m < 4; ++m) {
                const int row = u.rowbase + ai * HALF + wr * 64 + m * 16 + fr;
                const float rs = rsv[ai][m];
                float hr = rs;
                if (norm) {
                    float ss = 0.f;
#pragma unroll
                    for (int bj = 0; bj < 2; ++bj)
#pragma unroll
                        for (int n = 0; n < 2; ++n) { const f32x4 x = acc[ai][bj][m][n]; ss += (x[0] * x[0] + x[1] * x[1]) + (x[2] * x[2] + x[3] * x[3]); }
                    ss += shfl_x(ss, 16 * fq + fr, 16); ss += shfl_x(ss, 16 * fq + fr, 32);
                    hr = rs / sqrtf(ss * rs * rs * (1.0f / 64.0f) + EPS);
                }
                bf16_t* rowp = dil ? dst + ((size_t)(4 * pnl + wc) * NTOK + dil_row(row, 2 * ((4 * pnl + wc) >> 3))) * 64 + 8 * fq : dst + (size_t)row * ldc + col0;
#pragma unroll
                for (int bj = 0; bj < 2; ++bj) {
                    const f32x4 v0 = acc[ai][bj][m][0] * hr * gv[bj][0], v1 = acc[ai][bj][m][1] * hr * gv[bj][1];
                    u32x4 w; w.x = cvt_pk_bf16(v0[0], v0[1]); w.y = cvt_pk_bf16(v0[2], v0[3]); w.z = cvt_pk_bf16(v1[0], v1[1]); w.w = cvt_pk_bf16(v1[2], v1[3]);
                    st16_wt(rowp + 32 * bj, w); }
                if (m & 1) asm volatile("" ::: "memory");
            }
    }
};
__device__ __forceinline__ void unpack8(const u32x4 b, f32x4& lo, f32x4& hi) {
    lo = (f32x4){bf2f(b.x & 0xffffu), bf2f(b.x >> 16), bf2f(b.y & 0xffffu), bf2f(b.y >> 16)}; hi = (f32x4){bf2f(b.z & 0xffffu), bf2f(b.z >> 16), bf2f(b.w & 0xffffu), bf2f(b.w >> 16)}; }
struct EpiResid {
    static constexpr int BMODE = 1; static constexpr int NPF = 0;
    bf16_t* xb; float* stats; float ascale;
    __device__ __forceinline__ void operator()(const f32x4 (&acc)[2][2][4][2], const Unit& u, int wr, int wc, int fr, int fq) const {
        asm volatile("" : "+v"(fr), "+v"(fq));
        const int col0 = u.pn * BM + wc * 32 + 8 * fq;
#pragma unroll
        for (int ai = 0; ai < 2; ++ai) {
        u32x4 bb[2][4][2];
#pragma unroll
            for (int m = 0; m < 4; ++m)
#pragma unroll
                for (int bj = 0; bj < 2; ++bj) bb[ai][m][bj] = *(const GAS u32x4*)(xb + (size_t)(u.rowbase + ai * HALF + wr * 64 + m * 16 + fr) * 1024 + col0 + bj * HALF);
#pragma unroll
            for (int m = 0; m < 4; ++m) {
                const int row = u.rowbase + ai * HALF + wr * 64 + m * 16 + fr; const size_t off = (size_t)row * 1024 + col0; float ss = 0.f;
#pragma unroll
                for (int bj = 0; bj < 2; ++bj) { const size_t o = off + bj * HALF; f32x4 b0, b1; unpack8(bb[ai][m][bj], b0, b1);
                    const f32x4 v0 = b0 + acc[ai][bj][m][0] * ascale, v1 = b1 + acc[ai][bj][m][1] * ascale;
                    ss += ((v0[0] * v0[0] + v0[1] * v0[1]) + (v0[2] * v0[2] + v0[3] * v0[3])) + ((v1[0] * v1[0] + v1[1] * v1[1]) + (v1[2] * v1[2] + v1[3] * v1[3]));
                    u32x4 w; w.x = cvt_pk_bf16(v0[0], v0[1]); w.y = cvt_pk_bf16(v0[2], v0[3]); w.z = cvt_pk_bf16(v1[0], v1[1]); w.w = cvt_pk_bf16(v1[2], v1[3]); *(GAS u32x4*)(xb + o) = w; }
                ss += shfl_x(ss, 16 * fq + fr, 16); ss += shfl_x(ss, 16 * fq + fr, 32);
                if (fq == 0) ((GAS float*)stats)[(size_t)row * 16 + u.pn * 4 + wc] = ss;
            }
        asm volatile("" ::: "memory"); }
    }
};
struct EpiSwiglu {
    static constexpr int BMODE = 1;
    unsigned char* hid; const float* gsort;
    __device__ __forceinline__ void operator()(const f32x4 (&acc)[2][2][4][2], const Unit& u, int wr, int wc, int fr, int fq, int pf0, int pf1) const {
        asm volatile("" : "+v"(fr), "+v"(fq));
        const int col0 = 512 * (u.pn >> 2) + 128 * (u.pn & 3) + 32 * wc + 8 * fq;
#pragma unroll
        for (int ai = 0; ai < 2; ++ai)
#pragma unroll
            for (int m = 0; m < 4; ++m) {
                const int r = ai * HALF + wr * 64 + m * 16 + fr;
                const float gq = __int_as_float(shfl_from(ai == 0 ? pf0 : pf1, m * 16 + fr)); const float gw = (r < u.nvalid) ? gq * H8SCALE : 0.f;
                float h[8];
#pragma unroll
                for (int n = 0; n < 2; ++n)
#pragma unroll
                    for (int i = 0; i < 4; ++i) { const float g = acc[ai][0][m][n][i] * (1.0f / W8SCALE), up = acc[ai][1][m][n][i] * (1.0f / W8SCALE); const float sg = g * __builtin_amdgcn_rcpf(1.0f + __builtin_amdgcn_exp2f(-g * LOG2E)); h[4 * n + i] = __builtin_fminf(__builtin_fmaxf(sg * up * gw, -440.f), 440.f); }
                u32x2 w; w.x = pk4_fp8(h[0], h[1], h[2], h[3]); w.y = pk4_fp8(h[4], h[5], h[6], h[7]);
                { GAS u32x2* hp_ = (GAS u32x2*)(hid + (size_t)(u.rowbase + r) * 1024 + col0); asm volatile("global_store_dwordx2 %0, %1, off sc1" :: "v"(hp_), "v"(w) : "memory"); }
            }
    }
};
template <bool LAST> struct EpiScatter {
    static constexpr int BMODE = 1;
    bf16_t* xb; float* out; float* stats; const int* perm; float ascale;
    __device__ __forceinline__ void operator()(const f32x4 (&acc)[2][2][4][2], const Unit& u, int wr, int wc, int fr, int fq, int pf0, int pf1) const {
        asm volatile("" : "+v"(fr), "+v"(fq));
        const int col0 = u.pn * BM + wc * 32 + 8 * fq;
        int tokv[2][4];
#pragma unroll
        for (int ai = 0; ai < 2; ++ai)
#pragma unroll
            for (int m = 0; m < 4; ++m) { const int r = ai * HALF + wr * 64 + m * 16 + fr; const int tq = shfl_from(ai == 0 ? pf0 : pf1, m * 16 + fr); tokv[ai][m] = (r < u.nvalid) ? tq : -1; }
#pragma unroll
        for (int ai = 0; ai < 2; ++ai) {
        u32x4 bb[2][4][2];
#pragma unroll
            for (int m = 0; m < 4; ++m)
#pragma unroll
                for (int bj = 0; bj < 2; ++bj) bb[ai][m][bj] = *(const GAS u32x4*)(xb + (size_t)(tokv[ai][m] >= 0 ? tokv[ai][m] : 0) * 1024 + col0 + bj * HALF);
#pragma unroll
            for (int m = 0; m < 4; ++m) {
                const bool valid = tokv[ai][m] >= 0; const int tok = valid ? tokv[ai][m] : 0;
                const size_t off = (size_t)tok * 1024 + col0; float ss = 0.f;
#pragma unroll
                for (int bj = 0; bj < 2; ++bj) { const size_t o = off + bj * HALF; f32x4 b0, b1; unpack8(bb[ai][m][bj], b0, b1);
                    const f32x4 v0 = b0 + acc[ai][bj][m][0] * ascale, v1 = b1 + acc[ai][bj][m][1] * ascale;
                    ss += ((v0[0] * v0[0] + v0[1] * v0[1]) + (v0[2] * v0[2] + v0[3] * v0[3])) + ((v1[0] * v1[0] + v1[1] * v1[1]) + (v1[2] * v1[2] + v1[3] * v1[3]));
                    if (valid) {
                        if constexpr (LAST) { *(GAS f32x4*)(out + o) = v0; *(GAS f32x4*)(out + o + 4) = v1; }
                        else { u32x4 w; w.x = cvt_pk_bf16(v0[0], v0[1]); w.y = cvt_pk_bf16(v0[2], v0[3]); w.z = cvt_pk_bf16(v1[0], v1[1]); w.w = cvt_pk_bf16(v1[2], v1[3]); *(GAS u32x4*)(xb + o) = w;
                               u32x2 q8; q8.x = pk4_fp8(v0[0], v0[1], v0[2], v0[3]); q8.y = pk4_fp8(v1[0], v1[1], v1[2], v1[3]); *(GAS u32x2*)((unsigned char*)xb - (WS_XB - WS_XB8) + o) = q8; } } }
                if (!LAST) { ss += shfl_x(ss, 16 * fq + fr, 16); ss += shfl_x(ss, 16 * fq + fr, 32);
                    if (valid && fq == 0) ((GAS float*)stats)[(size_t)tok * 16 + u.pn * 4 + wc] = ss; }
            }
        asm volatile("" ::: "memory"); }
    }
};

template <bool LAST> struct EpiMoe {
    static constexpr int BMODE = 1;
    static constexpr int NPF = 2;
    EpiSwiglu sw; EpiScatter<LAST> sc;
    __device__ __forceinline__ void prefetch(const Unit& u, int wr, int lane, int& pf0, int& pf1) const {
        const int r0 = wr * 64 + lane;
        const GAS int* p0 = (u.type == 0) ? (const GAS int*)sw.gsort + 2 * (size_t)(u.permoff + r0) + (u.pn >> 2) : (const GAS int*)sc.perm + (u.permoff + r0);
        const GAS int* p1 = p0 + ((u.type == 0) ? 2 * HALF : HALF);
        asm volatile("global_load_dword %0, %2, off\n\tglobal_load_dword %1, %3, off" : "=&v"(pf0), "=&v"(pf1) : "v"(p0), "v"(p1) : "memory"); }
    __device__ __forceinline__ void operator()(const f32x4 (&acc)[2][2][4][2], const Unit& u, int wr, int wc, int fr, int fq, int pf0, int pf1) const {
        if (u.type == 0) sw(acc, u, wr, wc, fr, fq, pf0, pf1); else sc(acc, u, wr, wc, fr, fq, pf0, pf1); }
};

template <class Epi, class Sched, bool F8 = false>
__device__ __forceinline__ void gemm_phase(LAS unsigned char* lds, const GemmP g, const Sched& S, const Epi& E, int wave) {
    int tid = wave * 64 + lane_id(); asm volatile("" : "+v"(tid));
    const int wid = __builtin_amdgcn_readfirstlane(tid >> 6), lane = tid & 63, wr = wid >> 2, wc = wid & 3, fr = lane & 15, fq = lane >> 4;
    const int nt = g.Kbytes / 128;
    unsigned voffB[2]; int RbB[2], CbB[2];
#pragma unroll
    for (int i = 0; i < 2; ++i) { int R[2], C[2]; stage_rc(tid * 16 + i * 8192, R[i], C[i]);
        RbB[i] = (Epi::BMODE == 0) ? R[i] : (Epi::BMODE == 1) ? ((R[i] & ~31) + perm32(R[i] & 31)) : (64 * (R[i] >> 5) + perm32(R[i] & 31)); CbB[i] = 2 * C[i];
        voffB[i] = (unsigned)(RbB[i] * g.ldbB + CbB[i]); }
    const size_t kstep = (size_t)(BK * 2);
    size_t hstepB = (size_t)g.hstepB * g.ldbB; int nsplit = g.nsplit;
    const unsigned ldsw = (unsigned)wid * 1024u;
    const int aoff = lds_byte(wr * 64 + fr, fq * 8), boff = lds_byte(wc * 32 + fr, fq * 8);
    const char* const Ab = (const char*)g.A;
#define PG8_SA(b, h) (((b) * 2 + (h)) * HTB)
#define PG8_SB(b, h) ((4 + (b) * 2 + (h)) * HTB)
#define PG8_STAGE(bufoff, gbase, voff) do { _Pragma("unroll") for (int _i = 0; _i < 2; ++_i) \
        __builtin_amdgcn_global_load_lds((const unsigned*)((const char*)(gbase) + (voff)[_i]), (LAS unsigned*)(lds + (bufoff) + ldsw + _i * 8192), 16, 0, 0); } while (0)
#define PG8_LD8(p) __builtin_shufflevector(*(const LAS i32x4*)(p), *(const LAS i32x4*)((p) + 1024), 0, 1, 2, 3, 4, 5, 6, 7)
#define PG8_LDA(dst, b, h) do { if constexpr (F8) { _Pragma("unroll") for (int m = 0; m < 4; ++m) dst##8[m] = PG8_LD8(lds + PG8_SA(b, h) + aoff + m * 2048); } \
        else { _Pragma("unroll") for (int m = 0; m < 4; ++m) _Pragma("unroll") for (int k = 0; k < 2; ++k) dst[m][k] = *(const LAS bf16x8*)(lds + PG8_SA(b, h) + aoff + m * 2048 + k * 1024); } } while (0)
#define PG8_LDB(dst, b, h) do { if constexpr (F8) { _Pragma("unroll") for (int n = 0; n < 2; ++n) dst##8[n] = PG8_LD8(lds + PG8_SB(b, h) + boff + n * 2048); } \
        else { _Pragma("unroll") for (int n = 0; n < 2; ++n) _Pragma("unroll") for (int k = 0; k < 2; ++k) dst[n][k] = *(const LAS bf16x8*)(lds + PG8_SB(b, h) + boff + n * 2048 + k * 1024); } } while (0)
#define PG8_MMA(ai, bj, At, Bt) do { __builtin_amdgcn_s_setprio(1); \
        if constexpr (F8) { _Pragma("unroll") for (int m = 0; m < 4; ++m) _Pragma("unroll") for (int n = 0; n < 2; ++n) \
            acc[ai][bj][m][n] = __builtin_amdgcn_mfma_scale_f32_16x16x128_f8f6f4(Bt##8[n], At##8[m], acc[ai][bj][m][n], 0, 0, 0, 0, 0, 0); } \
        else { _Pragma("unroll") for (int m = 0; m < 4; ++m) _Pragma("unroll") for (int n = 0; n < 2; ++n) _Pragma("unroll") for (int k = 0; k < 2; ++k) \
            acc[ai][bj][m][n] = __builtin_amdgcn_mfma_f32_16x16x32_bf16(Bt[n][k], At[m][k], acc[ai][bj][m][n], 0, 0, 0); } \
        __builtin_amdgcn_s_setprio(0); } while (0)
#define PG8_WAIT_V(n) asm volatile("s_waitcnt vmcnt(" #n ")" ::: "memory")
#define PG8_WAIT_L(n) asm volatile("s_waitcnt lgkmcnt(" #n ")" ::: "memory")
#define PG8_BAR __builtin_amdgcn_s_barrier()
#define PG8_SCHED __builtin_amdgcn_sched_barrier(0)
#ifndef PROBE_K
#define PROBE_K 0
#endif
#ifndef PROBE_KSEL
#define PROBE_KSEL 0
#endif
    unsigned long long pk_acc = 0ull, pk_t0 = 0ull;
    unsigned pollv = 64u;
    int pf0 = 0, pf1 = 0, pend = -1;
    Unit cur, nxt; int ui = 0;
    if (!S.next(0, cur)) return;
    unsigned vc[2][2];
    LAS u32x4* const vnl = (LAS u32x4*)(lds + AUX_OFF + 2048) + tid;
    { int R[2], C[2]; int t_ = tid; asm volatile("" : "+v"(t_)); stage_rc(t_ * 16, R[0], C[0]); stage_rc(t_ * 16 + 8192, R[1], C[1]); S.aoff(cur, R, C, vc); }
    f32x4 acc[2][2][4][2];
#pragma unroll
    for (int a = 0; a < 2; ++a)
#pragma unroll
        for (int b = 0; b < 2; ++b)
#pragma unroll
            for (int m = 0; m < 4; ++m)
#pragma unroll
                for (int n = 0; n < 2; ++n) acc[a][b][m][n] = (f32x4){0.f, 0.f, 0.f, 0.f};
    bf16x8 At[4][2], B0[2][2], B1[2][2]; i32x8 At8[4], B08[2], B18[2];
    const char* cBl = S.blo(cur); const char* cBh = S.bhi(cur);
    if constexpr (Sched::MIX) { const int lb_ = S.ldbB(cur); voffB[0] = (unsigned)(RbB[0] * lb_ + CbB[0]); voffB[1] = (unsigned)(RbB[1] * lb_ + CbB[1]); hstepB = (size_t)S.hstepB(cur) * lb_; nsplit = S.nsplit(cur); S.a_ready(cur); }
    PG8_STAGE(PG8_SB(0, 0), cBl, voffB); PG8_STAGE(PG8_SB(0, 1), cBl + hstepB, voffB); PG8_STAGE(PG8_SA(0, 0), Ab, vc[0]); PG8_STAGE(PG8_SA(0, 1), Ab, vc[1]);
    if (wr == 1) PG8_BAR;
    PG8_WAIT_V(2); PG8_BAR;
    PG8_STAGE(PG8_SB(1, 0), cBl + kstep, voffB); PG8_STAGE(PG8_SA(1, 0), Ab + kstep, vc[0]); PG8_STAGE(PG8_SB(1, 1), cBl + hstepB + kstep, voffB);
    PG8_WAIT_V(6); PG8_BAR;
    for (;;) {
        const bool has_next = S.next(ui + 1, nxt);
        { unsigned vn[2][2];
          if (has_next) { int R[2], C[2]; int t_ = tid; asm volatile("" : "+v"(t_)); stage_rc(t_ * 16, R[0], C[0]); stage_rc(t_ * 16 + 8192, R[1], C[1]); S.aoff(nxt, R, C, vn); } else {
#pragma unroll
            for (int h = 0; h < 2; ++h)
#pragma unroll
                for (int i = 0; i < 2; ++i) vn[h][i] = vc[h][i]; }
          *vnl = (u32x4){vn[0][0], vn[0][1], vn[1][0], vn[1][1]}; }
        const char* nBl = has_next ? S.blo(nxt) : cBl; const char* nBh = has_next ? S.bhi(nxt) : cBh;
        if (PROBE_K == 1 || PROBE_K == 3) pk_t0 = __builtin_amdgcn_s_memrealtime();
#pragma unroll 1
        for (int t = 0; t < nt; t += 2) {
            const bool last = (t == nt - 2);
            const char* a1 = Ab + (size_t)(t + 1) * kstep;
            const char* a2 = last ? Ab : Ab + (size_t)(t + 2) * kstep;
            const char* b2 = last ? nBl : (((t + 2) < nsplit) ? cBl : cBh) + (size_t)(t + 2) * kstep;
            const char* a3 = a2 + kstep; const char* b3 = b2 + kstep;
            PG8_LDB(B0, 0, 0); PG8_LDB(B1, 0, 1); PG8_SCHED; PG8_LDA(At, 0, 0); PG8_STAGE(PG8_SA(1, 1), a1, vc[1]);
            PG8_WAIT_V(8); PG8_WAIT_L(0); PG8_BAR; PG8_MMA(0, 0, At, B0); PG8_MMA(0, 1, At, B1); PG8_BAR; PG8_SCHED;
            if constexpr (Sched::MIX) { if (t == nt - 4 && !last && has_next && nxt.type == 1) { const GAS unsigned* pa_ = (const GAS unsigned*)S.poll_addr(nxt);
                asm volatile("global_load_dword %0, %1, off sc1" : "=v"(pollv) : "v"(pa_) : "memory"); } }
            if (last) { if constexpr (Epi::NPF > 0) E.prefetch(cur, wr, lane, pf0, pf1);
                const u32x4 v_ = *vnl; vc[0][0] = v_[0]; vc[0][1] = v_[1]; vc[1][0] = v_[2]; vc[1][1] = v_[3];
                if constexpr (Sched::MIX) { if (has_next) { const int lb_ = S.ldbB(nxt); voffB[0] = (unsigned)(RbB[0] * lb_ + CbB[0]); voffB[1] = (unsigned)(RbB[1] * lb_ + CbB[1]); hstepB = (size_t)S.hstepB(nxt) * lb_;
                    if (nxt.type == 1) {
                        bool ok_ = false;
                        if (nt >= 8) { asm volatile("s_waitcnt vmcnt(18)" : "+v"(pollv) :: "memory"); ok_ = (unsigned)__builtin_amdgcn_readfirstlane((int)pollv) >= 64u; }
                        if (!ok_) S.a_ready(nxt); } } } }
            PG8_LDA(At, 0, 1); PG8_STAGE(PG8_SB(0, 0), b2, voffB); PG8_STAGE(PG8_SB(0, 1), b2 + hstepB, voffB); PG8_STAGE(PG8_SA(0, 0), a2, vc[0]);
            if (Epi::NPF > 0 && last) PG8_WAIT_V(10); else PG8_WAIT_V(8);
            PG8_WAIT_L(0); PG8_BAR; PG8_MMA(1, 0, At, B0); PG8_MMA(1, 1, At, B1); PG8_BAR; PG8_SCHED;
            PG8_LDB(B0, 1, 0); PG8_LDB(B1, 1, 1); PG8_SCHED; PG8_LDA(At, 1, 0); PG8_STAGE(PG8_SA(0, 1), a2, vc[1]);
            PG8_WAIT_V(8); PG8_WAIT_L(0); PG8_BAR; PG8_MMA(0, 0, At, B0); PG8_MMA(0, 1, At, B1); PG8_BAR; PG8_SCHED;
            if constexpr (Sched::MIX) { if (t == 0 && pend >= 0) { S.signal(pend, lane); pend = -1; } }
            PG8_LDA(At, 1, 1); PG8_STAGE(PG8_SB(1, 0), b3, voffB); PG8_STAGE(PG8_SB(1, 1), b3 + hstepB, voffB); PG8_STAGE(PG8_SA(1, 0), a3, vc[0]);
            PG8_WAIT_V(8); PG8_WAIT_L(0); PG8_BAR; PG8_MMA(1, 0, At, B0); PG8_MMA(1, 1, At, B1); PG8_BAR; PG8_SCHED;
        }
        if (PROBE_K == 1) pk_acc += __builtin_amdgcn_s_memrealtime() - pk_t0;
        if (PROBE_K == 2) pk_t0 = __builtin_amdgcn_s_memrealtime();
        if (wr == 0) PG8_BAR;
        if constexpr (Epi::NPF > 0) { asm volatile("s_waitcnt vmcnt(14)" : "+v"(pf0), "+v"(pf1) :: "memory"); E(acc, cur, wr, wc, fr, fq, pf0, pf1); }
        else E(acc, cur, wr, wc, fr, fq);
        if constexpr (Sched::MIX) pend = S.done_tile(cur);
        if (PROBE_K == 2) { asm volatile("s_waitcnt vmcnt(0)" ::: "memory"); pk_acc += __builtin_amdgcn_s_memrealtime() - pk_t0; }
        if (PROBE_K == 3) pk_acc += __builtin_amdgcn_s_memrealtime() - pk_t0;
        if (!has_next) break;
#pragma unroll
        for (int a = 0; a < 2; ++a)
#pragma unroll
            for (int b = 0; b < 2; ++b)
#pragma unroll
                for (int m = 0; m < 4; ++m)
#pragma unroll
                    for (int n = 0; n < 2; ++n) acc[a][b][m][n] = (f32x4){0.f, 0.f, 0.f, 0.f};
        cur = nxt; cBl = nBl; cBh = nBh; ++ui;
        if constexpr (Sched::MIX) nsplit = S.nsplit(cur);
        if (wr == 1) PG8_BAR;
    }
    PG8_WAIT_V(0);
    if constexpr (Sched::MIX) { if (pend >= 0) S.signal(pend, lane); }
    PG8_BAR;
    if (PROBE_K != 0 && g.pk && tid == 0) { LAS unsigned* pw_ = (LAS unsigned*)(lds + MISC_OFF) + 120; *pw_ += (unsigned)pk_acc; }
#undef PG8_SA
#undef PG8_SB
#undef PG8_STAGE
#undef PG8_LDA
#undef PG8_LDB
#undef PG8_MMA
#undef PG8_LD8
#undef PG8_WAIT_V
#undef PG8_WAIT_L
#undef PG8_BAR
#undef PG8_SCHED
}
}

namespace attn_body {
using bf16 = __hip_bfloat16;
constexpr int NHEAD = 16, D = 64, DMQ = NHEAD * D;
constexpr int NW = 8, QBLK = 32, QB = QBLK * NW, KVBLK = 64;
__device__ __forceinline__ int crow(int r, int hi) { return (r & 3) + 8 * (r >> 2) + 4 * hi; }
#define SBAR() __builtin_amdgcn_sched_barrier(0)
__device__ __forceinline__ void cmask(f32x16& p0, f32x16& p1, int jb, int qrel, int hi) {
  const float NEG = -INFINITY; int kb = 64 * jb + 4 * hi;
  #pragma unroll
  for (int r = 0; r < 16; ++r) { int kv = kb + (r & 3) + 8 * (r >> 2); if (kv > qrel) p0[r] = NEG; if (kv + 32 > qrel) p1[r] = NEG; }
}
constexpr int NSLOT = 3, SLOTB = 8192;
constexpr int LDS_K = 0, LDS_V = NSLOT * SLOTB, LDS_WS = 2 * NSLOT * SLOTB, LDS_OST = LDS_WS + NW * 64 * 4, ATT_LDS_BYTES = LDS_OST + NW * 4096;
constexpr int LDS_NCK = 86016;
__device__ __forceinline__ void glds16(const void* gsrc, unsigned lds_dst) { unsigned keep;
  asm volatile("s_mov_b32 %0, m0\n\ts_mov_b32 m0, %2\n\ts_nop 0\n\tglobal_load_lds_dwordx4 %1, off\n\ts_mov_b32 m0, %0" : "=&s"(keep) : "v"(gsrc), "s"(lds_dst) : "memory"); }
__device__ __forceinline__ float max3f(float a, float b, float c) { float r; asm("v_max3_f32 %0, %1, %2, %3" : "=v"(r) : "v"(a), "v"(b), "v"(c)); return r; }
__device__ __forceinline__ float max2f(float a, float b) { float r; asm("v_max_f32_e32 %0, %1, %2" : "=v"(r) : "v"(a), "v"(b)); return r; }
__device__ __forceinline__ float fadd_s(float a, float b) { float r; asm("v_add_f32_e32 %0, %1, %2" : "=v"(r) : "v"(a), "v"(b)); return r; }
__device__ __forceinline__ float fsub_s(float a, float b) { float r; asm("v_sub_f32_e32 %0, %1, %2" : "=v"(r) : "v"(a), "v"(b)); return r; }
typedef __bf16 bf16x2_t __attribute__((ext_vector_type(2)));
__device__ __forceinline__ unsigned cvtpk_s(float lo, float hi) { f32x2 v = {lo, hi}; bf16x2_t b = __builtin_convertvector(v, bf16x2_t); return __builtin_bit_cast(unsigned, b); }
#define WAIT_BAR(N) asm volatile("s_waitcnt vmcnt(" #N ") lgkmcnt(0)\n\ts_barrier" ::: "memory")
typedef LAS const char* lds_cptr;
typedef short v4i16_t __attribute__((ext_vector_type(4)));
__device__ __forceinline__ void qkt(f32x16& p0, f32x16& p1, lds_cptr Kslot, const bf16x8* qr, const f32x16& negm, int r32, int hi) {
  lds_cptr kb = Kslot + hi * 1024 + r32 * 16;
  #pragma unroll
  for (int d0 = 0; d0 < 4; ++d0) {
    const bf16x8 b0 = *(const LAS bf16x8*)(kb + d0 * 2048);
    const bf16x8 b1 = *(const LAS bf16x8*)(kb + d0 * 2048 + 512);
    if (d0 == 0) { p0 = __builtin_amdgcn_mfma_f32_32x32x16_bf16(b0, qr[0], negm, 0, 0, 0); p1 = __builtin_amdgcn_mfma_f32_32x32x16_bf16(b1, qr[0], negm, 0, 0, 0); }
    else { p0 = __builtin_amdgcn_mfma_f32_32x32x16_bf16(b0, qr[d0], p0, 0, 0, 0); p1 = __builtin_amdgcn_mfma_f32_32x32x16_bf16(b1, qr[d0], p1, 0, 0, 0); } }
}
__device__ __forceinline__ void kload8(bf16x8* kf, lds_cptr kp) {
  kf[0] = *(const LAS bf16x8*)(kp);        kf[1] = *(const LAS bf16x8*)(kp + 512);
  kf[2] = *(const LAS bf16x8*)(kp + 2048); kf[3] = *(const LAS bf16x8*)(kp + 2560);
  kf[4] = *(const LAS bf16x8*)(kp + 4096); kf[5] = *(const LAS bf16x8*)(kp + 4608);
  kf[6] = *(const LAS bf16x8*)(kp + 6144); kf[7] = *(const LAS bf16x8*)(kp + 6656);
}
__device__ __forceinline__ void kload2(bf16x8* kf, lds_cptr kp, int j) { kf[2 * j] = *(const LAS bf16x8*)(kp + j * 2048); kf[2 * j + 1] = *(const LAS bf16x8*)(kp + j * 2048 + 512); }
__device__ __forceinline__ s16x4 vtr(lds_cptr p) { return __builtin_bit_cast(s16x4, __builtin_amdgcn_ds_read_tr16_b64_v4i16((LAS v4i16_t*)p)); }
__device__ __forceinline__ float rowmax(const f32x16& p0, const f32x16& p1) {
  float a = max3f(p0[0], p0[1], p1[0]), b = max3f(p0[2], p0[3], p1[1]); a = max3f(a, p1[2], p1[3]);
  #pragma unroll
  for (int r = 4; r < 16; r += 4) { a = max3f(a, p0[r], p0[r + 1]); b = max3f(b, p0[r + 2], p0[r + 3]); a = max3f(a, p1[r], p1[r + 1]); b = max3f(b, p1[r + 2], p1[r + 3]); }
  const float m = max2f(a, b);
  auto rr = __builtin_amdgcn_permlane32_swap(__float_as_uint(m), __float_as_uint(m), false, false);
  return max2f(__uint_as_float(rr[0]), __uint_as_float(rr[1]));
}
__device__ __forceinline__ void pv(f32x16* o, int vb, bf16x8 pa0, bf16x8 pa1, bf16x8 pa2, bf16x8 pa3) {
  #pragma unroll
  for (int d0 = 0; d0 < 2; ++d0) { s16x4 lo[4], hi[4];
    #pragma unroll
    for (int ks = 0; ks < 4; ++ks) {
      asm volatile("ds_read_b64_tr_b16 %0,%1 offset:%c2" : "=&v"(lo[ks]) : "v"(vb), "i"(d0 * 4096 + ks * 1024) : "memory");
      asm volatile("ds_read_b64_tr_b16 %0,%1 offset:%c2" : "=&v"(hi[ks]) : "v"(vb), "i"(d0 * 4096 + ks * 1024 + 512) : "memory"); }
    asm volatile("s_waitcnt lgkmcnt(0)" ::: "memory"); SBAR();
    #define PK(k) (bf16x8){lo[k][0], lo[k][1], lo[k][2], lo[k][3], hi[k][0], hi[k][1], hi[k][2], hi[k][3]}
    o[d0] = __builtin_amdgcn_mfma_f32_32x32x16_bf16(pa0, PK(0), o[d0], 0, 0, 0);
    o[d0] = __builtin_amdgcn_mfma_f32_32x32x16_bf16(pa1, PK(1), o[d0], 0, 0, 0);
    o[d0] = __builtin_amdgcn_mfma_f32_32x32x16_bf16(pa2, PK(2), o[d0], 0, 0, 0);
    o[d0] = __builtin_amdgcn_mfma_f32_32x32x16_bf16(pa3, PK(3), o[d0], 0, 0, 0);
    #undef PK
  }
}

struct Xpf { bool primed, has_next; long Pn; const bf16* Qn; const bf16* Kn; const bf16* Vn; };
template<int THRL, bool WIN, bool XP> __device__ __forceinline__ void attn_unit_x(int qb, int T0, long P, const bf16* Q, const bf16* __restrict__ K, const bf16* __restrict__ V, bf16* O, char* shm, int wave,
                                                                        float* PML, long wtok0, int wtstride, const Xpf xp, bf16x8 (&qn)[4], int& rho) {
#ifndef PROBE_A
#define PROBE_A 0
#endif
  unsigned long long pa_t = 0ull;
#define PA_T0(k) do { if (WIN && PROBE_A == (k)) pa_t = __builtin_amdgcn_s_memrealtime(); } while (0)
#define PA_T1(k) do { if (WIN && PROBE_A == (k)) { const unsigned d_ = (unsigned)(__builtin_amdgcn_s_memrealtime() - pa_t); if (tid == 0) *(unsigned*)(shm + MISC_OFF + 4 * 121) += d_; } } while (0)
  int tid = wave * 64 + lane_id(); asm volatile("" : "+v"(tid));
  const int lane = tid & 63, r32 = lane & 31, hi = lane >> 5; const int wid = __builtin_amdgcn_readfirstlane(tid >> 6);
  PA_T0(1);
  const int q0 = qb * QB;
  const bf16* Qw = Q + (long)(q0 + wid * QBLK) * P;
  const bf16* Kh = K + (long)T0 * KVBLK * P, *Vh = V + (long)T0 * KVBLK * P;
  const unsigned lds0 = (unsigned)(uintptr_t)shm; const lds_cptr shm3 = (lds_cptr)shm;
  float* wsf = (float*)(shm + LDS_WS) + wid * 64;
  const int wbj = 383 - (q0 + wid * QBLK + r32 - T0 * KVBLK) + 4 * hi;
  const LAS float* nck0 = WIN ? (const LAS float*)((lds_cptr)shm + LDS_NCK) + (wbj & 3) * 640 + (wbj & ~3)
                              : (const LAS float*)((lds_cptr)shm + LDS_NCK) + T0 * KVBLK + 4 * hi;
  const float cq2 = WIN ? 0.f : -((const LAS float*)((lds_cptr)shm + LDS_NCK))[q0 + wid * QBLK + r32];
  const bf16* ksrc = Kh + (long)lane * P + wid * 8;
  const bf16* vsrc = Vh + (long)(16 * (wid & 3) + (lane >> 2)) * P + (wid >> 2) * 32 + (lane & 3) * 8;
  const unsigned kdst = lds0 + LDS_K + wid * 1024, vdst = lds0 + LDS_V + wid * 1024;
  #define DMA_K(t, slot) glds16(ksrc + (long)(t) * KVBLK * P, (unsigned)__builtin_amdgcn_readfirstlane(kdst + (slot)))
  #define DMA_V(t, slot) glds16(vsrc + (long)(t) * KVBLK * P, (unsigned)__builtin_amdgcn_readfirstlane(vdst + (slot)))
  const int vb0 = (int)(lds0 + LDS_V) + ((lane >> 4) & 1) * 32 + (lane & 3) * 8 + (4 * hi + ((lane & 15) >> 2)) * 64;
  bf16x8 kf[8];
  const lds_cptr kp0 = shm3 + LDS_K + hi * 1024 + r32 * 16; const lds_cptr vp0 = shm3 + LDS_V + ((lane >> 4) & 1) * 32 + (lane & 3) * 8 + (4 * hi + ((lane & 15) >> 2)) * 64;
  const int NT = (q0 + QB) / KVBLK - T0;
  #define NXS(s) (((s) == (NSLOT - 1) * SLOTB) ? 0 : (s) + SLOTB)
  const int s0 = XP ? __builtin_amdgcn_readfirstlane(rho) * SLOTB : 0, s1 = NXS(s0), s2 = NXS(s1);
  const bool primed = XP && xp.primed;
  if (!primed) { DMA_K(0, s0); DMA_V(0, s0); DMA_K(1, s1); }
  bf16x8 qr[4];
  const lds_cptr qp = shm3 + LDS_OST + wid * 4096 + lane * 16;
  if (!primed) {
  #pragma unroll
  for (int d0 = 0; d0 < 4; ++d0) qr[d0] = *reinterpret_cast<const bf16x8*>(&Qw[(long)r32 * P + d0 * 16 + hi * 8]);
  #pragma unroll
  for (int d0 = 0; d0 < 4; ++d0) *(LAS bf16x8*)(qp + d0 * 1024) = qr[d0];
  } else {
  #pragma unroll
  for (int d0 = 0; d0 < 4; ++d0) qr[d0] = qn[d0];
  }
  #define QLD(d) (*(const LAS bf16x8*)(qp + (d) * 1024))
  float nm = cq2, l_reg = 0.f; f32x16 o[2]; o[0] = f32x16{}; o[1] = f32x16{};
  const int qrel = wid * QBLK + r32;
  #define CMASK(P0, P1, t) do { if (!WIN) { int jb_ = (t) - (NT - 4); if (jb_ >= 0) cmask(P0, P1, jb_, qrel, hi); } } while (0)
  #define DECAY(P0, P1, t) do { const LAS float* nk_ = nck0 + ((t) << 6); \
    _Pragma("unroll") for (int g_ = 0; g_ < 4; ++g_) { const f32x4 a_ = *(const LAS f32x4*)(nk_ + 8 * g_); const f32x4 b_ = *(const LAS f32x4*)(nk_ + 32 + 8 * g_); \
      P0[4 * g_] += a_[0]; P0[4 * g_ + 1] += a_[1]; P0[4 * g_ + 2] += a_[2]; P0[4 * g_ + 3] += a_[3]; P1[4 * g_] += b_[0]; P1[4 * g_ + 1] += b_[1]; P1[4 * g_ + 2] += b_[2]; P1[4 * g_ + 3] += b_[3]; SBAR(); } } while (0)
  bool resc = false;
  #define START(P0, P1) do { const float rm = rowmax(P0, P1); resc = false; \
    { const float dl = max2f(rm, -1000.f); nm = fsub_s(nm, dl); \
      _Pragma("unroll") for (int r = 0; r < 16; ++r) { P0[r] = fsub_s(P0[r], dl); P1[r] = fsub_s(P1[r], dl); } } \
    _Pragma("unroll") for (int r = 0; r < 16; ++r) P0[r] = __builtin_amdgcn_exp2f(P0[r]); } while (0)
  #define RESC() do { if (resc) { asm volatile("s_waitcnt lgkmcnt(0)" ::: "memory"); \
      _Pragma("unroll") for (int d_ = 0; d_ < 2; ++d_) _Pragma("unroll") for (int r = 0; r < 16; ++r) o[d_][r] *= wsf[crow(r, hi)]; } } while (0)
  f32x16 pA0, pA1, pB0, pB1;
  int sl_prev = s0, sl_cur = s0, sl_next = s1;
  #define ROT() do { sl_prev = sl_cur; sl_cur = sl_next; sl_next = (sl_next == (NSLOT - 1) * SLOTB) ? 0 : sl_next + SLOTB; } while (0)
  if (!primed) { DMA_K(2, s2); WAIT_BAR(3); }
  PA_T1(1); PA_T0(2);
  { f32x16 negm;
    #pragma unroll
    for (int r = 0; r < 16; ++r) negm[r] = nm;
    qkt(pA0, pA1, shm3 + LDS_K + s0, qr, negm, r32, hi); }
  asm volatile("s_nop 15\n\ts_nop 7" : "+v"(pA0), "+v"(pA1)); DECAY(pA0, pA1, 0); CMASK(pA0, pA1, 0);
  asm volatile("s_nop 1" : "+v"(pA0), "+v"(pA1));
  START(pA0, pA1);
  _Pragma("unroll") for (int r = 0; r < 16; ++r) pA1[r] = __builtin_amdgcn_exp2f(pA1[r]);
  WAIT_BAR(0);
  DMA_K(3, s0); DMA_V(1, s1);
  ROT();
  kload8(kf, kp0 + sl_cur);
  WAIT_BAR(2);
  PA_T1(2); PA_T0(3);
  s16x4 vlo[8], vhi[8]; u32x4 pw0, pw1, pw2, pw3; bf16x8 qfa = QLD(0), qfb = QLD(1);
  #define PKW(P, B) cvtpk_s(P[B], P[B + 1])
  #define PAF(k) __builtin_bit_cast(bf16x8, pw##k)
  #define VFR(i) (bf16x8){vlo[i][0], vlo[i][1], vlo[i][2], vlo[i][3], vhi[i][0], vhi[i][1], vhi[i][2], vhi[i][3]}
  #define PIN(x) asm volatile("" : "+v"(x))
  #define MX3(a, b, c) __builtin_fmaxf(__builtin_fmaxf((a), (b)), (c))
  #define SPLAT(X) do { _Pragma("unroll") for (int r_ = 0; r_ < 16; ++r_) X[r_] = nm; PIN(X); } while (0)
  #define GAPA(MF, A0, A1, A2, A3, W0, W1, PW) do { MF; sacc += A0; sacc += A1; sacc += A2; sacc += A3; PIN(sacc); W0; W1; PIN(PW); SBAR(); } while (0)
  #define EX(v) __builtin_amdgcn_exp2f(v)
  #define GAPB(MF, X, B) do { MF; X[B] = EX(X[B]); X[B + 1] = EX(X[B + 1]); X[B + 2] = EX(X[B + 2]); X[B + 3] = EX(X[B + 3]); PIN(X); SBAR(); } while (0)
  #define VRD(i) do { vlo[i] = vtr(vp_ + (((i) >> 2) * 4096 + ((i) & 3) * 1024)); vhi[i] = vtr(vp_ + (((i) >> 2) * 4096 + ((i) & 3) * 1024 + 512)); } while (0)
  #define KRD(G, j) do { if (G) { kload2(kf, kp0 + sl_next, j); SBAR(); } } while (0)
  #define STEP(C0, C1, P0, P1, t, GK, GV, GL) do { SBAR(); \
    const lds_cptr vp_ = vp0 + sl_prev; \
    SPLAT(C0); VRD(0); SBAR(); float sacc = (P0[0] + P0[1]); \
    GAPA(C0 = __builtin_amdgcn_mfma_f32_32x32x16_bf16(kf[0], qfa, C0, 0, 0, 0), P0[2], P0[3], P0[4], P0[5],     pw0[0] = PKW(P0, 0), pw0[1] = PKW(P0, 2), pw0); \
    SPLAT(C1); VRD(4); SBAR(); GAPA(C1 = __builtin_amdgcn_mfma_f32_32x32x16_bf16(kf[1], qfa, C1, 0, 0, 0), P0[6], P0[7], P0[8], P0[9],     pw0[2] = PKW(P0, 4), pw0[3] = PKW(P0, 6), pw0); \
    qfa = QLD(2); VRD(1); SBAR(); GAPA(C0 = __builtin_amdgcn_mfma_f32_32x32x16_bf16(kf[2], qfb, C0, 0, 0, 0),   P0[10], P0[11], P0[12], P0[13], pw1[0] = PKW(P0, 8), pw1[1] = PKW(P0, 10), pw1); \
    VRD(5); SBAR(); GAPA(C1 = __builtin_amdgcn_mfma_f32_32x32x16_bf16(kf[3], qfb, C1, 0, 0, 0),   P0[14], P0[15], P1[0], P1[1],   pw1[2] = PKW(P0, 12), pw1[3] = PKW(P0, 14), pw1); \
    qfb = QLD(3); VRD(2); SBAR(); GAPA(C0 = __builtin_amdgcn_mfma_f32_32x32x16_bf16(kf[4], qfa, C0, 0, 0, 0),   P1[2], P1[3], P1[4], P1[5],     pw2[0] = PKW(P1, 0), pw2[1] = PKW(P1, 2), pw2); \
    VRD(6); SBAR(); GAPA(C1 = __builtin_amdgcn_mfma_f32_32x32x16_bf16(kf[5], qfa, C1, 0, 0, 0),   P1[6], P1[7], P1[8], P1[9],     pw2[2] = PKW(P1, 4), pw2[3] = PKW(P1, 6), pw2); \
    VRD(3); SBAR(); GAPA(C0 = __builtin_amdgcn_mfma_f32_32x32x16_bf16(kf[6], qfb, C0, 0, 0, 0),   P1[10], P1[11], P1[12], P1[13], pw3[0] = PKW(P1, 8), pw3[1] = PKW(P1, 10), pw3); \
    VRD(7); SBAR(); GAPA(C1 = __builtin_amdgcn_mfma_f32_32x32x16_bf16(kf[7], qfb, C1, 0, 0, 0),   P1[14], P1[15], 0.f, 0.f,       pw3[2] = PKW(P1, 12), pw3[3] = PKW(P1, 14), pw3); \
    l_reg += sacc; \
    if (GK) { DMA_K((t) + 3, sl_cur); } if (GV) { DMA_V((t) + 1, sl_next); } \
    DECAY(C0, C1, t); \
    CMASK(C0, C1, t); \
    { float a = MX3(C0[0], C0[1], C1[0]), b = MX3(C0[2], C0[3], C1[1]); a = MX3(a, C1[2], C1[3]); \
      _Pragma("unroll") for (int r = 4; r < 16; r += 4) { a = MX3(a, C0[r], C0[r + 1]); b = MX3(b, C0[r + 2], C0[r + 3]); a = MX3(a, C1[r], C1[r + 1]); b = MX3(b, C1[r + 2], C1[r + 3]); } \
      float rm = __builtin_fmaxf(a, b); { auto rr = __builtin_amdgcn_permlane32_swap(__float_as_uint(rm), __float_as_uint(rm), false, false); rm = __builtin_fmaxf(__uint_as_float(rr[0]), __uint_as_float(rr[1])); } \
      resc = false; \
      if (__builtin_expect(__any(rm > (float)THRL), 0)) { const float dl = __builtin_fmaxf(rm, 0.f); nm -= dl; \
        _Pragma("unroll") for (int r = 0; r < 16; ++r) { C0[r] -= dl; C1[r] -= dl; } \
        const float f = __builtin_amdgcn_exp2f(-dl); l_reg *= f; if (hi == 0) wsf[r32] = f; resc = true; } } \
    SBAR(); \
    GAPB(o[0] = __builtin_amdgcn_mfma_f32_32x32x16_bf16(PAF(0), VFR(0), o[0], 0, 0, 0), C0, 0); \
    GAPB(o[1] = __builtin_amdgcn_mfma_f32_32x32x16_bf16(PAF(0), VFR(4), o[1], 0, 0, 0), C0, 4); \
    KRD(GL, 0); GAPB(o[0] = __builtin_amdgcn_mfma_f32_32x32x16_bf16(PAF(1), VFR(1), o[0], 0, 0, 0), C0, 8); \
    KRD(GL, 1); GAPB(o[1] = __builtin_amdgcn_mfma_f32_32x32x16_bf16(PAF(1), VFR(5), o[1], 0, 0, 0), C0, 12); \
    KRD(GL, 2); GAPB(o[0] = __builtin_amdgcn_mfma_f32_32x32x16_bf16(PAF(2), VFR(2), o[0], 0, 0, 0), C1, 0); \
    KRD(GL, 3); GAPB(o[1] = __builtin_amdgcn_mfma_f32_32x32x16_bf16(PAF(2), VFR(6), o[1], 0, 0, 0), C1, 4); \
    GAPB(o[0] = __builtin_amdgcn_mfma_f32_32x32x16_bf16(PAF(3), VFR(3), o[0], 0, 0, 0), C1, 8); \
    qfa = QLD(0); qfb = QLD(1); SBAR(); \
    GAPB(o[1] = __builtin_amdgcn_mfma_f32_32x32x16_bf16(PAF(3), VFR(7), o[1], 0, 0, 0), C1, 12); \
    } while (0)
  int t = 1;
  #undef CMASK
  #define CMASK(P0, P1, t) do {} while (0)
  for (; t + 5 < NT; t += 2) {
    STEP(pB0, pB1, pA0, pA1, t, true, true, true);     WAIT_BAR(2); RESC(); ROT();
    STEP(pA0, pA1, pB0, pB1, t + 1, true, true, true); WAIT_BAR(2); RESC(); ROT();
  }
  #undef CMASK
  #define CMASK(P0, P1, t) do { if (!WIN) { int jb_ = (t) - (NT - 4); if (jb_ >= 0) cmask(P0, P1, jb_, qrel, hi); } } while (0)
  #define ENDW(tt) do { if ((tt) + 3 < NT) { WAIT_BAR(2); } else if ((tt) + 2 < NT) { WAIT_BAR(1); } else { WAIT_BAR(0); } } while (0)
  for (; t + 1 < NT; t += 2) {
    STEP(pB0, pB1, pA0, pA1, t, (t + 3 < NT), (t + 1 < NT), (t + 1 < NT));       ENDW(t);     RESC(); ROT();
    STEP(pA0, pA1, pB0, pB1, t + 1, (t + 4 < NT), (t + 2 < NT), (t + 2 < NT));   ENDW(t + 1); RESC(); ROT();
  }
  bool pf_next = false;
  if constexpr (XP) { pf_next = xp.has_next; if (pf_next) {
    const int n0 = sl_next, n1 = NXS(n0), n2 = NXS(n1);
    const bf16* ksn = xp.Kn + (long)lane * xp.Pn + wid * 8;
    const bf16* vsn = xp.Vn + (long)(16 * (wid & 3) + (lane >> 2)) * xp.Pn + (wid >> 2) * 32 + (lane & 3) * 8;
    glds16(ksn, (unsigned)__builtin_amdgcn_readfirstlane(kdst + n0));
    const bf16* Qwn = xp.Qn + (long)(wid * QBLK) * xp.Pn;
    #pragma unroll
    for (int d0 = 0; d0 < 4; ++d0) qn[d0] = *reinterpret_cast<const bf16x8*>(&Qwn[(long)r32 * xp.Pn + d0 * 16 + hi * 8]);
    glds16(vsn, (unsigned)__builtin_amdgcn_readfirstlane(vdst + n0));
    glds16(ksn + (long)KVBLK * xp.Pn, (unsigned)__builtin_amdgcn_readfirstlane(kdst + n1));
    glds16(ksn + (long)2 * KVBLK * xp.Pn, (unsigned)__builtin_amdgcn_readfirstlane(kdst + n2));
    rho = n0 / SLOTB; } }
  STEP(pB0, pB1, pA0, pA1, NT - 1, false, false, false); RESC();
  { float sacc = pB0[0] + pB0[1]; _Pragma("unroll") for (int r = 2; r < 16; ++r) sacc += pB0[r]; _Pragma("unroll") for (int r = 0; r < 16; ++r) sacc += pB1[r]; l_reg += sacc;
    pw0 = (u32x4){PKW(pB0, 0), PKW(pB0, 2), PKW(pB0, 4), PKW(pB0, 6)}; pw1 = (u32x4){PKW(pB0, 8), PKW(pB0, 10), PKW(pB0, 12), PKW(pB0, 14)}; pw2 = (u32x4){PKW(pB1, 0), PKW(pB1, 2), PKW(pB1, 4), PKW(pB1, 6)}; pw3 = (u32x4){PKW(pB1, 8), PKW(pB1, 10), PKW(pB1, 12), PKW(pB1, 14)};
    SBAR(); pv(o, vb0 + sl_cur, PAF(0), PAF(1), PAF(2), PAF(3)); }
  PA_T1(3); PA_T0(4);
  #undef PKW
  #undef PAF
  #undef VFR
  #undef PIN
  #undef MX3
  #undef GAPA
  #undef SPLAT
  #undef GAPB
  #undef EX
  #undef VRD
  #undef KRD
  #undef STEP
  #undef ENDW
  { auto rr = __builtin_amdgcn_permlane32_swap(__float_as_uint(l_reg), __float_as_uint(l_reg), false, false); l_reg = __uint_as_float(rr[0]) + __uint_as_float(rr[1]); }
  if (hi == 0) wsf[32 + r32] = l_reg; asm volatile("s_waitcnt lgkmcnt(0)" ::: "memory");
  float rli[16];
  #pragma unroll
  for (int r = 0; r < 16; ++r) rli[r] = WIN ? 1.0f : __builtin_amdgcn_rcpf(wsf[32 + crow(r, hi)]);
  if (WIN) { if (hi == 0) *(f32x2*)(PML + 2 * (wtok0 + (long)wtstride * (q0 + wid * QBLK + r32))) = (f32x2){-nm, l_reg}; }
  bf16* Ow = O + (long)(q0 + wid * QBLK) * P;
  { bf16* stg = (bf16*)(shm + LDS_OST) + wid * 2048;
    #pragma unroll
    for (int r = 0; r < 16; ++r) { const int orow = crow(r, hi);
      #pragma unroll
      for (int d0 = 0; d0 < 2; ++d0) stg[orow * 64 + d0 * 32 + r32] = __float2bfloat16(o[d0][r] * rli[r]); }
    asm volatile("s_waitcnt lgkmcnt(0)" ::: "memory");
    #pragma unroll
    for (int i = 0; i < 4; ++i) { const int row = i * 8 + (lane >> 3), ch = lane & 7; const u32x4 v = *(const u32x4*)(stg + row * 64 + ch * 8); *(u32x4*)(Ow + (long)row * P + ch * 8) = v; } }
  if constexpr (XP) { if (pf_next) {
    asm volatile("s_waitcnt vmcnt(5)" ::: "memory");
    #pragma unroll
    for (int d0 = 0; d0 < 4; ++d0) *(LAS bf16x8*)(qp + d0 * 1024) = qn[d0]; } }
  asm volatile("s_waitcnt lgkmcnt(0)\n\ts_barrier" ::: "memory");
  PA_T1(4);
  #undef DMA_K
  #undef DMA_V
  #undef NXS
  #undef CMASK
  #undef DECAY
  #undef START
  #undef RESC
  #undef ROT
  #undef QLD
}
template<int THRL, bool WIN> __device__ __forceinline__ void attn_unit(int qb, int T0, long P, const bf16* Q, const bf16* __restrict__ K, const bf16* __restrict__ V, bf16* O, char* shm, int wave,
                                                                        float* PML = nullptr, long wtok0 = 0, int wtstride = 0) {
  Xpf xp{}; bf16x8 qn[4]; int rho = 0;
  attn_unit_x<THRL, WIN, false>(qb, T0, P, Q, K, V, O, shm, wave, PML, wtok0, wtstride, xp, qn, rho);
}
#undef WAIT_BAR
}

namespace dil {
constexpr float NEGBIG = -1.0e30f;
__device__ __forceinline__ int t5_bucket(int dist) {
    if (dist < 16) return dist;
    const float v = logf((float)dist / 16.0f) / 4.852030263919617f * 16.0f;
    const int l = 16 + (int)v; return l < 31 ? l : 31;
}
__device__ __forceinline__ void build_table(LAS float* tb, const float* rel_bias, int g, int d, int j, int tid) {
    asm volatile("" : "+v"(tid));
    for (int e = tid; e < 640; e += 512) { const int n = e - 256; const float v = (n >= 0 && n <= 128) ? rel_bias[t5_bucket(n * d) * 24 + 8 * g + j] * LOG2E : NEGBIG; const int m = 639 - e;
#pragma unroll
        for (int sft = 0; sft < 4; ++sft) if (m - sft >= 0) tb[640 * sft + m - sft] = v; }
}
}

#define XB_TMO      128
#define XB_XCNT(j)  (256  + 64 * (j))
#define XB_XSUB(j)  (1280 + 64 * (j))
#define XB_XGEN(j)  (2304 + 64 * (j))
#define XB_TOP      3328
#define XB_TOPGEN   3392
#define XCD_BAR_WORDS 3456
#define XB_SPIN_CAP (1u << 18)
__device__ __forceinline__ unsigned xb_ld(unsigned* p)              { return __hip_atomic_load(p, __ATOMIC_RELAXED, __HIP_MEMORY_SCOPE_AGENT); }
__device__ __forceinline__ unsigned xb_add(unsigned* p, unsigned v) { return __hip_atomic_fetch_add(p, v, __ATOMIC_RELAXED, __HIP_MEMORY_SCOPE_AGENT); }
__device__ __forceinline__ unsigned xb_xcc_id() { return (unsigned)__builtin_amdgcn_s_getreg((3 << 11) | 20) & 0xFu; }
#define XB_SPIN(cond, bar) do { unsigned _sp = 0; while (cond) { __builtin_amdgcn_s_sleep(1); \
    if ((++_sp & 255u) == 0u) { if (xb_ld(&(bar)[XB_TMO])) break; if (_sp > XB_SPIN_CAP) { atomicAdd(&(bar)[XB_TMO], 1u); break; } } } } while (0)
struct XcdBarrier { unsigned* bar; unsigned x; volatile LAS unsigned* st; };
__device__ __forceinline__ XcdBarrier xcd_barrier_post(unsigned* bar, volatile LAS unsigned* st, bool leader) {
    XcdBarrier b; b.bar = bar; b.x = xb_xcc_id(); b.st = st;
    if (leader) (void)xb_add(&bar[XB_XCNT(b.x)], 1u);
    return b;
}
__device__ __forceinline__ void xcd_barrier_complete(unsigned* bar, unsigned x, unsigned& nloc, unsigned& nx) {
    const unsigned G = gridDim.x * gridDim.y * gridDim.z;
    unsigned sum, cnt, mine, sp = 0u;
    for (;;) {
        sum = 0u; cnt = 0u; mine = 0u;
#pragma unroll
        for (unsigned j = 0; j < 16; ++j) { const unsigned c = xb_ld(&bar[XB_XCNT(j)]); sum += c; cnt += (c > 0u) ? 1u : 0u; mine = (j == x) ? c : mine; }
        if (sum == G) break;
        __builtin_amdgcn_s_sleep(1);
        if ((++sp & 255u) == 0u) { if (xb_ld(&bar[XB_TMO])) break; if (sp > XB_SPIN_CAP) { atomicAdd(&bar[XB_TMO], 1u); break; } }
    }
    nloc = mine > 0u ? mine : 1u; nx = cnt > 0u ? cnt : 1u;
}
__device__ __forceinline__ void xcd_barrier(const XcdBarrier& b, bool leader) {
    asm volatile("s_waitcnt vmcnt(0)" ::: "memory");
    __syncthreads();
    if (leader) {
        unsigned* bar = b.bar;
        __builtin_amdgcn_s_waitcnt(0);
        unsigned nloc = b.st[0], nx = b.st[1];
        if (nloc == 0u) { xcd_barrier_complete(bar, b.x, nloc, nx); b.st[0] = nloc; b.st[1] = nx; }
        const unsigned old = xb_add(&bar[XB_XSUB(b.x)], 1u);
        const unsigned gen = old / nloc;
        if (old + 1u == (gen + 1u) * nloc) {
            __builtin_amdgcn_fence(__ATOMIC_RELEASE, "agent");
            asm volatile("s_waitcnt vmcnt(0)" ::: "memory");
            const unsigned og = xb_add(&bar[XB_TOP], 1u);
            const unsigned tg = og / nx;
            if (og + 1u == (tg + 1u) * nx) xb_add(&bar[XB_TOPGEN], 1u);
            else XB_SPIN(xb_ld(&bar[XB_TOPGEN]) == tg, bar);
            __builtin_amdgcn_fence(__ATOMIC_ACQUIRE, "agent");
            xb_add(&bar[XB_XGEN(b.x)], 1u);
            asm volatile("s_waitcnt vmcnt(0)" ::: "memory");
        } else {
            XB_SPIN(xb_ld(&bar[XB_XGEN(b.x)]) == gen, bar);
            __builtin_amdgcn_fence(__ATOMIC_ACQUIRE, "agent");
            asm volatile("s_waitcnt vmcnt(0)" ::: "memory");
        }
    }
    __syncthreads();
}

__device__ __forceinline__ const float* inptr(int k) {
    asm volatile("" : "+s"(k));
    return ((const float* const __attribute__((address_space(4)))*)__builtin_amdgcn_kernarg_segment_ptr())[k];
}
#define INP(k) inptr(k)
__device__ __forceinline__ int otid(int wave) { int t = wave * 64 + lane_id(); asm volatile("" : "+v"(t)); return t; }
__device__ __forceinline__ unsigned char* opq_ptr(unsigned char* p) { asm volatile("" : "+s"(p)); return p; }
struct Frame {
    LAS unsigned char* lds;
    volatile LAS unsigned* MISC;
    gu32* ctl;
    int wave;
    int vcu, G;
    float* out;
    unsigned char* ws;
};
__device__ __forceinline__ float wave_sum(float v, int lane) {
#pragma unroll
    for (int o = 1; o < 64; o <<= 1) v += shfl_x(v, lane, o);
    return v;
}

struct P0D { const float* W; int ldw; int K; bf16_t* WT; const float* gain; int kb, nb; int f8; };
__device__ __forceinline__ P0D p0_decode(int it, unsigned char* ws) {
    constexpr int I0 = 16 * 96, I1 = 16 * 32, I2 = 16 * 96, I3 = 16 * 48, I4 = 8 * 32, I5 = 32 * 256, I6 = 32 * 256;
    P0D d; int r = it;
    if (r < I0) { d.f8 = 1; d.W = INP(2); d.ldw = 3088; d.K = 1024; d.WT = (bf16_t*)(ws + WS_WQKVA); d.gain = INP(1); d.kb = r / 96; d.nb = r % 96; return d; } r -= I0;
    if (r < I1) { d.f8 = 0; d.W = INP(6); d.ldw = 1024; d.K = 1024; d.WT = (bf16_t*)(ws + WS_WOA); d.gain = nullptr; d.kb = r / 32; d.nb = r % 32; return d; } r -= I1;
    if (r < I2) { d.f8 = 1; d.W = INP(8); d.ldw = 3072; d.K = 1024; d.WT = (bf16_t*)(ws + WS_WKVQ); d.gain = INP(7); d.kb = r / 96; d.nb = r % 96; return d; } r -= I2;
    if (r < I3) { d.f8 = 1; d.W = INP(12); d.ldw = 1536; d.K = 1024; d.WT = (bf16_t*)(ws + WS_WKVQ + (size_t)3072 * 1024); d.gain = INP(11); d.kb = r / 48; d.nb = r % 48; return d; } r -= I3;
    if (r < I4) { d.f8 = 1; d.W = INP(14); d.ldw = 1024; d.K = 512; d.WT = (bf16_t*)(ws + WS_WOB); d.gain = nullptr; d.kb = r / 32; d.nb = r % 32; return d; } r -= I4;
    if (r < I5) { const int le = r / 256, q = r % 256;
        d.f8 = 1; d.W = INP(20) + (size_t)le * 1024 * 512; d.ldw = 512; d.K = 1024; d.WT = (bf16_t*)(ws + WS_WGU + (size_t)le * 1024 * 1024); d.gain = INP(15) + (le >> 4) * 1024; d.kb = q / 16; d.nb = q % 16; return d; } r -= I5;
    if (r < I6) { const int le = r / 256, q = r % 256;
        d.f8 = 1; d.W = INP(21) + (size_t)le * 1024 * 512; d.ldw = 512; d.K = 1024; d.WT = (bf16_t*)(ws + WS_WGU + (size_t)le * 1024 * 1024 + (size_t)512 * 1024); d.gain = INP(15) + (le >> 4) * 1024; d.kb = q / 16; d.nb = q % 16; return d; } r -= I6;
    { const int le = r / 256, q = r % 256;
        d.f8 = 1; d.W = INP(22) + (size_t)le * 512 * 1024; d.ldw = 1024; d.K = 512; d.WT = (bf16_t*)(ws + WS_WD + (size_t)le * 1024 * 512); d.gain = nullptr; d.kb = q / 32; d.nb = q % 32; return d; }
}
__device__ __forceinline__ void p0_load(const P0D& d, int lane, f32x4 (&v)[8], float (&gv)[8]) {
    const float* src = d.W + (size_t)(64 * d.kb + (lane >> 3)) * d.ldw + 32 * d.nb + 4 * (lane & 7);
#pragma unroll
    for (int i = 0; i < 8; ++i) { v[i] = *(const GAS f32x4*)(src + (size_t)(8 * i) * d.ldw); gv[i] = d.gain ? d.gain[64 * d.kb + (lane >> 3) + 8 * i] : 1.0f; }
}
__device__ __forceinline__ void p0_store(const P0D& d, int lane, const f32x4 (&v)[8], const float (&gv)[8], LAS float* scr) {
#pragma unroll
    for (int i = 0; i < 8; ++i) { LAS float* p = scr + ((lane >> 3) + 8 * i) * 33 + 4 * (lane & 7); const f32x4 x = v[i] * gv[i]; p[0] = x[0]; p[1] = x[1]; p[2] = x[2]; p[3] = x[3]; }
    LDS_WAIT(); asm volatile("" ::: "memory");
    const int c = lane & 7, k0 = 64 * d.kb, n0 = 32 * d.nb;
#pragma unroll
    for (int j = 0; j < 4; ++j) { const int n = (lane >> 3) + 8 * j; const LAS float* s = scr + (8 * c) * 33 + n;
        if (d.f8) { u32x2 o; o.x = pk4_fp8(s[0 * 33] * W8SCALE, s[1 * 33] * W8SCALE, s[2 * 33] * W8SCALE, s[3 * 33] * W8SCALE); o.y = pk4_fp8(s[4 * 33] * W8SCALE, s[5 * 33] * W8SCALE, s[6 * 33] * W8SCALE, s[7 * 33] * W8SCALE);
            *(GAS u32x2*)((unsigned char*)d.WT + (size_t)(n0 + n) * d.K + k0 + 8 * c) = o; }
        else { u32x4 o; o.x = pk2(s[0 * 33], s[1 * 33]); o.y = pk2(s[2 * 33], s[3 * 33]); o.z = pk2(s[4 * 33], s[5 * 33]); o.w = pk2(s[6 * 33], s[7 * 33]);
            *(GAS u32x4*)(d.WT + (size_t)(n0 + n) * d.K + k0 + 8 * c) = o; } }
    LDS_WAIT(); asm volatile("" ::: "memory");
}
struct P0H { const float* W; unsigned char* WT; int kb, nb; };
__device__ __forceinline__ P0H p0h_decode(int idx, unsigned char* ws) { const int le = idx >> 9, hq = idx & 511; P0H d; d.W = INP(22) + (size_t)le * 512 * 1024; d.WT = ws + WS_WD + (size_t)le * 1024 * 512; d.kb = hq >> 6; d.nb = hq & 63; return d; }
__device__ __forceinline__ void p0h_load(const P0H& d, int lane, f32x4 (&v)[4]) {
    const float* src = d.W + (size_t)(64 * d.kb + (lane >> 2)) * 1024 + 16 * d.nb + 4 * (lane & 3);
#pragma unroll
    for (int i = 0; i < 4; ++i) v[i] = *(const GAS f32x4*)(src + (size_t)(16 * i) * 1024);
}
__device__ __forceinline__ void p0h_store(const P0H& d, int lane, const f32x4 (&v)[4], LAS float* scr) {
#pragma unroll
    for (int i = 0; i < 4; ++i) { LAS float* p = scr + ((lane >> 2) + 16 * i) * 17 + 4 * (lane & 3); p[0] = v[i][0]; p[1] = v[i][1]; p[2] = v[i][2]; p[3] = v[i][3]; }
    LDS_WAIT(); asm volatile("" ::: "memory");
    const int n = lane >> 2, c = lane & 3; const LAS float* s = scr + (16 * c) * 17 + n;
    u32x4 o;
    o.x = pk4_fp8(s[0 * 17] * W8SCALE, s[1 * 17] * W8SCALE, s[2 * 17] * W8SCALE, s[3 * 17] * W8SCALE);     o.y = pk4_fp8(s[4 * 17] * W8SCALE, s[5 * 17] * W8SCALE, s[6 * 17] * W8SCALE, s[7 * 17] * W8SCALE);
    o.z = pk4_fp8(s[8 * 17] * W8SCALE, s[9 * 17] * W8SCALE, s[10 * 17] * W8SCALE, s[11 * 17] * W8SCALE); o.w = pk4_fp8(s[12 * 17] * W8SCALE, s[13 * 17] * W8SCALE, s[14 * 17] * W8SCALE, s[15 * 17] * W8SCALE);
    *(GAS u32x4*)(d.WT + (size_t)(16 * d.nb + n) * 512 + 64 * d.kb + 16 * c) = o;
    LDS_WAIT(); asm volatile("" ::: "memory");
}
__device__ __forceinline__ void p0_prologue(Frame& F) {
    const int tid_ = otid(F.wave), lane_ = tid_ & 63;
    LAS float* scr = (LAS float*)(F.lds + F.wave * 16384);
    const int gw = F.vcu * 8 + F.wave, NGW = F.G * 8;
    unsigned char* ws = F.ws;
    constexpr int NITEMS = 16 * 96 + 16 * 32 + 16 * 96 + 16 * 48 + 8 * 32 + 2 * 32 * 256;
    {
        f32x4 va[8], vb[8], vc_[8]; float ga[8], gb[8], gc[8]; P0D da, db, dc;
        int it = gw;
        if (it < NITEMS) { da = p0_decode(it, ws); p0_load(da, lane_, va, ga); }
        if (it + NGW < NITEMS) { db = p0_decode(it + NGW, ws); p0_load(db, lane_, vb, gb); }
        while (it < NITEMS) {
            if (it + 2 * NGW < NITEMS) { dc = p0_decode(it + 2 * NGW, ws); p0_load(dc, lane_, vc_, gc); }
            p0_store(da, lane_, va, ga, scr);
            if (it + NGW >= NITEMS) break;
            if (it + 3 * NGW < NITEMS) { da = p0_decode(it + 3 * NGW, ws); p0_load(da, lane_, va, ga); }
            p0_store(db, lane_, vb, gb, scr);
            if (it + 2 * NGW >= NITEMS) break;
            if (it + 4 * NGW < NITEMS) { db = p0_decode(it + 4 * NGW, ws); p0_load(db, lane_, vb, gb); }
            p0_store(dc, lane_, vc_, gc, scr);
            it += 3 * NGW;
        }
    }
    const int gt = gw * 64 + lane_, NGT = NGW * 64;
    { const float* an = INP(1); const float* awin = INP(2);
    for (int e = gt; e < 16 * 1024; e += NGT) { const int n = e >> 10, k = e & 1023; ((bf16_t*)(ws + WS_WF))[e] = (bf16_t)f2bf(an[k] * awin[(size_t)k * 3088 + 3072 + n]); } }
    const float* fn_ = INP(15); const float* wexp_ = INP(18); const float* wgrp_ = INP(16);
    for (int e = gt; e < 2 * 32 * 1024; e += NGT) { const int l = e >> 15, n = (e >> 10) & 31, k = e & 1023;
        float v = 0.f;
        if (n < 16) v = fn_[l * 1024 + k] * wexp_[((size_t)l * 1024 + k) * 16 + n];
        else if (n < 20) v = fn_[l * 1024 + k] * wgrp_[((size_t)l * 1024 + k) * 4 + (n - 16)];
        const unsigned hb = f2bf(v); const float lo = v - bf2f(hb);
        bf16_t* wr = (bf16_t*)(ws + WS_WR) + (size_t)l * 2 * 32 * 1024;
        wr[n * 1024 + k] = (bf16_t)hb; wr[32 * 1024 + n * 1024 + k] = (bf16_t)f2bf(lo); }
    if (gt < 6 * 64) { const int sgi = gt >> 6, d = gt & 63; float v = 1.0f;
        if (sgi == 0) v = INP(4)[d] * C2; else if (sgi == 1) v = INP(5)[d]; else if (sgi == 3) v = INP(9)[d]; else if (sgi == 5) v = INP(13)[d] * C2;
        ((float*)(ws + WS_GTAB))[gt] = v; }
    const float* x_ = INP(0);
    {
        f32x4 v[4], vn[4], vm[4];
        int m = gw;
        if (m < NTOK) { const GAS f32x4* xr = (const GAS f32x4*)(x_ + (size_t)m * DM) + lane_;
#pragma unroll
            for (int jj = 0; jj < 4; ++jj) v[jj] = xr[64 * jj]; }
        if (m + NGW < NTOK) { const GAS f32x4* xr = (const GAS f32x4*)(x_ + (size_t)(m + NGW) * DM) + lane_;
#pragma unroll
            for (int jj = 0; jj < 4; ++jj) vn[jj] = xr[64 * jj]; }
        while (m < NTOK) {
            if (m + 2 * NGW < NTOK) { const GAS f32x4* xr = (const GAS f32x4*)(x_ + (size_t)(m + 2 * NGW) * DM) + lane_;
#pragma unroll
                for (int jj = 0; jj < 4; ++jj) vm[jj] = xr[64 * jj]; }
            float sq = 0.f;
#pragma unroll
            for (int jj = 0; jj < 4; ++jj) sq += (v[jj].x * v[jj].x + v[jj].y * v[jj].y) + (v[jj].z * v[jj].z + v[jj].w * v[jj].w);
            const float rstd = 1.f / sqrtf(wave_sum(sq, lane_) * (1.f / DM) + EPS);
            GAS unsigned long long* o8 = (GAS unsigned long long*)((bf16_t*)(ws + WS_XB) + (size_t)m * DM) + lane_;
#pragma unroll
            for (int jj = 0; jj < 4; ++jj) o8[64 * jj] = (unsigned long long)pk2(v[jj].x, v[jj].y) | ((unsigned long long)pk2(v[jj].z, v[jj].w) << 32);
            GAS unsigned* q8 = (GAS unsigned*)(ws + WS_XB8 + (size_t)m * DM) + lane_;
#pragma unroll
            for (int jj = 0; jj < 4; ++jj) q8[64 * jj] = pk4_fp8(v[jj].x, v[jj].y, v[jj].z, v[jj].w);
            if (lane_ == 0) ((float*)(ws + WS_RSTD0))[m] = rstd;
#pragma unroll
            for (int jj = 0; jj < 4; ++jj) { v[jj] = vn[jj]; vn[jj] = vm[jj]; }
            m += NGW;
        }
    }
}

__device__ __forceinline__ void forget_phase(Frame& F) {
    const int tid_ = otid(F.wave), lane_ = tid_ & 63;
    const bf16_t* XB = (const bf16_t*)(F.ws + WS_XB); const bf16_t* WF = (const bf16_t*)(F.ws + WS_WF);
    const float* RSTD0 = (const float*)(F.ws + WS_RSTD0); const float* b_f = INP(3);
    float* LC = (float*)(F.ws + WS_LC); float* CT = (float*)(F.ws + WS_CT);
    LAS float* wt = (LAS float*)(F.lds + AUX_OFF);
    const int fr = lane_ & 15, fq = lane_ >> 4;
    for (int chunk = blockIdx.x; chunk < NTOK / 128; chunk += F.G) {
        const int row = chunk * 128 + F.wave * 16 + fr;
        const bf16_t* xa = XB + (size_t)row * DM + 8 * fq; const bf16_t* wb = WF + (size_t)fr * DM + 8 * fq;
        f32x4 acc = {0.f, 0.f, 0.f, 0.f};
#pragma unroll 8
        for (int kb = 0; kb < 32; ++kb) { const bf16x8 a = *(const bf16x8*)(xa + 32 * kb), w = *(const bf16x8*)(wb + 32 * kb); acc = __builtin_amdgcn_mfma_f32_16x16x32_bf16(w, a, acc, 0, 0, 0); }
        const float rs = RSTD0[row];
        float lf[4];
#pragma unroll
        for (int i = 0; i < 4; ++i) { const float z = acc[i] * rs + b_f[4 * fq + i]; lf[i] = fminf(z, 0.f) - log1pf(expf(-fabsf(z))); }
#pragma unroll
        for (int off = 1; off < 16; off <<= 1)
#pragma unroll
            for (int i = 0; i < 4; ++i) { const float t = shfl_from(lf[i], lane_ - off); if (fr >= off) lf[i] += t; }
        if (fr == 15) {
#pragma unroll
            for (int i = 0; i < 4; ++i) wt[F.wave * 16 + 4 * fq + i] = lf[i]; }
        __syncthreads();
#pragma unroll
        for (int i = 0; i < 4; ++i) { float p = 0.f; for (int w = 0; w < F.wave; ++w) p += wt[w * 16 + 4 * fq + i]; lf[i] += p; }
        const int b = row >> 13, s = row & (SEQ - 1);
#pragma unroll
        for (int i = 0; i < 4; ++i) LC[(size_t)(b * 16 + 4 * fq + i) * SEQ + s] = lf[i];
        if (F.wave == 7 && fr == 15) {
#pragma unroll
            for (int i = 0; i < 4; ++i) CT[(b * 16 + 4 * fq + i) * 64 + ((chunk * 128) & (SEQ - 1)) / 128] = lf[i]; }
        __syncthreads();
    }
}

__device__ __forceinline__ void attnA_phase(Frame& F, unsigned char* ldsg) {
    const int tid_ = otid(F.wave), lane_ = tid_ & 63;
    LAS float* NCK = (LAS float*)(F.lds + attn_body::LDS_NCK);
    LAS float* CPs = (LAS float*)(F.lds + AUX_OFF);
    volatile LAS int* ctl = (volatile LAS int*)(F.lds + AUX_OFF + 256);
    const float* LC = (const float*)(F.ws + WS_LC); const float* CT = (const float*)(F.ws + WS_CT);
    float mqk = 0.f;
    { const float* gq_ = INP(4); const float* gk_ = INP(5);
      for (int d = 0; d < 64; ++d) mqk = fmaxf(mqk, fabsf(gq_[d] * gk_[d])); }
    const float thr2 = (40.f + 2.f * 8.f * mqk * 1.03f) * LOG2E;
    unsigned* queue = (unsigned*)(F.ctl + CW_QUEUE);
    for (;;) {
        if (tid_ == 0) ctl[0] = (int)__hip_atomic_fetch_add(queue, 1u, RLX_AGENT);
        __syncthreads();
        const int u = ctl[0];
        if (u >= NBATCH * 16 * 32) break;
        const int qb = 31 - (u >> 6), bh = u & 63, b = bh >> 4, h = bh & 15, q0 = qb * 256, NTf = 4 * qb + 4, nkeys = q0 + 256;
        const float* lcp = LC + (size_t)bh * SEQ;
        f32x4 dva[4]; const P0H ddi = p0h_decode(8 * u + F.wave, F.ws); p0h_load(ddi, lane_, dva);
        if (F.wave == 0) { const float c = CT[bh * 64 + lane_]; float v = c;
#pragma unroll
            for (int off = 1; off < 64; off <<= 1) { const float t = shfl_from(v, lane_ - off); if (lane_ >= off) v += t; }
            const float excl = v - c; CPs[lane_] = excl;
            const float cumq = shfl_from(excl, q0 >> 7) + lcp[q0];
            const bool need = (lane_ <= (q0 >> 7)) && ((cumq - v) * LOG2E >= -thr2);
            const unsigned long long bm = __builtin_amdgcn_ballot_w64(need);
            int t0 = 2 * (int)__builtin_ctzll(bm | (1ull << 63)); t0 = t0 < NTf - 4 ? t0 : NTf - 4;
            if (lane_ == 0) ctl[1] = t0; }
        __syncthreads();
        const int T0 = ctl[1];
        const float cpq = CPs[q0 >> 7], lcq = lcp[q0];
        for (int s = 64 * T0 + tid_; s < nkeys; s += 512) NCK[s] = ((cpq - CPs[s >> 7]) + (lcq - lcp[s])) * LOG2E;
        __syncthreads();
        { const size_t ho = ((size_t)b * SEQ * 1024 + h * 64) * 2;
          attn_body::attn_unit<8, false>(qb, T0, 1024, (const attn_body::bf16*)(F.ws + WS_QA + ho), (const attn_body::bf16*)(F.ws + WS_KA + ho), (const attn_body::bf16*)(F.ws + WS_VA + ho), (attn_body::bf16*)(F.ws + WS_QA + ho), (char*)ldsg, F.wave); }
        p0h_store(ddi, lane_, dva, (LAS float*)(F.lds + F.wave * 8192));
    }
}

__device__ __forceinline__ void router_phase(Frame& F, int layer, const float* stats, float* rstd_out) {
    const int tid_ = otid(F.wave), lane_ = tid_ & 63;
    const bf16_t* XBr = (const bf16_t*)(F.ws + WS_XB); unsigned char* XN8 = (unsigned char*)(F.ws + WS_XN8); const bf16_t* WR = (const bf16_t*)(F.ws + WS_WR) + (size_t)layer * 2 * 32 * 1024;
    const float* b_group = INP(17) + layer * 4; const float* b_expert = INP(19) + layer * 16;
    float* GSORT = (float*)(F.ws + WS_GSORT); int* PERM = (int*)(F.ws + WS_PERM);
    unsigned* CNT = (unsigned*)(F.ctl + (layer == 0 ? CW_CNT0 : CW_CNT1));
    volatile LAS int* lcnt = (volatile LAS int*)(F.lds + AUX_OFF);
    const int fr = lane_ & 15, fq = lane_ >> 4;
#pragma unroll
    for (int p = 0; p < 16; ++p) { const int off = p * 8192 + tid_ * 16, n = off >> 11, pc = (off >> 4) & 127;
        __builtin_amdgcn_global_load_lds((const unsigned*)((const char*)WR + n * 2048 + ((pc ^ (n & 15)) << 4)), (LAS unsigned*)(F.lds + p * 8192 + F.wave * 1024), 16, 0, 0); }
    for (int chunk = blockIdx.x; chunk < NTOK / 128; chunk += F.G) {
        if (tid_ < 64) lcnt[tid_] = 0;
        VM_WAIT();
        __syncthreads();
        const int row = chunk * 128 + F.wave * 16 + fr;
        float ss; { const f32x4 p = *(const f32x4*)(stats + (size_t)row * 16 + 4 * fq); ss = (p[0] + p[1]) + (p[2] + p[3]); ss += shfl_x(ss, 16 * fq + fr, 16); ss += shfl_x(ss, 16 * fq + fr, 32); }
        const float rs = 1.0f / sqrtf(ss * (1.0f / 1024.0f) + EPS);
        const bf16_t* hp = XBr + (size_t)row * DM + 8 * fq;
        unsigned char* x8 = XN8 + (size_t)row * DM + 8 * fq;
        const LAS unsigned char* wl = F.lds + fr * 2048;
        f32x4 a0 = {0.f, 0.f, 0.f, 0.f}, a1 = {0.f, 0.f, 0.f, 0.f};
#pragma unroll 4
        for (int kb = 0; kb < 32; ++kb) {
            const bf16x8 xh = *(const bf16x8*)(hp + 32 * kb);
            const int wc_ = ((4 * kb + fq) ^ fr) << 4;
            const bf16x8 wh0 = *(const LAS bf16x8*)(wl + wc_), wl0 = *(const LAS bf16x8*)(wl + 32 * 2048 + wc_);
            const bf16x8 wh1 = *(const LAS bf16x8*)(wl + 16 * 2048 + wc_), wl1 = *(const LAS bf16x8*)(wl + 48 * 2048 + wc_);
            a0 = __builtin_amdgcn_mfma_f32_16x16x32_bf16(wh0, xh, a0, 0, 0, 0); a0 = __builtin_amdgcn_mfma_f32_16x16x32_bf16(wl0, xh, a0, 0, 0, 0);
            a1 = __builtin_amdgcn_mfma_f32_16x16x32_bf16(wh1, xh, a1, 0, 0, 0); a1 = __builtin_amdgcn_mfma_f32_16x16x32_bf16(wl1, xh, a1, 0, 0, 0);
            u32x2 q8; q8.x = pk4_fp8(bf2f((unsigned short)xh[0]) * rs, bf2f((unsigned short)xh[1]) * rs, bf2f((unsigned short)xh[2]) * rs, bf2f((unsigned short)xh[3]) * rs);
            q8.y = pk4_fp8(bf2f((unsigned short)xh[4]) * rs, bf2f((unsigned short)xh[5]) * rs, bf2f((unsigned short)xh[6]) * rs, bf2f((unsigned short)xh[7]) * rs);
            *(u32x2*)(x8 + 32 * kb) = q8;
        }
        if (fq == 0) rstd_out[row] = rs;
        float gl[4]; int gidx = 0; float gval = 0.f;
        {
#pragma unroll
            for (int i = 0; i < 4; ++i) gl[i] = a1[i] * rs + b_group[i];
            const float mx = fmaxf(fmaxf(gl[0], gl[1]), fmaxf(gl[2], gl[3]));
            float ex[4], sum = 0.f;
#pragma unroll
            for (int i = 0; i < 4; ++i) { ex[i] = expf(gl[i] - mx); sum += ex[i]; }
            float best = -1.f;
#pragma unroll
            for (int i = 0; i < 4; ++i) { const float p = ex[i] / sum; if (p > best) { best = p; gidx = i; } }
            gval = best;
        }
        gidx = shfl_from(gidx, fr); gval = shfl_from(gval, fr);
        int cls = -1, rank = 0; float gwlo = 0.f, gwhi = 0.f;
        if (fq == gidx) {
            float el[4];
#pragma unroll
            for (int i = 0; i < 4; ++i) el[i] = a0[i] * rs + b_expert[4 * fq + i];
            const float mx = fmaxf(fmaxf(el[0], el[1]), fmaxf(el[2], el[3]));
            float pr[4], sum = 0.f;
#pragma unroll
            for (int i = 0; i < 4; ++i) { pr[i] = expf(el[i] - mx); sum += pr[i]; }
#pragma unroll
            for (int i = 0; i < 4; ++i) pr[i] = pr[i] / sum;
            int i1 = 0; float p1 = -1.f;
#pragma unroll
            for (int i = 0; i < 4; ++i) if (pr[i] > p1) { p1 = pr[i]; i1 = i; }
            int i2 = 0; float p2 = -1.f;
#pragma unroll
            for (int i = 0; i < 4; ++i) if (i != i1 && pr[i] > p2) { p2 = pr[i]; i2 = i; }
            const float den = p1 + p2; const float w1g = gval * (p1 / den), w2g = gval * (p2 / den);
            const int lo = i1 < i2 ? i1 : i2, hi = i1 < i2 ? i2 : i1;
            const float wlo = i1 < i2 ? w1g : w2g, whi = i1 < i2 ? w2g : w1g;
            const int pidx = (lo == 0) ? hi - 1 : (lo == 1) ? hi + 1 : 5;
            cls = 6 * gidx + pidx;
            gwlo = wlo; gwhi = whi;
            rank = __hip_atomic_fetch_add((LAS int*)&lcnt[cls], 1, __ATOMIC_RELAXED, __HIP_MEMORY_SCOPE_WORKGROUP);
        }
        __syncthreads();
        if (tid_ < NCLASS) lcnt[32 + tid_] = (int)__hip_atomic_fetch_add(CNT + tid_, (unsigned)lcnt[tid_], RLX_AGENT);
        __syncthreads();
        if (cls >= 0) { const size_t p_ = (size_t)cls * CAP + lcnt[32 + cls] + rank; PERM[p_] = row; *(f32x2*)(GSORT + 2 * p_) = (f32x2){gwlo, gwhi}; }
        __syncthreads();
    }
}
__device__ __forceinline__ void moe_tile_prefix(Frame& F, const int* cnt, volatile LAS int* TP) {
    const int tid_ = otid(F.wave), lane_ = tid_ & 63;
    __syncthreads();
    if (tid_ == 0) { int acc = 0; for (int c = 0; c < NCLASS; ++c) { TP[c] = acc; acc += (cnt[c] + 255) >> 8; } TP[NCLASS] = acc; }
    __syncthreads();
}

__device__ __forceinline__ void dilated_phase(Frame& F, unsigned char* ldsg) {
    const int tid_ = otid(F.wave);
    LAS float* tb = (LAS float*)(F.lds + attn_body::LDS_NCK);
    const int per = (3072 + F.G - 1) / F.G;
    int gjprev = -1, rho = 0; bool primed = false; bf16x8 qn[4];
    for (int i = 0; i < per; ++i) {
        const int u = blockIdx.x * per + i; if (u >= 3072) break;
        const int g = u >> 10, v = u & 1023, j = v >> 7, b = (v >> 5) & 3, x = v & 31;
        const int D4 = 2 * g, d = 1 << D4, r = x & (d - 1), qb = x >> D4;
        unsigned long long pl_t = 0ull; if (PROBE_A == 5) pl_t = __builtin_amdgcn_s_memrealtime();
        if (g * 8 + j != gjprev) { __syncthreads(); dil::build_table(tb, INP(10), g, d, j, tid_); __syncthreads(); gjprev = g * 8 + j; }
        if (!primed) VM_WAIT();
        __syncthreads();
        if (PROBE_A == 5) { const unsigned d_ = (unsigned)(__builtin_amdgcn_s_memrealtime() - pl_t); if (tid_ == 0) ((LAS unsigned*)(F.lds + MISC_OFF))[121] += d_; }
        const size_t ho = (((size_t)(8 * g + j) * NTOK + (size_t)b * SEQ + (size_t)r * (SEQ >> D4)) * 64) * 2;
        const int T0 = qb == 0 ? 0 : 4 * qb - 2;
        attn_body::Xpf xp{}; xp.primed = primed; xp.has_next = (i + 1 < per) && (u + 1 < 3072);
        if (xp.has_next) { const int u2 = u + 1, g2 = u2 >> 10, v2 = u2 & 1023, j2 = v2 >> 7, b2 = (v2 >> 5) & 3, x2 = v2 & 31;
            const int D42 = 2 * g2, d2 = 1 << D42, r2 = x2 & (d2 - 1), qb2 = x2 >> D42, T02 = qb2 == 0 ? 0 : 4 * qb2 - 2;
            const size_t ho2 = (((size_t)(8 * g2 + j2) * NTOK + (size_t)b2 * SEQ + (size_t)r2 * (SEQ >> D42)) * 64) * 2; xp.Pn = 64;
            xp.Qn = (const attn_body::bf16*)(F.ws + WS_QB + ho2) + (long)qb2 * 256 * xp.Pn;
            xp.Kn = (const attn_body::bf16*)(F.ws + WS_KB + ho2) + (long)T02 * 64 * xp.Pn; xp.Vn = (const attn_body::bf16*)(F.ws + WS_VB + ho2) + (long)T02 * 64 * xp.Pn; }
        attn_body::attn_unit_x<8, true, true>(qb, T0, 64, (const attn_body::bf16*)(F.ws + WS_QB + ho), (const attn_body::bf16*)(F.ws + WS_KB + ho), (const attn_body::bf16*)(F.ws + WS_VB + ho),
                                      (attn_body::bf16*)(F.ws + WS_QB + ho), (char*)ldsg, F.wave, (float*)(F.ws + WS_DPML) + (size_t)(g * 8 + j) * NTOK * 2, (long)b * SEQ + r, d, xp, qn, rho);
        primed = xp.has_next;
    }
}
__device__ __forceinline__ void dilated_merge(Frame& F) {
    const int tid_ = otid(F.wave);
    bf16_t* QB = (bf16_t*)(F.ws + WS_QB); const float* PML = (const float*)(F.ws + WS_DPML);
    for (size_t it = (size_t)blockIdx.x * 512 + tid_; it < (size_t)NTOK * 64; it += (size_t)F.G * 512) {
        const int ch = (int)(it & 7), j = (int)((it >> 3) & 7); const size_t tok = it >> 6;
        f32x2 ml[3]; u32x4 o[3];
#pragma unroll
        for (int g = 0; g < 3; ++g) { ml[g] = *(const f32x2*)(PML + ((size_t)(g * 8 + j) * NTOK + tok) * 2); o[g] = *(const u32x4*)(QB + ((size_t)(8 * g + j) * NTOK + pg8::dil_row((int)tok, 2 * g)) * 64 + 8 * ch); }
        const float M = fmaxf(fmaxf(ml[0][0], ml[1][0]), ml[2][0]);
        float f[3], L = 0.f;
#pragma unroll
        for (int g = 0; g < 3; ++g) { f[g] = __builtin_amdgcn_exp2f(ml[g][0] - M); L += f[g] * ml[g][1]; }
        const float rl = 1.0f / L;
        float r8[8];
#pragma unroll
        for (int e = 0; e < 4; ++e) { float lo = 0.f, hh = 0.f;
#pragma unroll
            for (int g = 0; g < 3; ++g) { lo += bf2f(o[g][e] & 0xffffu) * f[g]; hh += bf2f(o[g][e] >> 16) * f[g]; }
            r8[2 * e] = lo * rl; r8[2 * e + 1] = hh * rl; }
        u32x2 q8; q8.x = pk4_fp8(r8[0], r8[1], r8[2], r8[3]); q8.y = pk4_fp8(r8[4], r8[5], r8[6], r8[7]);
        *(GAS u32x2*)(F.ws + WS_XB8 + tok * 512 + 64 * j + 8 * ch) = q8;
    }
}

struct Args { const float* in[23]; float* out; unsigned char* ws; };
__global__ void __launch_bounds__(512, 2) fwd_kernel(Args args) {
    extern __shared__ __attribute__((aligned(16))) unsigned char lds[];
    Frame F;
    F.lds = (LAS unsigned char*)lds;
    F.MISC = (volatile LAS unsigned*)(F.lds + MISC_OFF);
    F.wave = __builtin_amdgcn_readfirstlane((int)threadIdx.x >> 6);
    F.G = gridDim.x; { const int bx = blockIdx.x; F.vcu = (F.G % 8 == 0) ? (bx % 8) * (F.G / 8) + bx / 8 : bx; }
    F.out = args.out; F.ws = args.ws;
    F.ctl = (gu32*)(args.ws + WS_CTL);
    for (int u = otid(F.wave); u < 128; u += 512) ((LAS unsigned*)(F.lds + MISC_OFF))[u] = 0u;
    __syncthreads();
    XcdBarrier bar = xcd_barrier_post((unsigned*)(F.ctl + CW_BAR), F.MISC + 8, F.wave == 0 && lane_id() == 0);
#define GRID_BAR() xcd_barrier(bar, F.wave == 0 && lane_id() == 0)
#ifndef RUN_FROM
#define RUN_FROM 0
#endif
#define RUN(k) ((k) <= RUN_UPTO && (k) >= RUN_FROM)
#ifndef PROBE_MASK
#define PROBE_MASK 0
#endif
    unsigned long long pr_acc = 0ull, pr_t0 = 0ull;
#define PR_BEGIN(k) do { if ((PROBE_MASK >> (k)) & 1) pr_t0 = __builtin_amdgcn_s_memrealtime(); } while (0)
#define PR_END(k) do { if ((PROBE_MASK >> (k)) & 1) pr_acc += __builtin_amdgcn_s_memrealtime() - pr_t0; } while (0)

#define ws opq_ptr(F.ws)
#define XB ((bf16_t*)(ws + WS_XB))
#define H (F.out)
#define TP ((volatile LAS int*)(F.lds + AUX_OFF + 1024))

    PR_BEGIN(0); if (RUN(0)) { p0_prologue(F); GRID_BAR(); } PR_END(0);

    PR_BEGIN(1);
    if (RUN(1)) {
        pg8::GemmP g{(const void*)(ws + WS_XB8), 1024, 1024, 1 << 20, 32, (PROBE_KSEL >> 1) & 1};
        pg8::DenseSched S; S.so.init(NTOK, 3072, F.G, (int)blockIdx.x); S.Bt = (const bf16_t*)(ws + WS_WQKVA); S.lda = 512; S.ldb = 512;
        pg8::EpiHead E{(bf16_t*)(ws + WS_QA), (size_t)(WS_KA - WS_QA) / 2, (const float*)(ws + WS_GTAB), 2, 4, 8, 1024, (const float*)(ws + WS_RSTD0), nullptr, 1.0f / W8SCALE};
        pg8::gemm_phase<pg8::EpiHead, pg8::DenseSched, true>(F.lds, g, S, E, F.wave);
        forget_phase(F);
        GRID_BAR();
    }
    PR_END(1); PR_BEGIN(2);
    if (RUN(2)) { attnA_phase(F, lds); GRID_BAR(); }
    PR_END(2); PR_BEGIN(3);
    if (RUN(3)) {
        pg8::GemmP g{(const bf16_t*)(ws + WS_QA), 2048, 2048, 1 << 20, 128, (PROBE_KSEL >> 3) & 1};
        pg8::DenseSched S; S.so.init(NTOK, 1024, F.G, (int)blockIdx.x); S.Bt = (const bf16_t*)(ws + WS_WOA); S.lda = 1024; S.ldb = 1024;
        pg8::EpiResid E{XB, (float*)(ws + WS_STATS1), 1.0f};
        pg8::gemm_phase<pg8::EpiResid, pg8::DenseSched>(F.lds, g, S, E, F.wave);
        GRID_BAR();
    }
    PR_END(3);
#define MOE_LAYER(PH, layer, STATS_IN, RSTD_BUF, CW_CNT, LASTL, STATS_OUT) \
    PR_BEGIN(PH); if (RUN(PH)) { router_phase(F, layer, (const float*)(ws + STATS_IN), (float*)(ws + RSTD_BUF)); GRID_BAR(); } PR_END(PH); PR_BEGIN(PH + 1); \
    if (RUN(PH + 1)) { \
        const int* cnt = (const int*)(F.ctl + CW_CNT); moe_tile_prefix(F, cnt, TP); \
        pg8::GemmP g{(const void*)ws, 1024, 1024, 1 << 20, 512, (PROBE_KSEL >> (PH + 1)) & 1}; \
        pg8::MoeMixSched S{TP, cnt, (const int*)(ws + WS_PERM), (const unsigned char*)(ws + WS_WGU) + (size_t)layer * 16 * 1024 * 1024, (const unsigned char*)(ws + WS_WD) + (size_t)layer * 16 * 1024 * 512, \
                           F.G, (int)blockIdx.x, __builtin_amdgcn_readfirstlane(TP[NCLASS]), (unsigned*)(F.ctl + CW_DONE + layer * 16384), (unsigned*)(F.ctl + CW_BAR) + XB_TMO}; \
        pg8::EpiMoe<LASTL> E{pg8::EpiSwiglu{(unsigned char*)(ws + WS_HID), (const float*)(ws + WS_GSORT)}, \
                             pg8::EpiScatter<LASTL>{XB, H, STATS_OUT, (const int*)(ws + WS_PERM), 1.0f / (W8SCALE * H8SCALE)}}; \
        pg8::gemm_phase<pg8::EpiMoe<LASTL>, pg8::MoeMixSched, true>(F.lds, g, S, E, F.wave); \
        if (!(LASTL)) GRID_BAR(); } PR_END(PH + 1);
    MOE_LAYER(4, 0, WS_STATS1, WS_RSTD1, CW_CNT0, false, (float*)(ws + WS_STATS2))
    PR_BEGIN(7);
    if (RUN(7)) {
        pg8::GemmP g{(const void*)(ws + WS_XB8), 1024, 1024, 1 << 20, 32, (PROBE_KSEL >> 7) & 1};
        pg8::DenseSched S; S.so.init(NTOK, 4608, F.G, (int)blockIdx.x); S.Bt = (const bf16_t*)(ws + WS_WKVQ); S.lda = 512; S.ldb = 512;
        pg8::EpiHead E{(bf16_t*)(ws + WS_KB), (size_t)(WS_VB - WS_KB) / 2, (const float*)(ws + WS_GTAB) + 3 * 64, 1, 6, 12, KVW, nullptr, (const float*)(ws + WS_STATS2), 1.0f / W8SCALE, 1};
        pg8::gemm_phase<pg8::EpiHead, pg8::DenseSched, true>(F.lds, g, S, E, F.wave);
        GRID_BAR();
    }
    PR_END(7); PR_BEGIN(8);
    if (RUN(8)) { dilated_phase(F, lds); GRID_BAR(); dilated_merge(F); GRID_BAR(); }
    PR_END(8); PR_BEGIN(9);
    if (RUN(9)) {
        pg8::GemmP g{(const void*)(ws + WS_XB8), 512, 512, 1 << 20, 128, (PROBE_KSEL >> 9) & 1};
        pg8::DenseSched S; S.so.init(NTOK, 1024, F.G, (int)blockIdx.x); S.Bt = (const bf16_t*)(ws + WS_WOB); S.lda = 256; S.ldb = 256;
        pg8::EpiResid E{XB, (float*)(ws + WS_STATS3), 1.0f / W8SCALE};
        pg8::gemm_phase<pg8::EpiResid, pg8::DenseSched, true>(F.lds, g, S, E, F.wave);
        GRID_BAR();
    }
    PR_END(9);
    MOE_LAYER(10, 1, WS_STATS3, WS_RSTD3, CW_CNT1, true, (float*)nullptr)

#if RUN_UPTO < 12
    { const int gt = (blockIdx.x * 512 + otid(F.wave)); const f32x4* xs = (const f32x4*)INP(0); f32x4* od = (f32x4*)F.out;
      for (size_t e = gt; e < (size_t)NTOK * DM / 4; e += (size_t)F.G * 512) od[e] = xs[e]; }
#endif
    if (PROBE_K != 0) pr_acc += ((LAS unsigned*)(F.lds + MISC_OFF))[120];
    if (PROBE_A != 0) pr_acc += ((LAS unsigned*)(F.lds + MISC_OFF))[121];
    if (PROBE_MASK != 0 && blockIdx.x == 0 && otid(F.wave) == 0) { const unsigned long long t1 = __builtin_amdgcn_s_memrealtime(); while (__builtin_amdgcn_s_memrealtime() - t1 < pr_acc) __builtin_amdgcn_s_sleep(8); }
    if (__hip_atomic_load((unsigned*)(F.ctl + CW_BAR) + XB_TMO, RLX_AGENT) != 0u) {
        const int gt = (blockIdx.x * 512 + otid(F.wave)); const float q = __builtin_nanf("");
        for (size_t e = gt; e < (size_t)NTOK * DM; e += (size_t)F.G * 512) F.out[e] = q;
    }
}

#undef ws
#undef XB
#undef H
#undef TP
extern "C" void kernel_launch(void* const* d_in, const int* in_sizes, int n_in, void* d_out, int out_size, void* d_ws, size_t ws_size, hipStream_t stream) {
    static int grid = 0;
    if (grid == 0) {
        if (n_in != 23 || in_sizes[0] != NTOK * DM || out_size != NTOK * DM || ws_size < WS_END) { fprintf(stderr, "kernel_launch: unexpected shapes (n_in %d, in0 %d, out %d, ws %zu)\n", n_in, n_in > 0 ? in_sizes[0] : -1, out_size, ws_size); grid = -1; return; }
        int dev = 0, cus = 0, per_cu = 0;
        if (hipGetDevice(&dev) != hipSuccess || hipDeviceGetAttribute(&cus, hipDeviceAttributeMultiprocessorCount, dev) != hipSuccess) { grid = -1; return; }
        if (hipFuncSetAttribute((const void*)fwd_kernel, hipFuncAttributeMaxDynamicSharedMemorySize, LDS_BYTES) != hipSuccess) { fprintf(stderr, "kernel_launch: hipFuncSetAttribute failed\n"); grid = -1; return; }
        if (hipOccupancyMaxActiveBlocksPerMultiprocessor(&per_cu, (const void*)fwd_kernel, 512, LDS_BYTES) != hipSuccess || per_cu < 1) fprintf(stderr, "kernel_launch: occupancy query reports %d\n", per_cu);
        (void)hipGetLastError();
        grid = cus;
    }
    if (grid < 0) return;
    if (hipMemsetAsync((char*)d_ws + WS_CTL, 0, CTL_ZERO_BYTES, stream) != hipSuccess) return;
    Args a{};
    for (int i = 0; i < 23; ++i) a.in[i] = (const float*)d_in[i];
    a.out = (float*)d_out; a.ws = (unsigned char*)d_ws;
    hipLaunchKernelGGL(fwd_kernel, dim3(grid), dim3(512), LDS_BYTES, stream, a);
}
```

```cpp
#include <hip/hip_runtime.h>
#include <hip/hip_bf16.h>
#include <cstdio>
#include <cstdint>
#include <cmath>

#ifndef RUN_UPTO
#define RUN_UPTO 99
#endif

#define GAS __attribute__((address_space(1)))
#define LAS __attribute__((address_space(3)))
typedef unsigned short bf16_t;
typedef short bf16x8 __attribute__((ext_vector_type(8)));
typedef float f32x2 __attribute__((ext_vector_type(2)));
typedef float f32x4 __attribute__((ext_vector_type(4)));
typedef float f32x16 __attribute__((ext_vector_type(16)));
typedef unsigned u32x2 __attribute__((ext_vector_type(2)));
typedef unsigned u32x4 __attribute__((ext_vector_type(4)));
typedef short s16x4 __attribute__((ext_vector_type(4)));
typedef int i32x4 __attribute__((ext_vector_type(4)));
typedef int i32x8 __attribute__((ext_vector_type(8)));
typedef GAS unsigned gu32;

constexpr int NTOK = 32768, DM = 1024, SEQ = 8192, NBATCH = 4;
constexpr int KVW = 1536;
constexpr float EPS = 1e-6f;
constexpr float LOG2E = 1.4426950408889634f;
constexpr float C2 = 0.125f * LOG2E;
constexpr int NCLASS = 24, CAP = 32768;

constexpr size_t MiB = 1u << 20;
constexpr size_t WS_CTL = 0, CTL_ZERO_BYTES = 256 * 1024;
constexpr size_t WS_RSTD0 = 2 * MiB, WS_RSTD1 = 2 * MiB + 128 * 1024, WS_RSTD3 = 2 * MiB + 256 * 1024;
constexpr size_t WS_STATS1 = 3 * MiB, WS_STATS2 = 5 * MiB, WS_STATS3 = 7 * MiB;
constexpr size_t WS_GATES = 9 * MiB;
constexpr size_t WS_LC = 10 * MiB;
constexpr size_t WS_CT = 12 * MiB;
constexpr size_t WS_WF = 12 * MiB + 64 * 1024;
constexpr size_t WS_WR = 12 * MiB + 128 * 1024;
constexpr size_t WS_GTAB = 12 * MiB + 32 * 1024;
constexpr size_t WS_PERM = 13 * MiB;
constexpr size_t WS_WQKVA = 16 * MiB, WS_WOA = 22 * MiB, WS_WKVQ = 24 * MiB, WS_WOB = 33 * MiB;
constexpr size_t WS_WGU = 34 * MiB;
constexpr size_t WS_XB8 = 66 * MiB;
constexpr size_t WS_DPML = 114 * MiB;
constexpr size_t WS_WD = 98 * MiB;
constexpr size_t WS_GSORT = 120 * MiB;
constexpr size_t WS_XB = 132 * MiB;
constexpr size_t WS_R = 196 * MiB;
constexpr size_t WS_QA = WS_R, WS_KA = WS_R + 64 * MiB, WS_VA = WS_R + 128 * MiB;
constexpr size_t WS_HID = WS_R;
constexpr size_t WS_XN8 = WS_R + 44 * MiB;
constexpr size_t WS_KB = WS_R, WS_VB = WS_R + 96 * MiB, WS_QB = WS_R + 192 * MiB;
constexpr size_t WS_END = WS_R + 288 * MiB;
constexpr int CW_BAR = 4096, CW_QUEUE = 8192, CW_CNT0 = 9216, CW_CNT1 = 9216 + 64, CW_DONE = 32768;

constexpr int RING_BYTES = 131072;
constexpr int MISC_OFF = RING_BYTES;
constexpr int AUX_OFF = RING_BYTES + 512;
constexpr int LDS_BYTES = 155648;
constexpr int AUX_BYTES = LDS_BYTES - AUX_OFF;

#define LDS_WAIT() asm volatile("s_waitcnt lgkmcnt(0)" ::: "memory")
#define VM_WAIT() asm volatile("s_waitcnt vmcnt(0)" ::: "memory")
#define RLX_AGENT __ATOMIC_RELAXED, __HIP_MEMORY_SCOPE_AGENT

__device__ __forceinline__ int lane_id() { int l; asm volatile("v_mbcnt_lo_u32_b32 %0, -1, 0\n\tv_mbcnt_hi_u32_b32 %0, -1, %0" : "=v"(l)); return l; }
__device__ __forceinline__ void st16_wt(void* p, u32x4 v) { asm volatile("global_store_dwordx4 %0, %1, off sc1\n\ts_nop 2" :: "v"((GAS void*)p), "v"(v) : "memory"); }
__device__ __forceinline__ void st8_wt(void* p, u32x2 v) { asm volatile("global_store_dwordx2 %0, %1, off sc1" :: "v"((GAS void*)p), "v"(v) : "memory"); }
__device__ __forceinline__ float shfl_from(float v, int srclane) { return __int_as_float(__builtin_amdgcn_ds_bpermute(srclane << 2, __float_as_int(v))); }
__device__ __forceinline__ int shfl_from(int v, int srclane) { return __builtin_amdgcn_ds_bpermute(srclane << 2, v); }
__device__ __forceinline__ float shfl_x(float v, int lane, int mask) { return shfl_from(v, lane ^ mask); }
__device__ __forceinline__ unsigned f2bf(float f) { unsigned u = __builtin_bit_cast(unsigned, f); return (u + 0x7fffu + ((u >> 16) & 1u)) >> 16; }
__device__ __forceinline__ float bf2f(unsigned b) { return __builtin_bit_cast(float, b << 16); }
__device__ __forceinline__ unsigned pk2(float lo, float hi) { return f2bf(lo) | (f2bf(hi) << 16); }
__device__ __forceinline__ unsigned pk4_fp8(float a, float b, float c, float d) { int v = 0; v = __builtin_amdgcn_cvt_pk_fp8_f32(a, b, v, false); v = __builtin_amdgcn_cvt_pk_fp8_f32(c, d, v, true); return (unsigned)v; }
constexpr float W8SCALE = 32.0f, H8SCALE = 16.0f;
__device__ __forceinline__ unsigned cvt_pk_bf16(float lo, float hi) { unsigned r; asm volatile("v_cvt_pk_bf16_f32 %0, %1, %2" : "=v"(r) : "v"(lo), "v"(hi)); return r; }

namespace pg8 {
constexpr int BM = 256, BK = 64, HALF = 128, HTB = HALF * BK * 2, STAGE_BYTES = 8 * HTB, NXCD = 8, WGM = 8;
__host__ __device__ __forceinline__ int lds_byte(int r, int c) { const int st = (r >> 4) * 2 + (c >> 5), rr = r & 15, cc = c & 31, ob = rr * 64 + cc * 2; return st * 1024 + (ob ^ (((ob >> 9) & 1) << 5)); }
__host__ __device__ __forceinline__ void stage_rc(int b, int& R, int& C) { const int st = b / 1024, sb = b % 1024, swz = sb ^ (((sb >> 9) & 1) << 5); R = (st >> 1) * 16 + swz / 64; C = (st & 1) * 32 + (swz % 64) / 2; }
__host__ __device__ __forceinline__ int perm32(int rho) { const int n = rho >> 4, i = rho & 15; return 8 * (i >> 2) + 4 * n + (i & 3); }

struct Unit { int rowbase; int pn; int permoff; int nvalid; int e1; int e2; int type; };
struct GemmP { const void* A; int ldbB; int Kbytes; int nsplit; int hstepB; int pk = 0; };

struct StaticOrder {
    int nM, nN, nwg, G, c;
    __device__ void init(int M, int N, int G_, int c_) { nM = M / BM; nN = N / BM; nwg = nM * nN; G = G_; c = c_; }
    __device__ bool next(int i, int& pm, int& pn) const {
        const long L = (long)i * G + c; if (L >= nwg) return false;
        int wgid = (int)L; { const int q = nwg / NXCD, r = nwg % NXCD, xcd = wgid % NXCD, off = wgid / NXCD; wgid = (xcd < r ? xcd * (q + 1) : r * (q + 1) + (xcd - r) * q) + off; }
        const int nig = WGM * nN, gid = wgid / nig, fm = gid * WGM, gsz = (nM - fm) < WGM ? (nM - fm) : WGM;
        pm = fm + ((wgid % nig) % gsz); pn = (wgid % nig) / gsz; return true;
    }
};
struct DenseSched {
    static constexpr bool MIX = false;
    StaticOrder so; const bf16_t* Bt; int lda, ldb;
    __device__ __forceinline__ bool next(int i, Unit& u) const { int pm, pn; if (!so.next(i, pm, pn)) return false; u.rowbase = pm * BM; u.pn = pn; u.permoff = 0; u.nvalid = 256; u.e1 = 0; u.e2 = 0; u.type = 0; return true; }
    __device__ __forceinline__ void aoff(const Unit& u, const int (&R)[2], const int (&C)[2], unsigned (&v)[2][2]) const {
#pragma unroll
        for (int h = 0; h < 2; ++h)
#pragma unroll
            for (int i = 0; i < 2; ++i) v[h][i] = (unsigned)((u.rowbase + 128 * h + R[i]) * lda + C[i]) * 2u; }
    __device__ __forceinline__ const char* blo(const Unit& u) const { return (const char*)Bt + (size_t)u.pn * 256 * ldb * 2; }
    __device__ __forceinline__ const char* bhi(const Unit& u) const { return blo(u); }
};
__device__ __forceinline__ bool moe_unit(int L, int npn, int TT, const volatile LAS int* TP, const int* cnt, Unit& u) {
    if (L >= TT * npn) return false;
    const int tau = L / npn; u.pn = L % npn;
    int c = 0;
#pragma unroll 1
    for (int k = 1; k < NCLASS; ++k) if (TP[k] <= tau) c = k;
    const int rt = tau - TP[c]; const int n = cnt[c] - 256 * rt;
    u.rowbase = tau * 256; u.permoff = c * CAP + rt * 256; u.nvalid = n < 256 ? n : 256;
    const int g = c / 6, p = c % 6; const int a = (p < 3) ? 0 : (p < 5) ? 1 : 2; const int b = (p < 3) ? p + 1 : (p < 5) ? p - 1 : 3;
    u.e1 = 4 * g + a; u.e2 = 4 * g + b;
    u.rowbase = __builtin_amdgcn_readfirstlane(u.rowbase); u.pn = __builtin_amdgcn_readfirstlane(u.pn); u.permoff = __builtin_amdgcn_readfirstlane(u.permoff);
    u.nvalid = __builtin_amdgcn_readfirstlane(u.nvalid); u.e1 = __builtin_amdgcn_readfirstlane(u.e1); u.e2 = __builtin_amdgcn_readfirstlane(u.e2);
    return true;
}
struct Moe1Sched {      static constexpr bool MIX = false;
    const volatile LAS int* TP; const int* cnt; const int* perm; const unsigned char* Wgu; int G, c, TT;
    __device__ __forceinline__ bool next(int i, Unit& u) const { return moe_unit(i * G + c, 8, TT, TP, cnt, u); }
    __device__ __forceinline__ void aoff(const Unit& u, const int (&R)[2], const int (&C)[2], unsigned (&v)[2][2]) const {
#pragma unroll
        for (int h = 0; h < 2; ++h)
#pragma unroll
            for (int i = 0; i < 2; ++i) { const int r = 128 * h + R[i]; const int tok = (r < u.nvalid) ? ((const GAS int*)perm)[u.permoff + r] : 0; v[h][i] = (unsigned)(tok * 1024 + 2 * C[i]); } }
    __device__ __forceinline__ const char* blo(const Unit& u) const { const int e = (u.pn < 4) ? u.e1 : u.e2; return (const char*)Wgu + ((size_t)e * 1024 + 128 * (u.pn & 3)) * 1024; }
    __device__ __forceinline__ const char* bhi(const Unit& u) const { return blo(u); }
};
struct Moe2Sched {      static constexpr bool MIX = false;
    const volatile LAS int* TP; const int* cnt; const unsigned char* Wd; int G, c, TT;
    __device__ __forceinline__ bool next(int i, Unit& u) const { return moe_unit(i * G + c, 4, TT, TP, cnt, u); }
    __device__ __forceinline__ void aoff(const Unit& u, const int (&R)[2], const int (&C)[2], unsigned (&v)[2][2]) const {
#pragma unroll
        for (int h = 0; h < 2; ++h)
#pragma unroll
            for (int i = 0; i < 2; ++i) v[h][i] = (unsigned)((u.rowbase + 128 * h + R[i]) * 1024 + 2 * C[i]); }
    __device__ __forceinline__ const char* blo(const Unit& u) const { return (const char*)Wd + ((size_t)u.e1 * 1024 + 256 * u.pn) * 512; }
    __device__ __forceinline__ const char* bhi(const Unit& u) const { return (const char*)Wd + ((size_t)u.e2 * 1024 + 256 * u.pn) * 512 - 4 * 128; }
};

struct MoeMixSched {
    static constexpr bool MIX = true;
    const volatile LAS int* TP; const int* cnt; const int* perm; const unsigned char* Wgu; const unsigned char* Wd; int G, c, TT; unsigned* done; unsigned* tmo;
    __device__ __forceinline__ bool next(int i, Unit& u) const {
        const int cc = (G == 256) ? ((c & 7) * 32 + (c >> 3)) : c;
        const int L = i * G + cc, n1 = TT * 8;
        if (L < n1) { moe_unit(L, 8, TT, TP, cnt, u); u.type = 0; return true; }
        if (!moe_unit(L - n1, 4, TT, TP, cnt, u)) return false; u.type = 1; return true; }
    __device__ __forceinline__ void aoff(const Unit& u, const int (&R)[2], const int (&C)[2], unsigned (&v)[2][2]) const {
#pragma unroll
        for (int h = 0; h < 2; ++h)
#pragma unroll
            for (int i = 0; i < 2; ++i) { const int r = 128 * h + R[i];
                if (u.type == 0) { const int tok = (r < u.nvalid) ? ((const GAS int*)perm)[u.permoff + r] : 0; v[h][i] = (unsigned)WS_XN8 + (unsigned)(tok * 1024 + 2 * C[i]); }
                else v[h][i] = (unsigned)WS_HID + (unsigned)((u.rowbase + r) * 1024 + 2 * C[i]); } }
    __device__ __forceinline__ const char* blo(const Unit& u) const {
        if (u.type == 0) { const int e = (u.pn < 4) ? u.e1 : u.e2; return (const char*)Wgu + ((size_t)e * 1024 + 128 * (u.pn & 3)) * 1024; }
        return (const char*)Wd + ((size_t)u.e1 * 1024 + 256 * u.pn) * 512; }
    __device__ __forceinline__ const char* bhi(const Unit& u) const {
        if (u.type == 0) return blo(u);
        return (const char*)Wd + ((size_t)u.e2 * 1024 + 256 * u.pn) * 512 - 4 * 128; }
    __device__ __forceinline__ int ldbB(const Unit& u) const { return u.type == 0 ? 1024 : 512; }
    __device__ __forceinline__ int hstepB(const Unit& u) const { return u.type == 0 ? 512 : 128; }
    __device__ __forceinline__ int nsplit(const Unit& u) const { return u.type == 0 ? (1 << 20) : 4; }
    __device__ __forceinline__ void a_ready(const Unit& u) const {
        if (u.type == 1) { unsigned* w = done + 64 * (u.rowbase >> 8); unsigned sp = 0;
            while (__hip_atomic_load(w, __ATOMIC_RELAXED, __HIP_MEMORY_SCOPE_AGENT) < 64u) { __builtin_amdgcn_s_sleep(2); if (++sp > (1u << 20)) { __hip_atomic_store(tmo, 1u, __ATOMIC_RELAXED, __HIP_MEMORY_SCOPE_AGENT); break; } }
              } }
    __device__ __forceinline__ const unsigned* poll_addr(const Unit& u) const { return done + 64 * (u.rowbase >> 8); }
    __device__ __forceinline__ int done_tile(const Unit& u) const { return (u.type == 0) ? (u.rowbase >> 8) : -1; }
    __device__ __forceinline__ void signal(int tile, int lane) const { if (lane == 0) __hip_atomic_fetch_add(done + 64 * tile, 1u, __ATOMIC_RELAXED, __HIP_MEMORY_SCOPE_AGENT); }
};

__device__ __forceinline__ int dil_row(int tok, int D4) { const int s = tok & (SEQ - 1); return (tok & ~(SEQ - 1)) + ((s & ((1 << D4) - 1)) << (13 - D4)) + (s >> D4); }
__device__ __forceinline__ float row_rstd16(const float* stats, int row) {
    const f32x4* p = (const f32x4*)(stats + (size_t)row * 16); const f32x4 a = p[0], b = p[1], c = p[2], d = p[3];
    const float s = ((a[0] + a[1]) + (a[2] + a[3])) + ((b[0] + b[1]) + (b[2] + b[3])) + ((c[0] + c[1]) + (c[2] + c[3])) + ((d[0] + d[1]) + (d[2] + d[3]));
    return 1.0f / sqrtf(s * (1.0f / 1024.0f) + EPS);
}
struct EpiHead {
    static constexpr int BMODE = 2; static constexpr int NPF = 0;
    bf16_t* dbase; size_t dstride; const float* gtab; int plain_seg; int e0, e1;
    int ldc; const float* rstd; const float* stats; float ascale;
    int dil = 0;
    __device__ __forceinline__ void operator()(const f32x4 (&acc)[2][2][4][2], const Unit& u, int wr, int wc, int fr, int fq) const {
        asm volatile("" : "+v"(fr), "+v"(fq));
        const int pn = u.pn; const int seg = (pn < e0) ? 0 : (pn < e1) ? 1 : 2;
        bf16_t* dst = dbase + (size_t)seg * dstride; const float* gain = gtab + 64 * seg; const bool norm = (seg != plain_seg);
        const int pnl = pn - (seg == 0 ? 0 : seg == 1 ? e0 : e1);
        const int col0 = 64 * (4 * pnl + wc) + 8 * fq;
        f32x4 gv[2][2];
#pragma unroll
        for (int bj = 0; bj < 2; ++bj)
#pragma unroll
            for (int n = 0; n < 2; ++n) gv[bj][n] = *(const GAS f32x4*)(gain + 32 * bj + 8 * fq + 4 * n);
        float rsv[2][4];
        if (rstd) {
#pragma unroll
            for (int ai = 0; ai < 2; ++ai)
#pragma unroll
                for (int m = 0; m < 4; ++m) rsv[ai][m] = ((const GAS float*)rstd)[u.rowbase + ai * HALF + wr * 64 + m * 16 + fr] * ascale;
        } else {
            f32x4 pq[2][4];
#pragma unroll
            for (int ai = 0; ai < 2; ++ai)
#pragma unroll
                for (int m = 0; m < 4; ++m) pq[ai][m] = *(const GAS f32x4*)(stats + (size_t)(u.rowbase + ai * HALF + wr * 64 + m * 16 + fr) * 16 + 4 * fq);
#pragma unroll
            for (int ai = 0; ai < 2; ++ai)
#pragma unroll
                for (int m = 0; m < 4; ++m) { float sq = (pq[ai][m][0] + pq[ai][m][1]) + (pq[ai][m][2] + pq[ai][m][3]); sq += shfl_x(sq, 16 * fq + fr, 16); sq += shfl_x(sq, 16 * fq + fr, 32);
                    rsv[ai][m] = ascale / sqrtf(sq * (1.0f / 1024.0f) + EPS); }
        }
#pragma unroll
        for (int ai = 0; ai < 2; ++ai)
#pragma unroll
            for (int m = 0; m < 4; ++m) {
                const int row = u.rowbase + ai * HALF + wr * 64 + m * 16 + fr;
                const float rs = rsv[ai][m];
                float hr = rs;
                if (norm) {
                    float ss = 0.f;
#pragma unroll
                    for (int bj = 0; bj < 2; ++bj)
#pragma unroll
                        for (int n = 0; n < 2; ++n) { const f32x4 x = acc[ai][bj][m][n]; ss += (x[0] * x[0] + x[1] * x[1]) + (x[2] * x[2] + x[3] * x[3]); }
                    ss += shfl_x(ss, 16 * fq + fr, 16); ss += shfl_x(ss, 16 * fq + fr, 32);
                    hr = rs / sqrtf(ss * rs * rs * (1.0f / 64.0f) + EPS);
                }
                bf16_t* rowp = dil ? dst + ((size_t)(4 * pnl + wc) * NTOK + dil_row(row, 2 * ((4 * pnl + wc) >> 3))) * 64 + 8 * fq : dst + (size_t)row * ldc + col0;
#pragma unroll
                for (int bj = 0; bj < 2; ++bj) {
                    const f32x4 v0 = acc[ai][bj][m][0] * hr * gv[bj][0], v1 = acc[ai][bj][m][1] * hr * gv[bj][1];
                    u32x4 w; w.x = cvt_pk_bf16(v0[0], v0[1]); w.y = cvt_pk_bf16(v0[2], v0[3]); w.z = cvt_pk_bf16(v1[0], v1[1]); w.w = cvt_pk_bf16(v1[2], v1[3]);
                    st16_wt(rowp + 32 * bj, w); }
                if (m & 1) asm volatile("" ::: "memory");
            }
    }
};
__device__ __forceinline__ void unpack8(const u32x4 b, f32x4& lo, f32x4& hi) {
    lo = (f32x4){bf2f(b.x & 0xffffu), bf2f(b.x >> 16), bf2f(b.y & 0xffffu), bf2f(b.y >> 16)}; hi = (f32x4){bf2f(b.z & 0xffffu), bf2f(b.z >> 16), bf2f(b.w & 0xffffu), bf2f(b.w >> 16)}; }
struct EpiResid {
    static constexpr int BMODE = 1; static constexpr int NPF = 0;
    bf16_t* xb; float* stats; float ascale;
    __device__ __forceinline__ void operator()(const f32x4 (&acc)[2][2][4][2], const Unit& u, int wr, int wc, int fr, int fq) const {
        asm volatile("" : "+v"(fr), "+v"(fq));
        const int col0 = u.pn * BM + wc * 32 + 8 * fq;
#pragma unroll
        for (int ai = 0; ai < 2; ++ai) {
        u32x4 bb[2][4][2];
#pragma unroll
            for (int m = 0; m < 4; ++m)
#pragma unroll
                for (int bj = 0; bj < 2; ++bj) bb[ai][m][bj] = *(const GAS u32x4*)(xb + (size_t)(u.rowbase + ai * HALF + wr * 64 + m * 16 + fr) * 1024 + col0 + bj * HALF);
#pragma unroll
            for (int m = 0; m < 4; ++m) {
                const int row = u.rowbase + ai * HALF + wr * 64 + m * 16 + fr; const size_t off = (size_t)row * 1024 + col0; float ss = 0.f;
#pragma unroll
                for (int bj = 0; bj < 2; ++bj) { const size_t o = off + bj * HALF; f32x4 b0, b1; unpack8(bb[ai][m][bj], b0, b1);
                    const f32x4 v0 = b0 + acc[ai][bj][m][0] * ascale, v1 = b1 + acc[ai][bj][m][1] * ascale;
                    ss += ((v0[0] * v0[0] + v0[1] * v0[1]) + (v0[2] * v0[2] + v0[3] * v0[3])) + ((v1[0] * v1[0] + v1[1] * v1[1]) + (v1[2] * v1[2] + v1[3] * v1[3]));
                    u32x4 w; w.x = cvt_pk_bf16(v0[0], v0[1]); w.y = cvt_pk_bf16(v0[2], v0[3]); w.z = cvt_pk_bf16(v1[0], v1[1]); w.w = cvt_pk_bf16(v1[2], v1[3]); *(GAS u32x4*)(xb + o) = w; }
                ss += shfl_x(ss, 16 * fq + fr, 16); ss += shfl_x(ss, 16 * fq + fr, 32);
                if (fq == 0) ((GAS float*)stats)[(size_t)row * 16 + u.pn * 4 + wc] = ss;
            }
        asm volatile("" ::: "memory"); }
    }
};
struct EpiSwiglu {
    static constexpr int BMODE = 1;
    unsigned char* hid; const float* gsort;
    __device__ __forceinline__ void operator()(const f32x4 (&acc)[2][2][4][2], const Unit& u, int wr, int wc, int fr, int fq, int pf0, int pf1) const {
        asm volatile("" : "+v"(fr), "+v"(fq));
        const int col0 = 512 * (u.pn >> 2) + 128 * (u.pn & 3) + 32 * wc + 8 * fq;
#pragma unroll
        for (int ai = 0; ai < 2; ++ai)
#pragma unroll
            for (int m = 0; m < 4; ++m) {
                const int r = ai * HALF + wr * 64 + m * 16 + fr;
                const float gq = __int_as_float(shfl_from(ai == 0 ? pf0 : pf1, m * 16 + fr)); const float gw = (r < u.nvalid) ? gq * H8SCALE : 0.f;
                float h[8];
#pragma unroll
                for (int n = 0; n < 2; ++n)
#pragma unroll
                    for (int i = 0; i < 4; ++i) { const float g = acc[ai][0][m][n][i] * (1.0f / W8SCALE), up = acc[ai][1][m][n][i] * (1.0f / W8SCALE); const float sg = g * __builtin_amdgcn_rcpf(1.0f + __builtin_amdgcn_exp2f(-g * LOG2E)); h[4 * n + i] = __builtin_fminf(__builtin_fmaxf(sg * up * gw, -440.f), 440.f); }
                u32x2 w; w.x = pk4_fp8(h[0], h[1], h[2], h[3]); w.y = pk4_fp8(h[4], h[5], h[6], h[7]);
                { GAS u32x2* hp_ = (GAS u32x2*)(hid + (size_t)(u.rowbase + r) * 1024 + col0); asm volatile("global_store_dwordx2 %0, %1, off sc1" :: "v"(hp_), "v"(w) : "memory"); }
            }
    }
};
template <bool LAST> struct EpiScatter {
    static constexpr int BMODE = 1;
    bf16_t* xb; float* out; float* stats; const int* perm; float ascale;
    __device__ __forceinline__ void operator()(const f32x4 (&acc)[2][2][4][2], const Unit& u, int wr, int wc, int fr, int fq, int pf0, int pf1) const {
        asm volatile("" : "+v"(fr), "+v"(fq));
        const int col0 = u.pn * BM + wc * 32 + 8 * fq;
        int tokv[2][4];
#pragma unroll
        for (int ai = 0; ai < 2; ++ai)
#pragma unroll
            for (int m = 0; m < 4; ++m) { const int r = ai * HALF + wr * 64 + m * 16 + fr; const int tq = shfl_from(ai == 0 ? pf0 : pf1, m * 16 + fr); tokv[ai][m] = (r < u.nvalid) ? tq : -1; }
#pragma unroll
        for (int ai = 0; ai < 2; ++ai) {
        u32x4 bb[2][4][2];
#pragma unroll
            for (int m = 0; m < 4; ++m)
#pragma unroll
                for (int bj = 0; bj < 2; ++bj) bb[ai][m][bj] = *(const GAS u32x4*)(xb + (size_t)(tokv[ai][m] >= 0 ? tokv[ai][m] : 0) * 1024 + col0 + bj * HALF);
#pragma unroll
            for (int m = 0; m < 4; ++m) {
                const bool valid = tokv[ai][m] >= 0; const int tok = valid ? tokv[ai][m] : 0;
                const size_t off = (size_t)tok * 1024 + col0; float ss = 0.f;
#pragma unroll
                for (int bj = 0; bj < 2; ++bj) { const size_t o = off + bj * HALF; f32x4 b0, b1; unpack8(bb[ai][m][bj], b0, b1);
                    const f32x4 v0 = b0 + acc[ai][bj][m][0] * ascale, v1 = b1 + acc[ai][bj][m][1] * ascale;
                    ss += ((v0[0] * v0[0] + v0[1] * v0[1]) + (v0[2] * v0[2] + v0[3] * v0[3])) + ((v1[0] * v1[0] + v1[1] * v1[1]) + (v1[2] * v1[2] + v1[3] * v1[3]));
                    if (valid) {
                        if constexpr (LAST) { *(GAS f32x4*)(out + o) = v0; *(GAS f32x4*)(out + o + 4) = v1; }
                        else { u32x4 w; w.x = cvt_pk_bf16(v0[0], v0[1]); w.y = cvt_pk_bf16(v0[2], v0[3]); w.z = cvt_pk_bf16(v1[0], v1[1]); w.w = cvt_pk_bf16(v1[2], v1[3]); *(GAS u32x4*)(xb + o) = w;
                               u32x2 q8; q8.x = pk4_fp8(v0[0], v0[1], v0[2], v0[3]); q8.y = pk4_fp8(v1[0], v1[1], v1[2], v1[3]); *(GAS u32x2*)((unsigned char*)xb - (WS_XB - WS_XB8) + o) = q8; } } }
                if (!LAST) { ss += shfl_x(ss, 16 * fq + fr, 16); ss += shfl_x(ss, 16 * fq + fr, 32);
                    if (valid && fq == 0) ((GAS float*)stats)[(size_t)tok * 16 + u.pn * 4 + wc] = ss; }
            }
        asm volatile("" ::: "memory"); }
    }
};

template <bool LAST> struct EpiMoe {
    static constexpr int BMODE = 1;
    static constexpr int NPF = 2;
    EpiSwiglu sw; EpiScatter<LAST> sc;
    __device__ __forceinline__ void prefetch(const Unit& u, int wr, int lane, int& pf0, int& pf1) const {
        const int r0 = wr * 64 + lane;
        const GAS int* p0 = (u.type == 0) ? (const GAS int*)sw.gsort + 2 * (size_t)(u.permoff + r0) + (u.pn >> 2) : (const GAS int*)sc.perm + (u.permoff + r0);
        const GAS int* p1 = p0 + ((u.type == 0) ? 2 * HALF : HALF);
        asm volatile("global_load_dword %0, %2, off\n\tglobal_load_dword %1, %3, off" : "=&v"(pf0), "=&v"(pf1) : "v"(p0), "v"(p1) : "memory"); }
    __device__ __forceinline__ void operator()(const f32x4 (&acc)[2][2][4][2], const Unit& u, int wr, int wc, int fr, int fq, int pf0, int pf1) const {
        if (u.type == 0) sw(acc, u, wr, wc, fr, fq, pf0, pf1); else sc(acc, u, wr, wc, fr, fq, pf0, pf1); }
};

template <class Epi, class Sched, bool F8 = false>
__device__ __forceinline__ void gemm_phase(LAS unsigned char* lds, const GemmP g, const Sched& S, const Epi& E, int wave) {
    int tid = wave * 64 + lane_id(); asm volatile("" : "+v"(tid));
    const int wid = __builtin_amdgcn_readfirstlane(tid >> 6), lane = tid & 63, wr = wid >> 2, wc = wid & 3, fr = lane & 15, fq = lane >> 4;
    const int nt = g.Kbytes / 128;
    unsigned voffB[2]; int RbB[2], CbB[2];
#pragma unroll
    for (int i = 0; i < 2; ++i) { int R[2], C[2]; stage_rc(tid * 16 + i * 8192, R[i], C[i]);
        RbB[i] = (Epi::BMODE == 0) ? R[i] : (Epi::BMODE == 1) ? ((R[i] & ~31) + perm32(R[i] & 31)) : (64 * (R[i] >> 5) + perm32(R[i] & 31)); CbB[i] = 2 * C[i];
        voffB[i] = (unsigned)(RbB[i] * g.ldbB + CbB[i]); }
    const size_t kstep = (size_t)(BK * 2);
    size_t hstepB = (size_t)g.hstepB * g.ldbB; int nsplit = g.nsplit;
    const unsigned ldsw = (unsigned)wid * 1024u;
    const int aoff = lds_byte(wr * 64 + fr, fq * 8), boff = lds_byte(wc * 32 + fr, fq * 8);
    const char* const Ab = (const char*)g.A;
#define PG8_SA(b, h) (((b) * 2 + (h)) * HTB)
#define PG8_SB(b, h) ((4 + (b) * 2 + (h)) * HTB)
#define PG8_STAGE(bufoff, gbase, voff) do { _Pragma("unroll") for (int _i = 0; _i < 2; ++_i) \
        __builtin_amdgcn_global_load_lds((const unsigned*)((const char*)(gbase) + (voff)[_i]), (LAS unsigned*)(lds + (bufoff) + ldsw + _i * 8192), 16, 0, 0); } while (0)
#define PG8_LD8(p) __builtin_shufflevector(*(const LAS i32x4*)(p), *(const LAS i32x4*)((p) + 1024), 0, 1, 2, 3, 4, 5, 6, 7)
#define PG8_LDA(dst, b, h) do { if constexpr (F8) { _Pragma("unroll") for (int m = 0; m < 4; ++m) dst##8[m] = PG8_LD8(lds + PG8_SA(b, h) + aoff + m * 2048); } \
        else { _Pragma("unroll") for (int m = 0; m < 4; ++m) _Pragma("unroll") for (int k = 0; k < 2; ++k) dst[m][k] = *(const LAS bf16x8*)(lds + PG8_SA(b, h) + aoff + m * 2048 + k * 1024); } } while (0)
#define PG8_LDB(dst, b, h) do { if constexpr (F8) { _Pragma("unroll") for (int n = 0; n < 2; ++n) dst##8[n] = PG8_LD8(lds + PG8_SB(b, h) + boff + n * 2048); } \
        else { _Pragma("unroll") for (int n = 0; n < 2; ++n) _Pragma("unroll") for (int k = 0; k < 2; ++k) dst[n][k] = *(const LAS bf16x8*)(lds + PG8_SB(b, h) + boff + n * 2048 + k * 1024); } } while (0)
#define PG8_MMA(ai, bj, At, Bt) do { __builtin_amdgcn_s_setprio(1); \
        if constexpr (F8) { _Pragma("unroll") for (int m = 0; m < 4; ++m) _Pragma("unroll") for (int n = 0; n < 2; ++n) \
            acc[ai][bj][m][n] = __builtin_amdgcn_mfma_scale_f32_16x16x128_f8f6f4(Bt##8[n], At##8[m], acc[ai][bj][m][n], 0, 0, 0, 0, 0, 0); } \
        else { _Pragma("unroll") for (int m = 0; m < 4; ++m) _Pragma("unroll") for (int n = 0; n < 2; ++n) _Pragma("unroll") for (int k = 0; k < 2; ++k) \
            acc[ai][bj][m][n] = __builtin_amdgcn_mfma_f32_16x16x32_bf16(Bt[n][k], At[m][k], acc[ai][bj][m][n], 0, 0, 0); } \
        __builtin_amdgcn_s_setprio(0); } while (0)
#define PG8_WAIT_V(n) asm volatile("s_waitcnt vmcnt(" #n ")" ::: "memory")
#define PG8_WAIT_L(n) asm volatile("s_waitcnt lgkmcnt(" #n ")" ::: "memory")
#define PG8_BAR __builtin_amdgcn_s_barrier()
#define PG8_SCHED __builtin_amdgcn_sched_barrier(0)
#ifndef PROBE_K
#define PROBE_K 0
#endif
#ifndef PROBE_KSEL
#define PROBE_KSEL 0
#endif
    unsigned long long pk_acc = 0ull, pk_t0 = 0ull;
    unsigned pollv = 64u;
    int pf0 = 0, pf1 = 0, pend = -1;
    Unit cur, nxt; int ui = 0;
    if (!S.next(0, cur)) return;
    unsigned vc[2][2];
    LAS u32x4* const vnl = (LAS u32x4*)(lds + AUX_OFF + 2048) + tid;
    { int R[2], C[2]; int t_ = tid; asm volatile("" : "+v"(t_)); stage_rc(t_ * 16, R[0], C[0]); stage_rc(t_ * 16 + 8192, R[1], C[1]); S.aoff(cur, R, C, vc); }
    f32x4 acc[2][2][4][2];
#pragma unroll
    for (int a = 0; a < 2; ++a)
#pragma unroll
        for (int b = 0; b < 2; ++b)
#pragma unroll
            for (int m = 0; m < 4; ++m)
#pragma unroll
                for (int n = 0; n < 2; ++n) acc[a][b][m][n] = (f32x4){0.f, 0.f, 0.f, 0.f};
    bf16x8 At[4][2], B0[2][2], B1[2][2]; i32x8 At8[4], B08[2], B18[2];
    const char* cBl = S.blo(cur); const char* cBh = S.bhi(cur);
    if constexpr (Sched::MIX) { const int lb_ = S.ldbB(cur); voffB[0] = (unsigned)(RbB[0] * lb_ + CbB[0]); voffB[1] = (unsigned)(RbB[1] * lb_ + CbB[1]); hstepB = (size_t)S.hstepB(cur) * lb_; nsplit = S.nsplit(cur); S.a_ready(cur); }
    PG8_STAGE(PG8_SB(0, 0), cBl, voffB); PG8_STAGE(PG8_SB(0, 1), cBl + hstepB, voffB); PG8_STAGE(PG8_SA(0, 0), Ab, vc[0]); PG8_STAGE(PG8_SA(0, 1), Ab, vc[1]);
    if (wr == 1) PG8_BAR;
    PG8_WAIT_V(2); PG8_BAR;
    PG8_STAGE(PG8_SB(1, 0), cBl + kstep, voffB); PG8_STAGE(PG8_SA(1, 0), Ab + kstep, vc[0]); PG8_STAGE(PG8_SB(1, 1), cBl + hstepB + kstep, voffB);
    PG8_WAIT_V(6); PG8_BAR;
    for (;;) {
        const bool has_next = S.next(ui + 1, nxt);
        { unsigned vn[2][2];
          if (has_next) { int R[2], C[2]; int t_ = tid; asm volatile("" : "+v"(t_)); stage_rc(t_ * 16, R[0], C[0]); stage_rc(t_ * 16 + 8192, R[1], C[1]); S.aoff(nxt, R, C, vn); } else {
#pragma unroll
            for (int h = 0; h < 2; ++h)
#pragma unroll
                for (int i = 0; i < 2; ++i) vn[h][i] = vc[h][i]; }
          *vnl = (u32x4){vn[0][0], vn[0][1], vn[1][0], vn[1][1]}; }
        const char* nBl = has_next ? S.blo(nxt) : cBl; const char* nBh = has_next ? S.bhi(nxt) : cBh;
        if (PROBE_K == 1 || PROBE_K == 3) pk_t0 = __builtin_amdgcn_s_memrealtime();
#pragma unroll 1
        for (int t = 0; t < nt; t += 2) {
            const bool last = (t == nt - 2);
            const char* a1 = Ab + (size_t)(t + 1) * kstep;
            const char* a2 = last ? Ab : Ab + (size_t)(t + 2) * kstep;
            const char* b2 = last ? nBl : (((t + 2) < nsplit) ? cBl : cBh) + (size_t)(t + 2) * kstep;
            const char* a3 = a2 + kstep; const char* b3 = b2 + kstep;
            PG8_LDB(B0, 0, 0); PG8_LDB(B1, 0, 1); PG8_SCHED; PG8_LDA(At, 0, 0); PG8_STAGE(PG8_SA(1, 1), a1, vc[1]);
            PG8_WAIT_V(8); PG8_WAIT_L(0); PG8_BAR; PG8_MMA(0, 0, At, B0); PG8_MMA(0, 1, At, B1); PG8_BAR; PG8_SCHED;
            if constexpr (Sched::MIX) { if (t == nt - 4 && !last && has_next && nxt.type == 1) { const GAS unsigned* pa_ = (const GAS unsigned*)S.poll_addr(nxt);
                asm volatile("global_load_dword %0, %1, off sc1" : "=v"(pollv) : "v"(pa_) : "memory"); } }
            if (last) { if constexpr (Epi::NPF > 0) E.prefetch(cur, wr, lane, pf0, pf1);
                const u32x4 v_ = *vnl; vc[0][0] = v_[0]; vc[0][1] = v_[1]; vc[1][0] = v_[2]; vc[1][1] = v_[3];
                if constexpr (Sched::MIX) { if (has_next) { const int lb_ = S.ldbB(nxt); voffB[0] = (unsigned)(RbB[0] * lb_ + CbB[0]); voffB[1] = (unsigned)(RbB[1] * lb_ + CbB[1]); hstepB = (size_t)S.hstepB(nxt) * lb_;
                    if (nxt.type == 1) {
                        bool ok_ = false;
                        if (nt >= 8) { asm volatile("s_waitcnt vmcnt(18)" : "+v"(pollv) :: "memory"); ok_ = (unsigned)__builtin_amdgcn_readfirstlane((int)pollv) >= 64u; }
                        if (!ok_) S.a_ready(nxt); } } } }
            PG8_LDA(At, 0, 1); PG8_STAGE(PG8_SB(0, 0), b2, voffB); PG8_STAGE(PG8_SB(0, 1), b2 + hstepB, voffB); PG8_STAGE(PG8_SA(0, 0), a2, vc[0]);
            if (Epi::NPF > 0 && last) PG8_WAIT_V(10); else PG8_WAIT_V(8);
            PG8_WAIT_L(0); PG8_BAR; PG8_MMA(1, 0, At, B0); PG8_MMA(1, 1, At, B1); PG8_BAR; PG8_SCHED;
            PG8_LDB(B0, 1, 0); PG8_LDB(B1, 1, 1); PG8_SCHED; PG8_LDA(At, 1, 0); PG8_STAGE(PG8_SA(0, 1), a2, vc[1]);
            PG8_WAIT_V(8); PG8_WAIT_L(0); PG8_BAR; PG8_MMA(0, 0, At, B0); PG8_MMA(0, 1, At, B1); PG8_BAR; PG8_SCHED;
            if constexpr (Sched::MIX) { if (t == 0 && pend >= 0) { S.signal(pend, lane); pend = -1; } }
            PG8_LDA(At, 1, 1); PG8_STAGE(PG8_SB(1, 0), b3, voffB); PG8_STAGE(PG8_SB(1, 1), b3 + hstepB, voffB); PG8_STAGE(PG8_SA(1, 0), a3, vc[0]);
            PG8_WAIT_V(8); PG8_WAIT_L(0); PG8_BAR; PG8_MMA(1, 0, At, B0); PG8_MMA(1, 1, At, B1); PG8_BAR; PG8_SCHED;
        }
        if (PROBE_K == 1) pk_acc += __builtin_amdgcn_s_memrealtime() - pk_t0;
        if (PROBE_K == 2) pk_t0 = __builtin_amdgcn_s_memrealtime();
        if (wr == 0) PG8_BAR;
        if constexpr (Epi::NPF > 0) { asm volatile("s_waitcnt vmcnt(14)" : "+v"(pf0), "+v"(pf1) :: "memory"); E(acc, cur, wr, wc, fr, fq, pf0, pf1); }
        else E(acc, cur, wr, wc, fr, fq);
        if constexpr (Sched::MIX) pend = S.done_tile(cur);
        if (PROBE_K == 2) { asm volatile("s_waitcnt vmcnt(0)" ::: "memory"); pk_acc += __builtin_amdgcn_s_memrealtime() - pk_t0; }
        if (PROBE_K == 3) pk_acc += __builtin_amdgcn_s_memrealtime() - pk_t0;
        if (!has_next) break;
#pragma unroll
        for (int a = 0; a < 2; ++a)
#pragma unroll
            for (int b = 0; b < 2; ++b)
#pragma unroll
                for (int m = 0; m < 4; ++m)
#pragma unroll
                    for (int n = 0; n < 2; ++n) acc[a][b][m][n] = (f32x4){0.f, 0.f, 0.f, 0.f};
        cur = nxt; cBl = nBl; cBh = nBh; ++ui;
        if constexpr (Sched::MIX) nsplit = S.nsplit(cur);
        if (wr == 1) PG8_BAR;
    }
    PG8_WAIT_V(0);
    if constexpr (Sched::MIX) { if (pend >= 0) S.signal(pend, lane); }
    PG8_BAR;
    if (PROBE_K != 0 && g.pk && tid == 0) { LAS unsigned* pw_ = (LAS unsigned*)(lds + MISC_OFF) + 120; *pw_ += (unsigned)pk_acc; }
#undef PG8_SA
#undef PG8_SB
#undef PG8_STAGE
#undef PG8_LDA
#undef PG8_LDB
#undef PG8_MMA
#undef PG8_LD8
#undef PG8_WAIT_V
#undef PG8_WAIT_L
#undef PG8_BAR
#undef PG8_SCHED
}
}

namespace attn_body {
using bf16 = __hip_bfloat16;
constexpr int NHEAD = 16, D = 64, DMQ = NHEAD * D;
constexpr int NW = 8, QBLK = 32, QB = QBLK * NW, KVBLK = 64;
__device__ __forceinline__ int crow(int r, int hi) { return (r & 3) + 8 * (r >> 2) + 4 * hi; }
#define SBAR() __builtin_amdgcn_sched_barrier(0)
__device__ __forceinline__ void cmask(f32x16& p0, f32x16& p1, int jb, int qrel, int hi) {
  const float NEG = -INFINITY; int kb = 64 * jb + 4 * hi;
  #pragma unroll
  for (int r = 0; r < 16; ++r) { int kv = kb + (r & 3) + 8 * (r >> 2); if (kv > qrel) p0[r] = NEG; if (kv + 32 > qrel) p1[r] = NEG; }
}
constexpr int NSLOT = 3, SLOTB = 8192;
constexpr int LDS_K = 0, LDS_V = NSLOT * SLOTB, LDS_WS = 2 * NSLOT * SLOTB, LDS_OST = LDS_WS + NW * 64 * 4, ATT_LDS_BYTES = LDS_OST + NW * 4096;
constexpr int LDS_NCK = 86016;
__device__ __forceinline__ void glds16(const void* gsrc, unsigned lds_dst) { unsigned keep;
  asm volatile("s_mov_b32 %0, m0\n\ts_mov_b32 m0, %2\n\ts_nop 0\n\tglobal_load_lds_dwordx4 %1, off\n\ts_mov_b32 m0, %0" : "=&s"(keep) : "v"(gsrc), "s"(lds_dst) : "memory"); }
__device__ __forceinline__ float max3f(float a, float b, float c) { float r; asm("v_max3_f32 %0, %1, %2, %3" : "=v"(r) : "v"(a), "v"(b), "v"(c)); return r; }
__device__ __forceinline__ float max2f(float a, float b) { float r; asm("v_max_f32_e32 %0, %1, %2" : "=v"(r) : "v"(a), "v"(b)); return r; }
__device__ __forceinline__ float fadd_s(float a, float b) { float r; asm("v_add_f32_e32 %0, %1, %2" : "=v"(r) : "v"(a), "v"(b)); return r; }
__device__ __forceinline__ float fsub_s(float a, float b) { float r; asm("v_sub_f32_e32 %0, %1, %2" : "=v"(r) : "v"(a), "v"(b)); return r; }
typedef __bf16 bf16x2_t __attribute__((ext_vector_type(2)));
__device__ __forceinline__ unsigned cvtpk_s(float lo, float hi) { f32x2 v = {lo, hi}; bf16x2_t b = __builtin_convertvector(v, bf16x2_t); return __builtin_bit_cast(unsigned, b); }
#define WAIT_BAR(N) asm volatile("s_waitcnt vmcnt(" #N ") lgkmcnt(0)\n\ts_barrier" ::: "memory")
typedef LAS const char* lds_cptr;
typedef short v4i16_t __attribute__((ext_vector_type(4)));
__device__ __forceinline__ void qkt(f32x16& p0, f32x16& p1, lds_cptr Kslot, const bf16x8* qr, const f32x16& negm, int r32, int hi) {
  lds_cptr kb = Kslot + hi * 1024 + r32 * 16;
  #pragma unroll
  for (int d0 = 0; d0 < 4; ++d0) {
    const bf16x8 b0 = *(const LAS bf16x8*)(kb + d0 * 2048);
    const bf16x8 b1 = *(const LAS bf16x8*)(kb + d0 * 2048 + 512);
    if (d0 == 0) { p0 = __builtin_amdgcn_mfma_f32_32x32x16_bf16(b0, qr[0], negm, 0, 0, 0); p1 = __builtin_amdgcn_mfma_f32_32x32x16_bf16(b1, qr[0], negm, 0, 0, 0); }
    else { p0 = __builtin_amdgcn_mfma_f32_32x32x16_bf16(b0, qr[d0], p0, 0, 0, 0); p1 = __builtin_amdgcn_mfma_f32_32x32x16_bf16(b1, qr[d0], p1, 0, 0, 0); } }
}
__device__ __forceinline__ void kload8(bf16x8* kf, lds_cptr kp) {
  kf[0] = *(const LAS bf16x8*)(kp);        kf[1] = *(const LAS bf16x8*)(kp + 512);
  kf[2] = *(const LAS bf16x8*)(kp + 2048); kf[3] = *(const LAS bf16x8*)(kp + 2560);
  kf[4] = *(const LAS bf16x8*)(kp + 4096); kf[5] = *(const LAS bf16x8*)(kp + 4608);
  kf[6] = *(const LAS bf16x8*)(kp + 6144); kf[7] = *(const LAS bf16x8*)(kp + 6656);
}
__device__ __forceinline__ void kload2(bf16x8* kf, lds_cptr kp, int j) { kf[2 * j] = *(const LAS bf16x8*)(kp + j * 2048); kf[2 * j + 1] = *(const LAS bf16x8*)(kp + j * 2048 + 512); }
__device__ __forceinline__ s16x4 vtr(lds_cptr p) { return __builtin_bit_cast(s16x4, __builtin_amdgcn_ds_read_tr16_b64_v4i16((LAS v4i16_t*)p)); }
__device__ __forceinline__ float rowmax(const f32x16& p0, const f32x16& p1) {
  float a = max3f(p0[0], p0[1], p1[0]), b = max3f(p0[2], p0[3], p1[1]); a = max3f(a, p1[2], p1[3]);
  #pragma unroll
  for (int r = 4; r < 16; r += 4) { a = max3f(a, p0[r], p0[r + 1]); b = max3f(b, p0[r + 2], p0[r + 3]); a = max3f(a, p1[r], p1[r + 1]); b = max3f(b, p1[r + 2], p1[r + 3]); }
  const float m = max2f(a, b);
  auto rr = __builtin_amdgcn_permlane32_swap(__float_as_uint(m), __float_as_uint(m), false, false);
  return max2f(__uint_as_float(rr[0]), __uint_as_float(rr[1]));
}
__device__ __forceinline__ void pv(f32x16* o, int vb, bf16x8 pa0, bf16x8 pa1, bf16x8 pa2, bf16x8 pa3) {
  #pragma unroll
  for (int d0 = 0; d0 < 2; ++d0) { s16x4 lo[4], hi[4];
    #pragma unroll
    for (int ks = 0; ks < 4; ++ks) {
      asm volatile("ds_read_b64_tr_b16 %0,%1 offset:%c2" : "=&v"(lo[ks]) : "v"(vb), "i"(d0 * 4096 + ks * 1024) : "memory");
      asm volatile("ds_read_b64_tr_b16 %0,%1 offset:%c2" : "=&v"(hi[ks]) : "v"(vb), "i"(d0 * 4096 + ks * 1024 + 512) : "memory"); }
    asm volatile("s_waitcnt lgkmcnt(0)" ::: "memory"); SBAR();
    #define PK(k) (bf16x8){lo[k][0], lo[k][1], lo[k][2], lo[k][3], hi[k][0], hi[k][1], hi[k][2], hi[k][3]}
    o[d0] = __builtin_amdgcn_mfma_f32_32x32x16_bf16(pa0, PK(0), o[d0], 0, 0, 0);
    o[d0] = __builtin_amdgcn_mfma_f32_32x32x16_bf16(pa1, PK(1), o[d0], 0, 0, 0);
    o[d0] = __builtin_amdgcn_mfma_f32_32x32x16_bf16(pa2, PK(2), o[d0], 0, 0, 0);
    o[d0] = __builtin_amdgcn_mfma_f32_32x32x16_bf16(pa3, PK(3), o[d0], 0, 0, 0);
    #undef PK
  }
}

struct Xpf { bool primed, has_next; long Pn; const bf16* Qn; const bf16* Kn; const bf16* Vn; };
template<int THRL, bool WIN, bool XP> __device__ __forceinline__ void attn_unit_x(int qb, int T0, long P, const bf16* Q, const bf16* __restrict__ K, const bf16* __restrict__ V, bf16* O, char* shm, int wave,
                                                                        float* PML, long wtok0, int wtstride, const Xpf xp, bf16x8 (&qn)[4], int& rho) {
#ifndef PROBE_A
#define PROBE_A 0
#endif
  unsigned long long pa_t = 0ull;
#define PA_T0(k) do { if (WIN && PROBE_A == (k)) pa_t = __builtin_amdgcn_s_memrealtime(); } while (0)
#define PA_T1(k) do { if (WIN && PROBE_A == (k)) { const unsigned d_ = (unsigned)(__builtin_amdgcn_s_memrealtime() - pa_t); if (tid == 0) *(unsigned*)(shm + MISC_OFF + 4 * 121) += d_; } } while (0)
  int tid = wave * 64 + lane_id(); asm volatile("" : "+v"(tid));
  const int lane = tid & 63, r32 = lane & 31, hi = lane >> 5; const int wid = __builtin_amdgcn_readfirstlane(tid >> 6);
  PA_T0(1);
  const int q0 = qb * QB;
  const bf16* Qw = Q + (long)(q0 + wid * QBLK) * P;
  const bf16* Kh = K + (long)T0 * KVBLK * P, *Vh = V + (long)T0 * KVBLK * P;
  const unsigned lds0 = (unsigned)(uintptr_t)shm; const lds_cptr shm3 = (lds_cptr)shm;
  float* wsf = (float*)(shm + LDS_WS) + wid * 64;
  const int wbj = 383 - (q0 + wid * QBLK + r32 - T0 * KVBLK) + 4 * hi;
  const LAS float* nck0 = WIN ? (const LAS float*)((lds_cptr)shm + LDS_NCK) + (wbj & 3) * 640 + (wbj & ~3)
                              : (const LAS float*)((lds_cptr)shm + LDS_NCK) + T0 * KVBLK + 4 * hi;
  const float cq2 = WIN ? 0.f : -((const LAS float*)((lds_cptr)shm + LDS_NCK))[q0 + wid * QBLK + r32];
  const bf16* ksrc = Kh + (long)lane * P + wid * 8;
  const bf16* vsrc = Vh + (long)(16 * (wid & 3) + (lane >> 2)) * P + (wid >> 2) * 32 + (lane & 3) * 8;
  const unsigned kdst = lds0 + LDS_K + wid * 1024, vdst = lds0 + LDS_V + wid * 1024;
  #define DMA_K(t, slot) glds16(ksrc + (long)(t) * KVBLK * P, (unsigned)__builtin_amdgcn_readfirstlane(kdst + (slot)))
  #define DMA_V(t, slot) glds16(vsrc + (long)(t) * KVBLK * P, (unsigned)__builtin_amdgcn_readfirstlane(vdst + (slot)))
  const int vb0 = (int)(lds0 + LDS_V) + ((lane >> 4) & 1) * 32 + (lane & 3) * 8 + (4 * hi + ((lane & 15) >> 2)) * 64;
  bf16x8 kf[8];
  const lds_cptr kp0 = shm3 + LDS_K + hi * 1024 + r32 * 16; const lds_cptr vp0 = shm3 + LDS_V + ((lane >> 4) & 1) * 32 + (lane & 3) * 8 + (4 * hi + ((lane & 15) >> 2)) * 64;
  const int NT = (q0 + QB) / KVBLK - T0;
  #define NXS(s) (((s) == (NSLOT - 1) * SLOTB) ? 0 : (s) + SLOTB)
  const int s0 = XP ? __builtin_amdgcn_readfirstlane(rho) * SLOTB : 0, s1 = NXS(s0), s2 = NXS(s1);
  const bool primed = XP && xp.primed;
  if (!primed) { DMA_K(0, s0); DMA_V(0, s0); DMA_K(1, s1); }
  bf16x8 qr[4];
  const lds_cptr qp = shm3 + LDS_OST + wid * 4096 + lane * 16;
  if (!primed) {
  #pragma unroll
  for (int d0 = 0; d0 < 4; ++d0) qr[d0] = *reinterpret_cast<const bf16x8*>(&Qw[(long)r32 * P + d0 * 16 + hi * 8]);
  #pragma unroll
  for (int d0 = 0; d0 < 4; ++d0) *(LAS bf16x8*)(qp + d0 * 1024) = qr[d0];
  } else {
  #pragma unroll
  for (int d0 = 0; d0 < 4; ++d0) qr[d0] = qn[d0];
  }
  #define QLD(d) (*(const LAS bf16x8*)(qp + (d) * 1024))
  float nm = cq2, l_reg = 0.f; f32x16 o[2]; o[0] = f32x16{}; o[1] = f32x16{};
  const int qrel = wid * QBLK + r32;
  #define CMASK(P0, P1, t) do { if (!WIN) { int jb_ = (t) - (NT - 4); if (jb_ >= 0) cmask(P0, P1, jb_, qrel, hi); } } while (0)
  #define DECAY(P0, P1, t) do { const LAS float* nk_ = nck0 + ((t) << 6); \
    _Pragma("unroll") for (int g_ = 0; g_ < 4; ++g_) { const f32x4 a_ = *(const LAS f32x4*)(nk_ + 8 * g_); const f32x4 b_ = *(const LAS f32x4*)(nk_ + 32 + 8 * g_); \
      P0[4 * g_] += a_[0]; P0[4 * g_ + 1] += a_[1]; P0[4 * g_ + 2] += a_[2]; P0[4 * g_ + 3] += a_[3]; P1[4 * g_] += b_[0]; P1[4 * g_ + 1] += b_[1]; P1[4 * g_ + 2] += b_[2]; P1[4 * g_ + 3] += b_[3]; SBAR(); } } while (0)
  bool resc = false;
  #define START(P0, P1) do { const float rm = rowmax(P0, P1); resc = false; \
    { const float dl = max2f(rm, -1000.f); nm = fsub_s(nm, dl); \
      _Pragma("unroll") for (int r = 0; r < 16; ++r) { P0[r] = fsub_s(P0[r], dl); P1[r] = fsub_s(P1[r], dl); } } \
    _Pragma("unroll") for (int r = 0; r < 16; ++r) P0[r] = __builtin_amdgcn_exp2f(P0[r]); } while (0)
  #define RESC() do { if (resc) { asm volatile("s_waitcnt lgkmcnt(0)" ::: "memory"); \
      _Pragma("unroll") for (int d_ = 0; d_ < 2; ++d_) _Pragma("unroll") for (int r = 0; r < 16; ++r) o[d_][r] *= wsf[crow(r, hi)]; } } while (0)
  f32x16 pA0, pA1, pB0, pB1;
  int sl_prev = s0, sl_cur = s0, sl_next = s1;
  #define ROT() do { sl_prev = sl_cur; sl_cur = sl_next; sl_next = (sl_next == (NSLOT - 1) * SLOTB) ? 0 : sl_next + SLOTB; } while (0)
  if (!primed) { DMA_K(2, s2); WAIT_BAR(3); }
  PA_T1(1); PA_T0(2);
  { f32x16 negm;
    #pragma unroll
    for (int r = 0; r < 16; ++r) negm[r] = nm;
    qkt(pA0, pA1, shm3 + LDS_K + s0, qr, negm, r32, hi); }
  asm volatile("s_nop 15\n\ts_nop 7" : "+v"(pA0), "+v"(pA1)); DECAY(pA0, pA1, 0); CMASK(pA0, pA1, 0);
  asm volatile("s_nop 1" : "+v"(pA0), "+v"(pA1));
  START(pA0, pA1);
  _Pragma("unroll") for (int r = 0; r < 16; ++r) pA1[r] = __builtin_amdgcn_exp2f(pA1[r]);
  WAIT_BAR(0);
  DMA_K(3, s0); DMA_V(1, s1);
  ROT();
  kload8(kf, kp0 + sl_cur);
  WAIT_BAR(2);
  PA_T1(2); PA_T0(3);
  s16x4 vlo[8], vhi[8]; u32x4 pw0, pw1, pw2, pw3; bf16x8 qfa = QLD(0), qfb = QLD(1);
  #define PKW(P, B) cvtpk_s(P[B], P[B + 1])
  #define PAF(k) __builtin_bit_cast(bf16x8, pw##k)
  #define VFR(i) (bf16x8){vlo[i][0], vlo[i][1], vlo[i][2], vlo[i][3], vhi[i][0], vhi[i][1], vhi[i][2], vhi[i][3]}
  #define PIN(x) asm volatile("" : "+v"(x))
  #define MX3(a, b, c) __builtin_fmaxf(__builtin_fmaxf((a), (b)), (c))
  #define SPLAT(X) do { _Pragma("unroll") for (int r_ = 0; r_ < 16; ++r_) X[r_] = nm; PIN(X); } while (0)
  #define GAPA(MF, A0, A1, A2, A3, W0, W1, PW) do { MF; sacc += A0; sacc += A1; sacc += A2; sacc += A3; PIN(sacc); W0; W1; PIN(PW); SBAR(); } while (0)
  #define EX(v) __builtin_amdgcn_exp2f(v)
  #define GAPB(MF, X, B) do { MF; X[B] = EX(X[B]); X[B + 1] = EX(X[B + 1]); X[B + 2] = EX(X[B + 2]); X[B + 3] = EX(X[B + 3]); PIN(X); SBAR(); } while (0)
  #define VRD(i) do { vlo[i] = vtr(vp_ + (((i) >> 2) * 4096 + ((i) & 3) * 1024)); vhi[i] = vtr(vp_ + (((i) >> 2) * 4096 + ((i) & 3) * 1024 + 512)); } while (0)
  #define KRD(G, j) do { if (G) { kload2(kf, kp0 + sl_next, j); SBAR(); } } while (0)
  #define STEP(C0, C1, P0, P1, t, GK, GV, GL) do { SBAR(); \
    const lds_cptr vp_ = vp0 + sl_prev; \
    SPLAT(C0); VRD(0); SBAR(); float sacc = (P0[0] + P0[1]); \
    GAPA(C0 = __builtin_amdgcn_mfma_f32_32x32x16_bf16(kf[0], qfa, C0, 0, 0, 0), P0[2], P0[3], P0[4], P0[5],     pw0[0] = PKW(P0, 0), pw0[1] = PKW(P0, 2), pw0); \
    SPLAT(C1); VRD(4); SBAR(); GAPA(C1 = __builtin_amdgcn_mfma_f32_32x32x16_bf16(kf[1], qfa, C1, 0, 0, 0), P0[6], P0[7], P0[8], P0[9],     pw0[2] = PKW(P0, 4), pw0[3] = PKW(P0, 6), pw0); \
    qfa = QLD(2); VRD(1); SBAR(); GAPA(C0 = __builtin_amdgcn_mfma_f32_32x32x16_bf16(kf[2], qfb, C0, 0, 0, 0),   P0[10], P0[11], P0[12], P0[13], pw1[0] = PKW(P0, 8), pw1[1] = PKW(P0, 10), pw1); \
    VRD(5); SBAR(); GAPA(C1 = __builtin_amdgcn_mfma_f32_32x32x16_bf16(kf[3], qfb, C1, 0, 0, 0),   P0[14], P0[15], P1[0], P1[1],   pw1[2] = PKW(P0, 12), pw1[3] = PKW(P0, 14), pw1); \
    qfb = QLD(3); VRD(2); SBAR(); GAPA(C0 = __builtin_amdgcn_mfma_f32_32x32x16_bf16(kf[4], qfa, C0, 0, 0, 0),   P1[2], P1[3], P1[4], P1[5],     pw2[0] = PKW(P1, 0), pw2[1] = PKW(P1, 2), pw2); \
    VRD(6); SBAR(); GAPA(C1 = __builtin_amdgcn_mfma_f32_32x32x16_bf16(kf[5], qfa, C1, 0, 0, 0),   P1[6], P1[7], P1[8], P1[9],     pw2[2] = PKW(P1, 4), pw2[3] = PKW(P1, 6), pw2); \
    VRD(3); SBAR(); GAPA(C0 = __builtin_amdgcn_mfma_f32_32x32x16_bf16(kf[6], qfb, C0, 0, 0, 0),   P1[10], P1[11], P1[12], P1[13], pw3[0] = PKW(P1, 8), pw3[1] = PKW(P1, 10), pw3); \
    VRD(7); SBAR(); GAPA(C1 = __builtin_amdgcn_mfma_f32_32x32x16_bf16(kf[7], qfb, C1, 0, 0, 0),   P1[14], P1[15], 0.f, 0.f,       pw3[2] = PKW(P1, 12), pw3[3] = PKW(P1, 14), pw3); \
    l_reg += sacc; \
    if (GK) { DMA_K((t) + 3, sl_cur); } if (GV) { DMA_V((t) + 1, sl_next); } \
    DECAY(C0, C1, t); \
    CMASK(C0, C1, t); \
    { float a = MX3(C0[0], C0[1], C1[0]), b = MX3(C0[2], C0[3], C1[1]); a = MX3(a, C1[2], C1[3]); \
      _Pragma("unroll") for (int r = 4; r < 16; r += 4) { a = MX3(a, C0[r], C0[r + 1]); b = MX3(b, C0[r + 2], C0[r + 3]); a = MX3(a, C1[r], C1[r + 1]); b = MX3(b, C1[r + 2], C1[r + 3]); } \
      float rm = __builtin_fmaxf(a, b); { auto rr = __builtin_amdgcn_permlane32_swap(__float_as_uint(rm), __float_as_uint(rm), false, false); rm = __builtin_fmaxf(__uint_as_float(rr[0]), __uint_as_float(rr[1])); } \
      resc = false; \
      if (__builtin_expect(__any(rm > (float)THRL), 0)) { const float dl = __builtin_fmaxf(rm, 0.f); nm -= dl; \
        _Pragma("unroll") for (int r = 0; r < 16; ++r) { C0[r] -= dl; C1[r] -= dl; } \
        const float f = __builtin_amdgcn_exp2f(-dl); l_reg *= f; if (hi == 0) wsf[r32] = f; resc = true; } } \
    SBAR(); \
    GAPB(o[0] = __builtin_amdgcn_mfma_f32_32x32x16_bf16(PAF(0), VFR(0), o[0], 0, 0, 0), C0, 0); \
    GAPB(o[1] = __builtin_amdgcn_mfma_f32_32x32x16_bf16(PAF(0), VFR(4), o[1], 0, 0, 0), C0, 4); \
    KRD(GL, 0); GAPB(o[0] = __builtin_amdgcn_mfma_f32_32x32x16_bf16(PAF(1), VFR(1), o[0], 0, 0, 0), C0, 8); \
    KRD(GL, 1); GAPB(o[1] = __builtin_amdgcn_mfma_f32_32x32x16_bf16(PAF(1), VFR(5), o[1], 0, 0, 0), C0, 12); \
    KRD(GL, 2); GAPB(o[0] = __builtin_amdgcn_mfma_f32_32x32x16_bf16(PAF(2), VFR(2), o[0], 0, 0, 0), C1, 0); \
    KRD(GL, 3); GAPB(o[1] = __builtin_amdgcn_mfma_f32_32x32x16_bf16(PAF(2), VFR(6), o[1], 0, 0, 0), C1, 4); \
    GAPB(o[0] = __builtin_amdgcn_mfma_f32_32x32x16_bf16(PAF(3), VFR(3), o[0], 0, 0, 0), C1, 8); \
    qfa = QLD(0); qfb = QLD(1); SBAR(); \
    GAPB(o[1] = __builtin_amdgcn_mfma_f32_32x32x16_bf16(PAF(3), VFR(7), o[1], 0, 0, 0), C1, 12); \
    } while (0)
  int t = 1;
  #undef CMASK
  #define CMASK(P0, P1, t) do {} while (0)
  for (; t + 5 < NT; t += 2) {
    STEP(pB0, pB1, pA0, pA1, t, true, true, true);     WAIT_BAR(2); RESC(); ROT();
    STEP(pA0, pA1, pB0, pB1, t + 1, true, true, true); WAIT_BAR(2); RESC(); ROT();
  }
  #undef CMASK
  #define CMASK(P0, P1, t) do { if (!WIN) { int jb_ = (t) - (NT - 4); if (jb_ >= 0) cmask(P0, P1, jb_, qrel, hi); } } while (0)
  #define ENDW(tt) do { if ((tt) + 3 < NT) { WAIT_BAR(2); } else if ((tt) + 2 < NT) { WAIT_BAR(1); } else { WAIT_BAR(0); } } while (0)
  for (; t + 1 < NT; t += 2) {
    STEP(pB0, pB1, pA0, pA1, t, (t + 3 < NT), (t + 1 < NT), (t + 1 < NT));       ENDW(t);     RESC(); ROT();
    STEP(pA0, pA1, pB0, pB1, t + 1, (t + 4 < NT), (t + 2 < NT), (t + 2 < NT));   ENDW(t + 1); RESC(); ROT();
  }
  bool pf_next = false;
  if constexpr (XP) { pf_next = xp.has_next; if (pf_next) {
    const int n0 = sl_next, n1 = NXS(n0), n2 = NXS(n1);
    const bf16* ksn = xp.Kn + (long)lane * xp.Pn + wid * 8;
    const bf16* vsn = xp.Vn + (long)(16 * (wid & 3) + (lane >> 2)) * xp.Pn + (wid >> 2) * 32 + (lane & 3) * 8;
    glds16(ksn, (unsigned)__builtin_amdgcn_readfirstlane(kdst + n0));
    const bf16* Qwn = xp.Qn + (long)(wid * QBLK) * xp.Pn;
    #pragma unroll
    for (int d0 = 0; d0 < 4; ++d0) qn[d0] = *reinterpret_cast<const bf16x8*>(&Qwn[(long)r32 * xp.Pn + d0 * 16 + hi * 8]);
    glds16(vsn, (unsigned)__builtin_amdgcn_readfirstlane(vdst + n0));
    glds16(ksn + (long)KVBLK * xp.Pn, (unsigned)__builtin_amdgcn_readfirstlane(kdst + n1));
    glds16(ksn + (long)2 * KVBLK * xp.Pn, (unsigned)__builtin_amdgcn_readfirstlane(kdst + n2));
    rho = n0 / SLOTB; } }
  STEP(pB0, pB1, pA0, pA1, NT - 1, false, false, false); RESC();
  { float sacc = pB0[0] + pB0[1]; _Pragma("unroll") for (int r = 2; r < 16; ++r) sacc += pB0[r]; _Pragma("unroll") for (int r = 0; r < 16; ++r) sacc += pB1[r]; l_reg += sacc;
    pw0 = (u32x4){PKW(pB0, 0), PKW(pB0, 2), PKW(pB0, 4), PKW(pB0, 6)}; pw1 = (u32x4){PKW(pB0, 8), PKW(pB0, 10), PKW(pB0, 12), PKW(pB0, 14)}; pw2 = (u32x4){PKW(pB1, 0), PKW(pB1, 2), PKW(pB1, 4), PKW(pB1, 6)}; pw3 = (u32x4){PKW(pB1, 8), PKW(pB1, 10), PKW(pB1, 12), PKW(pB1, 14)};
    SBAR(); pv(o, vb0 + sl_cur, PAF(0), PAF(1), PAF(2), PAF(3)); }
  PA_T1(3); PA_T0(4);
  #undef PKW
  #undef PAF
  #undef VFR
  #undef PIN
  #undef MX3
  #undef GAPA
  #undef SPLAT
  #undef GAPB
  #undef EX
  #undef VRD
  #undef KRD
  #undef STEP
  #undef ENDW
  { auto rr = __builtin_amdgcn_permlane32_swap(__float_as_uint(l_reg), __float_as_uint(l_reg), false, false); l_reg = __uint_as_float(rr[0]) + __uint_as_float(rr[1]); }
  if (hi == 0) wsf[32 + r32] = l_reg; asm volatile("s_waitcnt lgkmcnt(0)" ::: "memory");
  float rli[16];
  #pragma unroll
  for (int r = 0; r < 16; ++r) rli[r] = WIN ? 1.0f : __builtin_amdgcn_rcpf(wsf[32 + crow(r, hi)]);
  if (WIN) { if (hi == 0) *(f32x2*)(PML + 2 * (wtok0 + (long)wtstride * (q0 + wid * QBLK + r32))) = (f32x2){-nm, l_reg}; }
  bf16* Ow = O + (long)(q0 + wid * QBLK) * P;
  { bf16* stg = (bf16*)(shm + LDS_OST) + wid * 2048;
    #pragma unroll
    for (int r = 0; r < 16; ++r) { const int orow = crow(r, hi);
      #pragma unroll
      for (int d0 = 0; d0 < 2; ++d0) stg[orow * 64 + d0 * 32 + r32] = __float2bfloat16(o[d0][r] * rli[r]); }
    asm volatile("s_waitcnt lgkmcnt(0)" ::: "memory");
    #pragma unroll
    for (int i = 0; i < 4; ++i) { const int row = i * 8 + (lane >> 3), ch = lane & 7; const u32x4 v = *(const u32x4*)(stg + row * 64 + ch * 8); *(u32x4*)(Ow + (long)row * P + ch * 8) = v; } }
  if constexpr (XP) { if (pf_next) {
    asm volatile("s_waitcnt vmcnt(5)" ::: "memory");
    #pragma unroll
    for (int d0 = 0; d0 < 4; ++d0) asm volatile("ds_write_b128 %0, %1 offset:%c2" :: "v"((unsigned)(uintptr_t)qp), "v"(qn[d0]), "i"(d0 * 1024) : "memory"); } }
  asm volatile("s_waitcnt lgkmcnt(0)\n\ts_barrier" ::: "memory");
  PA_T1(4);
  #undef DMA_K
  #undef DMA_V
  #undef NXS
  #undef CMASK
  #undef DECAY
  #undef START
  #undef RESC
  #undef ROT
  #undef QLD
}
template<int THRL, bool WIN> __device__ __forceinline__ void attn_unit(int qb, int T0, long P, const bf16* Q, const bf16* __restrict__ K, const bf16* __restrict__ V, bf16* O, char* shm, int wave,
                                                                        float* PML = nullptr, long wtok0 = 0, int wtstride = 0) {
  Xpf xp{}; bf16x8 qn[4]; int rho = 0;
  attn_unit_x<THRL, WIN, false>(qb, T0, P, Q, K, V, O, shm, wave, PML, wtok0, wtstride, xp, qn, rho);
}
#undef WAIT_BAR
}

namespace dil {
constexpr float NEGBIG = -1.0e30f;
__device__ __forceinline__ int t5_bucket(int dist) {
    if (dist < 16) return dist;
    const float v = logf((float)dist / 16.0f) / 4.852030263919617f * 16.0f;
    const int l = 16 + (int)v; return l < 31 ? l : 31;
}
__device__ __forceinline__ void build_table(LAS float* tb, const float* rel_bias, int g, int d, int j, int tid) {
    asm volatile("" : "+v"(tid));
    for (int e = tid; e < 640; e += 512) { const int n = e - 256; const float v = (n >= 0 && n <= 128) ? rel_bias[t5_bucket(n * d) * 24 + 8 * g + j] * LOG2E : NEGBIG; const int m = 639 - e;
#pragma unroll
        for (int sft = 0; sft < 4; ++sft) if (m - sft >= 0) tb[640 * sft + m - sft] = v; }
}
}

#define XB_TMO      128
#define XB_XCNT(j)  (256  + 64 * (j))
#define XB_XSUB(j)  (1280 + 64 * (j))
#define XB_XGEN(j)  (2304 + 64 * (j))
#define XB_TOP      3328
#define XB_TOPGEN   3392
#define XCD_BAR_WORDS 3456
#define XB_SPIN_CAP (1u << 18)
__device__ __forceinline__ unsigned xb_ld(unsigned* p)              { return __hip_atomic_load(p, __ATOMIC_RELAXED, __HIP_MEMORY_SCOPE_AGENT); }
__device__ __forceinline__ unsigned xb_add(unsigned* p, unsigned v) { return __hip_atomic_fetch_add(p, v, __ATOMIC_RELAXED, __HIP_MEMORY_SCOPE_AGENT); }
__device__ __forceinline__ unsigned xb_xcc_id() { return (unsigned)__builtin_amdgcn_s_getreg((3 << 11) | 20) & 0xFu; }
#define XB_SPIN(cond, bar) do { unsigned _sp = 0; while (cond) { __builtin_amdgcn_s_sleep(1); \
    if ((++_sp & 255u) == 0u) { if (xb_ld(&(bar)[XB_TMO])) break; if (_sp > XB_SPIN_CAP) { atomicAdd(&(bar)[XB_TMO], 1u); break; } } } } while (0)
struct XcdBarrier { unsigned* bar; unsigned x; volatile LAS unsigned* st; };
__device__ __forceinline__ XcdBarrier xcd_barrier_post(unsigned* bar, volatile LAS unsigned* st, bool leader) {
    XcdBarrier b; b.bar = bar; b.x = xb_xcc_id(); b.st = st;
    if (leader) (void)xb_add(&bar[XB_XCNT(b.x)], 1u);
    return b;
}
__device__ __forceinline__ void xcd_barrier_complete(unsigned* bar, unsigned x, unsigned& nloc, unsigned& nx) {
    const unsigned G = gridDim.x * gridDim.y * gridDim.z;
    unsigned sum, cnt, mine, sp = 0u;
    for (;;) {
        sum = 0u; cnt = 0u; mine = 0u;
#pragma unroll
        for (unsigned j = 0; j < 16; ++j) { const unsigned c = xb_ld(&bar[XB_XCNT(j)]); sum += c; cnt += (c > 0u) ? 1u : 0u; mine = (j == x) ? c : mine; }
        if (sum == G) break;
        __builtin_amdgcn_s_sleep(1);
        if ((++sp & 255u) == 0u) { if (xb_ld(&bar[XB_TMO])) break; if (sp > XB_SPIN_CAP) { atomicAdd(&bar[XB_TMO], 1u); break; } }
    }
    nloc = mine > 0u ? mine : 1u; nx = cnt > 0u ? cnt : 1u;
}
__device__ __forceinline__ void xcd_barrier(const XcdBarrier& b, bool leader) {
    asm volatile("s_waitcnt vmcnt(0)" ::: "memory");
    __syncthreads();
    if (leader) {
        unsigned* bar = b.bar;
        __builtin_amdgcn_s_waitcnt(0);
        unsigned nloc = b.st[0], nx = b.st[1];
        if (nloc == 0u) { xcd_barrier_complete(bar, b.x, nloc, nx); b.st[0] = nloc; b.st[1] = nx; }
        const unsigned old = xb_add(&bar[XB_XSUB(b.x)], 1u);
        const unsigned gen = old / nloc;
        if (old + 1u == (gen + 1u) * nloc) {
            __builtin_amdgcn_fence(__ATOMIC_RELEASE, "agent");
            asm volatile("s_waitcnt vmcnt(0)" ::: "memory");
            const unsigned og = xb_add(&bar[XB_TOP], 1u);
            const unsigned tg = og / nx;
            if (og + 1u == (tg + 1u) * nx) xb_add(&bar[XB_TOPGEN], 1u);
            else XB_SPIN(xb_ld(&bar[XB_TOPGEN]) == tg, bar);
            __builtin_amdgcn_fence(__ATOMIC_ACQUIRE, "agent");
            xb_add(&bar[XB_XGEN(b.x)], 1u);
            asm volatile("s_waitcnt vmcnt(0)" ::: "memory");
        } else {
            XB_SPIN(xb_ld(&bar[XB_XGEN(b.x)]) == gen, bar);
            __builtin_amdgcn_fence(__ATOMIC_ACQUIRE, "agent");
            asm volatile("s_waitcnt vmcnt(0)" ::: "memory");
        }
    }
    __syncthreads();
}

__device__ __forceinline__ const float* inptr(int k) {
    asm volatile("" : "+s"(k));
    return ((const float* const __attribute__((address_space(4)))*)__builtin_amdgcn_kernarg_segment_ptr())[k];
}
#define INP(k) inptr(k)
__device__ __forceinline__ int otid(int wave) { int t = wave * 64 + lane_id(); asm volatile("" : "+v"(t)); return t; }
__device__ __forceinline__ unsigned char* opq_ptr(unsigned char* p) { asm volatile("" : "+s"(p)); return p; }
struct Frame {
    LAS unsigned char* lds;
    volatile LAS unsigned* MISC;
    gu32* ctl;
    int wave;
    int vcu, G;
    float* out;
    unsigned char* ws;
};
__device__ __forceinline__ float wave_sum(float v, int lane) {
#pragma unroll
    for (int o = 1; o < 64; o <<= 1) v += shfl_x(v, lane, o);
    return v;
}

struct P0D { const float* W; int ldw; int K; bf16_t* WT; const float* gain; int kb, nb; int f8; };
__device__ __forceinline__ P0D p0_decode(int it, unsigned char* ws) {
    constexpr int I0 = 16 * 96, I1 = 16 * 32, I2 = 16 * 96, I3 = 16 * 48, I4 = 8 * 32, I5 = 32 * 256, I6 = 32 * 256;
    P0D d; int r = it;
    if (r < I0) { d.f8 = 1; d.W = INP(2); d.ldw = 3088; d.K = 1024; d.WT = (bf16_t*)(ws + WS_WQKVA); d.gain = INP(1); d.kb = r / 96; d.nb = r % 96; return d; } r -= I0;
    if (r < I1) { d.f8 = 0; d.W = INP(6); d.ldw = 1024; d.K = 1024; d.WT = (bf16_t*)(ws + WS_WOA); d.gain = nullptr; d.kb = r / 32; d.nb = r % 32; return d; } r -= I1;
    if (r < I2) { d.f8 = 1; d.W = INP(8); d.ldw = 3072; d.K = 1024; d.WT = (bf16_t*)(ws + WS_WKVQ); d.gain = INP(7); d.kb = r / 96; d.nb = r % 96; return d; } r -= I2;
    if (r < I3) { d.f8 = 1; d.W = INP(12); d.ldw = 1536; d.K = 1024; d.WT = (bf16_t*)(ws + WS_WKVQ + (size_t)3072 * 1024); d.gain = INP(11); d.kb = r / 48; d.nb = r % 48; return d; } r -= I3;
    if (r < I4) { d.f8 = 1; d.W = INP(14); d.ldw = 1024; d.K = 512; d.WT = (bf16_t*)(ws + WS_WOB); d.gain = nullptr; d.kb = r / 32; d.nb = r % 32; return d; } r -= I4;
    if (r < I5) { const int le = r / 256, q = r % 256;
        d.f8 = 1; d.W = INP(20) + (size_t)le * 1024 * 512; d.ldw = 512; d.K = 1024; d.WT = (bf16_t*)(ws + WS_WGU + (size_t)le * 1024 * 1024); d.gain = INP(15) + (le >> 4) * 1024; d.kb = q / 16; d.nb = q % 16; return d; } r -= I5;
    if (r < I6) { const int le = r / 256, q = r % 256;
        d.f8 = 1; d.W = INP(21) + (size_t)le * 1024 * 512; d.ldw = 512; d.K = 1024; d.WT = (bf16_t*)(ws + WS_WGU + (size_t)le * 1024 * 1024 + (size_t)512 * 1024); d.gain = INP(15) + (le >> 4) * 1024; d.kb = q / 16; d.nb = q % 16; return d; } r -= I6;
    { const int le = r / 256, q = r % 256;
        d.f8 = 1; d.W = INP(22) + (size_t)le * 512 * 1024; d.ldw = 1024; d.K = 512; d.WT = (bf16_t*)(ws + WS_WD + (size_t)le * 1024 * 512); d.gain = nullptr; d.kb = q / 32; d.nb = q % 32; return d; }
}
__device__ __forceinline__ void p0_load(const P0D& d, int lane, f32x4 (&v)[8], float (&gv)[8]) {
    const float* src = d.W + (size_t)(64 * d.kb + (lane >> 3)) * d.ldw + 32 * d.nb + 4 * (lane & 7);
#pragma unroll
    for (int i = 0; i < 8; ++i) { v[i] = *(const GAS f32x4*)(src + (size_t)(8 * i) * d.ldw); gv[i] = d.gain ? d.gain[64 * d.kb + (lane >> 3) + 8 * i] : 1.0f; }
}
__device__ __forceinline__ void p0_store(const P0D& d, int lane, const f32x4 (&v)[8], const float (&gv)[8], LAS float* scr) {
#pragma unroll
    for (int i = 0; i < 8; ++i) { LAS float* p = scr + ((lane >> 3) + 8 * i) * 33 + 4 * (lane & 7); const f32x4 x = v[i] * gv[i]; p[0] = x[0]; p[1] = x[1]; p[2] = x[2]; p[3] = x[3]; }
    LDS_WAIT(); asm volatile("" ::: "memory");
    const int c = lane & 7, k0 = 64 * d.kb, n0 = 32 * d.nb;
#pragma unroll
    for (int j = 0; j < 4; ++j) { const int n = (lane >> 3) + 8 * j; const LAS float* s = scr + (8 * c) * 33 + n;
        if (d.f8) { u32x2 o; o.x = pk4_fp8(s[0 * 33] * W8SCALE, s[1 * 33] * W8SCALE, s[2 * 33] * W8SCALE, s[3 * 33] * W8SCALE); o.y = pk4_fp8(s[4 * 33] * W8SCALE, s[5 * 33] * W8SCALE, s[6 * 33] * W8SCALE, s[7 * 33] * W8SCALE);
            *(GAS u32x2*)((unsigned char*)d.WT + (size_t)(n0 + n) * d.K + k0 + 8 * c) = o; }
        else { u32x4 o; o.x = pk2(s[0 * 33], s[1 * 33]); o.y = pk2(s[2 * 33], s[3 * 33]); o.z = pk2(s[4 * 33], s[5 * 33]); o.w = pk2(s[6 * 33], s[7 * 33]);
            *(GAS u32x4*)(d.WT + (size_t)(n0 + n) * d.K + k0 + 8 * c) = o; } }
    LDS_WAIT(); asm volatile("" ::: "memory");
}
struct P0H { const float* W; unsigned char* WT; int kb, nb; };
__device__ __forceinline__ P0H p0h_decode(int idx, unsigned char* ws) { const int le = idx >> 9, hq = idx & 511; P0H d; d.W = INP(22) + (size_t)le * 512 * 1024; d.WT = ws + WS_WD + (size_t)le * 1024 * 512; d.kb = hq >> 6; d.nb = hq & 63; return d; }
__device__ __forceinline__ void p0h_load(const P0H& d, int lane, f32x4 (&v)[4]) {
    const float* src = d.W + (size_t)(64 * d.kb + (lane >> 2)) * 1024 + 16 * d.nb + 4 * (lane & 3);
#pragma unroll
    for (int i = 0; i < 4; ++i) v[i] = *(const GAS f32x4*)(src + (size_t)(16 * i) * 1024);
}
__device__ __forceinline__ void p0h_store(const P0H& d, int lane, const f32x4 (&v)[4], LAS float* scr) {
#pragma unroll
    for (int i = 0; i < 4; ++i) { LAS float* p = scr + ((lane >> 2) + 16 * i) * 17 + 4 * (lane & 3); p[0] = v[i][0]; p[1] = v[i][1]; p[2] = v[i][2]; p[3] = v[i][3]; }
    LDS_WAIT(); asm volatile("" ::: "memory");
    const int n = lane >> 2, c = lane & 3; const LAS float* s = scr + (16 * c) * 17 + n;
    u32x4 o;
    o.x = pk4_fp8(s[0 * 17] * W8SCALE, s[1 * 17] * W8SCALE, s[2 * 17] * W8SCALE, s[3 * 17] * W8SCALE);     o.y = pk4_fp8(s[4 * 17] * W8SCALE, s[5 * 17] * W8SCALE, s[6 * 17] * W8SCALE, s[7 * 17] * W8SCALE);
    o.z = pk4_fp8(s[8 * 17] * W8SCALE, s[9 * 17] * W8SCALE, s[10 * 17] * W8SCALE, s[11 * 17] * W8SCALE); o.w = pk4_fp8(s[12 * 17] * W8SCALE, s[13 * 17] * W8SCALE, s[14 * 17] * W8SCALE, s[15 * 17] * W8SCALE);
    *(GAS u32x4*)(d.WT + (size_t)(16 * d.nb + n) * 512 + 64 * d.kb + 16 * c) = o;
    LDS_WAIT(); asm volatile("" ::: "memory");
}
__device__ __forceinline__ void p0_prologue(Frame& F) {
    const int tid_ = otid(F.wave), lane_ = tid_ & 63;
    LAS float* scr = (LAS float*)(F.lds + F.wave * 16384);
    const int gw = F.vcu * 8 + F.wave, NGW = F.G * 8;
    unsigned char* ws = F.ws;
    constexpr int NITEMS = 16 * 96 + 16 * 32 + 16 * 96 + 16 * 48 + 8 * 32 + 2 * 32 * 256;
    {
        f32x4 va[8], vb[8], vc_[8]; float ga[8], gb[8], gc[8]; P0D da, db, dc;
        int it = gw;
        if (it < NITEMS) { da = p0_decode(it, ws); p0_load(da, lane_, va, ga); }
        if (it + NGW < NITEMS) { db = p0_decode(it + NGW, ws); p0_load(db, lane_, vb, gb); }
        while (it < NITEMS) {
            if (it + 2 * NGW < NITEMS) { dc = p0_decode(it + 2 * NGW, ws); p0_load(dc, lane_, vc_, gc); }
            p0_store(da, lane_, va, ga, scr);
            if (it + NGW >= NITEMS) break;
            if (it + 3 * NGW < NITEMS) { da = p0_decode(it + 3 * NGW, ws); p0_load(da, lane_, va, ga); }
            p0_store(db, lane_, vb, gb, scr);
            if (it + 2 * NGW >= NITEMS) break;
            if (it + 4 * NGW < NITEMS) { db = p0_decode(it + 4 * NGW, ws); p0_load(db, lane_, vb, gb); }
            p0_store(dc, lane_, vc_, gc, scr);
            it += 3 * NGW;
        }
    }
    const int gt = gw * 64 + lane_, NGT = NGW * 64;
    { const float* an = INP(1); const float* awin = INP(2);
    for (int e = gt; e < 16 * 1024; e += NGT) { const int n = e >> 10, k = e & 1023; ((bf16_t*)(ws + WS_WF))[e] = (bf16_t)f2bf(an[k] * awin[(size_t)k * 3088 + 3072 + n]); } }
    const float* fn_ = INP(15); const float* wexp_ = INP(18); const float* wgrp_ = INP(16);
    for (int e = gt; e < 2 * 32 * 1024; e += NGT) { const int l = e >> 15, n = (e >> 10) & 31, k = e & 1023;
        float v = 0.f;
        if (n < 16) v = fn_[l * 1024 + k] * wexp_[((size_t)l * 1024 + k) * 16 + n];
        else if (n < 20) v = fn_[l * 1024 + k] * wgrp_[((size_t)l * 1024 + k) * 4 + (n - 16)];
        const unsigned hb = f2bf(v); const float lo = v - bf2f(hb);
        bf16_t* wr = (bf16_t*)(ws + WS_WR) + (size_t)l * 2 * 32 * 1024;
        wr[n * 1024 + k] = (bf16_t)hb; wr[32 * 1024 + n * 1024 + k] = (bf16_t)f2bf(lo); }
    if (gt < 6 * 64) { const int sgi = gt >> 6, d = gt & 63; float v = 1.0f;
        if (sgi == 0) v = INP(4)[d] * C2; else if (sgi == 1) v = INP(5)[d]; else if (sgi == 3) v = INP(9)[d]; else if (sgi == 5) v = INP(13)[d] * C2;
        ((float*)(ws + WS_GTAB))[gt] = v; }
    const float* x_ = INP(0);
    {
        f32x4 v[4], vn[4], vm[4];
        int m = gw;
        if (m < NTOK) { const GAS f32x4* xr = (const GAS f32x4*)(x_ + (size_t)m * DM) + lane_;
#pragma unroll
            for (int jj = 0; jj < 4; ++jj) v[jj] = xr[64 * jj]; }
        if (m + NGW < NTOK) { const GAS f32x4* xr = (const GAS f32x4*)(x_ + (size_t)(m + NGW) * DM) + lane_;
#pragma unroll
            for (int jj = 0; jj < 4; ++jj) vn[jj] = xr[64 * jj]; }
        while (m < NTOK) {
            if (m + 2 * NGW < NTOK) { const GAS f32x4* xr = (const GAS f32x4*)(x_ + (size_t)(m + 2 * NGW) * DM) + lane_;
#pragma unroll
                for (int jj = 0; jj < 4; ++jj) vm[jj] = xr[64 * jj]; }
            float sq = 0.f;
#pragma unroll
            for (int jj = 0; jj < 4; ++jj) sq += (v[jj].x * v[jj].x + v[jj].y * v[jj].y) + (v[jj].z * v[jj].z + v[jj].w * v[jj].w);
            const float rstd = 1.f / sqrtf(wave_sum(sq, lane_) * (1.f / DM) + EPS);
            GAS unsigned long long* o8 = (GAS unsigned long long*)((bf16_t*)(ws + WS_XB) + (size_t)m * DM) + lane_;
#pragma unroll
            for (int jj = 0; jj < 4; ++jj) o8[64 * jj] = (unsigned long long)pk2(v[jj].x, v[jj].y) | ((unsigned long long)pk2(v[jj].z, v[jj].w) << 32);
            GAS unsigned* q8 = (GAS unsigned*)(ws + WS_XB8 + (size_t)m * DM) + lane_;
#pragma unroll
            for (int jj = 0; jj < 4; ++jj) q8[64 * jj] = pk4_fp8(v[jj].x, v[jj].y, v[jj].z, v[jj].w);
            if (lane_ == 0) ((float*)(ws + WS_RSTD0))[m] = rstd;
#pragma unroll
            for (int jj = 0; jj < 4; ++jj) { v[jj] = vn[jj]; vn[jj] = vm[jj]; }
            m += NGW;
        }
    }
}

__device__ __forceinline__ void forget_phase(Frame& F) {
    const int tid_ = otid(F.wave), lane_ = tid_ & 63;
    const bf16_t* XB = (const bf16_t*)(F.ws + WS_XB); const bf16_t* WF = (const bf16_t*)(F.ws + WS_WF);
    const float* RSTD0 = (const float*)(F.ws + WS_RSTD0); const float* b_f = INP(3);
    float* LC = (float*)(F.ws + WS_LC); float* CT = (float*)(F.ws + WS_CT);
    LAS float* wt = (LAS float*)(F.lds + AUX_OFF);
    const int fr = lane_ & 15, fq = lane_ >> 4;
    for (int chunk = blockIdx.x; chunk < NTOK / 128; chunk += F.G) {
        const int row = chunk * 128 + F.wave * 16 + fr;
        const bf16_t* xa = XB + (size_t)row * DM + 8 * fq; const bf16_t* wb = WF + (size_t)fr * DM + 8 * fq;
        f32x4 acc = {0.f, 0.f, 0.f, 0.f};
#pragma unroll 8
        for (int kb = 0; kb < 32; ++kb) { const bf16x8 a = *(const bf16x8*)(xa + 32 * kb), w = *(const bf16x8*)(wb + 32 * kb); acc = __builtin_amdgcn_mfma_f32_16x16x32_bf16(w, a, acc, 0, 0, 0); }
        const float rs = RSTD0[row];
        float lf[4];
#pragma unroll
        for (int i = 0; i < 4; ++i) { const float z = acc[i] * rs + b_f[4 * fq + i]; lf[i] = fminf(z, 0.f) - log1pf(expf(-fabsf(z))); }
#pragma unroll
        for (int off = 1; off < 16; off <<= 1)
#pragma unroll
            for (int i = 0; i < 4; ++i) { const float t = shfl_from(lf[i], lane_ - off); if (fr >= off) lf[i] += t; }
        if (fr == 15) {
#pragma unroll
            for (int i = 0; i < 4; ++i) wt[F.wave * 16 + 4 * fq + i] = lf[i]; }
        __syncthreads();
#pragma unroll
        for (int i = 0; i < 4; ++i) { float p = 0.f; for (int w = 0; w < F.wave; ++w) p += wt[w * 16 + 4 * fq + i]; lf[i] += p; }
        const int b = row >> 13, s = row & (SEQ - 1);
#pragma unroll
        for (int i = 0; i < 4; ++i) LC[(size_t)(b * 16 + 4 * fq + i) * SEQ + s] = lf[i];
        if (F.wave == 7 && fr == 15) {
#pragma unroll
            for (int i = 0; i < 4; ++i) CT[(b * 16 + 4 * fq + i) * 64 + ((chunk * 128) & (SEQ - 1)) / 128] = lf[i]; }
        __syncthreads();
    }
}

__device__ __forceinline__ void attnA_phase(Frame& F, unsigned char* ldsg) {
    const int tid_ = otid(F.wave), lane_ = tid_ & 63;
    LAS float* NCK = (LAS float*)(F.lds + attn_body::LDS_NCK);
    LAS float* CPs = (LAS float*)(F.lds + AUX_OFF);
    volatile LAS int* ctl = (volatile LAS int*)(F.lds + AUX_OFF + 256);
    const float* LC = (const float*)(F.ws + WS_LC); const float* CT = (const float*)(F.ws + WS_CT);
    float mqk = 0.f;
    { const float* gq_ = INP(4); const float* gk_ = INP(5);
      for (int d = 0; d < 64; ++d) mqk = fmaxf(mqk, fabsf(gq_[d] * gk_[d])); }
    const float thr2 = (40.f + 2.f * 8.f * mqk * 1.03f) * LOG2E;
    unsigned* queue = (unsigned*)(F.ctl + CW_QUEUE);
    for (;;) {
        if (tid_ == 0) ctl[0] = (int)__hip_atomic_fetch_add(queue, 1u, RLX_AGENT);
        __syncthreads();
        const int u = ctl[0];
        if (u >= NBATCH * 16 * 32) break;
        const int qb = 31 - (u >> 6), bh = u & 63, b = bh >> 4, h = bh & 15, q0 = qb * 256, NTf = 4 * qb + 4, nkeys = q0 + 256;
        const float* lcp = LC + (size_t)bh * SEQ;
        f32x4 dva[4]; const P0H ddi = p0h_decode(8 * u + F.wave, F.ws); p0h_load(ddi, lane_, dva);
        if (F.wave == 0) { const float c = CT[bh * 64 + lane_]; float v = c;
#pragma unroll
            for (int off = 1; off < 64; off <<= 1) { const float t = shfl_from(v, lane_ - off); if (lane_ >= off) v += t; }
            const float excl = v - c; CPs[lane_] = excl;
            const float cumq = shfl_from(excl, q0 >> 7) + lcp[q0];
            const bool need = (lane_ <= (q0 >> 7)) && ((cumq - v) * LOG2E >= -thr2);
            const unsigned long long bm = __builtin_amdgcn_ballot_w64(need);
            int t0 = 2 * (int)__builtin_ctzll(bm | (1ull << 63)); t0 = t0 < NTf - 4 ? t0 : NTf - 4;
            if (lane_ == 0) ctl[1] = t0; }
        __syncthreads();
        const int T0 = ctl[1];
        const float cpq = CPs[q0 >> 7], lcq = lcp[q0];
        for (int s = 64 * T0 + tid_; s < nkeys; s += 512) NCK[s] = ((cpq - CPs[s >> 7]) + (lcq - lcp[s])) * LOG2E;
        __syncthreads();
        { const size_t ho = ((size_t)b * SEQ * 1024 + h * 64) * 2;
          attn_body::attn_unit<8, false>(qb, T0, 1024, (const attn_body::bf16*)(F.ws + WS_QA + ho), (const attn_body::bf16*)(F.ws + WS_KA + ho), (const attn_body::bf16*)(F.ws + WS_VA + ho), (attn_body::bf16*)(F.ws + WS_QA + ho), (char*)ldsg, F.wave); }
        p0h_store(ddi, lane_, dva, (LAS float*)(F.lds + F.wave * 8192));
    }
}

__device__ __forceinline__ void router_phase(Frame& F, int layer, const float* stats, float* rstd_out) {
    const int tid_ = otid(F.wave), lane_ = tid_ & 63;
    const bf16_t* XBr = (const bf16_t*)(F.ws + WS_XB); unsigned char* XN8 = (unsigned char*)(F.ws + WS_XN8); const bf16_t* WR = (const bf16_t*)(F.ws + WS_WR) + (size_t)layer * 2 * 32 * 1024;
    const float* b_group = INP(17) + layer * 4; const float* b_expert = INP(19) + layer * 16;
    float* GSORT = (float*)(F.ws + WS_GSORT); int* PERM = (int*)(F.ws + WS_PERM);
    unsigned* CNT = (unsigned*)(F.ctl + (layer == 0 ? CW_CNT0 : CW_CNT1));
    volatile LAS int* lcnt = (volatile LAS int*)(F.lds + AUX_OFF);
    const int fr = lane_ & 15, fq = lane_ >> 4;
#pragma unroll
    for (int p = 0; p < 16; ++p) { const int off = p * 8192 + tid_ * 16, n = off >> 11, pc = (off >> 4) & 127;
        __builtin_amdgcn_global_load_lds((const unsigned*)((const char*)WR + n * 2048 + ((pc ^ (n & 15)) << 4)), (LAS unsigned*)(F.lds + p * 8192 + F.wave * 1024), 16, 0, 0); }
    for (int chunk = blockIdx.x; chunk < NTOK / 128; chunk += F.G) {
        if (tid_ < 64) lcnt[tid_] = 0;
        VM_WAIT();
        __syncthreads();
        const int row = chunk * 128 + F.wave * 16 + fr;
        float ss; { const f32x4 p = *(const GAS f32x4*)(stats + (size_t)row * 16 + 4 * fq); ss = (p[0] + p[1]) + (p[2] + p[3]); ss += shfl_x(ss, 16 * fq + fr, 16); ss += shfl_x(ss, 16 * fq + fr, 32); }
        const float rs = 1.0f / sqrtf(ss * (1.0f / 1024.0f) + EPS);
        const bf16_t* hp = XBr + (size_t)row * DM + 8 * fq;
        unsigned char* x8 = XN8 + (size_t)row * DM + 8 * fq;
        const LAS unsigned char* wl = F.lds + fr * 2048;
        f32x4 a0 = {0.f, 0.f, 0.f, 0.f}, a1 = {0.f, 0.f, 0.f, 0.f};
#pragma unroll 4
        for (int kb = 0; kb < 32; ++kb) {
            const bf16x8 xh = *(const bf16x8*)(hp + 32 * kb);
            const int wc_ = ((4 * kb + fq) ^ fr) << 4;
            const bf16x8 wh0 = *(const LAS bf16x8*)(wl + wc_), wl0 = *(const LAS bf16x8*)(wl + 32 * 2048 + wc_);
            const bf16x8 wh1 = *(const LAS bf16x8*)(wl + 16 * 2048 + wc_), wl1 = *(const LAS bf16x8*)(wl + 48 * 2048 + wc_);
            a0 = __builtin_amdgcn_mfma_f32_16x16x32_bf16(wh0, xh, a0, 0, 0, 0); a0 = __builtin_amdgcn_mfma_f32_16x16x32_bf16(wl0, xh, a0, 0, 0, 0);
            a1 = __builtin_amdgcn_mfma_f32_16x16x32_bf16(wh1, xh, a1, 0, 0, 0); a1 = __builtin_amdgcn_mfma_f32_16x16x32_bf16(wl1, xh, a1, 0, 0, 0);
            u32x2 q8; q8.x = pk4_fp8(bf2f((unsigned short)xh[0]) * rs, bf2f((unsigned short)xh[1]) * rs, bf2f((unsigned short)xh[2]) * rs, bf2f((unsigned short)xh[3]) * rs);
            q8.y = pk4_fp8(bf2f((unsigned short)xh[4]) * rs, bf2f((unsigned short)xh[5]) * rs, bf2f((unsigned short)xh[6]) * rs, bf2f((unsigned short)xh[7]) * rs);
            *(u32x2*)(x8 + 32 * kb) = q8;
        }
        if (fq == 0) ((GAS float*)rstd_out)[row] = rs;
        float gl[4]; int gidx = 0; float gval = 0.f;
        {
#pragma unroll
            for (int i = 0; i < 4; ++i) gl[i] = a1[i] * rs + b_group[i];
            const float mx = fmaxf(fmaxf(gl[0], gl[1]), fmaxf(gl[2], gl[3]));
            float ex[4], sum = 0.f;
#pragma unroll
            for (int i = 0; i < 4; ++i) { ex[i] = expf(gl[i] - mx); sum += ex[i]; }
            float best = -1.f;
#pragma unroll
            for (int i = 0; i < 4; ++i) { const float p = ex[i] / sum; if (p > best) { best = p; gidx = i; } }
            gval = best;
        }
        gidx = shfl_from(gidx, fr); gval = shfl_from(gval, fr);
        int cls = -1, rank = 0; float gwlo = 0.f, gwhi = 0.f;
        if (fq == gidx) {
            float el[4];
#pragma unroll
            for (int i = 0; i < 4; ++i) el[i] = a0[i] * rs + b_expert[4 * fq + i];
            const float mx = fmaxf(fmaxf(el[0], el[1]), fmaxf(el[2], el[3]));
            float pr[4], sum = 0.f;
#pragma unroll
            for (int i = 0; i < 4; ++i) { pr[i] = expf(el[i] - mx); sum += pr[i]; }
#pragma unroll
            for (int i = 0; i < 4; ++i) pr[i] = pr[i] / sum;
            int i1 = 0; float p1 = -1.f;
#pragma unroll
            for (int i = 0; i < 4; ++i) if (pr[i] > p1) { p1 = pr[i]; i1 = i; }
            int i2 = 0; float p2 = -1.f;
#pragma unroll
            for (int i = 0; i < 4; ++i) if (i != i1 && pr[i] > p2) { p2 = pr[i]; i2 = i; }
            const float den = p1 + p2; const float w1g = gval * (p1 / den), w2g = gval * (p2 / den);
            const int lo = i1 < i2 ? i1 : i2, hi = i1 < i2 ? i2 : i1;
            const float wlo = i1 < i2 ? w1g : w2g, whi = i1 < i2 ? w2g : w1g;
            const int pidx = (lo == 0) ? hi - 1 : (lo == 1) ? hi + 1 : 5;
            cls = 6 * gidx + pidx;
            gwlo = wlo; gwhi = whi;
            rank = __hip_atomic_fetch_add((LAS int*)&lcnt[cls], 1, __ATOMIC_RELAXED, __HIP_MEMORY_SCOPE_WORKGROUP);
        }
        __syncthreads();
        if (tid_ < NCLASS) lcnt[32 + tid_] = (int)__hip_atomic_fetch_add(CNT + tid_, (unsigned)lcnt[tid_], RLX_AGENT);
        __syncthreads();
        if (cls >= 0) { const size_t p_ = (size_t)cls * CAP + lcnt[32 + cls] + rank; PERM[p_] = row; *(f32x2*)(GSORT + 2 * p_) = (f32x2){gwlo, gwhi}; }
        __syncthreads();
    }
}
__device__ __forceinline__ void moe_tile_prefix(Frame& F, const int* cnt, volatile LAS int* TP) {
    const int tid_ = otid(F.wave), lane_ = tid_ & 63;
    __syncthreads();
    if (tid_ == 0) { int acc = 0; for (int c = 0; c < NCLASS; ++c) { TP[c] = acc; acc += (cnt[c] + 255) >> 8; } TP[NCLASS] = acc; }
    __syncthreads();
}

__device__ __forceinline__ void dilated_phase(Frame& F, unsigned char* ldsg) {
    const int tid_ = otid(F.wave);
    LAS float* tb = (LAS float*)(F.lds + attn_body::LDS_NCK);
    const int per = (3072 + F.G - 1) / F.G;
    int gjprev = -1, rho = 0; bool primed = false; bf16x8 qn[4];
    for (int i = 0; i < per; ++i) {
        const int u = blockIdx.x * per + i; if (u >= 3072) break;
        const int g = u >> 10, v = u & 1023, j = v >> 7, b = (v >> 5) & 3, x = v & 31;
        const int D4 = 2 * g, d = 1 << D4, r = x & (d - 1), qb = x >> D4;
        unsigned long long pl_t = 0ull; if (PROBE_A == 5) pl_t = __builtin_amdgcn_s_memrealtime();
        if (g * 8 + j != gjprev) { __syncthreads(); dil::build_table(tb, INP(10), g, d, j, tid_); __syncthreads(); gjprev = g * 8 + j; }
        if (!primed) VM_WAIT();
        __syncthreads();
        if (PROBE_A == 5) { const unsigned d_ = (unsigned)(__builtin_amdgcn_s_memrealtime() - pl_t); if (tid_ == 0) ((LAS unsigned*)(F.lds + MISC_OFF))[121] += d_; }
        const size_t ho = (((size_t)(8 * g + j) * NTOK + (size_t)b * SEQ + (size_t)r * (SEQ >> D4)) * 64) * 2;
        const int T0 = qb == 0 ? 0 : 4 * qb - 2;
        attn_body::Xpf xp{}; xp.primed = primed; xp.has_next = (i + 1 < per) && (u + 1 < 3072);
        if (xp.has_next) { const int u2 = u + 1, g2 = u2 >> 10, v2 = u2 & 1023, j2 = v2 >> 7, b2 = (v2 >> 5) & 3, x2 = v2 & 31;
            const int D42 = 2 * g2, d2 = 1 << D42, r2 = x2 & (d2 - 1), qb2 = x2 >> D42, T02 = qb2 == 0 ? 0 : 4 * qb2 - 2;
            const size_t ho2 = (((size_t)(8 * g2 + j2) * NTOK + (size_t)b2 * SEQ + (size_t)r2 * (SEQ >> D42)) * 64) * 2; xp.Pn = 64;
            xp.Qn = (const attn_body::bf16*)(F.ws + WS_QB + ho2) + (long)qb2 * 256 * xp.Pn;
            xp.Kn = (const attn_body::bf16*)(F.ws + WS_KB + ho2) + (long)T02 * 64 * xp.Pn; xp.Vn = (const attn_body::bf16*)(F.ws + WS_VB + ho2) + (long)T02 * 64 * xp.Pn; }
        attn_body::attn_unit_x<8, true, true>(qb, T0, 64, (const attn_body::bf16*)(F.ws + WS_QB + ho), (const attn_body::bf16*)(F.ws + WS_KB + ho), (const attn_body::bf16*)(F.ws + WS_VB + ho),
                                      (attn_body::bf16*)(F.ws + WS_QB + ho), (char*)ldsg, F.wave, (float*)(F.ws + WS_DPML) + (size_t)(g * 8 + j) * NTOK * 2, (long)b * SEQ + r, d, xp, qn, rho);
        primed = xp.has_next;
    }
}
__device__ __forceinline__ void dilated_merge(Frame& F) {
    const int tid_ = otid(F.wave);
    bf16_t* QB = (bf16_t*)(F.ws + WS_QB); const float* PML = (const float*)(F.ws + WS_DPML);
    for (size_t it = (size_t)blockIdx.x * 512 + tid_; it < (size_t)NTOK * 64; it += (size_t)F.G * 512) {
        const int ch = (int)(it & 7), j = (int)((it >> 3) & 7); const size_t tok = it >> 6;
        f32x2 ml[3]; u32x4 o[3];
#pragma unroll
        for (int g = 0; g < 3; ++g) { ml[g] = *(const f32x2*)(PML + ((size_t)(g * 8 + j) * NTOK + tok) * 2); o[g] = *(const u32x4*)(QB + ((size_t)(8 * g + j) * NTOK + pg8::dil_row((int)tok, 2 * g)) * 64 + 8 * ch); }
        const float M = fmaxf(fmaxf(ml[0][0], ml[1][0]), ml[2][0]);
        float f[3], L = 0.f;
#pragma unroll
        for (int g = 0; g < 3; ++g) { f[g] = __builtin_amdgcn_exp2f(ml[g][0] - M); L += f[g] * ml[g][1]; }
        const float rl = 1.0f / L;
        float r8[8];
#pragma unroll
        for (int e = 0; e < 4; ++e) { float lo = 0.f, hh = 0.f;
#pragma unroll
            for (int g = 0; g < 3; ++g) { lo += bf2f(o[g][e] & 0xffffu) * f[g]; hh += bf2f(o[g][e] >> 16) * f[g]; }
            r8[2 * e] = lo * rl; r8[2 * e + 1] = hh * rl; }
        u32x2 q8; q8.x = pk4_fp8(r8[0], r8[1], r8[2], r8[3]); q8.y = pk4_fp8(r8[4], r8[5], r8[6], r8[7]);
        *(GAS u32x2*)(F.ws + WS_XB8 + tok * 512 + 64 * j + 8 * ch) = q8;
    }
}

struct Args { const float* in[23]; float* out; unsigned char* ws; };
__global__ void __launch_bounds__(512, 2) fwd_kernel(Args args) {
    extern __shared__ __attribute__((aligned(16))) unsigned char lds[];
    Frame F;
    F.lds = (LAS unsigned char*)lds;
    F.MISC = (volatile LAS unsigned*)(F.lds + MISC_OFF);
    F.wave = __builtin_amdgcn_readfirstlane((int)threadIdx.x >> 6);
    F.G = gridDim.x; { const int bx = blockIdx.x; F.vcu = (F.G % 8 == 0) ? (bx % 8) * (F.G / 8) + bx / 8 : bx; }
    F.out = args.out; F.ws = args.ws;
    F.ctl = (gu32*)(args.ws + WS_CTL);
    for (int u = otid(F.wave); u < 128; u += 512) ((LAS unsigned*)(F.lds + MISC_OFF))[u] = 0u;
    __syncthreads();
    XcdBarrier bar = xcd_barrier_post((unsigned*)(F.ctl + CW_BAR), F.MISC + 8, F.wave == 0 && lane_id() == 0);
#define GRID_BAR() xcd_barrier(bar, F.wave == 0 && lane_id() == 0)
#ifndef RUN_FROM
#define RUN_FROM 0
#endif
#define RUN(k) ((k) <= RUN_UPTO && (k) >= RUN_FROM)
#ifndef PROBE_MASK
#define PROBE_MASK 0
#endif
    unsigned long long pr_acc = 0ull, pr_t0 = 0ull;
#define PR_BEGIN(k) do { if ((PROBE_MASK >> (k)) & 1) pr_t0 = __builtin_amdgcn_s_memrealtime(); } while (0)
#define PR_END(k) do { if ((PROBE_MASK >> (k)) & 1) pr_acc += __builtin_amdgcn_s_memrealtime() - pr_t0; } while (0)

#define ws opq_ptr(F.ws)
#define XB ((bf16_t*)(ws + WS_XB))
#define H (F.out)
#define TP ((volatile LAS int*)(F.lds + AUX_OFF + 1024))

    PR_BEGIN(0); if (RUN(0)) { p0_prologue(F); GRID_BAR(); } PR_END(0);

    PR_BEGIN(1);
    if (RUN(1)) {
        pg8::GemmP g{(const void*)(ws + WS_XB8), 1024, 1024, 1 << 20, 32, (PROBE_KSEL >> 1) & 1};
        pg8::DenseSched S; S.so.init(NTOK, 3072, F.G, (int)blockIdx.x); S.Bt = (const bf16_t*)(ws + WS_WQKVA); S.lda = 512; S.ldb = 512;
        pg8::EpiHead E{(bf16_t*)(ws + WS_QA), (size_t)(WS_KA - WS_QA) / 2, (const float*)(ws + WS_GTAB), 2, 4, 8, 1024, (const float*)(ws + WS_RSTD0), nullptr, 1.0f / W8SCALE};
        pg8::gemm_phase<pg8::EpiHead, pg8::DenseSched, true>(F.lds, g, S, E, F.wave);
        forget_phase(F);
        GRID_BAR();
    }
    PR_END(1); PR_BEGIN(2);
    if (RUN(2)) { attnA_phase(F, lds); GRID_BAR(); }
    PR_END(2); PR_BEGIN(3);
    if (RUN(3)) {
        pg8::GemmP g{(const bf16_t*)(ws + WS_QA), 2048, 2048, 1 << 20, 128, (PROBE_KSEL >> 3) & 1};
        pg8::DenseSched S; S.so.init(NTOK, 1024, F.G, (int)blockIdx.x); S.Bt = (const bf16_t*)(ws + WS_WOA); S.lda = 1024; S.ldb = 1024;
        pg8::EpiResid E{XB, (float*)(ws + WS_STATS1), 1.0f};
        pg8::gemm_phase<pg8::EpiResid, pg8::DenseSched>(F.lds, g, S, E, F.wave);
        GRID_BAR();
    }
    PR_END(3);
#define MOE_LAYER(PH, layer, STATS_IN, RSTD_BUF, CW_CNT, LASTL, STATS_OUT) \
    PR_BEGIN(PH); if (RUN(PH)) { router_phase(F, layer, (const float*)(ws + STATS_IN), (float*)(ws + RSTD_BUF)); GRID_BAR(); } PR_END(PH); PR_BEGIN(PH + 1); \
    if (RUN(PH + 1)) { \
        const int* cnt = (const int*)(F.ctl + CW_CNT); moe_tile_prefix(F, cnt, TP); \
        pg8::GemmP g{(const void*)ws, 1024, 1024, 1 << 20, 512, (PROBE_KSEL >> (PH + 1)) & 1}; \
        pg8::MoeMixSched S{TP, cnt, (const int*)(ws + WS_PERM), (const unsigned char*)(ws + WS_WGU) + (size_t)layer * 16 * 1024 * 1024, (const unsigned char*)(ws + WS_WD) + (size_t)layer * 16 * 1024 * 512, \
                           F.G, (int)blockIdx.x, __builtin_amdgcn_readfirstlane(TP[NCLASS]), (unsigned*)(F.ctl + CW_DONE + layer * 16384), (unsigned*)(F.ctl + CW_BAR) + XB_TMO}; \
        pg8::EpiMoe<LASTL> E{pg8::EpiSwiglu{(unsigned char*)(ws + WS_HID), (const float*)(ws + WS_GSORT)}, \
                             pg8::EpiScatter<LASTL>{XB, H, STATS_OUT, (const int*)(ws + WS_PERM), 1.0f / (W8SCALE * H8SCALE)}}; \
        pg8::gemm_phase<pg8::EpiMoe<LASTL>, pg8::MoeMixSched, true>(F.lds, g, S, E, F.wave); \
        if (!(LASTL)) GRID_BAR(); } PR_END(PH + 1);
    MOE_LAYER(4, 0, WS_STATS1, WS_RSTD1, CW_CNT0, false, (float*)(ws + WS_STATS2))
    PR_BEGIN(7);
    if (RUN(7)) {
        pg8::GemmP g{(const void*)(ws + WS_XB8), 1024, 1024, 1 << 20, 32, (PROBE_KSEL >> 7) & 1};
        pg8::DenseSched S; S.so.init(NTOK, 4608, F.G, (int)blockIdx.x); S.Bt = (const bf16_t*)(ws + WS_WKVQ); S.lda = 512; S.ldb = 512;
        pg8::EpiHead E{(bf16_t*)(ws + WS_KB), (size_t)(WS_VB - WS_KB) / 2, (const float*)(ws + WS_GTAB) + 3 * 64, 1, 6, 12, KVW, nullptr, (const float*)(ws + WS_STATS2), 1.0f / W8SCALE, 1};
        pg8::gemm_phase<pg8::EpiHead, pg8::DenseSched, true>(F.lds, g, S, E, F.wave);
        GRID_BAR();
    }
    PR_END(7); PR_BEGIN(8);
    if (RUN(8)) { dilated_phase(F, lds); GRID_BAR(); dilated_merge(F); GRID_BAR(); }
    PR_END(8); PR_BEGIN(9);
    if (RUN(9)) {
        pg8::GemmP g{(const void*)(ws + WS_XB8), 512, 512, 1 << 20, 128, (PROBE_KSEL >> 9) & 1};
        pg8::DenseSched S; S.so.init(NTOK, 1024, F.G, (int)blockIdx.x); S.Bt = (const bf16_t*)(ws + WS_WOB); S.lda = 256; S.ldb = 256;
        pg8::EpiResid E{XB, (float*)(ws + WS_STATS3), 1.0f / W8SCALE};
        pg8::gemm_phase<pg8::EpiResid, pg8::DenseSched, true>(F.lds, g, S, E, F.wave);
        GRID_BAR();
    }
    PR_END(9);
    MOE_LAYER(10, 1, WS_STATS3, WS_RSTD3, CW_CNT1, true, (float*)nullptr)

#if RUN_UPTO < 12
    { const int gt = (blockIdx.x * 512 + otid(F.wave)); const f32x4* xs = (const f32x4*)INP(0); f32x4* od = (f32x4*)F.out;
      for (size_t e = gt; e < (size_t)NTOK * DM / 4; e += (size_t)F.G * 512) od[e] = xs[e]; }
#endif
    if (PROBE_K != 0) pr_acc += ((LAS unsigned*)(F.lds + MISC_OFF))[120];
    if (PROBE_A != 0) pr_acc += ((LAS unsigned*)(F.lds + MISC_OFF))[121];
    if (PROBE_MASK != 0 && blockIdx.x == 0 && otid(F.wave) == 0) { const unsigned long long t1 = __builtin_amdgcn_s_memrealtime(); while (__builtin_amdgcn_s_memrealtime() - t1 < pr_acc) __builtin_amdgcn_s_sleep(8); }
    if (__hip_atomic_load((unsigned*)(F.ctl + CW_BAR) + XB_TMO, RLX_AGENT) != 0u) {
        const int gt = (blockIdx.x * 512 + otid(F.wave)); const float q = __builtin_nanf("");
        for (size_t e = gt; e < (size_t)NTOK * DM; e += (size_t)F.G * 512) F.out[e] = q;
    }
}

#undef ws
#undef XB
#undef H
#undef TP
extern "C" void kernel_launch(void* const* d_in, const int* in_sizes, int n_in, void* d_out, int out_size, void* d_ws, size_t ws_size, hipStream_t stream) {
    static int grid = 0;
    if (grid == 0) {
        if (n_in != 23 || in_sizes[0] != NTOK * DM || out_size != NTOK * DM || ws_size < WS_END) { fprintf(stderr, "kernel_launch: unexpected shapes (n_in %d, in0 %d, out %d, ws %zu)\n", n_in, n_in > 0 ? in_sizes[0] : -1, out_size, ws_size); grid = -1; return; }
        int dev = 0, cus = 0, per_cu = 0;
        if (hipGetDevice(&dev) != hipSuccess || hipDeviceGetAttribute(&cus, hipDeviceAttributeMultiprocessorCount, dev) != hipSuccess) { grid = -1; return; }
        if (hipFuncSetAttribute((const void*)fwd_kernel, hipFuncAttributeMaxDynamicSharedMemorySize, LDS_BYTES) != hipSuccess) { fprintf(stderr, "kernel_launch: hipFuncSetAttribute failed\n"); grid = -1; return; }
        if (hipOccupancyMaxActiveBlocksPerMultiprocessor(&per_cu, (const void*)fwd_kernel, 512, LDS_BYTES) != hipSuccess || per_cu < 1) fprintf(stderr, "kernel_launch: occupancy query reports %d\n", per_cu);
        (void)hipGetLastError();
        grid = cus;
    }
    if (grid < 0) return;
    if (hipMemsetAsync((char*)d_ws + WS_CTL, 0, CTL_ZERO_BYTES, stream) != hipSuccess) return;
    Args a{};
    for (int i = 0; i < 23; ++i) a.in[i] = (const float*)d_in[i];
    a.out = (float*)d_out; a.ws = (unsigned char*)d_ws;
    hipLaunchKernelGGL(fwd_kernel, dim3(grid), dim3(512), LDS_BYTES, stream, a);
}
```

```cpp
#include <hip/hip_runtime.h>
#include <hip/hip_bf16.h>
#include <cstdio>
#include <cstdint>
#include <cmath>

#ifndef RUN_UPTO
#define RUN_UPTO 99
#endif

#define GAS __attribute__((address_space(1)))
#define LAS __attribute__((address_space(3)))
typedef unsigned short bf16_t;
typedef short bf16x8 __attribute__((ext_vector_type(8)));
typedef float f32x2 __attribute__((ext_vector_type(2)));
typedef float f32x4 __attribute__((ext_vector_type(4)));
typedef float f32x16 __attribute__((ext_vector_type(16)));
typedef unsigned u32x2 __attribute__((ext_vector_type(2)));
typedef unsigned u32x4 __attribute__((ext_vector_type(4)));
typedef short s16x4 __attribute__((ext_vector_type(4)));
typedef int i32x4 __attribute__((ext_vector_type(4)));
typedef int i32x8 __attribute__((ext_vector_type(8)));
typedef GAS unsigned gu32;

constexpr int NTOK = 32768, DM = 1024, SEQ = 8192, NBATCH = 4;
constexpr int KVW = 1536;
constexpr float EPS = 1e-6f;
constexpr float LOG2E = 1.4426950408889634f;
constexpr float C2 = 0.125f * LOG2E;
constexpr int NCLASS = 24, CAP = 32768;

constexpr size_t MiB = 1u << 20;
constexpr size_t WS_CTL = 0, CTL_ZERO_BYTES = 256 * 1024;
constexpr size_t WS_RSTD0 = 2 * MiB, WS_RSTD1 = 2 * MiB + 128 * 1024, WS_RSTD3 = 2 * MiB + 256 * 1024;
constexpr size_t WS_STATS1 = 3 * MiB, WS_STATS2 = 5 * MiB, WS_STATS3 = 7 * MiB;
constexpr size_t WS_GATES = 9 * MiB;
constexpr size_t WS_LC = 10 * MiB;
constexpr size_t WS_CT = 12 * MiB;
constexpr size_t WS_WF = 12 * MiB + 64 * 1024;
constexpr size_t WS_WR = 12 * MiB + 128 * 1024;
constexpr size_t WS_GTAB = 12 * MiB + 32 * 1024;
constexpr size_t WS_PERM = 13 * MiB;
constexpr size_t WS_WQKVA = 16 * MiB, WS_WOA = 22 * MiB, WS_WKVQ = 24 * MiB, WS_WOB = 33 * MiB;
constexpr size_t WS_WGU = 34 * MiB;
constexpr size_t WS_XB8 = 66 * MiB;
constexpr size_t WS_DPML = 114 * MiB;
constexpr size_t WS_WD = 98 * MiB;
constexpr size_t WS_GSORT = 120 * MiB;
constexpr size_t WS_XB = 132 * MiB;
constexpr size_t WS_R = 196 * MiB;
constexpr size_t WS_QA = WS_R, WS_KA = WS_R + 64 * MiB, WS_VA = WS_R + 128 * MiB;
constexpr size_t WS_HID = WS_R;
constexpr size_t WS_XN8 = WS_R + 44 * MiB;
constexpr size_t WS_KB = WS_R, WS_VB = WS_R + 96 * MiB, WS_QB = WS_R + 192 * MiB;
constexpr size_t WS_END = WS_R + 288 * MiB;
constexpr int CW_BAR = 4096, CW_QUEUE = 8192, CW_CNT0 = 9216, CW_CNT1 = 9216 + 64, CW_DONE = 32768;

constexpr int RING_BYTES = 131072;
constexpr int MISC_OFF = RING_BYTES;
constexpr int AUX_OFF = RING_BYTES + 512;
constexpr int LDS_BYTES = 155648;
constexpr int AUX_BYTES = LDS_BYTES - AUX_OFF;

#define LDS_WAIT() asm volatile("s_waitcnt lgkmcnt(0)" ::: "memory")
#define VM_WAIT() asm volatile("s_waitcnt vmcnt(0)" ::: "memory")
#define RLX_AGENT __ATOMIC_RELAXED, __HIP_MEMORY_SCOPE_AGENT

__device__ __forceinline__ int lane_id() { int l; asm volatile("v_mbcnt_lo_u32_b32 %0, -1, 0\n\tv_mbcnt_hi_u32_b32 %0, -1, %0" : "=v"(l)); return l; }
__device__ __forceinline__ void st16_wt(void* p, u32x4 v) { asm volatile("global_store_dwordx4 %0, %1, off sc1\n\ts_nop 2" :: "v"((GAS void*)p), "v"(v) : "memory"); }
__device__ __forceinline__ void st8_wt(void* p, u32x2 v) { asm volatile("global_store_dwordx2 %0, %1, off sc1" :: "v"((GAS void*)p), "v"(v) : "memory"); }
__device__ __forceinline__ float shfl_from(float v, int srclane) { return __int_as_float(__builtin_amdgcn_ds_bpermute(srclane << 2, __float_as_int(v))); }
__device__ __forceinline__ int shfl_from(int v, int srclane) { return __builtin_amdgcn_ds_bpermute(srclane << 2, v); }
__device__ __forceinline__ float shfl_x(float v, int lane, int mask) { return shfl_from(v, lane ^ mask); }
__device__ __forceinline__ unsigned f2bf(float f) { unsigned u = __builtin_bit_cast(unsigned, f); return (u + 0x7fffu + ((u >> 16) & 1u)) >> 16; }
__device__ __forceinline__ float bf2f(unsigned b) { return __builtin_bit_cast(float, b << 16); }
__device__ __forceinline__ unsigned pk2(float lo, float hi) { return f2bf(lo) | (f2bf(hi) << 16); }
__device__ __forceinline__ unsigned pk4_fp8(float a, float b, float c, float d) { int v = 0; v = __builtin_amdgcn_cvt_pk_fp8_f32(a, b, v, false); v = __builtin_amdgcn_cvt_pk_fp8_f32(c, d, v, true); return (unsigned)v; }
constexpr float W8SCALE = 32.0f, H8SCALE = 16.0f;
__device__ __forceinline__ unsigned cvt_pk_bf16(float lo, float hi) { unsigned r; asm volatile("v_cvt_pk_bf16_f32 %0, %1, %2" : "=v"(r) : "v"(lo), "v"(hi)); return r; }

namespace pg8 {
constexpr int BM = 256, BK = 64, HALF = 128, HTB = HALF * BK * 2, STAGE_BYTES = 8 * HTB, NXCD = 8, WGM = 8;
__host__ __device__ __forceinline__ int lds_byte(int r, int c) { const int st = (r >> 4) * 2 + (c >> 5), rr = r & 15, cc = c & 31, ob = rr * 64 + cc * 2; return st * 1024 + (ob ^ (((ob >> 9) & 1) << 5)); }
__host__ __device__ __forceinline__ void stage_rc(int b, int& R, int& C) { const int st = b / 1024, sb = b % 1024, swz = sb ^ (((sb >> 9) & 1) << 5); R = (st >> 1) * 16 + swz / 64; C = (st & 1) * 32 + (swz % 64) / 2; }
__host__ __device__ __forceinline__ int perm32(int rho) { const int n = rho >> 4, i = rho & 15; return 8 * (i >> 2) + 4 * n + (i & 3); }

struct Unit { int rowbase; int pn; int permoff; int nvalid; int e1; int e2; int type; };
struct GemmP { const void* A; int ldbB; int Kbytes; int nsplit; int hstepB; int pk = 0; };

struct StaticOrder {
    int nM, nN, nwg, G, c;
    __device__ void init(int M, int N, int G_, int c_) { nM = M / BM; nN = N / BM; nwg = nM * nN; G = G_; c = c_; }
    __device__ bool next(int i, int& pm, int& pn) const {
        const long L = (long)i * G + c; if (L >= nwg) return false;
        int wgid = (int)L; { const int q = nwg / NXCD, r = nwg % NXCD, xcd = wgid % NXCD, off = wgid / NXCD; wgid = (xcd < r ? xcd * (q + 1) : r * (q + 1) + (xcd - r) * q) + off; }
        const int nig = WGM * nN, gid = wgid / nig, fm = gid * WGM, gsz = (nM - fm) < WGM ? (nM - fm) : WGM;
        pm = fm + ((wgid % nig) % gsz); pn = (wgid % nig) / gsz; return true;
    }
};
struct DenseSched {
    static constexpr bool MIX = false;
    StaticOrder so; const bf16_t* Bt; int lda, ldb;
    __device__ __forceinline__ bool next(int i, Unit& u) const { int pm, pn; if (!so.next(i, pm, pn)) return false; u.rowbase = pm * BM; u.pn = pn; u.permoff = 0; u.nvalid = 256; u.e1 = 0; u.e2 = 0; u.type = 0; return true; }
    __device__ __forceinline__ void aoff(const Unit& u, const int (&R)[2], const int (&C)[2], unsigned (&v)[2][2]) const {
#pragma unroll
        for (int h = 0; h < 2; ++h)
#pragma unroll
            for (int i = 0; i < 2; ++i) v[h][i] = (unsigned)((u.rowbase + 128 * h + R[i]) * lda + C[i]) * 2u; }
    __device__ __forceinline__ const char* blo(const Unit& u) const { return (const char*)Bt + (size_t)u.pn * 256 * ldb * 2; }
    __device__ __forceinline__ const char* bhi(const Unit& u) const { return blo(u); }
};
__device__ __forceinline__ bool moe_unit(int L, int npn, int TT, const volatile LAS int* TP, const int* cnt, Unit& u) {
    if (L >= TT * npn) return false;
    const int tau = L / npn; u.pn = L % npn;
    int c = 0;
#pragma unroll 1
    for (int k = 1; k < NCLASS; ++k) if (TP[k] <= tau) c = k;
    const int rt = tau - TP[c]; const int n = cnt[c] - 256 * rt;
    u.rowbase = tau * 256; u.permoff = c * CAP + rt * 256; u.nvalid = n < 256 ? n : 256;
    const int g = c / 6, p = c % 6; const int a = (p < 3) ? 0 : (p < 5) ? 1 : 2; const int b = (p < 3) ? p + 1 : (p < 5) ? p - 1 : 3;
    u.e1 = 4 * g + a; u.e2 = 4 * g + b;
    u.rowbase = __builtin_amdgcn_readfirstlane(u.rowbase); u.pn = __builtin_amdgcn_readfirstlane(u.pn); u.permoff = __builtin_amdgcn_readfirstlane(u.permoff);
    u.nvalid = __builtin_amdgcn_readfirstlane(u.nvalid); u.e1 = __builtin_amdgcn_readfirstlane(u.e1); u.e2 = __builtin_amdgcn_readfirstlane(u.e2);
    return true;
}
struct Moe1Sched {      static constexpr bool MIX = false;
    const volatile LAS int* TP; const int* cnt; const int* perm; const unsigned char* Wgu; int G, c, TT;
    __device__ __forceinline__ bool next(int i, Unit& u) const { return moe_unit(i * G + c, 8, TT, TP, cnt, u); }
    __device__ __forceinline__ void aoff(const Unit& u, const int (&R)[2], const int (&C)[2], unsigned (&v)[2][2]) const {
#pragma unroll
        for (int h = 0; h < 2; ++h)
#pragma unroll
            for (int i = 0; i < 2; ++i) { const int r = 128 * h + R[i]; const int tok = (r < u.nvalid) ? ((const GAS int*)perm)[u.permoff + r] : 0; v[h][i] = (unsigned)(tok * 1024 + 2 * C[i]); } }
    __device__ __forceinline__ const char* blo(const Unit& u) const { const int e = (u.pn < 4) ? u.e1 : u.e2; return (const char*)Wgu + ((size_t)e * 1024 + 128 * (u.pn & 3)) * 1024; }
    __device__ __forceinline__ const char* bhi(const Unit& u) const { return blo(u); }
};
struct Moe2Sched {      static constexpr bool MIX = false;
    const volatile LAS int* TP; const int* cnt; const unsigned char* Wd; int G, c, TT;
    __device__ __forceinline__ bool next(int i, Unit& u) const { return moe_unit(i * G + c, 4, TT, TP, cnt, u); }
    __device__ __forceinline__ void aoff(const Unit& u, const int (&R)[2], const int (&C)[2], unsigned (&v)[2][2]) const {
#pragma unroll
        for (int h = 0; h < 2; ++h)
#pragma unroll
            for (int i = 0; i < 2; ++i) v[h][i] = (unsigned)((u.rowbase + 128 * h + R[i]) * 1024 + 2 * C[i]); }
    __device__ __forceinline__ const char* blo(const Unit& u) const { return (const char*)Wd + ((size_t)u.e1 * 1024 + 256 * u.pn) * 512; }
    __device__ __forceinline__ const char* bhi(const Unit& u) const { return (const char*)Wd + ((size_t)u.e2 * 1024 + 256 * u.pn) * 512 - 4 * 128; }
};

struct MoeMixSched {
    static constexpr bool MIX = true;
    const volatile LAS int* TP; const int* cnt; const int* perm; const unsigned char* Wgu; const unsigned char* Wd; int G, c, TT; unsigned* done; unsigned* tmo;
    __device__ __forceinline__ bool next(int i, Unit& u) const {
        const int cc = (G == 256) ? ((c & 7) * 32 + (c >> 3)) : c;
        const int L = i * G + cc, n1 = TT * 8;
        if (L < n1) { moe_unit(L, 8, TT, TP, cnt, u); u.type = 0; return true; }
        if (!moe_unit(L - n1, 4, TT, TP, cnt, u)) return false; u.type = 1; return true; }
    __device__ __forceinline__ void aoff(const Unit& u, const int (&R)[2], const int (&C)[2], unsigned (&v)[2][2]) const {
#pragma unroll
        for (int h = 0; h < 2; ++h)
#pragma unroll
            for (int i = 0; i < 2; ++i) { const int r = 128 * h + R[i];
                if (u.type == 0) { const int tok = (r < u.nvalid) ? ((const GAS int*)perm)[u.permoff + r] : 0; v[h][i] = (unsigned)WS_XN8 + (unsigned)(tok * 1024 + 2 * C[i]); }
                else v[h][i] = (unsigned)WS_HID + (unsigned)((u.rowbase + r) * 1024 + 2 * C[i]); } }
    __device__ __forceinline__ const char* blo(const Unit& u) const {
        if (u.type == 0) { const int e = (u.pn < 4) ? u.e1 : u.e2; return (const char*)Wgu + ((size_t)e * 1024 + 128 * (u.pn & 3)) * 1024; }
        return (const char*)Wd + ((size_t)u.e1 * 1024 + 256 * u.pn) * 512; }
    __device__ __forceinline__ const char* bhi(const Unit& u) const {
        if (u.type == 0) return blo(u);
        return (const char*)Wd + ((size_t)u.e2 * 1024 + 256 * u.pn) * 512 - 4 * 128; }
    __device__ __forceinline__ int ldbB(const Unit& u) const { return u.type == 0 ? 1024 : 512; }
    __device__ __forceinline__ int hstepB(const Unit& u) const { return u.type == 0 ? 512 : 128; }
    __device__ __forceinline__ int nsplit(const Unit& u) const { return u.type == 0 ? (1 << 20) : 4; }
    __device__ __forceinline__ void a_ready(const Unit& u) const {
        if (u.type == 1) { unsigned* w = done + 64 * (u.rowbase >> 8); unsigned sp = 0;
            while (__hip_atomic_load(w, __ATOMIC_RELAXED, __HIP_MEMORY_SCOPE_AGENT) < 64u) { __builtin_amdgcn_s_sleep(2); if (++sp > (1u << 20)) { __hip_atomic_store(tmo, 1u, __ATOMIC_RELAXED, __HIP_MEMORY_SCOPE_AGENT); break; } }
              } }
    __device__ __forceinline__ const unsigned* poll_addr(const Unit& u) const { return done + 64 * (u.rowbase >> 8); }
    __device__ __forceinline__ int done_tile(const Unit& u) const { return (u.type == 0) ? (u.rowbase >> 8) : -1; }
    __device__ __forceinline__ void signal(int tile, int lane) const { if (lane == 0) __hip_atomic_fetch_add(done + 64 * tile, 1u, __ATOMIC_RELAXED, __HIP_MEMORY_SCOPE_AGENT); }
};

__device__ __forceinline__ int dil_row(int tok, int D4) { const int s = tok & (SEQ - 1); return (tok & ~(SEQ - 1)) + ((s & ((1 << D4) - 1)) << (13 - D4)) + (s >> D4); }
__device__ __forceinline__ float row_rstd16(const float* stats, int row) {
    const f32x4* p = (const f32x4*)(stats + (size_t)row * 16); const f32x4 a = p[0], b = p[1], c = p[2], d = p[3];
    const float s = ((a[0] + a[1]) + (a[2] + a[3])) + ((b[0] + b[1]) + (b[2] + b[3])) + ((c[0] + c[1]) + (c[2] + c[3])) + ((d[0] + d[1]) + (d[2] + d[3]));
    return 1.0f / sqrtf(s * (1.0f / 1024.0f) + EPS);
}
struct EpiHead {
    static constexpr int BMODE = 2; static constexpr int NPF = 0;
    bf16_t* dbase; size_t dstride; const float* gtab; int plain_seg; int e0, e1;
    int ldc; const float* rstd; const float* stats; float ascale;
    int dil = 0;
    __device__ __forceinline__ void operator()(const f32x4 (&acc)[2][2][4][2], const Unit& u, int wr, int wc, int fr, int fq) const {
        asm volatile("" : "+v"(fr), "+v"(fq));
        const int pn = u.pn; const int seg = (pn < e0) ? 0 : (pn < e1) ? 1 : 2;
        bf16_t* dst = dbase + (size_t)seg * dstride; const float* gain = gtab + 64 * seg; const bool norm = (seg != plain_seg);
        const int pnl = pn - (seg == 0 ? 0 : seg == 1 ? e0 : e1);
        const int col0 = 64 * (4 * pnl + wc) + 8 * fq;
        f32x4 gv[2][2];
#pragma unroll
        for (int bj = 0; bj < 2; ++bj)
#pragma unroll
            for (int n = 0; n < 2; ++n) gv[bj][n] = *(const GAS f32x4*)(gain + 32 * bj + 8 * fq + 4 * n);
        float rsv[2][4];
        if (rstd) {
#pragma unroll
            for (int ai = 0; ai < 2; ++ai)
#pragma unroll
                for (int m = 0; m < 4; ++m) rsv[ai][m] = ((const GAS float*)rstd)[u.rowbase + ai * HALF + wr * 64 + m * 16 + fr] * ascale;
        } else {
            f32x4 pq[2][4];
#pragma unroll
            for (int ai = 0; ai < 2; ++ai)
#pragma unroll
                for (int m = 0; m < 4; ++m) pq[ai][m] = *(const GAS f32x4*)(stats + (size_t)(u.rowbase + ai * HALF + wr * 64 + m * 16 + fr) * 16 + 4 * fq);
#pragma unroll
            for (int ai = 0; ai < 2; ++ai)
#pragma unroll
                for (int m = 0; m < 4; ++m) { float sq = (pq[ai][m][0] + pq[ai][m][1]) + (pq[ai][m][2] + pq[ai][m][3]); sq += shfl_x(sq, 16 * fq + fr, 16); sq += shfl_x(sq, 16 * fq + fr, 32);
                    rsv[ai][m] = ascale * __builtin_amdgcn_rsqf(sq * (1.0f / 1024.0f) + EPS); }
        }
#pragma unroll
        for (int ai = 0; ai < 2; ++ai)
#pragma unroll
            for (int m = 0; m < 4; ++m) {
                const int row = u.rowbase + ai * HALF + wr * 64 + m * 16 + fr;
                const float rs = rsv[ai][m];
                float hr = rs;
                if (norm) {
                    float ss = 0.f;
#pragma unroll
                    for (int bj = 0; bj < 2; ++bj)
#pragma unroll
                        for (int n = 0; n < 2; ++n) { const f32x4 x = acc[ai][bj][m][n]; ss += (x[0] * x[0] + x[1] * x[1]) + (x[2] * x[2] + x[3] * x[3]); }
                    ss += shfl_x(ss, 16 * fq + fr, 16); ss += shfl_x(ss, 16 * fq + fr, 32);
                    hr = rs * __builtin_amdgcn_rsqf(ss * rs * rs * (1.0f / 64.0f) + EPS);
                }
                bf16_t* rowp = dil ? dst + ((size_t)(4 * pnl + wc) * NTOK + dil_row(row, 2 * ((4 * pnl + wc) >> 3))) * 64 + 8 * fq : dst + (size_t)row * ldc + col0;
#pragma unroll
                for (int bj = 0; bj < 2; ++bj) {
                    const f32x4 v0 = acc[ai][bj][m][0] * hr * gv[bj][0], v1 = acc[ai][bj][m][1] * hr * gv[bj][1];
                    u32x4 w; w.x = cvt_pk_bf16(v0[0], v0[1]); w.y = cvt_pk_bf16(v0[2], v0[3]); w.z = cvt_pk_bf16(v1[0], v1[1]); w.w = cvt_pk_bf16(v1[2], v1[3]);
                    st16_wt(rowp + 32 * bj, w); }
                if (m & 1) asm volatile("" ::: "memory");
            }
    }
};
__device__ __forceinline__ void unpack8(const u32x4 b, f32x4& lo, f32x4& hi) {
    lo = (f32x4){bf2f(b.x & 0xffffu), bf2f(b.x >> 16), bf2f(b.y & 0xffffu), bf2f(b.y >> 16)}; hi = (f32x4){bf2f(b.z & 0xffffu), bf2f(b.z >> 16), bf2f(b.w & 0xffffu), bf2f(b.w >> 16)}; }
struct EpiResid {
    static constexpr int BMODE = 1; static constexpr int NPF = 0;
    bf16_t* xb; float* stats; float ascale;
    __device__ __forceinline__ void operator()(const f32x4 (&acc)[2][2][4][2], const Unit& u, int wr, int wc, int fr, int fq) const {
        asm volatile("" : "+v"(fr), "+v"(fq));
        const int col0 = u.pn * BM + wc * 32 + 8 * fq;
#pragma unroll
        for (int ai = 0; ai < 2; ++ai) {
        u32x4 bb[2][4][2];
#pragma unroll
            for (int m = 0; m < 4; ++m)
#pragma unroll
                for (int bj = 0; bj < 2; ++bj) bb[ai][m][bj] = *(const GAS u32x4*)(xb + (size_t)(u.rowbase + ai * HALF + wr * 64 + m * 16 + fr) * 1024 + col0 + bj * HALF);
#pragma unroll
            for (int m = 0; m < 4; ++m) {
                const int row = u.rowbase + ai * HALF + wr * 64 + m * 16 + fr; const size_t off = (size_t)row * 1024 + col0; float ss = 0.f;
#pragma unroll
                for (int bj = 0; bj < 2; ++bj) { const size_t o = off + bj * HALF; f32x4 b0, b1; unpack8(bb[ai][m][bj], b0, b1);
                    const f32x4 v0 = b0 + acc[ai][bj][m][0] * ascale, v1 = b1 + acc[ai][bj][m][1] * ascale;
                    ss += ((v0[0] * v0[0] + v0[1] * v0[1]) + (v0[2] * v0[2] + v0[3] * v0[3])) + ((v1[0] * v1[0] + v1[1] * v1[1]) + (v1[2] * v1[2] + v1[3] * v1[3]));
                    u32x4 w; w.x = cvt_pk_bf16(v0[0], v0[1]); w.y = cvt_pk_bf16(v0[2], v0[3]); w.z = cvt_pk_bf16(v1[0], v1[1]); w.w = cvt_pk_bf16(v1[2], v1[3]); *(GAS u32x4*)(xb + o) = w; }
                ss += shfl_x(ss, 16 * fq + fr, 16); ss += shfl_x(ss, 16 * fq + fr, 32);
                if (fq == 0) ((GAS float*)stats)[(size_t)row * 16 + u.pn * 4 + wc] = ss;
            }
        asm volatile("" ::: "memory"); }
    }
};
struct EpiSwiglu {
    static constexpr int BMODE = 1;
    unsigned char* hid; const float* gsort;
    __device__ __forceinline__ void operator()(const f32x4 (&acc)[2][2][4][2], const Unit& u, int wr, int wc, int fr, int fq, int pf0, int pf1) const {
        asm volatile("" : "+v"(fr), "+v"(fq));
        const int col0 = 512 * (u.pn >> 2) + 128 * (u.pn & 3) + 32 * wc + 8 * fq;
#pragma unroll
        for (int ai = 0; ai < 2; ++ai)
#pragma unroll
            for (int m = 0; m < 4; ++m) {
                const int r = ai * HALF + wr * 64 + m * 16 + fr;
                const float gq = __int_as_float(shfl_from(ai == 0 ? pf0 : pf1, m * 16 + fr)); const float gw = (r < u.nvalid) ? gq * H8SCALE : 0.f;
                float h[8];
#pragma unroll
                for (int n = 0; n < 2; ++n)
#pragma unroll
                    for (int i = 0; i < 4; ++i) { const float g = acc[ai][0][m][n][i] * (1.0f / W8SCALE), up = acc[ai][1][m][n][i] * (1.0f / W8SCALE); const float sg = g * __builtin_amdgcn_rcpf(1.0f + __builtin_amdgcn_exp2f(-g * LOG2E)); h[4 * n + i] = __builtin_fminf(__builtin_fmaxf(sg * up * gw, -440.f), 440.f); }
                u32x2 w; w.x = pk4_fp8(h[0], h[1], h[2], h[3]); w.y = pk4_fp8(h[4], h[5], h[6], h[7]);
                { GAS u32x2* hp_ = (GAS u32x2*)(hid + (size_t)(u.rowbase + r) * 1024 + col0); asm volatile("global_store_dwordx2 %0, %1, off sc1" :: "v"(hp_), "v"(w) : "memory"); }
            }
    }
};
template <bool LAST> struct EpiScatter {
    static constexpr int BMODE = 1;
    bf16_t* xb; float* out; float* stats; const int* perm; float ascale;
    __device__ __forceinline__ void operator()(const f32x4 (&acc)[2][2][4][2], const Unit& u, int wr, int wc, int fr, int fq, int pf0, int pf1) const {
        asm volatile("" : "+v"(fr), "+v"(fq));
        const int col0 = u.pn * BM + wc * 32 + 8 * fq;
        int tokv[2][4];
#pragma unroll
        for (int ai = 0; ai < 2; ++ai)
#pragma unroll
            for (int m = 0; m < 4; ++m) { const int r = ai * HALF + wr * 64 + m * 16 + fr; const int tq = shfl_from(ai == 0 ? pf0 : pf1, m * 16 + fr); tokv[ai][m] = (r < u.nvalid) ? tq : -1; }
#pragma unroll
        for (int ai = 0; ai < 2; ++ai) {
        u32x4 bb[2][4][2];
#pragma unroll
            for (int m = 0; m < 4; ++m)
#pragma unroll
                for (int bj = 0; bj < 2; ++bj) bb[ai][m][bj] = *(const GAS u32x4*)(xb + (size_t)(tokv[ai][m] >= 0 ? tokv[ai][m] : 0) * 1024 + col0 + bj * HALF);
#pragma unroll
            for (int m = 0; m < 4; ++m) {
                const bool valid = tokv[ai][m] >= 0; const int tok = valid ? tokv[ai][m] : 0;
                const size_t off = (size_t)tok * 1024 + col0; float ss = 0.f;
#pragma unroll
                for (int bj = 0; bj < 2; ++bj) { const size_t o = off + bj * HALF; f32x4 b0, b1; unpack8(bb[ai][m][bj], b0, b1);
                    const f32x4 v0 = b0 + acc[ai][bj][m][0] * ascale, v1 = b1 + acc[ai][bj][m][1] * ascale;
                    ss += ((v0[0] * v0[0] + v0[1] * v0[1]) + (v0[2] * v0[2] + v0[3] * v0[3])) + ((v1[0] * v1[0] + v1[1] * v1[1]) + (v1[2] * v1[2] + v1[3] * v1[3]));
                    if (valid) {
                        if constexpr (LAST) { *(GAS f32x4*)(out + o) = v0; *(GAS f32x4*)(out + o + 4) = v1; }
                        else { u32x4 w; w.x = cvt_pk_bf16(v0[0], v0[1]); w.y = cvt_pk_bf16(v0[2], v0[3]); w.z = cvt_pk_bf16(v1[0], v1[1]); w.w = cvt_pk_bf16(v1[2], v1[3]); *(GAS u32x4*)(xb + o) = w;
                               u32x2 q8; q8.x = pk4_fp8(v0[0], v0[1], v0[2], v0[3]); q8.y = pk4_fp8(v1[0], v1[1], v1[2], v1[3]); *(GAS u32x2*)((unsigned char*)xb - (WS_XB - WS_XB8) + o) = q8; } } }
                if (!LAST) { ss += shfl_x(ss, 16 * fq + fr, 16); ss += shfl_x(ss, 16 * fq + fr, 32);
                    if (valid && fq == 0) ((GAS float*)stats)[(size_t)tok * 16 + u.pn * 4 + wc] = ss; }
            }
        asm volatile("" ::: "memory"); }
    }
};

template <bool LAST> struct EpiMoe {
    static constexpr int BMODE = 1;
    static constexpr int NPF = 2;
    EpiSwiglu sw; EpiScatter<LAST> sc;
    __device__ __forceinline__ void prefetch(const Unit& u, int wr, int lane, int& pf0, int& pf1) const {
        const int r0 = wr * 64 + lane;
        const GAS int* p0 = (u.type == 0) ? (const GAS int*)sw.gsort + 2 * (size_t)(u.permoff + r0) + (u.pn >> 2) : (const GAS int*)sc.perm + (u.permoff + r0);
        const GAS int* p1 = p0 + ((u.type == 0) ? 2 * HALF : HALF);
        asm volatile("global_load_dword %0, %2, off\n\tglobal_load_dword %1, %3, off" : "=&v"(pf0), "=&v"(pf1) : "v"(p0), "v"(p1) : "memory"); }
    __device__ __forceinline__ void operator()(const f32x4 (&acc)[2][2][4][2], const Unit& u, int wr, int wc, int fr, int fq, int pf0, int pf1) const {
        if (u.type == 0) sw(acc, u, wr, wc, fr, fq, pf0, pf1); else sc(acc, u, wr, wc, fr, fq, pf0, pf1); }
};

template <class Epi, class Sched, bool F8 = false>
__device__ __forceinline__ void gemm_phase(LAS unsigned char* lds, const GemmP g, const Sched& S, const Epi& E, int wave) {
    int tid = wave * 64 + lane_id(); asm volatile("" : "+v"(tid));
    const int wid = __builtin_amdgcn_readfirstlane(tid >> 6), lane = tid & 63, wr = wid >> 2, wc = wid & 3, fr = lane & 15, fq = lane >> 4;
    const int nt = g.Kbytes / 128;
    unsigned voffB[2]; int RbB[2], CbB[2];
#pragma unroll
    for (int i = 0; i < 2; ++i) { int R[2], C[2]; stage_rc(tid * 16 + i * 8192, R[i], C[i]);
        RbB[i] = (Epi::BMODE == 0) ? R[i] : (Epi::BMODE == 1) ? ((R[i] & ~31) + perm32(R[i] & 31)) : (64 * (R[i] >> 5) + perm32(R[i] & 31)); CbB[i] = 2 * C[i];
        voffB[i] = (unsigned)(RbB[i] * g.ldbB + CbB[i]); }
    const size_t kstep = (size_t)(BK * 2);
    size_t hstepB = (size_t)g.hstepB * g.ldbB; int nsplit = g.nsplit;
    const unsigned ldsw = (unsigned)wid * 1024u;
    const int aoff = lds_byte(wr * 64 + fr, fq * 8), boff = lds_byte(wc * 32 + fr, fq * 8);
    const char* const Ab = (const char*)g.A;
#define PG8_SA(b, h) (((b) * 2 + (h)) * HTB)
#define PG8_SB(b, h) ((4 + (b) * 2 + (h)) * HTB)
#define PG8_STAGE(bufoff, gbase, voff) do { _Pragma("unroll") for (int _i = 0; _i < 2; ++_i) \
        __builtin_amdgcn_global_load_lds((const unsigned*)((const char*)(gbase) + (voff)[_i]), (LAS unsigned*)(lds + (bufoff) + ldsw + _i * 8192), 16, 0, 0); } while (0)
#define PG8_LD8(p) __builtin_shufflevector(*(const LAS i32x4*)(p), *(const LAS i32x4*)((p) + 1024), 0, 1, 2, 3, 4, 5, 6, 7)
#define PG8_LDA(dst, b, h) do { if constexpr (F8) { _Pragma("unroll") for (int m = 0; m < 4; ++m) dst##8[m] = PG8_LD8(lds + PG8_SA(b, h) + aoff + m * 2048); } \
        else { _Pragma("unroll") for (int m = 0; m < 4; ++m) _Pragma("unroll") for (int k = 0; k < 2; ++k) dst[m][k] = *(const LAS bf16x8*)(lds + PG8_SA(b, h) + aoff + m * 2048 + k * 1024); } } while (0)
#define PG8_LDB(dst, b, h) do { if constexpr (F8) { _Pragma("unroll") for (int n = 0; n < 2; ++n) dst##8[n] = PG8_LD8(lds + PG8_SB(b, h) + boff + n * 2048); } \
        else { _Pragma("unroll") for (int n = 0; n < 2; ++n) _Pragma("unroll") for (int k = 0; k < 2; ++k) dst[n][k] = *(const LAS bf16x8*)(lds + PG8_SB(b, h) + boff + n * 2048 + k * 1024); } } while (0)
#define PG8_MMA(ai, bj, At, Bt) do { __builtin_amdgcn_s_setprio(1); \
        if constexpr (F8) { _Pragma("unroll") for (int m = 0; m < 4; ++m) _Pragma("unroll") for (int n = 0; n < 2; ++n) \
            acc[ai][bj][m][n] = __builtin_amdgcn_mfma_scale_f32_16x16x128_f8f6f4(Bt##8[n], At##8[m], acc[ai][bj][m][n], 0, 0, 0, 0, 0, 0); } \
        else { _Pragma("unroll") for (int m = 0; m < 4; ++m) _Pragma("unroll") for (int n = 0; n < 2; ++n) _Pragma("unroll") for (int k = 0; k < 2; ++k) \
            acc[ai][bj][m][n] = __builtin_amdgcn_mfma_f32_16x16x32_bf16(Bt[n][k], At[m][k], acc[ai][bj][m][n], 0, 0, 0); } \
        __builtin_amdgcn_s_setprio(0); } while (0)
#define PG8_WAIT_V(n) asm volatile("s_waitcnt vmcnt(" #n ")" ::: "memory")
#define PG8_WAIT_L(n) asm volatile("s_waitcnt lgkmcnt(" #n ")" ::: "memory")
#define PG8_BAR __builtin_amdgcn_s_barrier()
#define PG8_SCHED __builtin_amdgcn_sched_barrier(0)
#ifndef PROBE_K
#define PROBE_K 0
#endif
#ifndef PROBE_KSEL
#define PROBE_KSEL 0
#endif
    unsigned long long pk_acc = 0ull, pk_t0 = 0ull;
    unsigned pollv = 64u;
    int pf0 = 0, pf1 = 0, pend = -1;
    Unit cur, nxt; int ui = 0;
    if (!S.next(0, cur)) return;
    unsigned vc[2][2];
    LAS u32x4* const vnl = (LAS u32x4*)(lds + AUX_OFF + 2048) + tid;
    { int R[2], C[2]; int t_ = tid; asm volatile("" : "+v"(t_)); stage_rc(t_ * 16, R[0], C[0]); stage_rc(t_ * 16 + 8192, R[1], C[1]); S.aoff(cur, R, C, vc); }
    f32x4 acc[2][2][4][2];
#pragma unroll
    for (int a = 0; a < 2; ++a)
#pragma unroll
        for (int b = 0; b < 2; ++b)
#pragma unroll
            for (int m = 0; m < 4; ++m)
#pragma unroll
                for (int n = 0; n < 2; ++n) acc[a][b][m][n] = (f32x4){0.f, 0.f, 0.f, 0.f};
    bf16x8 At[4][2], B0[2][2], B1[2][2]; i32x8 At8[4], B08[2], B18[2];
    const char* cBl = S.blo(cur); const char* cBh = S.bhi(cur);
    if constexpr (Sched::MIX) { const int lb_ = S.ldbB(cur); voffB[0] = (unsigned)(RbB[0] * lb_ + CbB[0]); voffB[1] = (unsigned)(RbB[1] * lb_ + CbB[1]); hstepB = (size_t)S.hstepB(cur) * lb_; nsplit = S.nsplit(cur); S.a_ready(cur); }
    PG8_STAGE(PG8_SB(0, 0), cBl, voffB); PG8_STAGE(PG8_SB(0, 1), cBl + hstepB, voffB); PG8_STAGE(PG8_SA(0, 0), Ab, vc[0]); PG8_STAGE(PG8_SA(0, 1), Ab, vc[1]);
    if (wr == 1) PG8_BAR;
    PG8_WAIT_V(2); PG8_BAR;
    PG8_STAGE(PG8_SB(1, 0), cBl + kstep, voffB); PG8_STAGE(PG8_SA(1, 0), Ab + kstep, vc[0]); PG8_STAGE(PG8_SB(1, 1), cBl + hstepB + kstep, voffB);
    PG8_WAIT_V(6); PG8_BAR;
    for (;;) {
        const bool has_next = S.next(ui + 1, nxt);
        { unsigned vn[2][2];
          if (has_next) { int R[2], C[2]; int t_ = tid; asm volatile("" : "+v"(t_)); stage_rc(t_ * 16, R[0], C[0]); stage_rc(t_ * 16 + 8192, R[1], C[1]); S.aoff(nxt, R, C, vn); } else {
#pragma unroll
            for (int h = 0; h < 2; ++h)
#pragma unroll
                for (int i = 0; i < 2; ++i) vn[h][i] = vc[h][i]; }
          *vnl = (u32x4){vn[0][0], vn[0][1], vn[1][0], vn[1][1]}; }
        const char* nBl = has_next ? S.blo(nxt) : cBl; const char* nBh = has_next ? S.bhi(nxt) : cBh;
        if (PROBE_K == 1 || PROBE_K == 3) pk_t0 = __builtin_amdgcn_s_memrealtime();
#pragma unroll 1
        for (int t = 0; t < nt; t += 2) {
            const bool last = (t == nt - 2);
            const char* a1 = Ab + (size_t)(t + 1) * kstep;
            const char* a2 = last ? Ab : Ab + (size_t)(t + 2) * kstep;
            const char* b2 = last ? nBl : (((t + 2) < nsplit) ? cBl : cBh) + (size_t)(t + 2) * kstep;
            const char* a3 = a2 + kstep; const char* b3 = b2 + kstep;
            PG8_LDB(B0, 0, 0); PG8_LDB(B1, 0, 1); PG8_SCHED; PG8_LDA(At, 0, 0); PG8_STAGE(PG8_SA(1, 1), a1, vc[1]);
            PG8_WAIT_V(8); PG8_WAIT_L(0); PG8_BAR; PG8_MMA(0, 0, At, B0); PG8_MMA(0, 1, At, B1); PG8_BAR; PG8_SCHED;
            if constexpr (Sched::MIX) { if (t == nt - 4 && !last && has_next && nxt.type == 1) { const GAS unsigned* pa_ = (const GAS unsigned*)S.poll_addr(nxt);
                asm volatile("global_load_dword %0, %1, off sc1" : "=v"(pollv) : "v"(pa_) : "memory"); } }
            if (last) { if constexpr (Epi::NPF > 0) E.prefetch(cur, wr, lane, pf0, pf1);
                const u32x4 v_ = *vnl; vc[0][0] = v_[0]; vc[0][1] = v_[1]; vc[1][0] = v_[2]; vc[1][1] = v_[3];
                if constexpr (Sched::MIX) { if (has_next) { const int lb_ = S.ldbB(nxt); voffB[0] = (unsigned)(RbB[0] * lb_ + CbB[0]); voffB[1] = (unsigned)(RbB[1] * lb_ + CbB[1]); hstepB = (size_t)S.hstepB(nxt) * lb_;
                    if (nxt.type == 1) {
                        bool ok_ = false;
                        if (nt >= 8) { asm volatile("s_waitcnt vmcnt(18)" : "+v"(pollv) :: "memory"); ok_ = (unsigned)__builtin_amdgcn_readfirstlane((int)pollv) >= 64u; }
                        if (!ok_) S.a_ready(nxt); } } } }
            PG8_LDA(At, 0, 1); PG8_STAGE(PG8_SB(0, 0), b2, voffB); PG8_STAGE(PG8_SB(0, 1), b2 + hstepB, voffB); PG8_STAGE(PG8_SA(0, 0), a2, vc[0]);
            if (Epi::NPF > 0 && last) PG8_WAIT_V(10); else PG8_WAIT_V(8);
            PG8_WAIT_L(0); PG8_BAR; PG8_MMA(1, 0, At, B0); PG8_MMA(1, 1, At, B1); PG8_BAR; PG8_SCHED;
            PG8_LDB(B0, 1, 0); PG8_LDB(B1, 1, 1); PG8_SCHED; PG8_LDA(At, 1, 0); PG8_STAGE(PG8_SA(0, 1), a2, vc[1]);
            PG8_WAIT_V(8); PG8_WAIT_L(0); PG8_BAR; PG8_MMA(0, 0, At, B0); PG8_MMA(0, 1, At, B1); PG8_BAR; PG8_SCHED;
            if constexpr (Sched::MIX) { if (t == 0 && pend >= 0) { S.signal(pend, lane); pend = -1; } }
            PG8_LDA(At, 1, 1); PG8_STAGE(PG8_SB(1, 0), b3, voffB); PG8_STAGE(PG8_SB(1, 1), b3 + hstepB, voffB); PG8_STAGE(PG8_SA(1, 0), a3, vc[0]);
            PG8_WAIT_V(8); PG8_WAIT_L(0); PG8_BAR; PG8_MMA(1, 0, At, B0); PG8_MMA(1, 1, At, B1); PG8_BAR; PG8_SCHED;
        }
        if (PROBE_K == 1) pk_acc += __builtin_amdgcn_s_memrealtime() - pk_t0;
        if (PROBE_K == 2) pk_t0 = __builtin_amdgcn_s_memrealtime();
        if (wr == 0) PG8_BAR;
        if constexpr (Epi::NPF > 0) { asm volatile("s_waitcnt vmcnt(14)" : "+v"(pf0), "+v"(pf1) :: "memory"); E(acc, cur, wr, wc, fr, fq, pf0, pf1); }
        else E(acc, cur, wr, wc, fr, fq);
        if constexpr (Sched::MIX) pend = S.done_tile(cur);
        if (PROBE_K == 2) { asm volatile("s_waitcnt vmcnt(0)" ::: "memory"); pk_acc += __builtin_amdgcn_s_memrealtime() - pk_t0; }
        if (PROBE_K == 3) pk_acc += __builtin_amdgcn_s_memrealtime() - pk_t0;
        if (!has_next) break;
#pragma unroll
        for (int a = 0; a < 2; ++a)
#pragma unroll
            for (int b = 0; b < 2; ++b)
#pragma unroll
                for (int m = 0; m < 4; ++m)
#pragma unroll
                    for (int n = 0; n < 2; ++n) acc[a][b][m][n] = (f32x4){0.f, 0.f, 0.f, 0.f};
        cur = nxt; cBl = nBl; cBh = nBh; ++ui;
        if constexpr (Sched::MIX) nsplit = S.nsplit(cur);
        if (wr == 1) PG8_BAR;
    }
    PG8_WAIT_V(0);
    if constexpr (Sched::MIX) { if (pend >= 0) S.signal(pend, lane); }
    PG8_BAR;
    if (PROBE_K != 0 && g.pk && tid == 0) { LAS unsigned* pw_ = (LAS unsigned*)(lds + MISC_OFF) + 120; *pw_ += (unsigned)pk_acc; }
#undef PG8_SA
#undef PG8_SB
#undef PG8_STAGE
#undef PG8_LDA
#undef PG8_LDB
#undef PG8_MMA
#undef PG8_LD8
#undef PG8_WAIT_V
#undef PG8_WAIT_L
#undef PG8_BAR
#undef PG8_SCHED
}
}

namespace attn_body {
using bf16 = __hip_bfloat16;
constexpr int NHEAD = 16, D = 64, DMQ = NHEAD * D;
constexpr int NW = 8, QBLK = 32, QB = QBLK * NW, KVBLK = 64;
__device__ __forceinline__ int crow(int r, int hi) { return (r & 3) + 8 * (r >> 2) + 4 * hi; }
#define SBAR() __builtin_amdgcn_sched_barrier(0)
__device__ __forceinline__ void cmask(f32x16& p0, f32x16& p1, int jb, int qrel, int hi) {
  const float NEG = -INFINITY; int kb = 64 * jb + 4 * hi;
  #pragma unroll
  for (int r = 0; r < 16; ++r) { int kv = kb + (r & 3) + 8 * (r >> 2); if (kv > qrel) p0[r] = NEG; if (kv + 32 > qrel) p1[r] = NEG; }
}
constexpr int NSLOT = 3, SLOTB = 8192;
constexpr int LDS_K = 0, LDS_V = NSLOT * SLOTB, LDS_WS = 2 * NSLOT * SLOTB, LDS_OST = LDS_WS + NW * 64 * 4, ATT_LDS_BYTES = LDS_OST + NW * 4096;
constexpr int LDS_NCK = 86016;
__device__ __forceinline__ void glds16(const void* gsrc, unsigned lds_dst) { unsigned keep;
  asm volatile("s_mov_b32 %0, m0\n\ts_mov_b32 m0, %2\n\ts_nop 0\n\tglobal_load_lds_dwordx4 %1, off\n\ts_mov_b32 m0, %0" : "=&s"(keep) : "v"(gsrc), "s"(lds_dst) : "memory"); }
__device__ __forceinline__ float max3f(float a, float b, float c) { float r; asm("v_max3_f32 %0, %1, %2, %3" : "=v"(r) : "v"(a), "v"(b), "v"(c)); return r; }
__device__ __forceinline__ float max2f(float a, float b) { float r; asm("v_max_f32_e32 %0, %1, %2" : "=v"(r) : "v"(a), "v"(b)); return r; }
__device__ __forceinline__ float fadd_s(float a, float b) { float r; asm("v_add_f32_e32 %0, %1, %2" : "=v"(r) : "v"(a), "v"(b)); return r; }
__device__ __forceinline__ float fsub_s(float a, float b) { float r; asm("v_sub_f32_e32 %0, %1, %2" : "=v"(r) : "v"(a), "v"(b)); return r; }
typedef __bf16 bf16x2_t __attribute__((ext_vector_type(2)));
__device__ __forceinline__ unsigned cvtpk_s(float lo, float hi) { f32x2 v = {lo, hi}; bf16x2_t b = __builtin_convertvector(v, bf16x2_t); return __builtin_bit_cast(unsigned, b); }
#define WAIT_BAR(N) asm volatile("s_waitcnt vmcnt(" #N ") lgkmcnt(0)\n\ts_barrier" ::: "memory")
typedef LAS const char* lds_cptr;
typedef short v4i16_t __attribute__((ext_vector_type(4)));
__device__ __forceinline__ void qkt(f32x16& p0, f32x16& p1, lds_cptr Kslot, const bf16x8* qr, const f32x16& negm, int r32, int hi) {
  lds_cptr kb = Kslot + hi * 1024 + r32 * 16;
  #pragma unroll
  for (int d0 = 0; d0 < 4; ++d0) {
    const bf16x8 b0 = *(const LAS bf16x8*)(kb + d0 * 2048);
    const bf16x8 b1 = *(const LAS bf16x8*)(kb + d0 * 2048 + 512);
    if (d0 == 0) { p0 = __builtin_amdgcn_mfma_f32_32x32x16_bf16(b0, qr[0], negm, 0, 0, 0); p1 = __builtin_amdgcn_mfma_f32_32x32x16_bf16(b1, qr[0], negm, 0, 0, 0); }
    else { p0 = __builtin_amdgcn_mfma_f32_32x32x16_bf16(b0, qr[d0], p0, 0, 0, 0); p1 = __builtin_amdgcn_mfma_f32_32x32x16_bf16(b1, qr[d0], p1, 0, 0, 0); } }
}
__device__ __forceinline__ void kload8(bf16x8* kf, lds_cptr kp) {
  kf[0] = *(const LAS bf16x8*)(kp);        kf[1] = *(const LAS bf16x8*)(kp + 512);
  kf[2] = *(const LAS bf16x8*)(kp + 2048); kf[3] = *(const LAS bf16x8*)(kp + 2560);
  kf[4] = *(const LAS bf16x8*)(kp + 4096); kf[5] = *(const LAS bf16x8*)(kp + 4608);
  kf[6] = *(const LAS bf16x8*)(kp + 6144); kf[7] = *(const LAS bf16x8*)(kp + 6656);
}
__device__ __forceinline__ void kload2(bf16x8* kf, lds_cptr kp, int j) { kf[2 * j] = *(const LAS bf16x8*)(kp + j * 2048); kf[2 * j + 1] = *(const LAS bf16x8*)(kp + j * 2048 + 512); }
__device__ __forceinline__ s16x4 vtr(lds_cptr p) { return __builtin_bit_cast(s16x4, __builtin_amdgcn_ds_read_tr16_b64_v4i16((LAS v4i16_t*)p)); }
__device__ __forceinline__ float rowmax(const f32x16& p0, const f32x16& p1) {
  float a = max3f(p0[0], p0[1], p1[0]), b = max3f(p0[2], p0[3], p1[1]); a = max3f(a, p1[2], p1[3]);
  #pragma unroll
  for (int r = 4; r < 16; r += 4) { a = max3f(a, p0[r], p0[r + 1]); b = max3f(b, p0[r + 2], p0[r + 3]); a = max3f(a, p1[r], p1[r + 1]); b = max3f(b, p1[r + 2], p1[r + 3]); }
  const float m = max2f(a, b);
  auto rr = __builtin_amdgcn_permlane32_swap(__float_as_uint(m), __float_as_uint(m), false, false);
  return max2f(__uint_as_float(rr[0]), __uint_as_float(rr[1]));
}
__device__ __forceinline__ void pv(f32x16* o, int vb, bf16x8 pa0, bf16x8 pa1, bf16x8 pa2, bf16x8 pa3) {
  #pragma unroll
  for (int d0 = 0; d0 < 2; ++d0) { s16x4 lo[4], hi[4];
    #pragma unroll
    for (int ks = 0; ks < 4; ++ks) {
      asm volatile("ds_read_b64_tr_b16 %0,%1 offset:%c2" : "=&v"(lo[ks]) : "v"(vb), "i"(d0 * 4096 + ks * 1024) : "memory");
      asm volatile("ds_read_b64_tr_b16 %0,%1 offset:%c2" : "=&v"(hi[ks]) : "v"(vb), "i"(d0 * 4096 + ks * 1024 + 512) : "memory"); }
    asm volatile("s_waitcnt lgkmcnt(0)" ::: "memory"); SBAR();
    #define PK(k) (bf16x8){lo[k][0], lo[k][1], lo[k][2], lo[k][3], hi[k][0], hi[k][1], hi[k][2], hi[k][3]}
    o[d0] = __builtin_amdgcn_mfma_f32_32x32x16_bf16(pa0, PK(0), o[d0], 0, 0, 0);
    o[d0] = __builtin_amdgcn_mfma_f32_32x32x16_bf16(pa1, PK(1), o[d0], 0, 0, 0);
    o[d0] = __builtin_amdgcn_mfma_f32_32x32x16_bf16(pa2, PK(2), o[d0], 0, 0, 0);
    o[d0] = __builtin_amdgcn_mfma_f32_32x32x16_bf16(pa3, PK(3), o[d0], 0, 0, 0);
    #undef PK
  }
}

struct Xpf { bool primed, has_next; long Pn; const bf16* Qn; const bf16* Kn; const bf16* Vn; };
template<int THRL, bool WIN, bool XP> __device__ __forceinline__ void attn_unit_x(int qb, int T0, long P, const bf16* Q, const bf16* __restrict__ K, const bf16* __restrict__ V, bf16* O, char* shm, int wave,
                                                                        float* PML, long wtok0, int wtstride, const Xpf xp, bf16x8 (&qn)[4], int& rho) {
#ifndef PROBE_A
#define PROBE_A 0
#endif
  unsigned long long pa_t = 0ull;
#define PA_T0(k) do { if (WIN && PROBE_A == (k)) pa_t = __builtin_amdgcn_s_memrealtime(); } while (0)
#define PA_T1(k) do { if (WIN && PROBE_A == (k)) { const unsigned d_ = (unsigned)(__builtin_amdgcn_s_memrealtime() - pa_t); if (tid == 0) *(unsigned*)(shm + MISC_OFF + 4 * 121) += d_; } } while (0)
  int tid = wave * 64 + lane_id(); asm volatile("" : "+v"(tid));
  const int lane = tid & 63, r32 = lane & 31, hi = lane >> 5; const int wid = __builtin_amdgcn_readfirstlane(tid >> 6);
  PA_T0(1);
  const int q0 = qb * QB;
  const bf16* Qw = Q + (long)(q0 + wid * QBLK) * P;
  const bf16* Kh = K + (long)T0 * KVBLK * P, *Vh = V + (long)T0 * KVBLK * P;
  const unsigned lds0 = (unsigned)(uintptr_t)shm; const lds_cptr shm3 = (lds_cptr)shm;
  float* wsf = (float*)(shm + LDS_WS) + wid * 64;
  const int wbj = 383 - (q0 + wid * QBLK + r32 - T0 * KVBLK) + 4 * hi;
  const LAS float* nck0 = WIN ? (const LAS float*)((lds_cptr)shm + LDS_NCK) + (wbj & 3) * 640 + (wbj & ~3)
                              : (const LAS float*)((lds_cptr)shm + LDS_NCK) + T0 * KVBLK + 4 * hi;
  const float cq2 = WIN ? 0.f : -((const LAS float*)((lds_cptr)shm + LDS_NCK))[q0 + wid * QBLK + r32];
  const bf16* ksrc = Kh + (long)lane * P + wid * 8;
  const bf16* vsrc = Vh + (long)(16 * (wid & 3) + (lane >> 2)) * P + (wid >> 2) * 32 + (lane & 3) * 8;
  const unsigned kdst = lds0 + LDS_K + wid * 1024, vdst = lds0 + LDS_V + wid * 1024;
  #define DMA_K(t, slot) glds16(ksrc + (long)(t) * KVBLK * P, (unsigned)__builtin_amdgcn_readfirstlane(kdst + (slot)))
  #define DMA_V(t, slot) glds16(vsrc + (long)(t) * KVBLK * P, (unsigned)__builtin_amdgcn_readfirstlane(vdst + (slot)))
  const int vb0 = (int)(lds0 + LDS_V) + ((lane >> 4) & 1) * 32 + (lane & 3) * 8 + (4 * hi + ((lane & 15) >> 2)) * 64;
  bf16x8 kf[8];
  const lds_cptr kp0 = shm3 + LDS_K + hi * 1024 + r32 * 16; const lds_cptr vp0 = shm3 + LDS_V + ((lane >> 4) & 1) * 32 + (lane & 3) * 8 + (4 * hi + ((lane & 15) >> 2)) * 64;
  const int NT = (q0 + QB) / KVBLK - T0;
  #define NXS(s) (((s) == (NSLOT - 1) * SLOTB) ? 0 : (s) + SLOTB)
  const int s0 = XP ? __builtin_amdgcn_readfirstlane(rho) * SLOTB : 0, s1 = NXS(s0), s2 = NXS(s1);
  const bool primed = XP && xp.primed;
  if (!primed) { DMA_K(0, s0); DMA_V(0, s0); DMA_K(1, s1); }
  bf16x8 qr[4];
  const lds_cptr qp = shm3 + LDS_OST + wid * 4096 + lane * 16;
  if (!primed) {
  #pragma unroll
  for (int d0 = 0; d0 < 4; ++d0) qr[d0] = *reinterpret_cast<const bf16x8*>(&Qw[(long)r32 * P + d0 * 16 + hi * 8]);
  #pragma unroll
  for (int d0 = 0; d0 < 4; ++d0) *(LAS bf16x8*)(qp + d0 * 1024) = qr[d0];
  } else {
  #pragma unroll
  for (int d0 = 0; d0 < 4; ++d0) qr[d0] = qn[d0];
  }
  #define QLD(d) (*(const LAS bf16x8*)(qp + (d) * 1024))
  float nm = cq2, l_reg = 0.f; f32x16 o[2]; o[0] = f32x16{}; o[1] = f32x16{};
  const int qrel = wid * QBLK + r32;
  #define CMASK(P0, P1, t) do { if (!WIN) { int jb_ = (t) - (NT - 4); if (jb_ >= 0) cmask(P0, P1, jb_, qrel, hi); } } while (0)
  #define DECAY(P0, P1, t) do { const LAS float* nk_ = nck0 + ((t) << 6); \
    _Pragma("unroll") for (int g_ = 0; g_ < 4; ++g_) { const f32x4 a_ = *(const LAS f32x4*)(nk_ + 8 * g_); const f32x4 b_ = *(const LAS f32x4*)(nk_ + 32 + 8 * g_); \
      P0[4 * g_] += a_[0]; P0[4 * g_ + 1] += a_[1]; P0[4 * g_ + 2] += a_[2]; P0[4 * g_ + 3] += a_[3]; P1[4 * g_] += b_[0]; P1[4 * g_ + 1] += b_[1]; P1[4 * g_ + 2] += b_[2]; P1[4 * g_ + 3] += b_[3]; SBAR(); } } while (0)
  bool resc = false;
  #define START(P0, P1) do { const float rm = rowmax(P0, P1); resc = false; \
    { const float dl = max2f(rm, -1000.f); nm = fsub_s(nm, dl); \
      _Pragma("unroll") for (int r = 0; r < 16; ++r) { P0[r] = fsub_s(P0[r], dl); P1[r] = fsub_s(P1[r], dl); } } \
    _Pragma("unroll") for (int r = 0; r < 16; ++r) P0[r] = __builtin_amdgcn_exp2f(P0[r]); } while (0)
  #define RESC() do { if (resc) { asm volatile("s_waitcnt lgkmcnt(0)" ::: "memory"); \
      _Pragma("unroll") for (int d_ = 0; d_ < 2; ++d_) _Pragma("unroll") for (int r = 0; r < 16; ++r) o[d_][r] *= wsf[crow(r, hi)]; } } while (0)
  f32x16 pA0, pA1, pB0, pB1;
  int sl_prev = s0, sl_cur = s0, sl_next = s1;
  #define ROT() do { sl_prev = sl_cur; sl_cur = sl_next; sl_next = (sl_next == (NSLOT - 1) * SLOTB) ? 0 : sl_next + SLOTB; } while (0)
  if (!primed) { DMA_K(2, s2); WAIT_BAR(3); }
  PA_T1(1); PA_T0(2);
  { f32x16 negm;
    #pragma unroll
    for (int r = 0; r < 16; ++r) negm[r] = nm;
    qkt(pA0, pA1, shm3 + LDS_K + s0, qr, negm, r32, hi); }
  asm volatile("s_nop 15\n\ts_nop 7" : "+v"(pA0), "+v"(pA1)); DECAY(pA0, pA1, 0); CMASK(pA0, pA1, 0);
  asm volatile("s_nop 1" : "+v"(pA0), "+v"(pA1));
  START(pA0, pA1);
  _Pragma("unroll") for (int r = 0; r < 16; ++r) pA1[r] = __builtin_amdgcn_exp2f(pA1[r]);
  WAIT_BAR(0);
  DMA_K(3, s0); DMA_V(1, s1);
  ROT();
  kload8(kf, kp0 + sl_cur);
  WAIT_BAR(2);
  PA_T1(2); PA_T0(3);
  s16x4 vlo[8], vhi[8]; u32x4 pw0, pw1, pw2, pw3; bf16x8 qfa = QLD(0), qfb = QLD(1);
  #define PKW(P, B) cvtpk_s(P[B], P[B + 1])
  #define PAF(k) __builtin_bit_cast(bf16x8, pw##k)
  #define VFR(i) (bf16x8){vlo[i][0], vlo[i][1], vlo[i][2], vlo[i][3], vhi[i][0], vhi[i][1], vhi[i][2], vhi[i][3]}
  #define PIN(x) asm volatile("" : "+v"(x))
  #define MX3(a, b, c) __builtin_fmaxf(__builtin_fmaxf((a), (b)), (c))
  #define SPLAT(X) do { _Pragma("unroll") for (int r_ = 0; r_ < 16; ++r_) X[r_] = nm; PIN(X); } while (0)
  #define GAPA(MF, A0, A1, A2, A3, W0, W1, PW) do { MF; sacc += A0; sacc += A1; sacc += A2; sacc += A3; PIN(sacc); W0; W1; PIN(PW); SBAR(); } while (0)
  #define EX(v) __builtin_amdgcn_exp2f(v)
  #define GAPB(MF, X, B) do { MF; X[B] = EX(X[B]); X[B + 1] = EX(X[B + 1]); X[B + 2] = EX(X[B + 2]); X[B + 3] = EX(X[B + 3]); PIN(X); SBAR(); } while (0)
  #define VRD(i) do { vlo[i] = vtr(vp_ + (((i) >> 2) * 4096 + ((i) & 3) * 1024)); vhi[i] = vtr(vp_ + (((i) >> 2) * 4096 + ((i) & 3) * 1024 + 512)); } while (0)
  #define KRD(G, j) do { if (G) { kload2(kf, kp0 + sl_next, j); SBAR(); } } while (0)
  #define STEP(C0, C1, P0, P1, t, GK, GV, GL) do { SBAR(); \
    const lds_cptr vp_ = vp0 + sl_prev; \
    SPLAT(C0); VRD(0); SBAR(); float sacc = (P0[0] + P0[1]); \
    GAPA(C0 = __builtin_amdgcn_mfma_f32_32x32x16_bf16(kf[0], qfa, C0, 0, 0, 0), P0[2], P0[3], P0[4], P0[5],     pw0[0] = PKW(P0, 0), pw0[1] = PKW(P0, 2), pw0); \
    SPLAT(C1); VRD(4); SBAR(); GAPA(C1 = __builtin_amdgcn_mfma_f32_32x32x16_bf16(kf[1], qfa, C1, 0, 0, 0), P0[6], P0[7], P0[8], P0[9],     pw0[2] = PKW(P0, 4), pw0[3] = PKW(P0, 6), pw0); \
    qfa = QLD(2); VRD(1); SBAR(); GAPA(C0 = __builtin_amdgcn_mfma_f32_32x32x16_bf16(kf[2], qfb, C0, 0, 0, 0),   P0[10], P0[11], P0[12], P0[13], pw1[0] = PKW(P0, 8), pw1[1] = PKW(P0, 10), pw1); \
    VRD(5); SBAR(); GAPA(C1 = __builtin_amdgcn_mfma_f32_32x32x16_bf16(kf[3], qfb, C1, 0, 0, 0),   P0[14], P0[15], P1[0], P1[1],   pw1[2] = PKW(P0, 12), pw1[3] = PKW(P0, 14), pw1); \
    qfb = QLD(3); VRD(2); SBAR(); GAPA(C0 = __builtin_amdgcn_mfma_f32_32x32x16_bf16(kf[4], qfa, C0, 0, 0, 0),   P1[2], P1[3], P1[4], P1[5],     pw2[0] = PKW(P1, 0), pw2[1] = PKW(P1, 2), pw2); \
    VRD(6); SBAR(); GAPA(C1 = __builtin_amdgcn_mfma_f32_32x32x16_bf16(kf[5], qfa, C1, 0, 0, 0),   P1[6], P1[7], P1[8], P1[9],     pw2[2] = PKW(P1, 4), pw2[3] = PKW(P1, 6), pw2); \
    VRD(3); SBAR(); GAPA(C0 = __builtin_amdgcn_mfma_f32_32x32x16_bf16(kf[6], qfb, C0, 0, 0, 0),   P1[10], P1[11], P1[12], P1[13], pw3[0] = PKW(P1, 8), pw3[1] = PKW(P1, 10), pw3); \
    VRD(7); SBAR(); GAPA(C1 = __builtin_amdgcn_mfma_f32_32x32x16_bf16(kf[7], qfb, C1, 0, 0, 0),   P1[14], P1[15], 0.f, 0.f,       pw3[2] = PKW(P1, 12), pw3[3] = PKW(P1, 14), pw3); \
    l_reg += sacc; \
    if (GK) { DMA_K((t) + 3, sl_cur); } if (GV) { DMA_V((t) + 1, sl_next); } \
    DECAY(C0, C1, t); \
    CMASK(C0, C1, t); \
    { float a = MX3(C0[0], C0[1], C1[0]), b = MX3(C0[2], C0[3], C1[1]); a = MX3(a, C1[2], C1[3]); \
      _Pragma("unroll") for (int r = 4; r < 16; r += 4) { a = MX3(a, C0[r], C0[r + 1]); b = MX3(b, C0[r + 2], C0[r + 3]); a = MX3(a, C1[r], C1[r + 1]); b = MX3(b, C1[r + 2], C1[r + 3]); } \
      float rm = __builtin_fmaxf(a, b); { auto rr = __builtin_amdgcn_permlane32_swap(__float_as_uint(rm), __float_as_uint(rm), false, false); rm = __builtin_fmaxf(__uint_as_float(rr[0]), __uint_as_float(rr[1])); } \
      resc = false; \
      if (__builtin_expect(__any(rm > (float)THRL), 0)) { const float dl = __builtin_fmaxf(rm, 0.f); nm -= dl; \
        _Pragma("unroll") for (int r = 0; r < 16; ++r) { C0[r] -= dl; C1[r] -= dl; } \
        const float f = __builtin_amdgcn_exp2f(-dl); l_reg *= f; if (hi == 0) wsf[r32] = f; resc = true; } } \
    SBAR(); \
    GAPB(o[0] = __builtin_amdgcn_mfma_f32_32x32x16_bf16(PAF(0), VFR(0), o[0], 0, 0, 0), C0, 0); \
    GAPB(o[1] = __builtin_amdgcn_mfma_f32_32x32x16_bf16(PAF(0), VFR(4), o[1], 0, 0, 0), C0, 4); \
    KRD(GL, 0); GAPB(o[0] = __builtin_amdgcn_mfma_f32_32x32x16_bf16(PAF(1), VFR(1), o[0], 0, 0, 0), C0, 8); \
    KRD(GL, 1); GAPB(o[1] = __builtin_amdgcn_mfma_f32_32x32x16_bf16(PAF(1), VFR(5), o[1], 0, 0, 0), C0, 12); \
    KRD(GL, 2); GAPB(o[0] = __builtin_amdgcn_mfma_f32_32x32x16_bf16(PAF(2), VFR(2), o[0], 0, 0, 0), C1, 0); \
    KRD(GL, 3); GAPB(o[1] = __builtin_amdgcn_mfma_f32_32x32x16_bf16(PAF(2), VFR(6), o[1], 0, 0, 0), C1, 4); \
    GAPB(o[0] = __builtin_amdgcn_mfma_f32_32x32x16_bf16(PAF(3), VFR(3), o[0], 0, 0, 0), C1, 8); \
    qfa = QLD(0); qfb = QLD(1); SBAR(); \
    GAPB(o[1] = __builtin_amdgcn_mfma_f32_32x32x16_bf16(PAF(3), VFR(7), o[1], 0, 0, 0), C1, 12); \
    } while (0)
  int t = 1;
  #undef CMASK
  #define CMASK(P0, P1, t) do {} while (0)
  for (; t + 5 < NT; t += 2) {
    STEP(pB0, pB1, pA0, pA1, t, true, true, true);     WAIT_BAR(2); RESC(); ROT();
    STEP(pA0, pA1, pB0, pB1, t + 1, true, true, true); WAIT_BAR(2); RESC(); ROT();
  }
  #undef CMASK
  #define CMASK(P0, P1, t) do { if (!WIN) { int jb_ = (t) - (NT - 4); if (jb_ >= 0) cmask(P0, P1, jb_, qrel, hi); } } while (0)
  #define ENDW(tt) do { if ((tt) + 3 < NT) { WAIT_BAR(2); } else if ((tt) + 2 < NT) { WAIT_BAR(1); } else { WAIT_BAR(0); } } while (0)
  for (; t + 1 < NT; t += 2) {
    STEP(pB0, pB1, pA0, pA1, t, (t + 3 < NT), (t + 1 < NT), (t + 1 < NT));       ENDW(t);     RESC(); ROT();
    STEP(pA0, pA1, pB0, pB1, t + 1, (t + 4 < NT), (t + 2 < NT), (t + 2 < NT));   ENDW(t + 1); RESC(); ROT();
  }
  bool pf_next = false;
  if constexpr (XP) { pf_next = xp.has_next; if (pf_next) {
    const int n0 = sl_next, n1 = NXS(n0), n2 = NXS(n1);
    const bf16* ksn = xp.Kn + (long)lane * xp.Pn + wid * 8;
    const bf16* vsn = xp.Vn + (long)(16 * (wid & 3) + (lane >> 2)) * xp.Pn + (wid >> 2) * 32 + (lane & 3) * 8;
    glds16(ksn, (unsigned)__builtin_amdgcn_readfirstlane(kdst + n0));
    const bf16* Qwn = xp.Qn + (long)(wid * QBLK) * xp.Pn;
    #pragma unroll
    for (int d0 = 0; d0 < 4; ++d0) qn[d0] = *reinterpret_cast<const bf16x8*>(&Qwn[(long)r32 * xp.Pn + d0 * 16 + hi * 8]);
    glds16(vsn, (unsigned)__builtin_amdgcn_readfirstlane(vdst + n0));
    glds16(ksn + (long)KVBLK * xp.Pn, (unsigned)__builtin_amdgcn_readfirstlane(kdst + n1));
    glds16(ksn + (long)2 * KVBLK * xp.Pn, (unsigned)__builtin_amdgcn_readfirstlane(kdst + n2));
    rho = n0 / SLOTB; } }
  STEP(pB0, pB1, pA0, pA1, NT - 1, false, false, false); RESC();
  { float sacc = pB0[0] + pB0[1]; _Pragma("unroll") for (int r = 2; r < 16; ++r) sacc += pB0[r]; _Pragma("unroll") for (int r = 0; r < 16; ++r) sacc += pB1[r]; l_reg += sacc;
    pw0 = (u32x4){PKW(pB0, 0), PKW(pB0, 2), PKW(pB0, 4), PKW(pB0, 6)}; pw1 = (u32x4){PKW(pB0, 8), PKW(pB0, 10), PKW(pB0, 12), PKW(pB0, 14)}; pw2 = (u32x4){PKW(pB1, 0), PKW(pB1, 2), PKW(pB1, 4), PKW(pB1, 6)}; pw3 = (u32x4){PKW(pB1, 8), PKW(pB1, 10), PKW(pB1, 12), PKW(pB1, 14)};
    SBAR(); pv(o, vb0 + sl_cur, PAF(0), PAF(1), PAF(2), PAF(3)); }
  PA_T1(3); PA_T0(4);
  #undef PKW
  #undef PAF
  #undef VFR
  #undef PIN
  #undef MX3
  #undef GAPA
  #undef SPLAT
  #undef GAPB
  #undef EX
  #undef VRD
  #undef KRD
  #undef STEP
  #undef ENDW
  { auto rr = __builtin_amdgcn_permlane32_swap(__float_as_uint(l_reg), __float_as_uint(l_reg), false, false); l_reg = __uint_as_float(rr[0]) + __uint_as_float(rr[1]); }
  if (hi == 0) wsf[32 + r32] = l_reg; asm volatile("s_waitcnt lgkmcnt(0)" ::: "memory");
  float rli[16];
  #pragma unroll
  for (int r = 0; r < 16; ++r) rli[r] = WIN ? 1.0f : __builtin_amdgcn_rcpf(wsf[32 + crow(r, hi)]);
  if (WIN) { if (hi == 0) *(f32x2*)(PML + 2 * (wtok0 + (long)wtstride * (q0 + wid * QBLK + r32))) = (f32x2){-nm, l_reg}; }
  bf16* Ow = O + (long)(q0 + wid * QBLK) * P;
  { bf16* stg = (bf16*)(shm + LDS_OST) + wid * 2048;
    #pragma unroll
    for (int r = 0; r < 16; ++r) { const int orow = crow(r, hi);
      #pragma unroll
      for (int d0 = 0; d0 < 2; ++d0) stg[orow * 64 + d0 * 32 + r32] = __float2bfloat16(o[d0][r] * rli[r]); }
    asm volatile("s_waitcnt lgkmcnt(0)" ::: "memory");
    #pragma unroll
    for (int i = 0; i < 4; ++i) { const int row = i * 8 + (lane >> 3), ch = lane & 7; const u32x4 v = *(const u32x4*)(stg + row * 64 + ch * 8); *(u32x4*)(Ow + (long)row * P + ch * 8) = v; } }
  if constexpr (XP) { if (pf_next) {
    asm volatile("s_waitcnt vmcnt(5)" ::: "memory");
    #pragma unroll
    for (int d0 = 0; d0 < 4; ++d0) asm volatile("ds_write_b128 %0, %1 offset:%c2" :: "v"((unsigned)(uintptr_t)qp), "v"(qn[d0]), "i"(d0 * 1024) : "memory"); } }
  asm volatile("s_waitcnt lgkmcnt(0)\n\ts_barrier" ::: "memory");
  PA_T1(4);
  #undef DMA_K
  #undef DMA_V
  #undef NXS
  #undef CMASK
  #undef DECAY
  #undef START
  #undef RESC
  #undef ROT
  #undef QLD
}
template<int THRL, bool WIN> __device__ __forceinline__ void attn_unit(int qb, int T0, long P, const bf16* Q, const bf16* __restrict__ K, const bf16* __restrict__ V, bf16* O, char* shm, int wave,
                                                                        float* PML = nullptr, long wtok0 = 0, int wtstride = 0) {
  Xpf xp{}; bf16x8 qn[4]; int rho = 0;
  attn_unit_x<THRL, WIN, false>(qb, T0, P, Q, K, V, O, shm, wave, PML, wtok0, wtstride, xp, qn, rho);
}
#undef WAIT_BAR
}

namespace dil {
constexpr float NEGBIG = -1.0e30f;
__device__ __forceinline__ int t5_bucket(int dist) {
    if (dist < 16) return dist;
    const float v = logf((float)dist / 16.0f) / 4.852030263919617f * 16.0f;
    const int l = 16 + (int)v; return l < 31 ? l : 31;
}
__device__ __forceinline__ void build_table(LAS float* tb, const float* rel_bias, int g, int d, int j, int tid) {
    asm volatile("" : "+v"(tid));
    for (int e = tid; e < 640; e += 512) { const int n = e - 256; const float v = (n >= 0 && n <= 128) ? rel_bias[t5_bucket(n * d) * 24 + 8 * g + j] * LOG2E : NEGBIG; const int m = 639 - e;
#pragma unroll
        for (int sft = 0; sft < 4; ++sft) if (m - sft >= 0) tb[640 * sft + m - sft] = v; }
}
}

#define XB_TMO      128
#define XB_XCNT(j)  (256  + 64 * (j))
#define XB_XSUB(j)  (1280 + 64 * (j))
#define XB_XGEN(j)  (2304 + 64 * (j))
#define XB_TOP      3328
#define XB_TOPGEN   3392
#define XCD_BAR_WORDS 3456
#define XB_SPIN_CAP (1u << 18)
__device__ __forceinline__ unsigned xb_ld(unsigned* p)              { return __hip_atomic_load(p, __ATOMIC_RELAXED, __HIP_MEMORY_SCOPE_AGENT); }
__device__ __forceinline__ unsigned xb_add(unsigned* p, unsigned v) { return __hip_atomic_fetch_add(p, v, __ATOMIC_RELAXED, __HIP_MEMORY_SCOPE_AGENT); }
__device__ __forceinline__ unsigned xb_xcc_id() { return (unsigned)__builtin_amdgcn_s_getreg((3 << 11) | 20) & 0xFu; }
#define XB_SPIN(cond, bar) do { unsigned _sp = 0; while (cond) { __builtin_amdgcn_s_sleep(1); \
    if ((++_sp & 255u) == 0u) { if (xb_ld(&(bar)[XB_TMO])) break; if (_sp > XB_SPIN_CAP) { atomicAdd(&(bar)[XB_TMO], 1u); break; } } } } while (0)
struct XcdBarrier { unsigned* bar; unsigned x; volatile LAS unsigned* st; };
__device__ __forceinline__ XcdBarrier xcd_barrier_post(unsigned* bar, volatile LAS unsigned* st, bool leader) {
    XcdBarrier b; b.bar = bar; b.x = xb_xcc_id(); b.st = st;
    if (leader) (void)xb_add(&bar[XB_XCNT(b.x)], 1u);
    return b;
}
__device__ __forceinline__ void xcd_barrier_complete(unsigned* bar, unsigned x, unsigned& nloc, unsigned& nx) {
    const unsigned G = gridDim.x * gridDim.y * gridDim.z;
    unsigned sum, cnt, mine, sp = 0u;
    for (;;) {
        sum = 0u; cnt = 0u; mine = 0u;
#pragma unroll
        for (unsigned j = 0; j < 16; ++j) { const unsigned c = xb_ld(&bar[XB_XCNT(j)]); sum += c; cnt += (c > 0u) ? 1u : 0u; mine = (j == x) ? c : mine; }
        if (sum == G) break;
        __builtin_amdgcn_s_sleep(1);
        if ((++sp & 255u) == 0u) { if (xb_ld(&bar[XB_TMO])) break; if (sp > XB_SPIN_CAP) { atomicAdd(&bar[XB_TMO], 1u); break; } }
    }
    nloc = mine > 0u ? mine : 1u; nx = cnt > 0u ? cnt : 1u;
}
__device__ __forceinline__ void xcd_barrier(const XcdBarrier& b, bool leader) {
    asm volatile("s_waitcnt vmcnt(0)" ::: "memory");
    __syncthreads();
    if (leader) {
        unsigned* bar = b.bar;
        __builtin_amdgcn_s_waitcnt(0);
        unsigned nloc = b.st[0], nx = b.st[1];
        if (nloc == 0u) { xcd_barrier_complete(bar, b.x, nloc, nx); b.st[0] = nloc; b.st[1] = nx; }
        const unsigned old = xb_add(&bar[XB_XSUB(b.x)], 1u);
        const unsigned gen = old / nloc;
        if (old + 1u == (gen + 1u) * nloc) {
            __builtin_amdgcn_fence(__ATOMIC_RELEASE, "agent");
            asm volatile("s_waitcnt vmcnt(0)" ::: "memory");
            const unsigned og = xb_add(&bar[XB_TOP], 1u);
            const unsigned tg = og / nx;
            if (og + 1u == (tg + 1u) * nx) xb_add(&bar[XB_TOPGEN], 1u);
            else XB_SPIN(xb_ld(&bar[XB_TOPGEN]) == tg, bar);
            __builtin_amdgcn_fence(__ATOMIC_ACQUIRE, "agent");
            xb_add(&bar[XB_XGEN(b.x)], 1u);
            asm volatile("s_waitcnt vmcnt(0)" ::: "memory");
        } else {
            XB_SPIN(xb_ld(&bar[XB_XGEN(b.x)]) == gen, bar);
            __builtin_amdgcn_fence(__ATOMIC_ACQUIRE, "agent");
            asm volatile("s_waitcnt vmcnt(0)" ::: "memory");
        }
    }
    __syncthreads();
}

__device__ __forceinline__ const float* inptr(int k) {
    asm volatile("" : "+s"(k));
    return ((const float* const __attribute__((address_space(4)))*)__builtin_amdgcn_kernarg_segment_ptr())[k];
}
#define INP(k) inptr(k)
__device__ __forceinline__ int otid(int wave) { int t = wave * 64 + lane_id(); asm volatile("" : "+v"(t)); return t; }
__device__ __forceinline__ unsigned char* opq_ptr(unsigned char* p) { asm volatile("" : "+s"(p)); return p; }
struct Frame {
    LAS unsigned char* lds;
    volatile LAS unsigned* MISC;
    gu32* ctl;
    int wave;
    int vcu, G;
    float* out;
    unsigned char* ws;
};
__device__ __forceinline__ float wave_sum(float v, int lane) {
#pragma unroll
    for (int o = 1; o < 64; o <<= 1) v += shfl_x(v, lane, o);
    return v;
}

struct P0D { const float* W; int ldw; int K; bf16_t* WT; const float* gain; int kb, nb; int f8; };
__device__ __forceinline__ P0D p0_decode(int it, unsigned char* ws) {
    constexpr int I0 = 16 * 96, I1 = 16 * 32, I2 = 16 * 96, I3 = 16 * 48, I4 = 8 * 32, I5 = 32 * 256, I6 = 32 * 256;
    P0D d; int r = it;
    if (r < I0) { d.f8 = 1; d.W = INP(2); d.ldw = 3088; d.K = 1024; d.WT = (bf16_t*)(ws + WS_WQKVA); d.gain = INP(1); d.kb = r / 96; d.nb = r % 96; return d; } r -= I0;
    if (r < I1) { d.f8 = 0; d.W = INP(6); d.ldw = 1024; d.K = 1024; d.WT = (bf16_t*)(ws + WS_WOA); d.gain = nullptr; d.kb = r / 32; d.nb = r % 32; return d; } r -= I1;
    if (r < I2) { d.f8 = 1; d.W = INP(8); d.ldw = 3072; d.K = 1024; d.WT = (bf16_t*)(ws + WS_WKVQ); d.gain = INP(7); d.kb = r / 96; d.nb = r % 96; return d; } r -= I2;
    if (r < I3) { d.f8 = 1; d.W = INP(12); d.ldw = 1536; d.K = 1024; d.WT = (bf16_t*)(ws + WS_WKVQ + (size_t)3072 * 1024); d.gain = INP(11); d.kb = r / 48; d.nb = r % 48; return d; } r -= I3;
    if (r < I4) { d.f8 = 1; d.W = INP(14); d.ldw = 1024; d.K = 512; d.WT = (bf16_t*)(ws + WS_WOB); d.gain = nullptr; d.kb = r / 32; d.nb = r % 32; return d; } r -= I4;
    if (r < I5) { const int le = r / 256, q = r % 256;
        d.f8 = 1; d.W = INP(20) + (size_t)le * 1024 * 512; d.ldw = 512; d.K = 1024; d.WT = (bf16_t*)(ws + WS_WGU + (size_t)le * 1024 * 1024); d.gain = INP(15) + (le >> 4) * 1024; d.kb = q / 16; d.nb = q % 16; return d; } r -= I5;
    if (r < I6) { const int le = r / 256, q = r % 256;
        d.f8 = 1; d.W = INP(21) + (size_t)le * 1024 * 512; d.ldw = 512; d.K = 1024; d.WT = (bf16_t*)(ws + WS_WGU + (size_t)le * 1024 * 1024 + (size_t)512 * 1024); d.gain = INP(15) + (le >> 4) * 1024; d.kb = q / 16; d.nb = q % 16; return d; } r -= I6;
    { const int le = r / 256, q = r % 256;
        d.f8 = 1; d.W = INP(22) + (size_t)le * 512 * 1024; d.ldw = 1024; d.K = 512; d.WT = (bf16_t*)(ws + WS_WD + (size_t)le * 1024 * 512); d.gain = nullptr; d.kb = q / 32; d.nb = q % 32; return d; }
}
__device__ __forceinline__ void p0_load(const P0D& d, int lane, f32x4 (&v)[8], float (&gv)[8]) {
    const float* src = d.W + (size_t)(64 * d.kb + (lane >> 3)) * d.ldw + 32 * d.nb + 4 * (lane & 7);
#pragma unroll
    for (int i = 0; i < 8; ++i) { v[i] = *(const GAS f32x4*)(src + (size_t)(8 * i) * d.ldw); gv[i] = d.gain ? d.gain[64 * d.kb + (lane >> 3) + 8 * i] : 1.0f; }
}
__device__ __forceinline__ void p0_store(const P0D& d, int lane, const f32x4 (&v)[8], const float (&gv)[8], LAS float* scr) {
#pragma unroll
    for (int i = 0; i < 8; ++i) { LAS float* p = scr + ((lane >> 3) + 8 * i) * 33 + 4 * (lane & 7); const f32x4 x = v[i] * gv[i]; p[0] = x[0]; p[1] = x[1]; p[2] = x[2]; p[3] = x[3]; }
    LDS_WAIT(); asm volatile("" ::: "memory");
    const int c = lane & 7, k0 = 64 * d.kb, n0 = 32 * d.nb;
#pragma unroll
    for (int j = 0; j < 4; ++j) { const int n = (lane >> 3) + 8 * j; const LAS float* s = scr + (8 * c) * 33 + n;
        if (d.f8) { u32x2 o; o.x = pk4_fp8(s[0 * 33] * W8SCALE, s[1 * 33] * W8SCALE, s[2 * 33] * W8SCALE, s[3 * 33] * W8SCALE); o.y = pk4_fp8(s[4 * 33] * W8SCALE, s[5 * 33] * W8SCALE, s[6 * 33] * W8SCALE, s[7 * 33] * W8SCALE);
            *(GAS u32x2*)((unsigned char*)d.WT + (size_t)(n0 + n) * d.K + k0 + 8 * c) = o; }
        else { u32x4 o; o.x = pk2(s[0 * 33], s[1 * 33]); o.y = pk2(s[2 * 33], s[3 * 33]); o.z = pk2(s[4 * 33], s[5 * 33]); o.w = pk2(s[6 * 33], s[7 * 33]);
            *(GAS u32x4*)(d.WT + (size_t)(n0 + n) * d.K + k0 + 8 * c) = o; } }
    LDS_WAIT(); asm volatile("" ::: "memory");
}
struct P0H { const float* W; unsigned char* WT; int kb, nb; };
__device__ __forceinline__ P0H p0h_decode(int idx, unsigned char* ws) { const int le = idx >> 9, hq = idx & 511; P0H d; d.W = INP(22) + (size_t)le * 512 * 1024; d.WT = ws + WS_WD + (size_t)le * 1024 * 512; d.kb = hq >> 6; d.nb = hq & 63; return d; }
__device__ __forceinline__ void p0h_load(const P0H& d, int lane, f32x4 (&v)[4]) {
    const float* src = d.W + (size_t)(64 * d.kb + (lane >> 2)) * 1024 + 16 * d.nb + 4 * (lane & 3);
#pragma unroll
    for (int i = 0; i < 4; ++i) v[i] = *(const GAS f32x4*)(src + (size_t)(16 * i) * 1024);
}
__device__ __forceinline__ void p0h_store(const P0H& d, int lane, const f32x4 (&v)[4], LAS float* scr) {
#pragma unroll
    for (int i = 0; i < 4; ++i) { LAS float* p = scr + ((lane >> 2) + 16 * i) * 17 + 4 * (lane & 3); p[0] = v[i][0]; p[1] = v[i][1]; p[2] = v[i][2]; p[3] = v[i][3]; }
    LDS_WAIT(); asm volatile("" ::: "memory");
    const int n = lane >> 2, c = lane & 3; const LAS float* s = scr + (16 * c) * 17 + n;
    u32x4 o;
    o.x = pk4_fp8(s[0 * 17] * W8SCALE, s[1 * 17] * W8SCALE, s[2 * 17] * W8SCALE, s[3 * 17] * W8SCALE);     o.y = pk4_fp8(s[4 * 17] * W8SCALE, s[5 * 17] * W8SCALE, s[6 * 17] * W8SCALE, s[7 * 17] * W8SCALE);
    o.z = pk4_fp8(s[8 * 17] * W8SCALE, s[9 * 17] * W8SCALE, s[10 * 17] * W8SCALE, s[11 * 17] * W8SCALE); o.w = pk4_fp8(s[12 * 17] * W8SCALE, s[13 * 17] * W8SCALE, s[14 * 17] * W8SCALE, s[15 * 17] * W8SCALE);
    *(GAS u32x4*)(d.WT + (size_t)(16 * d.nb + n) * 512 + 64 * d.kb + 16 * c) = o;
    LDS_WAIT(); asm volatile("" ::: "memory");
}
__device__ __forceinline__ void p0_prologue(Frame& F) {
    const int tid_ = otid(F.wave), lane_ = tid_ & 63;
    LAS float* scr = (LAS float*)(F.lds + F.wave * 16384);
    const int gw = F.vcu * 8 + F.wave, NGW = F.G * 8;
    unsigned char* ws = F.ws;
    constexpr int NITEMS = 16 * 96 + 16 * 32 + 16 * 96 + 16 * 48 + 8 * 32 + 2 * 32 * 256;
    {
        f32x4 va[8], vb[8], vc_[8]; float ga[8], gb[8], gc[8]; P0D da, db, dc;
        int it = gw;
        if (it < NITEMS) { da = p0_decode(it, ws); p0_load(da, lane_, va, ga); }
        if (it + NGW < NITEMS) { db = p0_decode(it + NGW, ws); p0_load(db, lane_, vb, gb); }
        while (it < NITEMS) {
            if (it + 2 * NGW < NITEMS) { dc = p0_decode(it + 2 * NGW, ws); p0_load(dc, lane_, vc_, gc); }
            p0_store(da, lane_, va, ga, scr);
            if (it + NGW >= NITEMS) break;
            if (it + 3 * NGW < NITEMS) { da = p0_decode(it + 3 * NGW, ws); p0_load(da, lane_, va, ga); }
            p0_store(db, lane_, vb, gb, scr);
            if (it + 2 * NGW >= NITEMS) break;
            if (it + 4 * NGW < NITEMS) { db = p0_decode(it + 4 * NGW, ws); p0_load(db, lane_, vb, gb); }
            p0_store(dc, lane_, vc_, gc, scr);
            it += 3 * NGW;
        }
    }
    const int gt = gw * 64 + lane_, NGT = NGW * 64;
    { const float* an = INP(1); const float* awin = INP(2);
    for (int e = gt; e < 16 * 1024; e += NGT) { const int n = e >> 10, k = e & 1023; ((bf16_t*)(ws + WS_WF))[e] = (bf16_t)f2bf(an[k] * awin[(size_t)k * 3088 + 3072 + n]); } }
    const float* fn_ = INP(15); const float* wexp_ = INP(18); const float* wgrp_ = INP(16);
    for (int e = gt; e < 2 * 32 * 1024; e += NGT) { const int l = e >> 15, n = (e >> 10) & 31, k = e & 1023;
        float v = 0.f;
        if (n < 16) v = fn_[l * 1024 + k] * wexp_[((size_t)l * 1024 + k) * 16 + n];
        else if (n < 20) v = fn_[l * 1024 + k] * wgrp_[((size_t)l * 1024 + k) * 4 + (n - 16)];
        const unsigned hb = f2bf(v); const float lo = v - bf2f(hb);
        bf16_t* wr = (bf16_t*)(ws + WS_WR) + (size_t)l * 2 * 32 * 1024;
        wr[n * 1024 + k] = (bf16_t)hb; wr[32 * 1024 + n * 1024 + k] = (bf16_t)f2bf(lo); }
    if (gt < 6 * 64) { const int sgi = gt >> 6, d = gt & 63; float v = 1.0f;
        if (sgi == 0) v = INP(4)[d] * C2; else if (sgi == 1) v = INP(5)[d]; else if (sgi == 3) v = INP(9)[d]; else if (sgi == 5) v = INP(13)[d] * C2;
        ((float*)(ws + WS_GTAB))[gt] = v; }
    const float* x_ = INP(0);
    {
        f32x4 v[4], vn[4], vm[4];
        int m = gw;
        if (m < NTOK) { const GAS f32x4* xr = (const GAS f32x4*)(x_ + (size_t)m * DM) + lane_;
#pragma unroll
            for (int jj = 0; jj < 4; ++jj) v[jj] = xr[64 * jj]; }
        if (m + NGW < NTOK) { const GAS f32x4* xr = (const GAS f32x4*)(x_ + (size_t)(m + NGW) * DM) + lane_;
#pragma unroll
            for (int jj = 0; jj < 4; ++jj) vn[jj] = xr[64 * jj]; }
        while (m < NTOK) {
            if (m + 2 * NGW < NTOK) { const GAS f32x4* xr = (const GAS f32x4*)(x_ + (size_t)(m + 2 * NGW) * DM) + lane_;
#pragma unroll
                for (int jj = 0; jj < 4; ++jj) vm[jj] = xr[64 * jj]; }
            float sq = 0.f;
#pragma unroll
            for (int jj = 0; jj < 4; ++jj) sq += (v[jj].x * v[jj].x + v[jj].y * v[jj].y) + (v[jj].z * v[jj].z + v[jj].w * v[jj].w);
            const float rstd = 1.f / sqrtf(wave_sum(sq, lane_) * (1.f / DM) + EPS);
            GAS unsigned long long* o8 = (GAS unsigned long long*)((bf16_t*)(ws + WS_XB) + (size_t)m * DM) + lane_;
#pragma unroll
            for (int jj = 0; jj < 4; ++jj) o8[64 * jj] = (unsigned long long)pk2(v[jj].x, v[jj].y) | ((unsigned long long)pk2(v[jj].z, v[jj].w) << 32);
            GAS unsigned* q8 = (GAS unsigned*)(ws + WS_XB8 + (size_t)m * DM) + lane_;
#pragma unroll
            for (int jj = 0; jj < 4; ++jj) q8[64 * jj] = pk4_fp8(v[jj].x, v[jj].y, v[jj].z, v[jj].w);
            if (lane_ == 0) ((float*)(ws + WS_RSTD0))[m] = rstd;
#pragma unroll
            for (int jj = 0; jj < 4; ++jj) { v[jj] = vn[jj]; vn[jj] = vm[jj]; }
            m += NGW;
        }
    }
}

__device__ __forceinline__ void forget_phase(Frame& F) {
    const int tid_ = otid(F.wave), lane_ = tid_ & 63;
    const bf16_t* XB = (const bf16_t*)(F.ws + WS_XB); const bf16_t* WF = (const bf16_t*)(F.ws + WS_WF);
    const float* RSTD0 = (const float*)(F.ws + WS_RSTD0); const float* b_f = INP(3);
    float* LC = (float*)(F.ws + WS_LC); float* CT = (float*)(F.ws + WS_CT);
    LAS float* wt = (LAS float*)(F.lds + AUX_OFF);
    const int fr = lane_ & 15, fq = lane_ >> 4;
    for (int chunk = blockIdx.x; chunk < NTOK / 128; chunk += F.G) {
        const int row = chunk * 128 + F.wave * 16 + fr;
        const bf16_t* xa = XB + (size_t)row * DM + 8 * fq; const bf16_t* wb = WF + (size_t)fr * DM + 8 * fq;
        f32x4 acc = {0.f, 0.f, 0.f, 0.f};
#pragma unroll 8
        for (int kb = 0; kb < 32; ++kb) { const bf16x8 a = *(const bf16x8*)(xa + 32 * kb), w = *(const bf16x8*)(wb + 32 * kb); acc = __builtin_amdgcn_mfma_f32_16x16x32_bf16(w, a, acc, 0, 0, 0); }
        const float rs = RSTD0[row];
        float lf[4];
#pragma unroll
        for (int i = 0; i < 4; ++i) { const float z = acc[i] * rs + b_f[4 * fq + i]; lf[i] = fminf(z, 0.f) - log1pf(expf(-fabsf(z))); }
#pragma unroll
        for (int off = 1; off < 16; off <<= 1)
#pragma unroll
            for (int i = 0; i < 4; ++i) { const float t = shfl_from(lf[i], lane_ - off); if (fr >= off) lf[i] += t; }
        if (fr == 15) {
#pragma unroll
            for (int i = 0; i < 4; ++i) wt[F.wave * 16 + 4 * fq + i] = lf[i]; }
        __syncthreads();
#pragma unroll
        for (int i = 0; i < 4; ++i) { float p = 0.f; for (int w = 0; w < F.wave; ++w) p += wt[w * 16 + 4 * fq + i]; lf[i] += p; }
        const int b = row >> 13, s = row & (SEQ - 1);
#pragma unroll
        for (int i = 0; i < 4; ++i) LC[(size_t)(b * 16 + 4 * fq + i) * SEQ + s] = lf[i];
        if (F.wave == 7 && fr == 15) {
#pragma unroll
            for (int i = 0; i < 4; ++i) CT[(b * 16 + 4 * fq + i) * 64 + ((chunk * 128) & (SEQ - 1)) / 128] = lf[i]; }
        __syncthreads();
    }
}

__device__ __forceinline__ void attnA_phase(Frame& F, unsigned char* ldsg) {
    const int tid_ = otid(F.wave), lane_ = tid_ & 63;
    LAS float* NCK = (LAS float*)(F.lds + attn_body::LDS_NCK);
    LAS float* CPs = (LAS float*)(F.lds + AUX_OFF);
    volatile LAS int* ctl = (volatile LAS int*)(F.lds + AUX_OFF + 256);
    const float* LC = (const float*)(F.ws + WS_LC); const float* CT = (const float*)(F.ws + WS_CT);
    float mqk = 0.f;
    { const float* gq_ = INP(4); const float* gk_ = INP(5);
      for (int d = 0; d < 64; ++d) mqk = fmaxf(mqk, fabsf(gq_[d] * gk_[d])); }
    const float thr2 = (40.f + 2.f * 8.f * mqk * 1.03f) * LOG2E;
    unsigned* queue = (unsigned*)(F.ctl + CW_QUEUE);
    for (;;) {
        if (tid_ == 0) ctl[0] = (int)__hip_atomic_fetch_add(queue, 1u, RLX_AGENT);
        __syncthreads();
        const int u = ctl[0];
        if (u >= NBATCH * 16 * 32) break;
        const int qb = 31 - (u >> 6), bh = u & 63, b = bh >> 4, h = bh & 15, q0 = qb * 256, NTf = 4 * qb + 4, nkeys = q0 + 256;
        const float* lcp = LC + (size_t)bh * SEQ;
        f32x4 dva[4]; const P0H ddi = p0h_decode(8 * u + F.wave, F.ws); p0h_load(ddi, lane_, dva);
        if (F.wave == 0) { const float c = CT[bh * 64 + lane_]; float v = c;
#pragma unroll
            for (int off = 1; off < 64; off <<= 1) { const float t = shfl_from(v, lane_ - off); if (lane_ >= off) v += t; }
            const float excl = v - c; CPs[lane_] = excl;
            const float cumq = shfl_from(excl, q0 >> 7) + lcp[q0];
            const bool need = (lane_ <= (q0 >> 7)) && ((cumq - v) * LOG2E >= -thr2);
            const unsigned long long bm = __builtin_amdgcn_ballot_w64(need);
            int t0 = 2 * (int)__builtin_ctzll(bm | (1ull << 63)); t0 = t0 < NTf - 4 ? t0 : NTf - 4;
            if (lane_ == 0) ctl[1] = t0; }
        __syncthreads();
        const int T0 = ctl[1];
        const float cpq = CPs[q0 >> 7], lcq = lcp[q0];
        for (int s = 64 * T0 + tid_; s < nkeys; s += 512) NCK[s] = ((cpq - CPs[s >> 7]) + (lcq - lcp[s])) * LOG2E;
        __syncthreads();
        { const size_t ho = ((size_t)b * SEQ * 1024 + h * 64) * 2;
          attn_body::attn_unit<8, false>(qb, T0, 1024, (const attn_body::bf16*)(F.ws + WS_QA + ho), (const attn_body::bf16*)(F.ws + WS_KA + ho), (const attn_body::bf16*)(F.ws + WS_VA + ho), (attn_body::bf16*)(F.ws + WS_QA + ho), (char*)ldsg, F.wave); }
        p0h_store(ddi, lane_, dva, (LAS float*)(F.lds + F.wave * 8192));
    }
}

__device__ __forceinline__ void router_phase(Frame& F, int layer, const float* stats, float* rstd_out) {
    const int tid_ = otid(F.wave), lane_ = tid_ & 63;
    const bf16_t* XBr = (const bf16_t*)(F.ws + WS_XB); unsigned char* XN8 = (unsigned char*)(F.ws + WS_XN8); const bf16_t* WR = (const bf16_t*)(F.ws + WS_WR) + (size_t)layer * 2 * 32 * 1024;
    const float* b_group = INP(17) + layer * 4; const float* b_expert = INP(19) + layer * 16;
    float* GSORT = (float*)(F.ws + WS_GSORT); int* PERM = (int*)(F.ws + WS_PERM);
    unsigned* CNT = (unsigned*)(F.ctl + (layer == 0 ? CW_CNT0 : CW_CNT1));
    volatile LAS int* lcnt = (volatile LAS int*)(F.lds + AUX_OFF);
    const int fr = lane_ & 15, fq = lane_ >> 4;
#pragma unroll
    for (int p = 0; p < 16; ++p) { const int off = p * 8192 + tid_ * 16, n = off >> 11, pc = (off >> 4) & 127;
        __builtin_amdgcn_global_load_lds((const unsigned*)((const char*)WR + n * 2048 + ((pc ^ (n & 15)) << 4)), (LAS unsigned*)(F.lds + p * 8192 + F.wave * 1024), 16, 0, 0); }
    for (int chunk = blockIdx.x; chunk < NTOK / 128; chunk += F.G) {
        if (tid_ < 64) lcnt[tid_] = 0;
        VM_WAIT();
        __syncthreads();
        const int row = chunk * 128 + F.wave * 16 + fr;
        float ss; { const f32x4 p = *(const GAS f32x4*)(stats + (size_t)row * 16 + 4 * fq); ss = (p[0] + p[1]) + (p[2] + p[3]); ss += shfl_x(ss, 16 * fq + fr, 16); ss += shfl_x(ss, 16 * fq + fr, 32); }
        const float rs = 1.0f / sqrtf(ss * (1.0f / 1024.0f) + EPS);
        const bf16_t* hp = XBr + (size_t)row * DM + 8 * fq;
        unsigned char* x8 = XN8 + (size_t)row * DM + 8 * fq;
        const LAS unsigned char* wl = F.lds + fr * 2048;
        f32x4 a0 = {0.f, 0.f, 0.f, 0.f}, a1 = {0.f, 0.f, 0.f, 0.f};
#pragma unroll 4
        for (int kb = 0; kb < 32; ++kb) {
            const bf16x8 xh = *(const bf16x8*)(hp + 32 * kb);
            const int wc_ = ((4 * kb + fq) ^ fr) << 4;
            const bf16x8 wh0 = *(const LAS bf16x8*)(wl + wc_), wl0 = *(const LAS bf16x8*)(wl + 32 * 2048 + wc_);
            const bf16x8 wh1 = *(const LAS bf16x8*)(wl + 16 * 2048 + wc_), wl1 = *(const LAS bf16x8*)(wl + 48 * 2048 + wc_);
            a0 = __builtin_amdgcn_mfma_f32_16x16x32_bf16(wh0, xh, a0, 0, 0, 0); a0 = __builtin_amdgcn_mfma_f32_16x16x32_bf16(wl0, xh, a0, 0, 0, 0);
            a1 = __builtin_amdgcn_mfma_f32_16x16x32_bf16(wh1, xh, a1, 0, 0, 0); a1 = __builtin_amdgcn_mfma_f32_16x16x32_bf16(wl1, xh, a1, 0, 0, 0);
            u32x2 q8; q8.x = pk4_fp8(bf2f((unsigned short)xh[0]) * rs, bf2f((unsigned short)xh[1]) * rs, bf2f((unsigned short)xh[2]) * rs, bf2f((unsigned short)xh[3]) * rs);
            q8.y = pk4_fp8(bf2f((unsigned short)xh[4]) * rs, bf2f((unsigned short)xh[5]) * rs, bf2f((unsigned short)xh[6]) * rs, bf2f((unsigned short)xh[7]) * rs);
            *(u32x2*)(x8 + 32 * kb) = q8;
        }
        if (fq == 0) ((GAS float*)rstd_out)[row] = rs;
        float gl[4]; int gidx = 0; float gval = 0.f;
        {
#pragma unroll
            for (int i = 0; i < 4; ++i) gl[i] = a1[i] * rs + b_group[i];
            const float mx = fmaxf(fmaxf(gl[0], gl[1]), fmaxf(gl[2], gl[3]));
            float ex[4], sum = 0.f;
#pragma unroll
            for (int i = 0; i < 4; ++i) { ex[i] = expf(gl[i] - mx); sum += ex[i]; }
            float best = -1.f;
#pragma unroll
            for (int i = 0; i < 4; ++i) { const float p = ex[i] / sum; if (p > best) { best = p; gidx = i; } }
            gval = best;
        }
        gidx = shfl_from(gidx, fr); gval = shfl_from(gval, fr);
        int cls = -1, rank = 0; float gwlo = 0.f, gwhi = 0.f;
        if (fq == gidx) {
            float el[4];
#pragma unroll
            for (int i = 0; i < 4; ++i) el[i] = a0[i] * rs + b_expert[4 * fq + i];
            const float mx = fmaxf(fmaxf(el[0], el[1]), fmaxf(el[2], el[3]));
            float pr[4], sum = 0.f;
#pragma unroll
            for (int i = 0; i < 4; ++i) { pr[i] = expf(el[i] - mx); sum += pr[i]; }
#pragma unroll
            for (int i = 0; i < 4; ++i) pr[i] = pr[i] / sum;
            int i1 = 0; float p1 = -1.f;
#pragma unroll
            for (int i = 0; i < 4; ++i) if (pr[i] > p1) { p1 = pr[i]; i1 = i; }
            int i2 = 0; float p2 = -1.f;
#pragma unroll
            for (int i = 0; i < 4; ++i) if (i != i1 && pr[i] > p2) { p2 = pr[i]; i2 = i; }
            const float den = p1 + p2; const float w1g = gval * (p1 / den), w2g = gval * (p2 / den);
            const int lo = i1 < i2 ? i1 : i2, hi = i1 < i2 ? i2 : i1;
            const float wlo = i1 < i2 ? w1g : w2g, whi = i1 < i2 ? w2g : w1g;
            const int pidx = (lo == 0) ? hi - 1 : (lo == 1) ? hi + 1 : 5;
            cls = 6 * gidx + pidx;
            gwlo = wlo; gwhi = whi;
            rank = __hip_atomic_fetch_add((LAS int*)&lcnt[cls], 1, __ATOMIC_RELAXED, __HIP_MEMORY_SCOPE_WORKGROUP);
        }
        __syncthreads();
        if (tid_ < NCLASS) lcnt[32 + tid_] = (int)__hip_atomic_fetch_add(CNT + tid_, (unsigned)lcnt[tid_], RLX_AGENT);
        __syncthreads();
        if (cls >= 0) { const size_t p_ = (size_t)cls * CAP + lcnt[32 + cls] + rank; PERM[p_] = row; *(f32x2*)(GSORT + 2 * p_) = (f32x2){gwlo, gwhi}; }
        __syncthreads();
    }
}
__device__ __forceinline__ void moe_tile_prefix(Frame& F, const int* cnt, volatile LAS int* TP) {
    const int tid_ = otid(F.wave), lane_ = tid_ & 63;
    __syncthreads();
    if (tid_ == 0) { int acc = 0; for (int c = 0; c < NCLASS; ++c) { TP[c] = acc; acc += (cnt[c] + 255) >> 8; } TP[NCLASS] = acc; }
    __syncthreads();
}

__device__ __forceinline__ void dilated_phase(Frame& F, unsigned char* ldsg) {
    const int tid_ = otid(F.wave);
    LAS float* tb = (LAS float*)(F.lds + attn_body::LDS_NCK);
    const int per = (3072 + F.G - 1) / F.G;
    int gjprev = -1, rho = 0; bool primed = false; bf16x8 qn[4];
    for (int i = 0; i < per; ++i) {
        const int u = blockIdx.x * per + i; if (u >= 3072) break;
        const int g = u >> 10, v = u & 1023, j = v >> 7, b = (v >> 5) & 3, x = v & 31;
        const int D4 = 2 * g, d = 1 << D4, r = x & (d - 1), qb = x >> D4;
        unsigned long long pl_t = 0ull; if (PROBE_A == 5) pl_t = __builtin_amdgcn_s_memrealtime();
        if (g * 8 + j != gjprev) { __syncthreads(); dil::build_table(tb, INP(10), g, d, j, tid_); __syncthreads(); gjprev = g * 8 + j; }
        if (!primed) VM_WAIT();
        __syncthreads();
        if (PROBE_A == 5) { const unsigned d_ = (unsigned)(__builtin_amdgcn_s_memrealtime() - pl_t); if (tid_ == 0) ((LAS unsigned*)(F.lds + MISC_OFF))[121] += d_; }
        const size_t ho = (((size_t)(8 * g + j) * NTOK + (size_t)b * SEQ + (size_t)r * (SEQ >> D4)) * 64) * 2;
        const int T0 = qb == 0 ? 0 : 4 * qb - 2;
        attn_body::Xpf xp{}; xp.primed = primed; xp.has_next = (i + 1 < per) && (u + 1 < 3072);
        if (xp.has_next) { const int u2 = u + 1, g2 = u2 >> 10, v2 = u2 & 1023, j2 = v2 >> 7, b2 = (v2 >> 5) & 3, x2 = v2 & 31;
            const int D42 = 2 * g2, d2 = 1 << D42, r2 = x2 & (d2 - 1), qb2 = x2 >> D42, T02 = qb2 == 0 ? 0 : 4 * qb2 - 2;
            const size_t ho2 = (((size_t)(8 * g2 + j2) * NTOK + (size_t)b2 * SEQ + (size_t)r2 * (SEQ >> D42)) * 64) * 2; xp.Pn = 64;
            xp.Qn = (const attn_body::bf16*)(F.ws + WS_QB + ho2) + (long)qb2 * 256 * xp.Pn;
            xp.Kn = (const attn_body::bf16*)(F.ws + WS_KB + ho2) + (long)T02 * 64 * xp.Pn; xp.Vn = (const attn_body::bf16*)(F.ws + WS_VB + ho2) + (long)T02 * 64 * xp.Pn; }
        attn_body::attn_unit_x<8, true, true>(qb, T0, 64, (const attn_body::bf16*)(F.ws + WS_QB + ho), (const attn_body::bf16*)(F.ws + WS_KB + ho), (const attn_body::bf16*)(F.ws + WS_VB + ho),
                                      (attn_body::bf16*)(F.ws + WS_QB + ho), (char*)ldsg, F.wave, (float*)(F.ws + WS_DPML) + (size_t)(g * 8 + j) * NTOK * 2, (long)b * SEQ + r, d, xp, qn, rho);
        primed = xp.has_next;
    }
}
__device__ __forceinline__ void dilated_merge(Frame& F) {
    const int tid_ = otid(F.wave);
    bf16_t* QB = (bf16_t*)(F.ws + WS_QB); const float* PML = (const float*)(F.ws + WS_DPML);
    for (size_t it = (size_t)blockIdx.x * 512 + tid_; it < (size_t)NTOK * 64; it += (size_t)F.G * 512) {
        const int ch = (int)(it & 7), j = (int)((it >> 3) & 7); const size_t tok = it >> 6;
        f32x2 ml[3]; u32x4 o[3];
#pragma unroll
        for (int g = 0; g < 3; ++g) { ml[g] = *(const f32x2*)(PML + ((size_t)(g * 8 + j) * NTOK + tok) * 2); o[g] = *(const u32x4*)(QB + ((size_t)(8 * g + j) * NTOK + pg8::dil_row((int)tok, 2 * g)) * 64 + 8 * ch); }
        const float M = fmaxf(fmaxf(ml[0][0], ml[1][0]), ml[2][0]);
        float f[3], L = 0.f;
#pragma unroll
        for (int g = 0; g < 3; ++g) { f[g] = __builtin_amdgcn_exp2f(ml[g][0] - M); L += f[g] * ml[g][1]; }
        const float rl = 1.0f / L;
        float r8[8];
#pragma unroll
        for (int e = 0; e < 4; ++e) { float lo = 0.f, hh = 0.f;
#pragma unroll
            for (int g = 0; g < 3; ++g) { lo += bf2f(o[g][e] & 0xffffu) * f[g]; hh += bf2f(o[g][e] >> 16) * f[g]; }
            r8[2 * e] = lo * rl; r8[2 * e + 1] = hh * rl; }
        u32x2 q8; q8.x = pk4_fp8(r8[0], r8[1], r8[2], r8[3]); q8.y = pk4_fp8(r8[4], r8[5], r8[6], r8[7]);
        *(GAS u32x2*)(F.ws + WS_XB8 + tok * 512 + 64 * j + 8 * ch) = q8;
    }
}

struct Args { const float* in[23]; float* out; unsigned char* ws; };
__global__ void __launch_bounds__(512, 2) fwd_kernel(Args args) {
    extern __shared__ __attribute__((aligned(16))) unsigned char lds[];
    Frame F;
    F.lds = (LAS unsigned char*)lds;
    F.MISC = (volatile LAS unsigned*)(F.lds + MISC_OFF);
    F.wave = __builtin_amdgcn_readfirstlane((int)threadIdx.x >> 6);
    F.G = gridDim.x; { const int bx = blockIdx.x; F.vcu = (F.G % 8 == 0) ? (bx % 8) * (F.G / 8) + bx / 8 : bx; }
    F.out = args.out; F.ws = args.ws;
    F.ctl = (gu32*)(args.ws + WS_CTL);
    for (int u = otid(F.wave); u < 128; u += 512) ((LAS unsigned*)(F.lds + MISC_OFF))[u] = 0u;
    __syncthreads();
    XcdBarrier bar = xcd_barrier_post((unsigned*)(F.ctl + CW_BAR), F.MISC + 8, F.wave == 0 && lane_id() == 0);
#define GRID_BAR() xcd_barrier(bar, F.wave == 0 && lane_id() == 0)
#ifndef RUN_FROM
#define RUN_FROM 0
#endif
#define RUN(k) ((k) <= RUN_UPTO && (k) >= RUN_FROM)
#ifndef PROBE_MASK
#define PROBE_MASK 0
#endif
    unsigned long long pr_acc = 0ull, pr_t0 = 0ull;
#define PR_BEGIN(k) do { if ((PROBE_MASK >> (k)) & 1) pr_t0 = __builtin_amdgcn_s_memrealtime(); } while (0)
#define PR_END(k) do { if ((PROBE_MASK >> (k)) & 1) pr_acc += __builtin_amdgcn_s_memrealtime() - pr_t0; } while (0)

#define ws opq_ptr(F.ws)
#define XB ((bf16_t*)(ws + WS_XB))
#define H (F.out)
#define TP ((volatile LAS int*)(F.lds + AUX_OFF + 1024))

    PR_BEGIN(0); if (RUN(0)) { p0_prologue(F); GRID_BAR(); } PR_END(0);

    PR_BEGIN(1);
    if (RUN(1)) {
        pg8::GemmP g{(const void*)(ws + WS_XB8), 1024, 1024, 1 << 20, 32, (PROBE_KSEL >> 1) & 1};
        pg8::DenseSched S; S.so.init(NTOK, 3072, F.G, (int)blockIdx.x); S.Bt = (const bf16_t*)(ws + WS_WQKVA); S.lda = 512; S.ldb = 512;
        pg8::EpiHead E{(bf16_t*)(ws + WS_QA), (size_t)(WS_KA - WS_QA) / 2, (const float*)(ws + WS_GTAB), 2, 4, 8, 1024, (const float*)(ws + WS_RSTD0), nullptr, 1.0f / W8SCALE};
        pg8::gemm_phase<pg8::EpiHead, pg8::DenseSched, true>(F.lds, g, S, E, F.wave);
        forget_phase(F);
        GRID_BAR();
    }
    PR_END(1); PR_BEGIN(2);
    if (RUN(2)) { attnA_phase(F, lds); GRID_BAR(); }
    PR_END(2); PR_BEGIN(3);
    if (RUN(3)) {
        pg8::GemmP g{(const bf16_t*)(ws + WS_QA), 2048, 2048, 1 << 20, 128, (PROBE_KSEL >> 3) & 1};
        pg8::DenseSched S; S.so.init(NTOK, 1024, F.G, (int)blockIdx.x); S.Bt = (const bf16_t*)(ws + WS_WOA); S.lda = 1024; S.ldb = 1024;
        pg8::EpiResid E{XB, (float*)(ws + WS_STATS1), 1.0f};
        pg8::gemm_phase<pg8::EpiResid, pg8::DenseSched>(F.lds, g, S, E, F.wave);
        GRID_BAR();
    }
    PR_END(3);
#define MOE_LAYER(PH, layer, STATS_IN, RSTD_BUF, CW_CNT, LASTL, STATS_OUT) \
    PR_BEGIN(PH); if (RUN(PH)) { router_phase(F, layer, (const float*)(ws + STATS_IN), (float*)(ws + RSTD_BUF)); GRID_BAR(); } PR_END(PH); PR_BEGIN(PH + 1); \
    if (RUN(PH + 1)) { \
        const int* cnt = (const int*)(F.ctl + CW_CNT); moe_tile_prefix(F, cnt, TP); \
        pg8::GemmP g{(const void*)ws, 1024, 1024, 1 << 20, 512, (PROBE_KSEL >> (PH + 1)) & 1}; \
        pg8::MoeMixSched S{TP, cnt, (const int*)(ws + WS_PERM), (const unsigned char*)(ws + WS_WGU) + (size_t)layer * 16 * 1024 * 1024, (const unsigned char*)(ws + WS_WD) + (size_t)layer * 16 * 1024 * 512, \
                           F.G, (int)blockIdx.x, __builtin_amdgcn_readfirstlane(TP[NCLASS]), (unsigned*)(F.ctl + CW_DONE + layer * 16384), (unsigned*)(F.ctl + CW_BAR) + XB_TMO}; \
        pg8::EpiMoe<LASTL> E{pg8::EpiSwiglu{(unsigned char*)(ws + WS_HID), (const float*)(ws + WS_GSORT)}, \
                             pg8::EpiScatter<LASTL>{XB, H, STATS_OUT, (const int*)(ws + WS_PERM), 1.0f / (W8SCALE * H8SCALE)}}; \
        pg8::gemm_phase<pg8::EpiMoe<LASTL>, pg8::MoeMixSched, true>(F.lds, g, S, E, F.wave); \
        if (!(LASTL)) GRID_BAR(); } PR_END(PH + 1);
    MOE_LAYER(4, 0, WS_STATS1, WS_RSTD1, CW_CNT0, false, (float*)(ws + WS_STATS2))
    PR_BEGIN(7);
    if (RUN(7)) {
        pg8::GemmP g{(const void*)(ws + WS_XB8), 1024, 1024, 1 << 20, 32, (PROBE_KSEL >> 7) & 1};
        pg8::DenseSched S; S.so.init(NTOK, 4608, F.G, (int)blockIdx.x); S.Bt = (const bf16_t*)(ws + WS_WKVQ); S.lda = 512; S.ldb = 512;
        pg8::EpiHead E{(bf16_t*)(ws + WS_KB), (size_t)(WS_VB - WS_KB) / 2, (const float*)(ws + WS_GTAB) + 3 * 64, 1, 6, 12, KVW, nullptr, (const float*)(ws + WS_STATS2), 1.0f / W8SCALE, 1};
        pg8::gemm_phase<pg8::EpiHead, pg8::DenseSched, true>(F.lds, g, S, E, F.wave);
        GRID_BAR();
    }
    PR_END(7); PR_BEGIN(8);
    if (RUN(8)) { dilated_phase(F, lds); GRID_BAR(); dilated_merge(F); GRID_BAR(); }
    PR_END(8); PR_BEGIN(9);
    if (RUN(9)) {
        pg8::GemmP g{(const void*)(ws + WS_XB8), 512, 512, 1 << 20, 128, (PROBE_KSEL >> 9) & 1};
        pg8::DenseSched S; S.so.init(NTOK, 1024, F.G, (int)blockIdx.x); S.Bt = (const bf16_t*)(ws + WS_WOB); S.lda = 256; S.ldb = 256;
        pg8::EpiResid E{XB, (float*)(ws + WS_STATS3), 1.0f / W8SCALE};
        pg8::gemm_phase<pg8::EpiResid, pg8::DenseSched, true>(F.lds, g, S, E, F.wave);
        GRID_BAR();
    }
    PR_END(9);
    MOE_LAYER(10, 1, WS_STATS3, WS_RSTD3, CW_CNT1, true, (float*)nullptr)

#if RUN_UPTO < 12
    { const int gt = (blockIdx.x * 512 + otid(F.wave)); const f32x4* xs = (const f32x4*)INP(0); f32x4* od = (f32x4*)F.out;
      for (size_t e = gt; e < (size_t)NTOK * DM / 4; e += (size_t)F.G * 512) od[e] = xs[e]; }
#endif
    if (PROBE_K != 0) pr_acc += ((LAS unsigned*)(F.lds + MISC_OFF))[120];
    if (PROBE_A != 0) pr_acc += ((LAS unsigned*)(F.lds + MISC_OFF))[121];
    if (PROBE_MASK != 0 && blockIdx.x == 0 && otid(F.wave) == 0) { const unsigned long long t1 = __builtin_amdgcn_s_memrealtime(); while (__builtin_amdgcn_s_memrealtime() - t1 < pr_acc) __builtin_amdgcn_s_sleep(8); }
    if (__hip_atomic_load((unsigned*)(F.ctl + CW_BAR) + XB_TMO, RLX_AGENT) != 0u) {
        const int gt = (blockIdx.x * 512 + otid(F.wave)); const float q = __builtin_nanf("");
        for (size_t e = gt; e < (size_t)NTOK * DM; e += (size_t)F.G * 512) F.out[e] = q;
    }
}

#undef ws
#undef XB
#undef H
#undef TP
extern "C" void kernel_launch(void* const* d_in, const int* in_sizes, int n_in, void* d_out, int out_size, void* d_ws, size_t ws_size, hipStream_t stream) {
    static int grid = 0;
    if (grid == 0) {
        if (n_in != 23 || in_sizes[0] != NTOK * DM || out_size != NTOK * DM || ws_size < WS_END) { fprintf(stderr, "kernel_launch: unexpected shapes (n_in %d, in0 %d, out %d, ws %zu)\n", n_in, n_in > 0 ? in_sizes[0] : -1, out_size, ws_size); grid = -1; return; }
        int dev = 0, cus = 0, per_cu = 0;
        if (hipGetDevice(&dev) != hipSuccess || hipDeviceGetAttribute(&cus, hipDeviceAttributeMultiprocessorCount, dev) != hipSuccess) { grid = -1; return; }
        if (hipFuncSetAttribute((const void*)fwd_kernel, hipFuncAttributeMaxDynamicSharedMemorySize, LDS_BYTES) != hipSuccess) { fprintf(stderr, "kernel_launch: hipFuncSetAttribute failed\n"); grid = -1; return; }
        if (hipOccupancyMaxActiveBlocksPerMultiprocessor(&per_cu, (const void*)fwd_kernel, 512, LDS_BYTES) != hipSuccess || per_cu < 1) fprintf(stderr, "kernel_launch: occupancy query reports %d\n", per_cu);
        (void)hipGetLastError();
        grid = cus;
    }
    if (grid < 0) return;
    if (hipMemsetAsync((char*)d_ws + WS_CTL, 0, CTL_ZERO_BYTES, stream) != hipSuccess) return;
    Args a{};
    for (int i = 0; i < 23; ++i) a.in[i] = (const float*)d_in[i];
    a.out = (float*)d_out; a.ws = (unsigned char*)d_ws;
    hipLaunchKernelGGL(fwd_kernel, dim3(grid), dim3(512), LDS_BYTES, stream, a);
}
```

```cpp
#include <hip/hip_runtime.h>
#include <hip/hip_bf16.h>
#include <cstdio>
#include <cstdint>
#include <cmath>

#ifndef RUN_UPTO
#define RUN_UPTO 99
#endif

#define GAS __attribute__((address_space(1)))
#define LAS __attribute__((address_space(3)))
typedef unsigned short bf16_t;
typedef short bf16x8 __attribute__((ext_vector_type(8)));
typedef float f32x2 __attribute__((ext_vector_type(2)));
typedef float f32x4 __attribute__((ext_vector_type(4)));
typedef float f32x16 __attribute__((ext_vector_type(16)));
typedef unsigned u32x2 __attribute__((ext_vector_type(2)));
typedef unsigned u32x4 __attribute__((ext_vector_type(4)));
typedef short s16x4 __attribute__((ext_vector_type(4)));
typedef int i32x4 __attribute__((ext_vector_type(4)));
typedef int i32x8 __attribute__((ext_vector_type(8)));
typedef GAS unsigned gu32;

constexpr int NTOK = 32768, DM = 1024, SEQ = 8192, NBATCH = 4;
constexpr int KVW = 1536;
constexpr float EPS = 1e-6f;
constexpr float LOG2E = 1.4426950408889634f;
constexpr float C2 = 0.125f * LOG2E;
constexpr int NCLASS = 24, CAP = 32768;

constexpr size_t MiB = 1u << 20;
constexpr size_t WS_CTL = 0, CTL_ZERO_BYTES = 256 * 1024;
constexpr size_t WS_RSTD0 = 2 * MiB, WS_RSTD1 = 2 * MiB + 128 * 1024, WS_RSTD3 = 2 * MiB + 256 * 1024;
constexpr size_t WS_STATS1 = 3 * MiB, WS_STATS2 = 5 * MiB, WS_STATS3 = 7 * MiB;
constexpr size_t WS_GATES = 9 * MiB;
constexpr size_t WS_LC = 10 * MiB;
constexpr size_t WS_CT = 12 * MiB;
constexpr size_t WS_WF = 12 * MiB + 64 * 1024;
constexpr size_t WS_WR = 12 * MiB + 128 * 1024;
constexpr size_t WS_GTAB = 12 * MiB + 32 * 1024;
constexpr size_t WS_PERM = 13 * MiB;
constexpr size_t WS_WQKVA = 16 * MiB, WS_WOA = 22 * MiB, WS_WKVQ = 24 * MiB, WS_WOB = 33 * MiB;
constexpr size_t WS_WGU = 34 * MiB;
constexpr size_t WS_XB8 = 66 * MiB;
constexpr size_t WS_DPML = 114 * MiB;
constexpr size_t WS_WD = 98 * MiB;
constexpr size_t WS_GSORT = 120 * MiB;
constexpr size_t WS_XB = 132 * MiB;
constexpr size_t WS_R = 196 * MiB;
constexpr size_t WS_QA = WS_R, WS_KA = WS_R + 64 * MiB, WS_VA = WS_R + 128 * MiB;
constexpr size_t WS_HID = WS_R;
constexpr size_t WS_XN8 = WS_R + 44 * MiB;
constexpr size_t WS_KB = WS_R, WS_VB = WS_R + 96 * MiB, WS_QB = WS_R + 192 * MiB;
constexpr size_t WS_END = WS_R + 288 * MiB;
constexpr int CW_BAR = 4096, CW_QUEUE = 8192, CW_CNT0 = 9216, CW_CNT1 = 9216 + 64, CW_DONE = 32768;

constexpr int RING_BYTES = 131072;
constexpr int MISC_OFF = RING_BYTES;
constexpr int AUX_OFF = RING_BYTES + 512;
constexpr int LDS_BYTES = 155648;
constexpr int AUX_BYTES = LDS_BYTES - AUX_OFF;

#define LDS_WAIT() asm volatile("s_waitcnt lgkmcnt(0)" ::: "memory")
#define VM_WAIT() asm volatile("s_waitcnt vmcnt(0)" ::: "memory")
#define RLX_AGENT __ATOMIC_RELAXED, __HIP_MEMORY_SCOPE_AGENT

__device__ __forceinline__ int lane_id() { int l; asm volatile("v_mbcnt_lo_u32_b32 %0, -1, 0\n\tv_mbcnt_hi_u32_b32 %0, -1, %0" : "=v"(l)); return l; }
__device__ __forceinline__ void st16_wt(void* p, u32x4 v) { asm volatile("global_store_dwordx4 %0, %1, off sc1\n\ts_nop 2" :: "v"((GAS void*)p), "v"(v) : "memory"); }
__device__ __forceinline__ void st8_wt(void* p, u32x2 v) { asm volatile("global_store_dwordx2 %0, %1, off sc1" :: "v"((GAS void*)p), "v"(v) : "memory"); }
__device__ __forceinline__ float shfl_from(float v, int srclane) { return __int_as_float(__builtin_amdgcn_ds_bpermute(srclane << 2, __float_as_int(v))); }
__device__ __forceinline__ int shfl_from(int v, int srclane) { return __builtin_amdgcn_ds_bpermute(srclane << 2, v); }
__device__ __forceinline__ float shfl_x(float v, int lane, int mask) { return shfl_from(v, lane ^ mask); }
__device__ __forceinline__ unsigned f2bf(float f) { unsigned u = __builtin_bit_cast(unsigned, f); return (u + 0x7fffu + ((u >> 16) & 1u)) >> 16; }
__device__ __forceinline__ float bf2f(unsigned b) { return __builtin_bit_cast(float, b << 16); }
__device__ __forceinline__ unsigned pk2(float lo, float hi) { return f2bf(lo) | (f2bf(hi) << 16); }
__device__ __forceinline__ unsigned pk4_fp8(float a, float b, float c, float d) { int v = 0; v = __builtin_amdgcn_cvt_pk_fp8_f32(a, b, v, false); v = __builtin_amdgcn_cvt_pk_fp8_f32(c, d, v, true); return (unsigned)v; }
constexpr float W8SCALE = 32.0f, H8SCALE = 16.0f;
__device__ __forceinline__ unsigned cvt_pk_bf16(float lo, float hi) { unsigned r; asm volatile("v_cvt_pk_bf16_f32 %0, %1, %2" : "=v"(r) : "v"(lo), "v"(hi)); return r; }

namespace pg8 {
constexpr int BM = 256, BK = 64, HALF = 128, HTB = HALF * BK * 2, STAGE_BYTES = 8 * HTB, NXCD = 8, WGM = 8;
__host__ __device__ __forceinline__ int lds_byte(int r, int c) { const int st = (r >> 4) * 2 + (c >> 5), rr = r & 15, cc = c & 31, ob = rr * 64 + cc * 2; return st * 1024 + (ob ^ (((ob >> 9) & 1) << 5)); }
__host__ __device__ __forceinline__ void stage_rc(int b, int& R, int& C) { const int st = b / 1024, sb = b % 1024, swz = sb ^ (((sb >> 9) & 1) << 5); R = (st >> 1) * 16 + swz / 64; C = (st & 1) * 32 + (swz % 64) / 2; }
__host__ __device__ __forceinline__ int perm32(int rho) { const int n = rho >> 4, i = rho & 15; return 8 * (i >> 2) + 4 * n + (i & 3); }

struct Unit { int rowbase; int pn; int permoff; int nvalid; int e1; int e2; int type; };
struct GemmP { const void* A; int ldbB; int Kbytes; int nsplit; int hstepB; int pk = 0; };

struct StaticOrder {
    int nM, nN, nwg, G, c;
    __device__ void init(int M, int N, int G_, int c_) { nM = M / BM; nN = N / BM; nwg = nM * nN; G = G_; c = c_; }
    __device__ bool next(int i, int& pm, int& pn) const {
        const long L = (long)i * G + c; if (L >= nwg) return false;
        int wgid = (int)L; { const int q = nwg / NXCD, r = nwg % NXCD, xcd = wgid % NXCD, off = wgid / NXCD; wgid = (xcd < r ? xcd * (q + 1) : r * (q + 1) + (xcd - r) * q) + off; }
        const int nig = WGM * nN, gid = wgid / nig, fm = gid * WGM, gsz = (nM - fm) < WGM ? (nM - fm) : WGM;
        pm = fm + ((wgid % nig) % gsz); pn = (wgid % nig) / gsz; return true;
    }
};
struct DenseSched {
    static constexpr bool MIX = false;
    StaticOrder so; const bf16_t* Bt; int lda, ldb;
    __device__ __forceinline__ bool next(int i, Unit& u) const { int pm, pn; if (!so.next(i, pm, pn)) return false; u.rowbase = pm * BM; u.pn = pn; u.permoff = 0; u.nvalid = 256; u.e1 = 0; u.e2 = 0; u.type = 0; return true; }
    __device__ __forceinline__ void aoff(const Unit& u, const int (&R)[2], const int (&C)[2], unsigned (&v)[2][2]) const {
#pragma unroll
        for (int h = 0; h < 2; ++h)
#pragma unroll
            for (int i = 0; i < 2; ++i) v[h][i] = (unsigned)((u.rowbase + 128 * h + R[i]) * lda + C[i]) * 2u; }
    __device__ __forceinline__ const char* blo(const Unit& u) const { return (const char*)Bt + (size_t)u.pn * 256 * ldb * 2; }
    __device__ __forceinline__ const char* bhi(const Unit& u) const { return blo(u); }
};
__device__ __forceinline__ bool moe_unit(int L, int npn, int TT, const volatile LAS int* TP, const int* cnt, Unit& u) {
    if (L >= TT * npn) return false;
    const int tau = L / npn; u.pn = L % npn;
    const int c = TP[64 + tau];
    const int rt = tau - TP[c]; const int n = TP[32 + c] - 256 * rt;
    u.rowbase = tau * 256; u.permoff = c * CAP + rt * 256; u.nvalid = n < 256 ? n : 256;
    const int g = c / 6, p = c % 6; const int a = (p < 3) ? 0 : (p < 5) ? 1 : 2; const int b = (p < 3) ? p + 1 : (p < 5) ? p - 1 : 3;
    u.e1 = 4 * g + a; u.e2 = 4 * g + b;
    u.rowbase = __builtin_amdgcn_readfirstlane(u.rowbase); u.pn = __builtin_amdgcn_readfirstlane(u.pn); u.permoff = __builtin_amdgcn_readfirstlane(u.permoff);
    u.nvalid = __builtin_amdgcn_readfirstlane(u.nvalid); u.e1 = __builtin_amdgcn_readfirstlane(u.e1); u.e2 = __builtin_amdgcn_readfirstlane(u.e2);
    return true;
}
struct Moe1Sched {      static constexpr bool MIX = false;
    const volatile LAS int* TP; const int* cnt; const int* perm; const unsigned char* Wgu; int G, c, TT;
    __device__ __forceinline__ bool next(int i, Unit& u) const { return moe_unit(i * G + c, 8, TT, TP, cnt, u); }
    __device__ __forceinline__ void aoff(const Unit& u, const int (&R)[2], const int (&C)[2], unsigned (&v)[2][2]) const {
#pragma unroll
        for (int h = 0; h < 2; ++h)
#pragma unroll
            for (int i = 0; i < 2; ++i) { const int r = 128 * h + R[i]; const int tok = (r < u.nvalid) ? ((const GAS int*)perm)[u.permoff + r] : 0; v[h][i] = (unsigned)(tok * 1024 + 2 * C[i]); } }
    __device__ __forceinline__ const char* blo(const Unit& u) const { const int e = (u.pn < 4) ? u.e1 : u.e2; return (const char*)Wgu + ((size_t)e * 1024 + 128 * (u.pn & 3)) * 1024; }
    __device__ __forceinline__ const char* bhi(const Unit& u) const { return blo(u); }
};
struct Moe2Sched {      static constexpr bool MIX = false;
    const volatile LAS int* TP; const int* cnt; const unsigned char* Wd; int G, c, TT;
    __device__ __forceinline__ bool next(int i, Unit& u) const { return moe_unit(i * G + c, 4, TT, TP, cnt, u); }
    __device__ __forceinline__ void aoff(const Unit& u, const int (&R)[2], const int (&C)[2], unsigned (&v)[2][2]) const {
#pragma unroll
        for (int h = 0; h < 2; ++h)
#pragma unroll
            for (int i = 0; i < 2; ++i) v[h][i] = (unsigned)((u.rowbase + 128 * h + R[i]) * 1024 + 2 * C[i]); }
    __device__ __forceinline__ const char* blo(const Unit& u) const { return (const char*)Wd + ((size_t)u.e1 * 1024 + 256 * u.pn) * 512; }
    __device__ __forceinline__ const char* bhi(const Unit& u) const { return (const char*)Wd + ((size_t)u.e2 * 1024 + 256 * u.pn) * 512 - 4 * 128; }
};

struct MoeMixSched {
    static constexpr bool MIX = true;
    const volatile LAS int* TP; const int* cnt; const int* perm; const unsigned char* Wgu; const unsigned char* Wd; int G, c, TT; unsigned* done; unsigned* tmo;
    __device__ __forceinline__ bool next(int i, Unit& u) const {
        const int cc = (G == 256) ? ((c & 7) * 32 + (c >> 3)) : c;
        const int L = i * G + cc, n1 = TT * 8;
        if (L < n1) { moe_unit(L, 8, TT, TP, cnt, u); u.type = 0; return true; }
        if (!moe_unit(L - n1, 4, TT, TP, cnt, u)) return false; u.type = 1; return true; }
    __device__ __forceinline__ void aoff(const Unit& u, const int (&R)[2], const int (&C)[2], unsigned (&v)[2][2]) const {
#pragma unroll
        for (int h = 0; h < 2; ++h)
#pragma unroll
            for (int i = 0; i < 2; ++i) { const int r = 128 * h + R[i];
                if (u.type == 0) { const int tok = (r < u.nvalid) ? ((const GAS int*)perm)[u.permoff + r] : 0; v[h][i] = (unsigned)WS_XN8 + (unsigned)(tok * 1024 + 2 * C[i]); }
                else v[h][i] = (unsigned)WS_HID + (unsigned)((u.rowbase + r) * 1024 + 2 * C[i]); } }
    __device__ __forceinline__ const char* blo(const Unit& u) const {
        if (u.type == 0) { const int e = (u.pn < 4) ? u.e1 : u.e2; return (const char*)Wgu + ((size_t)e * 1024 + 128 * (u.pn & 3)) * 1024; }
        return (const char*)Wd + ((size_t)u.e1 * 1024 + 256 * u.pn) * 512; }
    __device__ __forceinline__ const char* bhi(const Unit& u) const {
        if (u.type == 0) return blo(u);
        return (const char*)Wd + ((size_t)u.e2 * 1024 + 256 * u.pn) * 512 - 4 * 128; }
    __device__ __forceinline__ int ldbB(const Unit& u) const { return u.type == 0 ? 1024 : 512; }
    __device__ __forceinline__ int hstepB(const Unit& u) const { return u.type == 0 ? 512 : 128; }
    __device__ __forceinline__ int nsplit(const Unit& u) const { return u.type == 0 ? (1 << 20) : 4; }
    __device__ __forceinline__ void a_ready(const Unit& u) const {
        if (u.type == 1) { unsigned* w = done + 64 * (u.rowbase >> 8); unsigned sp = 0;
            while (__hip_atomic_load(w, __ATOMIC_RELAXED, __HIP_MEMORY_SCOPE_AGENT) < 64u) { __builtin_amdgcn_s_sleep(2); if (++sp > (1u << 20)) { __hip_atomic_store(tmo, 1u, __ATOMIC_RELAXED, __HIP_MEMORY_SCOPE_AGENT); break; } }
              } }
    __device__ __forceinline__ const unsigned* poll_addr(const Unit& u) const { return done + 64 * (u.rowbase >> 8); }
    __device__ __forceinline__ int done_tile(const Unit& u) const { return (u.type == 0) ? (u.rowbase >> 8) : -1; }
    __device__ __forceinline__ void signal(int tile, int lane) const { if (lane == 0) __hip_atomic_fetch_add(done + 64 * tile, 1u, __ATOMIC_RELAXED, __HIP_MEMORY_SCOPE_AGENT); }
};

__device__ __forceinline__ int dil_row(int tok, int D4) { const int s = tok & (SEQ - 1); return (tok & ~(SEQ - 1)) + ((s & ((1 << D4) - 1)) << (13 - D4)) + (s >> D4); }
__device__ __forceinline__ float row_rstd16(const float* stats, int row) {
    const f32x4* p = (const f32x4*)(stats + (size_t)row * 16); const f32x4 a = p[0], b = p[1], c = p[2], d = p[3];
    const float s = ((a[0] + a[1]) + (a[2] + a[3])) + ((b[0] + b[1]) + (b[2] + b[3])) + ((c[0] + c[1]) + (c[2] + c[3])) + ((d[0] + d[1]) + (d[2] + d[3]));
    return 1.0f / sqrtf(s * (1.0f / 1024.0f) + EPS);
}
struct EpiHead {
    static constexpr int BMODE = 2; static constexpr int NPF = 0;
    bf16_t* dbase; size_t dstride; const float* gtab; int plain_seg; int e0, e1;
    int ldc; const float* rstd; const float* stats; float ascale;
    int dil = 0;
    __device__ __forceinline__ void operator()(const f32x4 (&acc)[2][2][4][2], const Unit& u, int wr, int wc, int fr, int fq) const {
        asm volatile("" : "+v"(fr), "+v"(fq));
        const int pn = u.pn; const int seg = (pn < e0) ? 0 : (pn < e1) ? 1 : 2;
        bf16_t* dst = dbase + (size_t)seg * dstride; const float* gain = gtab + 64 * seg; const bool norm = (seg != plain_seg);
        const int pnl = pn - (seg == 0 ? 0 : seg == 1 ? e0 : e1);
        const int col0 = 64 * (4 * pnl + wc) + 8 * fq;
        f32x4 gv[2][2];
#pragma unroll
        for (int bj = 0; bj < 2; ++bj)
#pragma unroll
            for (int n = 0; n < 2; ++n) gv[bj][n] = *(const GAS f32x4*)(gain + 32 * bj + 8 * fq + 4 * n);
        float rsv[2][4];
        if (rstd) {
#pragma unroll
            for (int ai = 0; ai < 2; ++ai)
#pragma unroll
                for (int m = 0; m < 4; ++m) rsv[ai][m] = ((const GAS float*)rstd)[u.rowbase + ai * HALF + wr * 64 + m * 16 + fr] * ascale;
        } else {
            f32x4 pq[2][4];
#pragma unroll
            for (int ai = 0; ai < 2; ++ai)
#pragma unroll
                for (int m = 0; m < 4; ++m) pq[ai][m] = *(const GAS f32x4*)(stats + (size_t)(u.rowbase + ai * HALF + wr * 64 + m * 16 + fr) * 16 + 4 * fq);
#pragma unroll
            for (int ai = 0; ai < 2; ++ai)
#pragma unroll
                for (int m = 0; m < 4; ++m) { float sq = (pq[ai][m][0] + pq[ai][m][1]) + (pq[ai][m][2] + pq[ai][m][3]); sq += shfl_x(sq, 16 * fq + fr, 16); sq += shfl_x(sq, 16 * fq + fr, 32);
                    rsv[ai][m] = ascale * __builtin_amdgcn_rsqf(sq * (1.0f / 1024.0f) + EPS); }
        }
#pragma unroll
        for (int ai = 0; ai < 2; ++ai)
#pragma unroll
            for (int m = 0; m < 4; ++m) {
                const int row = u.rowbase + ai * HALF + wr * 64 + m * 16 + fr;
                const float rs = rsv[ai][m];
                float hr = rs;
                if (norm) {
                    float ss = 0.f;
#pragma unroll
                    for (int bj = 0; bj < 2; ++bj)
#pragma unroll
                        for (int n = 0; n < 2; ++n) { const f32x4 x = acc[ai][bj][m][n]; ss += (x[0] * x[0] + x[1] * x[1]) + (x[2] * x[2] + x[3] * x[3]); }
                    ss += shfl_x(ss, 16 * fq + fr, 16); ss += shfl_x(ss, 16 * fq + fr, 32);
                    hr = rs * __builtin_amdgcn_rsqf(ss * rs * rs * (1.0f / 64.0f) + EPS);
                }
                bf16_t* rowp = dil ? dst + ((size_t)(4 * pnl + wc) * NTOK + dil_row(row, 2 * ((4 * pnl + wc) >> 3))) * 64 + 8 * fq : dst + (size_t)row * ldc + col0;
#pragma unroll
                for (int bj = 0; bj < 2; ++bj) {
                    const f32x4 v0 = acc[ai][bj][m][0] * hr * gv[bj][0], v1 = acc[ai][bj][m][1] * hr * gv[bj][1];
                    u32x4 w; w.x = cvt_pk_bf16(v0[0], v0[1]); w.y = cvt_pk_bf16(v0[2], v0[3]); w.z = cvt_pk_bf16(v1[0], v1[1]); w.w = cvt_pk_bf16(v1[2], v1[3]);
                    st16_wt(rowp + 32 * bj, w); }
                if (m & 1) asm volatile("" ::: "memory");
            }
    }
};
__device__ __forceinline__ void unpack8(const u32x4 b, f32x4& lo, f32x4& hi) {
    lo = (f32x4){bf2f(b.x & 0xffffu), bf2f(b.x >> 16), bf2f(b.y & 0xffffu), bf2f(b.y >> 16)}; hi = (f32x4){bf2f(b.z & 0xffffu), bf2f(b.z >> 16), bf2f(b.w & 0xffffu), bf2f(b.w >> 16)}; }
struct EpiResid {
    static constexpr int BMODE = 1; static constexpr int NPF = 0;
    bf16_t* xb; float* stats; float ascale;
    __device__ __forceinline__ void operator()(const f32x4 (&acc)[2][2][4][2], const Unit& u, int wr, int wc, int fr, int fq) const {
        asm volatile("" : "+v"(fr), "+v"(fq));
        const int col0 = u.pn * BM + wc * 32 + 8 * fq;
#pragma unroll
        for (int ai = 0; ai < 2; ++ai) {
        u32x4 bb[2][4][2];
#pragma unroll
            for (int m = 0; m < 4; ++m)
#pragma unroll
                for (int bj = 0; bj < 2; ++bj) bb[ai][m][bj] = *(const GAS u32x4*)(xb + (size_t)(u.rowbase + ai * HALF + wr * 64 + m * 16 + fr) * 1024 + col0 + bj * HALF);
#pragma unroll
            for (int m = 0; m < 4; ++m) {
                const int row = u.rowbase + ai * HALF + wr * 64 + m * 16 + fr; const size_t off = (size_t)row * 1024 + col0; float ss = 0.f;
#pragma unroll
                for (int bj = 0; bj < 2; ++bj) { const size_t o = off + bj * HALF; f32x4 b0, b1; unpack8(bb[ai][m][bj], b0, b1);
                    const f32x4 v0 = b0 + acc[ai][bj][m][0] * ascale, v1 = b1 + acc[ai][bj][m][1] * ascale;
                    ss += ((v0[0] * v0[0] + v0[1] * v0[1]) + (v0[2] * v0[2] + v0[3] * v0[3])) + ((v1[0] * v1[0] + v1[1] * v1[1]) + (v1[2] * v1[2] + v1[3] * v1[3]));
                    u32x4 w; w.x = cvt_pk_bf16(v0[0], v0[1]); w.y = cvt_pk_bf16(v0[2], v0[3]); w.z = cvt_pk_bf16(v1[0], v1[1]); w.w = cvt_pk_bf16(v1[2], v1[3]); *(GAS u32x4*)(xb + o) = w; }
                ss += shfl_x(ss, 16 * fq + fr, 16); ss += shfl_x(ss, 16 * fq + fr, 32);
                if (fq == 0) ((GAS float*)stats)[(size_t)row * 16 + u.pn * 4 + wc] = ss;
            }
        asm volatile("" ::: "memory"); }
    }
};
struct EpiSwiglu {
    static constexpr int BMODE = 1;
    unsigned char* hid; const float* gsort;
    __device__ __forceinline__ void operator()(const f32x4 (&acc)[2][2][4][2], const Unit& u, int wr, int wc, int fr, int fq, int pf0, int pf1) const {
        asm volatile("" : "+v"(fr), "+v"(fq));
        const int col0 = 512 * (u.pn >> 2) + 128 * (u.pn & 3) + 32 * wc + 8 * fq;
#pragma unroll
        for (int ai = 0; ai < 2; ++ai)
#pragma unroll
            for (int m = 0; m < 4; ++m) {
                const int r = ai * HALF + wr * 64 + m * 16 + fr;
                const float gq = __int_as_float(shfl_from(ai == 0 ? pf0 : pf1, m * 16 + fr)); const float gw = (r < u.nvalid) ? gq * H8SCALE : 0.f;
                float h[8];
#pragma unroll
                for (int n = 0; n < 2; ++n)
#pragma unroll
                    for (int i = 0; i < 4; ++i) { const float g = acc[ai][0][m][n][i] * (1.0f / W8SCALE), up = acc[ai][1][m][n][i] * (1.0f / W8SCALE); const float sg = g * __builtin_amdgcn_rcpf(1.0f + __builtin_amdgcn_exp2f(-g * LOG2E)); h[4 * n + i] = __builtin_fminf(__builtin_fmaxf(sg * up * gw, -440.f), 440.f); }
                u32x2 w; w.x = pk4_fp8(h[0], h[1], h[2], h[3]); w.y = pk4_fp8(h[4], h[5], h[6], h[7]);
                { GAS u32x2* hp_ = (GAS u32x2*)(hid + (size_t)(u.rowbase + r) * 1024 + col0); asm volatile("global_store_dwordx2 %0, %1, off sc1" :: "v"(hp_), "v"(w) : "memory"); }
            }
    }
};
template <bool LAST> struct EpiScatter {
    static constexpr int BMODE = 1;
    bf16_t* xb; float* out; float* stats; const int* perm; float ascale;
    __device__ __forceinline__ void operator()(const f32x4 (&acc)[2][2][4][2], const Unit& u, int wr, int wc, int fr, int fq, int pf0, int pf1) const {
        asm volatile("" : "+v"(fr), "+v"(fq));
        const int col0 = u.pn * BM + wc * 32 + 8 * fq;
        int tokv[2][4];
#pragma unroll
        for (int ai = 0; ai < 2; ++ai)
#pragma unroll
            for (int m = 0; m < 4; ++m) { const int r = ai * HALF + wr * 64 + m * 16 + fr; const int tq = shfl_from(ai == 0 ? pf0 : pf1, m * 16 + fr); tokv[ai][m] = (r < u.nvalid) ? tq : -1; }
#pragma unroll
        for (int ai = 0; ai < 2; ++ai) {
        u32x4 bb[2][4][2];
#pragma unroll
            for (int m = 0; m < 4; ++m)
#pragma unroll
                for (int bj = 0; bj < 2; ++bj) bb[ai][m][bj] = *(const GAS u32x4*)(xb + (size_t)(tokv[ai][m] >= 0 ? tokv[ai][m] : 0) * 1024 + col0 + bj * HALF);
#pragma unroll
            for (int m = 0; m < 4; ++m) {
                const bool valid = tokv[ai][m] >= 0; const int tok = valid ? tokv[ai][m] : 0;
                const size_t off = (size_t)tok * 1024 + col0; float ss = 0.f;
#pragma unroll
                for (int bj = 0; bj < 2; ++bj) { const size_t o = off + bj * HALF; f32x4 b0, b1; unpack8(bb[ai][m][bj], b0, b1);
                    const f32x4 v0 = b0 + acc[ai][bj][m][0] * ascale, v1 = b1 + acc[ai][bj][m][1] * ascale;
                    ss += ((v0[0] * v0[0] + v0[1] * v0[1]) + (v0[2] * v0[2] + v0[3] * v0[3])) + ((v1[0] * v1[0] + v1[1] * v1[1]) + (v1[2] * v1[2] + v1[3] * v1[3]));
                    if (valid) {
                        if constexpr (LAST) { *(GAS f32x4*)(out + o) = v0; *(GAS f32x4*)(out + o + 4) = v1; }
                        else { u32x4 w; w.x = cvt_pk_bf16(v0[0], v0[1]); w.y = cvt_pk_bf16(v0[2], v0[3]); w.z = cvt_pk_bf16(v1[0], v1[1]); w.w = cvt_pk_bf16(v1[2], v1[3]); *(GAS u32x4*)(xb + o) = w;
                               u32x2 q8; q8.x = pk4_fp8(v0[0], v0[1], v0[2], v0[3]); q8.y = pk4_fp8(v1[0], v1[1], v1[2], v1[3]); *(GAS u32x2*)((unsigned char*)xb - (WS_XB - WS_XB8) + o) = q8; } } }
                if (!LAST) { ss += shfl_x(ss, 16 * fq + fr, 16); ss += shfl_x(ss, 16 * fq + fr, 32);
                    if (valid && fq == 0) ((GAS float*)stats)[(size_t)tok * 16 + u.pn * 4 + wc] = ss; }
            }
        asm volatile("" ::: "memory"); }
    }
};

template <bool LAST> struct EpiMoe {
    static constexpr int BMODE = 1;
    static constexpr int NPF = 2;
    EpiSwiglu sw; EpiScatter<LAST> sc;
    __device__ __forceinline__ void prefetch(const Unit& u, int wr, int lane, int& pf0, int& pf1) const {
        const int r0 = wr * 64 + lane;
        const GAS int* p0 = (u.type == 0) ? (const GAS int*)sw.gsort + 2 * (size_t)(u.permoff + r0) + (u.pn >> 2) : (const GAS int*)sc.perm + (u.permoff + r0);
        const GAS int* p1 = p0 + ((u.type == 0) ? 2 * HALF : HALF);
        asm volatile("global_load_dword %0, %2, off\n\tglobal_load_dword %1, %3, off" : "=&v"(pf0), "=&v"(pf1) : "v"(p0), "v"(p1) : "memory"); }
    __device__ __forceinline__ void operator()(const f32x4 (&acc)[2][2][4][2], const Unit& u, int wr, int wc, int fr, int fq, int pf0, int pf1) const {
        if (u.type == 0) sw(acc, u, wr, wc, fr, fq, pf0, pf1); else sc(acc, u, wr, wc, fr, fq, pf0, pf1); }
};

template <class Epi, class Sched, bool F8 = false>
__device__ __forceinline__ void gemm_phase(LAS unsigned char* lds, const GemmP g, const Sched& S, const Epi& E, int wave) {
    int tid = wave * 64 + lane_id(); asm volatile("" : "+v"(tid));
    const int wid = __builtin_amdgcn_readfirstlane(tid >> 6), lane = tid & 63, wr = wid >> 2, wc = wid & 3, fr = lane & 15, fq = lane >> 4;
    const int nt = g.Kbytes / 128;
    unsigned voffB[2]; int RbB[2], CbB[2];
#pragma unroll
    for (int i = 0; i < 2; ++i) { int R[2], C[2]; stage_rc(tid * 16 + i * 8192, R[i], C[i]);
        RbB[i] = (Epi::BMODE == 0) ? R[i] : (Epi::BMODE == 1) ? ((R[i] & ~31) + perm32(R[i] & 31)) : (64 * (R[i] >> 5) + perm32(R[i] & 31)); CbB[i] = 2 * C[i];
        voffB[i] = (unsigned)(RbB[i] * g.ldbB + CbB[i]); }
    const size_t kstep = (size_t)(BK * 2);
    size_t hstepB = (size_t)g.hstepB * g.ldbB; int nsplit = g.nsplit;
    const unsigned ldsw = (unsigned)wid * 1024u;
    const int aoff = lds_byte(wr * 64 + fr, fq * 8), boff = lds_byte(wc * 32 + fr, fq * 8);
    const char* const Ab = (const char*)g.A;
#define PG8_SA(b, h) (((b) * 2 + (h)) * HTB)
#define PG8_SB(b, h) ((4 + (b) * 2 + (h)) * HTB)
#define PG8_STAGE(bufoff, gbase, voff) do { _Pragma("unroll") for (int _i = 0; _i < 2; ++_i) \
        __builtin_amdgcn_global_load_lds((const unsigned*)((const char*)(gbase) + (voff)[_i]), (LAS unsigned*)(lds + (bufoff) + ldsw + _i * 8192), 16, 0, 0); } while (0)
#define PG8_LD8(p) __builtin_shufflevector(*(const LAS i32x4*)(p), *(const LAS i32x4*)((p) + 1024), 0, 1, 2, 3, 4, 5, 6, 7)
#define PG8_LDA(dst, b, h) do { if constexpr (F8) { _Pragma("unroll") for (int m = 0; m < 4; ++m) dst##8[m] = PG8_LD8(lds + PG8_SA(b, h) + aoff + m * 2048); } \
        else { _Pragma("unroll") for (int m = 0; m < 4; ++m) _Pragma("unroll") for (int k = 0; k < 2; ++k) dst[m][k] = *(const LAS bf16x8*)(lds + PG8_SA(b, h) + aoff + m * 2048 + k * 1024); } } while (0)
#define PG8_LDB(dst, b, h) do { if constexpr (F8) { _Pragma("unroll") for (int n = 0; n < 2; ++n) dst##8[n] = PG8_LD8(lds + PG8_SB(b, h) + boff + n * 2048); } \
        else { _Pragma("unroll") for (int n = 0; n < 2; ++n) _Pragma("unroll") for (int k = 0; k < 2; ++k) dst[n][k] = *(const LAS bf16x8*)(lds + PG8_SB(b, h) + boff + n * 2048 + k * 1024); } } while (0)
#define PG8_MMA(ai, bj, At, Bt) do { __builtin_amdgcn_s_setprio(1); \
        if constexpr (F8) { _Pragma("unroll") for (int m = 0; m < 4; ++m) _Pragma("unroll") for (int n = 0; n < 2; ++n) \
            acc[ai][bj][m][n] = __builtin_amdgcn_mfma_scale_f32_16x16x128_f8f6f4(Bt##8[n], At##8[m], acc[ai][bj][m][n], 0, 0, 0, 0, 0, 0); } \
        else { _Pragma("unroll") for (int m = 0; m < 4; ++m) _Pragma("unroll") for (int n = 0; n < 2; ++n) _Pragma("unroll") for (int k = 0; k < 2; ++k) \
            acc[ai][bj][m][n] = __builtin_amdgcn_mfma_f32_16x16x32_bf16(Bt[n][k], At[m][k], acc[ai][bj][m][n], 0, 0, 0); } \
        __builtin_amdgcn_s_setprio(0); } while (0)
#define PG8_WAIT_V(n) asm volatile("s_waitcnt vmcnt(" #n ")" ::: "memory")
#define PG8_WAIT_L(n) asm volatile("s_waitcnt lgkmcnt(" #n ")" ::: "memory")
#define PG8_BAR __builtin_amdgcn_s_barrier()
#define PG8_SCHED __builtin_amdgcn_sched_barrier(0)
#ifndef PROBE_K
#define PROBE_K 0
#endif
#ifndef PROBE_KSEL
#define PROBE_KSEL 0
#endif
    unsigned long long pk_acc = 0ull, pk_t0 = 0ull;
    unsigned pollv = 64u;
    int pf0 = 0, pf1 = 0, pend = -1;
    Unit cur, nxt; int ui = 0;
    if (!S.next(0, cur)) return;
    unsigned vc[2][2];
    LAS u32x4* const vnl = (LAS u32x4*)(lds + AUX_OFF + 2048) + tid;
    { int R[2], C[2]; int t_ = tid; asm volatile("" : "+v"(t_)); stage_rc(t_ * 16, R[0], C[0]); stage_rc(t_ * 16 + 8192, R[1], C[1]); S.aoff(cur, R, C, vc); }
    f32x4 acc[2][2][4][2];
#pragma unroll
    for (int a = 0; a < 2; ++a)
#pragma unroll
        for (int b = 0; b < 2; ++b)
#pragma unroll
            for (int m = 0; m < 4; ++m)
#pragma unroll
                for (int n = 0; n < 2; ++n) acc[a][b][m][n] = (f32x4){0.f, 0.f, 0.f, 0.f};
    bf16x8 At[4][2], B0[2][2], B1[2][2]; i32x8 At8[4], B08[2], B18[2];
    const char* cBl = S.blo(cur); const char* cBh = S.bhi(cur);
    if constexpr (Sched::MIX) { const int lb_ = S.ldbB(cur); voffB[0] = (unsigned)(RbB[0] * lb_ + CbB[0]); voffB[1] = (unsigned)(RbB[1] * lb_ + CbB[1]); hstepB = (size_t)S.hstepB(cur) * lb_; nsplit = S.nsplit(cur); S.a_ready(cur); }
    PG8_STAGE(PG8_SB(0, 0), cBl, voffB); PG8_STAGE(PG8_SB(0, 1), cBl + hstepB, voffB); PG8_STAGE(PG8_SA(0, 0), Ab, vc[0]); PG8_STAGE(PG8_SA(0, 1), Ab, vc[1]);
    if (wr == 1) PG8_BAR;
    PG8_WAIT_V(2); PG8_BAR;
    PG8_STAGE(PG8_SB(1, 0), cBl + kstep, voffB); PG8_STAGE(PG8_SA(1, 0), Ab + kstep, vc[0]); PG8_STAGE(PG8_SB(1, 1), cBl + hstepB + kstep, voffB);
    PG8_WAIT_V(6); PG8_BAR;
    for (;;) {
        const bool has_next = S.next(ui + 1, nxt);
        { unsigned vn[2][2];
          if (has_next) { int R[2], C[2]; int t_ = tid; asm volatile("" : "+v"(t_)); stage_rc(t_ * 16, R[0], C[0]); stage_rc(t_ * 16 + 8192, R[1], C[1]); S.aoff(nxt, R, C, vn); } else {
#pragma unroll
            for (int h = 0; h < 2; ++h)
#pragma unroll
                for (int i = 0; i < 2; ++i) vn[h][i] = vc[h][i]; }
          *vnl = (u32x4){vn[0][0], vn[0][1], vn[1][0], vn[1][1]}; }
        const char* nBl = has_next ? S.blo(nxt) : cBl; const char* nBh = has_next ? S.bhi(nxt) : cBh;
        if (PROBE_K == 1 || PROBE_K == 3) pk_t0 = __builtin_amdgcn_s_memrealtime();
#pragma unroll 1
        for (int t = 0; t < nt; t += 2) {
            const bool last = (t == nt - 2);
            const char* a1 = Ab + (size_t)(t + 1) * kstep;
            const char* a2 = last ? Ab : Ab + (size_t)(t + 2) * kstep;
            const char* b2 = last ? nBl : (((t + 2) < nsplit) ? cBl : cBh) + (size_t)(t + 2) * kstep;
            const char* a3 = a2 + kstep; const char* b3 = b2 + kstep;
            PG8_LDB(B0, 0, 0); PG8_LDB(B1, 0, 1); PG8_SCHED; PG8_LDA(At, 0, 0); PG8_STAGE(PG8_SA(1, 1), a1, vc[1]);
            PG8_WAIT_V(8); PG8_WAIT_L(0); PG8_BAR; PG8_MMA(0, 0, At, B0); PG8_MMA(0, 1, At, B1); PG8_BAR; PG8_SCHED;
            if constexpr (Sched::MIX) { if (t == nt - 4 && !last && has_next && nxt.type == 1) { const GAS unsigned* pa_ = (const GAS unsigned*)S.poll_addr(nxt);
                asm volatile("global_load_dword %0, %1, off sc1" : "=v"(pollv) : "v"(pa_) : "memory"); } }
            if (last) { if constexpr (Epi::NPF > 0) E.prefetch(cur, wr, lane, pf0, pf1);
                const u32x4 v_ = *vnl; vc[0][0] = v_[0]; vc[0][1] = v_[1]; vc[1][0] = v_[2]; vc[1][1] = v_[3];
                if constexpr (Sched::MIX) { if (has_next) { const int lb_ = S.ldbB(nxt); voffB[0] = (unsigned)(RbB[0] * lb_ + CbB[0]); voffB[1] = (unsigned)(RbB[1] * lb_ + CbB[1]); hstepB = (size_t)S.hstepB(nxt) * lb_;
                    if (nxt.type == 1) {
                        bool ok_ = false;
                        if (nt >= 8) { asm volatile("s_waitcnt vmcnt(18)" : "+v"(pollv) :: "memory"); ok_ = (unsigned)__builtin_amdgcn_readfirstlane((int)pollv) >= 64u; }
                        if (!ok_) S.a_ready(nxt); } } } }
            PG8_LDA(At, 0, 1); PG8_STAGE(PG8_SB(0, 0), b2, voffB); PG8_STAGE(PG8_SB(0, 1), b2 + hstepB, voffB); PG8_STAGE(PG8_SA(0, 0), a2, vc[0]);
            if (Epi::NPF > 0 && last) PG8_WAIT_V(10); else PG8_WAIT_V(8);
            PG8_WAIT_L(0); PG8_BAR; PG8_MMA(1, 0, At, B0); PG8_MMA(1, 1, At, B1); PG8_BAR; PG8_SCHED;
            PG8_LDB(B0, 1, 0); PG8_LDB(B1, 1, 1); PG8_SCHED; PG8_LDA(At, 1, 0); PG8_STAGE(PG8_SA(0, 1), a2, vc[1]);
            PG8_WAIT_V(8); PG8_WAIT_L(0); PG8_BAR; PG8_MMA(0, 0, At, B0); PG8_MMA(0, 1, At, B1); PG8_BAR; PG8_SCHED;
            if constexpr (Sched::MIX) { if (t == 0 && pend >= 0) { S.signal(pend, lane); pend = -1; } }
            PG8_LDA(At, 1, 1); PG8_STAGE(PG8_SB(1, 0), b3, voffB); PG8_STAGE(PG8_SB(1, 1), b3 + hstepB, voffB); PG8_STAGE(PG8_SA(1, 0), a3, vc[0]);
            PG8_WAIT_V(8); PG8_WAIT_L(0); PG8_BAR; PG8_MMA(1, 0, At, B0); PG8_MMA(1, 1, At, B1); PG8_BAR; PG8_SCHED;
        }
        if (PROBE_K == 1) pk_acc += __builtin_amdgcn_s_memrealtime() - pk_t0;
        if (PROBE_K == 2) pk_t0 = __builtin_amdgcn_s_memrealtime();
        if (wr == 0) PG8_BAR;
        if constexpr (Epi::NPF > 0) { asm volatile("s_waitcnt vmcnt(14)" : "+v"(pf0), "+v"(pf1) :: "memory"); E(acc, cur, wr, wc, fr, fq, pf0, pf1); }
        else E(acc, cur, wr, wc, fr, fq);
        if constexpr (Sched::MIX) pend = S.done_tile(cur);
        if (PROBE_K == 2) { asm volatile("s_waitcnt vmcnt(0)" ::: "memory"); pk_acc += __builtin_amdgcn_s_memrealtime() - pk_t0; }
        if (PROBE_K == 3) pk_acc += __builtin_amdgcn_s_memrealtime() - pk_t0;
        if (!has_next) break;
#pragma unroll
        for (int a = 0; a < 2; ++a)
#pragma unroll
            for (int b = 0; b < 2; ++b)
#pragma unroll
                for (int m = 0; m < 4; ++m)
#pragma unroll
                    for (int n = 0; n < 2; ++n) acc[a][b][m][n] = (f32x4){0.f, 0.f, 0.f, 0.f};
        cur = nxt; cBl = nBl; cBh = nBh; ++ui;
        if constexpr (Sched::MIX) nsplit = S.nsplit(cur);
        if (wr == 1) PG8_BAR;
    }
    PG8_WAIT_V(0);
    if constexpr (Sched::MIX) { if (pend >= 0) S.signal(pend, lane); }
    PG8_BAR;
    if (PROBE_K != 0 && g.pk && tid == 0) { LAS unsigned* pw_ = (LAS unsigned*)(lds + MISC_OFF) + 120; *pw_ += (unsigned)pk_acc; }
#undef PG8_SA
#undef PG8_SB
#undef PG8_STAGE
#undef PG8_LDA
#undef PG8_LDB
#undef PG8_MMA
#undef PG8_LD8
#undef PG8_WAIT_V
#undef PG8_WAIT_L
#undef PG8_BAR
#undef PG8_SCHED
}
}

namespace attn_body {
using bf16 = __hip_bfloat16;
constexpr int NHEAD = 16, D = 64, DMQ = NHEAD * D;
constexpr int NW = 8, QBLK = 32, QB = QBLK * NW, KVBLK = 64;
__device__ __forceinline__ int crow(int r, int hi) { return (r & 3) + 8 * (r >> 2) + 4 * hi; }
#define SBAR() __builtin_amdgcn_sched_barrier(0)
__device__ __forceinline__ void cmask(f32x16& p0, f32x16& p1, int jb, int qrel, int hi) {
  const float NEG = -INFINITY; int kb = 64 * jb + 4 * hi;
  #pragma unroll
  for (int r = 0; r < 16; ++r) { int kv = kb + (r & 3) + 8 * (r >> 2); if (kv > qrel) p0[r] = NEG; if (kv + 32 > qrel) p1[r] = NEG; }
}
constexpr int NSLOT = 3, SLOTB = 8192;
constexpr int LDS_K = 0, LDS_V = NSLOT * SLOTB, LDS_WS = 2 * NSLOT * SLOTB, LDS_OST = LDS_WS + NW * 64 * 4, ATT_LDS_BYTES = LDS_OST + NW * 4096;
constexpr int LDS_NCK = 86016;
__device__ __forceinline__ void glds16(const void* gsrc, unsigned lds_dst) { unsigned keep;
  asm volatile("s_mov_b32 %0, m0\n\ts_mov_b32 m0, %2\n\ts_nop 0\n\tglobal_load_lds_dwordx4 %1, off\n\ts_mov_b32 m0, %0" : "=&s"(keep) : "v"(gsrc), "s"(lds_dst) : "memory"); }
__device__ __forceinline__ float max3f(float a, float b, float c) { float r; asm("v_max3_f32 %0, %1, %2, %3" : "=v"(r) : "v"(a), "v"(b), "v"(c)); return r; }
__device__ __forceinline__ float max2f(float a, float b) { float r; asm("v_max_f32_e32 %0, %1, %2" : "=v"(r) : "v"(a), "v"(b)); return r; }
__device__ __forceinline__ float fadd_s(float a, float b) { float r; asm("v_add_f32_e32 %0, %1, %2" : "=v"(r) : "v"(a), "v"(b)); return r; }
__device__ __forceinline__ float fsub_s(float a, float b) { float r; asm("v_sub_f32_e32 %0, %1, %2" : "=v"(r) : "v"(a), "v"(b)); return r; }
typedef __bf16 bf16x2_t __attribute__((ext_vector_type(2)));
__device__ __forceinline__ unsigned cvtpk_s(float lo, float hi) { f32x2 v = {lo, hi}; bf16x2_t b = __builtin_convertvector(v, bf16x2_t); return __builtin_bit_cast(unsigned, b); }
#define WAIT_BAR(N) asm volatile("s_waitcnt vmcnt(" #N ") lgkmcnt(0)\n\ts_barrier" ::: "memory")
typedef LAS const char* lds_cptr;
typedef short v4i16_t __attribute__((ext_vector_type(4)));
__device__ __forceinline__ void qkt(f32x16& p0, f32x16& p1, lds_cptr Kslot, const bf16x8* qr, const f32x16& negm, int r32, int hi) {
  lds_cptr kb = Kslot + hi * 1024 + r32 * 16;
  #pragma unroll
  for (int d0 = 0; d0 < 4; ++d0) {
    const bf16x8 b0 = *(const LAS bf16x8*)(kb + d0 * 2048);
    const bf16x8 b1 = *(const LAS bf16x8*)(kb + d0 * 2048 + 512);
    if (d0 == 0) { p0 = __builtin_amdgcn_mfma_f32_32x32x16_bf16(b0, qr[0], negm, 0, 0, 0); p1 = __builtin_amdgcn_mfma_f32_32x32x16_bf16(b1, qr[0], negm, 0, 0, 0); }
    else { p0 = __builtin_amdgcn_mfma_f32_32x32x16_bf16(b0, qr[d0], p0, 0, 0, 0); p1 = __builtin_amdgcn_mfma_f32_32x32x16_bf16(b1, qr[d0], p1, 0, 0, 0); } }
}
__device__ __forceinline__ void kload8(bf16x8* kf, lds_cptr kp) {
  kf[0] = *(const LAS bf16x8*)(kp);        kf[1] = *(const LAS bf16x8*)(kp + 512);
  kf[2] = *(const LAS bf16x8*)(kp + 2048); kf[3] = *(const LAS bf16x8*)(kp + 2560);
  kf[4] = *(const LAS bf16x8*)(kp + 4096); kf[5] = *(const LAS bf16x8*)(kp + 4608);
  kf[6] = *(const LAS bf16x8*)(kp + 6144); kf[7] = *(const LAS bf16x8*)(kp + 6656);
}
__device__ __forceinline__ void kload2(bf16x8* kf, lds_cptr kp, int j) { kf[2 * j] = *(const LAS bf16x8*)(kp + j * 2048); kf[2 * j + 1] = *(const LAS bf16x8*)(kp + j * 2048 + 512); }
__device__ __forceinline__ s16x4 vtr(lds_cptr p) { return __builtin_bit_cast(s16x4, __builtin_amdgcn_ds_read_tr16_b64_v4i16((LAS v4i16_t*)p)); }
__device__ __forceinline__ float rowmax(const f32x16& p0, const f32x16& p1) {
  float a = max3f(p0[0], p0[1], p1[0]), b = max3f(p0[2], p0[3], p1[1]); a = max3f(a, p1[2], p1[3]);
  #pragma unroll
  for (int r = 4; r < 16; r += 4) { a = max3f(a, p0[r], p0[r + 1]); b = max3f(b, p0[r + 2], p0[r + 3]); a = max3f(a, p1[r], p1[r + 1]); b = max3f(b, p1[r + 2], p1[r + 3]); }
  const float m = max2f(a, b);
  auto rr = __builtin_amdgcn_permlane32_swap(__float_as_uint(m), __float_as_uint(m), false, false);
  return max2f(__uint_as_float(rr[0]), __uint_as_float(rr[1]));
}
__device__ __forceinline__ void pv(f32x16* o, int vb, bf16x8 pa0, bf16x8 pa1, bf16x8 pa2, bf16x8 pa3) {
  #pragma unroll
  for (int d0 = 0; d0 < 2; ++d0) { s16x4 lo[4], hi[4];
    #pragma unroll
    for (int ks = 0; ks < 4; ++ks) {
      asm volatile("ds_read_b64_tr_b16 %0,%1 offset:%c2" : "=&v"(lo[ks]) : "v"(vb), "i"(d0 * 4096 + ks * 1024) : "memory");
      asm volatile("ds_read_b64_tr_b16 %0,%1 offset:%c2" : "=&v"(hi[ks]) : "v"(vb), "i"(d0 * 4096 + ks * 1024 + 512) : "memory"); }
    asm volatile("s_waitcnt lgkmcnt(0)" ::: "memory"); SBAR();
    #define PK(k) (bf16x8){lo[k][0], lo[k][1], lo[k][2], lo[k][3], hi[k][0], hi[k][1], hi[k][2], hi[k][3]}
    o[d0] = __builtin_amdgcn_mfma_f32_32x32x16_bf16(pa0, PK(0), o[d0], 0, 0, 0);
    o[d0] = __builtin_amdgcn_mfma_f32_32x32x16_bf16(pa1, PK(1), o[d0], 0, 0, 0);
    o[d0] = __builtin_amdgcn_mfma_f32_32x32x16_bf16(pa2, PK(2), o[d0], 0, 0, 0);
    o[d0] = __builtin_amdgcn_mfma_f32_32x32x16_bf16(pa3, PK(3), o[d0], 0, 0, 0);
    #undef PK
  }
}

struct Xpf { bool primed, has_next; long Pn; const bf16* Qn; const bf16* Kn; const bf16* Vn; };
template<int THRL, bool WIN, bool XP> __device__ __forceinline__ void attn_unit_x(int qb, int T0, long P, const bf16* Q, const bf16* __restrict__ K, const bf16* __restrict__ V, bf16* O, char* shm, int wave,
                                                                        float* PML, long wtok0, int wtstride, const Xpf xp, bf16x8 (&qn)[4], int& rho) {
#ifndef PROBE_A
#define PROBE_A 0
#endif
  unsigned long long pa_t = 0ull;
#define PA_T0(k) do { if (WIN && PROBE_A == (k)) pa_t = __builtin_amdgcn_s_memrealtime(); } while (0)
#define PA_T1(k) do { if (WIN && PROBE_A == (k)) { const unsigned d_ = (unsigned)(__builtin_amdgcn_s_memrealtime() - pa_t); if (tid == 0) *(unsigned*)(shm + MISC_OFF + 4 * 121) += d_; } } while (0)
  int tid = wave * 64 + lane_id(); asm volatile("" : "+v"(tid));
  const int lane = tid & 63, r32 = lane & 31, hi = lane >> 5; const int wid = __builtin_amdgcn_readfirstlane(tid >> 6);
  PA_T0(1);
  const int q0 = qb * QB;
  const bf16* Qw = Q + (long)(q0 + wid * QBLK) * P;
  const bf16* Kh = K + (long)T0 * KVBLK * P, *Vh = V + (long)T0 * KVBLK * P;
  const unsigned lds0 = (unsigned)(uintptr_t)shm; const lds_cptr shm3 = (lds_cptr)shm;
  float* wsf = (float*)(shm + LDS_WS) + wid * 64;
  const int wbj = 383 - (q0 + wid * QBLK + r32 - T0 * KVBLK) + 4 * hi;
  const LAS float* nck0 = WIN ? (const LAS float*)((lds_cptr)shm + LDS_NCK) + (wbj & 3) * 640 + (wbj & ~3)
                              : (const LAS float*)((lds_cptr)shm + LDS_NCK) + T0 * KVBLK + 4 * hi;
  const float cq2 = WIN ? 0.f : -((const LAS float*)((lds_cptr)shm + LDS_NCK))[q0 + wid * QBLK + r32];
  const bf16* ksrc = Kh + (long)lane * P + wid * 8;
  const bf16* vsrc = Vh + (long)(16 * (wid & 3) + (lane >> 2)) * P + (wid >> 2) * 32 + (lane & 3) * 8;
  const unsigned kdst = lds0 + LDS_K + wid * 1024, vdst = lds0 + LDS_V + wid * 1024;
  #define DMA_K(t, slot) glds16(ksrc + (long)(t) * KVBLK * P, (unsigned)__builtin_amdgcn_readfirstlane(kdst + (slot)))
  #define DMA_V(t, slot) glds16(vsrc + (long)(t) * KVBLK * P, (unsigned)__builtin_amdgcn_readfirstlane(vdst + (slot)))
  const int vb0 = (int)(lds0 + LDS_V) + ((lane >> 4) & 1) * 32 + (lane & 3) * 8 + (4 * hi + ((lane & 15) >> 2)) * 64;
  bf16x8 kf[8];
  const lds_cptr kp0 = shm3 + LDS_K + hi * 1024 + r32 * 16; const lds_cptr vp0 = shm3 + LDS_V + ((lane >> 4) & 1) * 32 + (lane & 3) * 8 + (4 * hi + ((lane & 15) >> 2)) * 64;
  const int NT = (q0 + QB) / KVBLK - T0;
  #define NXS(s) (((s) == (NSLOT - 1) * SLOTB) ? 0 : (s) + SLOTB)
  const int s0 = XP ? __builtin_amdgcn_readfirstlane(rho) * SLOTB : 0, s1 = NXS(s0), s2 = NXS(s1);
  const bool primed = XP && xp.primed;
  if (!primed) { DMA_K(0, s0); DMA_V(0, s0); DMA_K(1, s1); }
  bf16x8 qr[4];
  const lds_cptr qp = shm3 + LDS_OST + wid * 4096 + lane * 16;
  if (!primed) {
  #pragma unroll
  for (int d0 = 0; d0 < 4; ++d0) qr[d0] = *reinterpret_cast<const bf16x8*>(&Qw[(long)r32 * P + d0 * 16 + hi * 8]);
  #pragma unroll
  for (int d0 = 0; d0 < 4; ++d0) *(LAS bf16x8*)(qp + d0 * 1024) = qr[d0];
  } else {
  #pragma unroll
  for (int d0 = 0; d0 < 4; ++d0) qr[d0] = qn[d0];
  }
  #define QLD(d) (*(const LAS bf16x8*)(qp + (d) * 1024))
  float nm = cq2, l_reg = 0.f; f32x16 o[2]; o[0] = f32x16{}; o[1] = f32x16{};
  const int qrel = wid * QBLK + r32;
  #define CMASK(P0, P1, t) do { if (!WIN) { int jb_ = (t) - (NT - 4); if (jb_ >= 0) cmask(P0, P1, jb_, qrel, hi); } } while (0)
  #define DECAY(P0, P1, t) do { const LAS float* nk_ = nck0 + ((t) << 6); \
    _Pragma("unroll") for (int g_ = 0; g_ < 4; ++g_) { const f32x4 a_ = *(const LAS f32x4*)(nk_ + 8 * g_); const f32x4 b_ = *(const LAS f32x4*)(nk_ + 32 + 8 * g_); \
      P0[4 * g_] += a_[0]; P0[4 * g_ + 1] += a_[1]; P0[4 * g_ + 2] += a_[2]; P0[4 * g_ + 3] += a_[3]; P1[4 * g_] += b_[0]; P1[4 * g_ + 1] += b_[1]; P1[4 * g_ + 2] += b_[2]; P1[4 * g_ + 3] += b_[3]; SBAR(); } } while (0)
  bool resc = false;
  #define START(P0, P1) do { const float rm = rowmax(P0, P1); resc = false; \
    { const float dl = max2f(rm, -1000.f); nm = fsub_s(nm, dl); \
      _Pragma("unroll") for (int r = 0; r < 16; ++r) { P0[r] = fsub_s(P0[r], dl); P1[r] = fsub_s(P1[r], dl); } } \
    _Pragma("unroll") for (int r = 0; r < 16; ++r) P0[r] = __builtin_amdgcn_exp2f(P0[r]); } while (0)
  #define RESC() do { if (resc) { asm volatile("s_waitcnt lgkmcnt(0)" ::: "memory"); \
      _Pragma("unroll") for (int d_ = 0; d_ < 2; ++d_) _Pragma("unroll") for (int r = 0; r < 16; ++r) o[d_][r] *= wsf[crow(r, hi)]; } } while (0)
  f32x16 pA0, pA1, pB0, pB1;
  int sl_prev = s0, sl_cur = s0, sl_next = s1;
  #define ROT() do { sl_prev = sl_cur; sl_cur = sl_next; sl_next = (sl_next == (NSLOT - 1) * SLOTB) ? 0 : sl_next + SLOTB; } while (0)
  if (!primed) { DMA_K(2, s2); WAIT_BAR(3); }
  PA_T1(1); PA_T0(2);
  { f32x16 negm;
    #pragma unroll
    for (int r = 0; r < 16; ++r) negm[r] = nm;
    qkt(pA0, pA1, shm3 + LDS_K + s0, qr, negm, r32, hi); }
  asm volatile("s_nop 15\n\ts_nop 7" : "+v"(pA0), "+v"(pA1)); DECAY(pA0, pA1, 0); CMASK(pA0, pA1, 0);
  asm volatile("s_nop 1" : "+v"(pA0), "+v"(pA1));
  START(pA0, pA1);
  _Pragma("unroll") for (int r = 0; r < 16; ++r) pA1[r] = __builtin_amdgcn_exp2f(pA1[r]);
  WAIT_BAR(0);
  DMA_K(3, s0); DMA_V(1, s1);
  ROT();
  kload8(kf, kp0 + sl_cur);
  WAIT_BAR(2);
  PA_T1(2); PA_T0(3);
  s16x4 vlo[8], vhi[8]; u32x4 pw0, pw1, pw2, pw3; bf16x8 qfa = QLD(0), qfb = QLD(1);
  #define PKW(P, B) cvtpk_s(P[B], P[B + 1])
  #define PAF(k) __builtin_bit_cast(bf16x8, pw##k)
  #define VFR(i) (bf16x8){vlo[i][0], vlo[i][1], vlo[i][2], vlo[i][3], vhi[i][0], vhi[i][1], vhi[i][2], vhi[i][3]}
  #define PIN(x) asm volatile("" : "+v"(x))
  #define MX3(a, b, c) __builtin_fmaxf(__builtin_fmaxf((a), (b)), (c))
  #define SPLAT(X) do { _Pragma("unroll") for (int r_ = 0; r_ < 16; ++r_) X[r_] = nm; PIN(X); } while (0)
  #define GAPA(MF, A0, A1, A2, A3, W0, W1, PW) do { MF; sacc += A0; sacc += A1; sacc += A2; sacc += A3; PIN(sacc); W0; W1; PIN(PW); SBAR(); } while (0)
  #define EX(v) __builtin_amdgcn_exp2f(v)
  #define GAPB(MF, X, B) do { MF; X[B] = EX(X[B]); X[B + 1] = EX(X[B + 1]); X[B + 2] = EX(X[B + 2]); X[B + 3] = EX(X[B + 3]); PIN(X); SBAR(); } while (0)
  #define VRD(i) do { vlo[i] = vtr(vp_ + (((i) >> 2) * 4096 + ((i) & 3) * 1024)); vhi[i] = vtr(vp_ + (((i) >> 2) * 4096 + ((i) & 3) * 1024 + 512)); } while (0)
  #define KRD(G, j) do { if (G) { kload2(kf, kp0 + sl_next, j); SBAR(); } } while (0)
  #define STEP(C0, C1, P0, P1, t, GK, GV, GL) do { SBAR(); \
    const lds_cptr vp_ = vp0 + sl_prev; \
    SPLAT(C0); VRD(0); SBAR(); float sacc = (P0[0] + P0[1]); \
    GAPA(C0 = __builtin_amdgcn_mfma_f32_32x32x16_bf16(kf[0], qfa, C0, 0, 0, 0), P0[2], P0[3], P0[4], P0[5],     pw0[0] = PKW(P0, 0), pw0[1] = PKW(P0, 2), pw0); \
    SPLAT(C1); VRD(4); SBAR(); GAPA(C1 = __builtin_amdgcn_mfma_f32_32x32x16_bf16(kf[1], qfa, C1, 0, 0, 0), P0[6], P0[7], P0[8], P0[9],     pw0[2] = PKW(P0, 4), pw0[3] = PKW(P0, 6), pw0); \
    qfa = QLD(2); VRD(1); SBAR(); GAPA(C0 = __builtin_amdgcn_mfma_f32_32x32x16_bf16(kf[2], qfb, C0, 0, 0, 0),   P0[10], P0[11], P0[12], P0[13], pw1[0] = PKW(P0, 8), pw1[1] = PKW(P0, 10), pw1); \
    VRD(5); SBAR(); GAPA(C1 = __builtin_amdgcn_mfma_f32_32x32x16_bf16(kf[3], qfb, C1, 0, 0, 0),   P0[14], P0[15], P1[0], P1[1],   pw1[2] = PKW(P0, 12), pw1[3] = PKW(P0, 14), pw1); \
    qfb = QLD(3); VRD(2); SBAR(); GAPA(C0 = __builtin_amdgcn_mfma_f32_32x32x16_bf16(kf[4], qfa, C0, 0, 0, 0),   P1[2], P1[3], P1[4], P1[5],     pw2[0] = PKW(P1, 0), pw2[1] = PKW(P1, 2), pw2); \
    VRD(6); SBAR(); GAPA(C1 = __builtin_amdgcn_mfma_f32_32x32x16_bf16(kf[5], qfa, C1, 0, 0, 0),   P1[6], P1[7], P1[8], P1[9],     pw2[2] = PKW(P1, 4), pw2[3] = PKW(P1, 6), pw2); \
    VRD(3); SBAR(); GAPA(C0 = __builtin_amdgcn_mfma_f32_32x32x16_bf16(kf[6], qfb, C0, 0, 0, 0),   P1[10], P1[11], P1[12], P1[13], pw3[0] = PKW(P1, 8), pw3[1] = PKW(P1, 10), pw3); \
    VRD(7); SBAR(); GAPA(C1 = __builtin_amdgcn_mfma_f32_32x32x16_bf16(kf[7], qfb, C1, 0, 0, 0),   P1[14], P1[15], 0.f, 0.f,       pw3[2] = PKW(P1, 12), pw3[3] = PKW(P1, 14), pw3); \
    l_reg += sacc; \
    if (GK) { DMA_K((t) + 3, sl_cur); } if (GV) { DMA_V((t) + 1, sl_next); } \
    DECAY(C0, C1, t); \
    CMASK(C0, C1, t); \
    { float a = MX3(C0[0], C0[1], C1[0]), b = MX3(C0[2], C0[3], C1[1]); a = MX3(a, C1[2], C1[3]); \
      _Pragma("unroll") for (int r = 4; r < 16; r += 4) { a = MX3(a, C0[r], C0[r + 1]); b = MX3(b, C0[r + 2], C0[r + 3]); a = MX3(a, C1[r], C1[r + 1]); b = MX3(b, C1[r + 2], C1[r + 3]); } \
      float rm = __builtin_fmaxf(a, b); { auto rr = __builtin_amdgcn_permlane32_swap(__float_as_uint(rm), __float_as_uint(rm), false, false); rm = __builtin_fmaxf(__uint_as_float(rr[0]), __uint_as_float(rr[1])); } \
      resc = false; \
      if (__builtin_expect(__any(rm > (float)THRL), 0)) { const float dl = __builtin_fmaxf(rm, 0.f); nm -= dl; \
        _Pragma("unroll") for (int r = 0; r < 16; ++r) { C0[r] -= dl; C1[r] -= dl; } \
        const float f = __builtin_amdgcn_exp2f(-dl); l_reg *= f; if (hi == 0) wsf[r32] = f; resc = true; } } \
    SBAR(); \
    GAPB(o[0] = __builtin_amdgcn_mfma_f32_32x32x16_bf16(PAF(0), VFR(0), o[0], 0, 0, 0), C0, 0); \
    GAPB(o[1] = __builtin_amdgcn_mfma_f32_32x32x16_bf16(PAF(0), VFR(4), o[1], 0, 0, 0), C0, 4); \
    KRD(GL, 0); GAPB(o[0] = __builtin_amdgcn_mfma_f32_32x32x16_bf16(PAF(1), VFR(1), o[0], 0, 0, 0), C0, 8); \
    KRD(GL, 1); GAPB(o[1] = __builtin_amdgcn_mfma_f32_32x32x16_bf16(PAF(1), VFR(5), o[1], 0, 0, 0), C0, 12); \
    KRD(GL, 2); GAPB(o[0] = __builtin_amdgcn_mfma_f32_32x32x16_bf16(PAF(2), VFR(2), o[0], 0, 0, 0), C1, 0); \
    KRD(GL, 3); GAPB(o[1] = __builtin_amdgcn_mfma_f32_32x32x16_bf16(PAF(2), VFR(6), o[1], 0, 0, 0), C1, 4); \
    GAPB(o[0] = __builtin_amdgcn_mfma_f32_32x32x16_bf16(PAF(3), VFR(3), o[0], 0, 0, 0), C1, 8); \
    qfa = QLD(0); qfb = QLD(1); SBAR(); \
    GAPB(o[1] = __builtin_amdgcn_mfma_f32_32x32x16_bf16(PAF(3), VFR(7), o[1], 0, 0, 0), C1, 12); \
    } while (0)
  int t = 1;
  #undef CMASK
  #define CMASK(P0, P1, t) do {} while (0)
  for (; t + 5 < NT; t += 2) {
    STEP(pB0, pB1, pA0, pA1, t, true, true, true);     WAIT_BAR(2); RESC(); ROT();
    STEP(pA0, pA1, pB0, pB1, t + 1, true, true, true); WAIT_BAR(2); RESC(); ROT();
  }
  #undef CMASK
  #define CMASK(P0, P1, t) do { if (!WIN) { int jb_ = (t) - (NT - 4); if (jb_ >= 0) cmask(P0, P1, jb_, qrel, hi); } } while (0)
  #define ENDW(tt) do { if ((tt) + 3 < NT) { WAIT_BAR(2); } else if ((tt) + 2 < NT) { WAIT_BAR(1); } else { WAIT_BAR(0); } } while (0)
  for (; t + 1 < NT; t += 2) {
    STEP(pB0, pB1, pA0, pA1, t, (t + 3 < NT), (t + 1 < NT), (t + 1 < NT));       ENDW(t);     RESC(); ROT();
    STEP(pA0, pA1, pB0, pB1, t + 1, (t + 4 < NT), (t + 2 < NT), (t + 2 < NT));   ENDW(t + 1); RESC(); ROT();
  }
  bool pf_next = false;
  if constexpr (XP) { pf_next = xp.has_next; if (pf_next) {
    const int n0 = sl_next, n1 = NXS(n0), n2 = NXS(n1);
    const bf16* ksn = xp.Kn + (long)lane * xp.Pn + wid * 8;
    const bf16* vsn = xp.Vn + (long)(16 * (wid & 3) + (lane >> 2)) * xp.Pn + (wid >> 2) * 32 + (lane & 3) * 8;
    glds16(ksn, (unsigned)__builtin_amdgcn_readfirstlane(kdst + n0));
    const bf16* Qwn = xp.Qn + (long)(wid * QBLK) * xp.Pn;
    #pragma unroll
    for (int d0 = 0; d0 < 4; ++d0) qn[d0] = *reinterpret_cast<const bf16x8*>(&Qwn[(long)r32 * xp.Pn + d0 * 16 + hi * 8]);
    glds16(vsn, (unsigned)__builtin_amdgcn_readfirstlane(vdst + n0));
    glds16(ksn + (long)KVBLK * xp.Pn, (unsigned)__builtin_amdgcn_readfirstlane(kdst + n1));
    glds16(ksn + (long)2 * KVBLK * xp.Pn, (unsigned)__builtin_amdgcn_readfirstlane(kdst + n2));
    rho = n0 / SLOTB; } }
  STEP(pB0, pB1, pA0, pA1, NT - 1, false, false, false); RESC();
  { float sacc = pB0[0] + pB0[1]; _Pragma("unroll") for (int r = 2; r < 16; ++r) sacc += pB0[r]; _Pragma("unroll") for (int r = 0; r < 16; ++r) sacc += pB1[r]; l_reg += sacc;
    pw0 = (u32x4){PKW(pB0, 0), PKW(pB0, 2), PKW(pB0, 4), PKW(pB0, 6)}; pw1 = (u32x4){PKW(pB0, 8), PKW(pB0, 10), PKW(pB0, 12), PKW(pB0, 14)}; pw2 = (u32x4){PKW(pB1, 0), PKW(pB1, 2), PKW(pB1, 4), PKW(pB1, 6)}; pw3 = (u32x4){PKW(pB1, 8), PKW(pB1, 10), PKW(pB1, 12), PKW(pB1, 14)};
    SBAR(); pv(o, vb0 + sl_cur, PAF(0), PAF(1), PAF(2), PAF(3)); }
  PA_T1(3); PA_T0(4);
  #undef PKW
  #undef PAF
  #undef VFR
  #undef PIN
  #undef MX3
  #undef GAPA
  #undef SPLAT
  #undef GAPB
  #undef EX
  #undef VRD
  #undef KRD
  #undef STEP
  #undef ENDW
  { auto rr = __builtin_amdgcn_permlane32_swap(__float_as_uint(l_reg), __float_as_uint(l_reg), false, false); l_reg = __uint_as_float(rr[0]) + __uint_as_float(rr[1]); }
  if (hi == 0) wsf[32 + r32] = l_reg; asm volatile("s_waitcnt lgkmcnt(0)" ::: "memory");
  float rli[16];
  #pragma unroll
  for (int r = 0; r < 16; ++r) rli[r] = WIN ? 1.0f : __builtin_amdgcn_rcpf(wsf[32 + crow(r, hi)]);
  if (WIN) { if (hi == 0) *(f32x2*)(PML + 2 * (wtok0 + (long)wtstride * (q0 + wid * QBLK + r32))) = (f32x2){-nm, l_reg}; }
  bf16* Ow = O + (long)(q0 + wid * QBLK) * P;
  { bf16* stg = (bf16*)(shm + LDS_OST) + wid * 2048;
    #pragma unroll
    for (int r = 0; r < 16; ++r) { const int orow = crow(r, hi);
      #pragma unroll
      for (int d0 = 0; d0 < 2; ++d0) stg[orow * 64 + d0 * 32 + r32] = __float2bfloat16(o[d0][r] * rli[r]); }
    asm volatile("s_waitcnt lgkmcnt(0)" ::: "memory");
    #pragma unroll
    for (int i = 0; i < 4; ++i) { const int row = i * 8 + (lane >> 3), ch = lane & 7; const u32x4 v = *(const u32x4*)(stg + row * 64 + ch * 8); *(u32x4*)(Ow + (long)row * P + ch * 8) = v; } }
  if constexpr (XP) { if (pf_next) {
    asm volatile("s_waitcnt vmcnt(5)" ::: "memory");
    #pragma unroll
    for (int d0 = 0; d0 < 4; ++d0) asm volatile("ds_write_b128 %0, %1 offset:%c2" :: "v"((unsigned)(uintptr_t)qp), "v"(qn[d0]), "i"(d0 * 1024) : "memory"); } }
  asm volatile("s_waitcnt lgkmcnt(0)\n\ts_barrier" ::: "memory");
  PA_T1(4);
  #undef DMA_K
  #undef DMA_V
  #undef NXS
  #undef CMASK
  #undef DECAY
  #undef START
  #undef RESC
  #undef ROT
  #undef QLD
}
template<int THRL, bool WIN> __device__ __forceinline__ void attn_unit(int qb, int T0, long P, const bf16* Q, const bf16* __restrict__ K, const bf16* __restrict__ V, bf16* O, char* shm, int wave,
                                                                        float* PML = nullptr, long wtok0 = 0, int wtstride = 0) {
  Xpf xp{}; bf16x8 qn[4]; int rho = 0;
  attn_unit_x<THRL, WIN, false>(qb, T0, P, Q, K, V, O, shm, wave, PML, wtok0, wtstride, xp, qn, rho);
}
#undef WAIT_BAR
}

namespace dil {
constexpr float NEGBIG = -1.0e30f;
__device__ __forceinline__ int t5_bucket(int dist) {
    if (dist < 16) return dist;
    const float v = logf((float)dist / 16.0f) / 4.852030263919617f * 16.0f;
    const int l = 16 + (int)v; return l < 31 ? l : 31;
}
__device__ __forceinline__ void build_table(LAS float* tb, const float* rel_bias, int g, int d, int j, int tid) {
    asm volatile("" : "+v"(tid));
    for (int e = tid; e < 640; e += 512) { const int n = e - 256; const float v = (n >= 0 && n <= 128) ? rel_bias[t5_bucket(n * d) * 24 + 8 * g + j] * LOG2E : NEGBIG; const int m = 639 - e;
#pragma unroll
        for (int sft = 0; sft < 4; ++sft) if (m - sft >= 0) tb[640 * sft + m - sft] = v; }
}
}

#define XB_TMO      128
#define XB_XCNT(j)  (256  + 64 * (j))
#define XB_XSUB(j)  (1280 + 64 * (j))
#define XB_XGEN(j)  (2304 + 64 * (j))
#define XB_TOP      3328
#define XB_TOPGEN   3392
#define XCD_BAR_WORDS 3456
#define XB_SPIN_CAP (1u << 18)
__device__ __forceinline__ unsigned xb_ld(unsigned* p)              { return __hip_atomic_load(p, __ATOMIC_RELAXED, __HIP_MEMORY_SCOPE_AGENT); }
__device__ __forceinline__ unsigned xb_add(unsigned* p, unsigned v) { return __hip_atomic_fetch_add(p, v, __ATOMIC_RELAXED, __HIP_MEMORY_SCOPE_AGENT); }
__device__ __forceinline__ unsigned xb_xcc_id() { return (unsigned)__builtin_amdgcn_s_getreg((3 << 11) | 20) & 0xFu; }
#define XB_SPIN(cond, bar) do { unsigned _sp = 0; while (cond) { __builtin_amdgcn_s_sleep(1); \
    if ((++_sp & 255u) == 0u) { if (xb_ld(&(bar)[XB_TMO])) break; if (_sp > XB_SPIN_CAP) { atomicAdd(&(bar)[XB_TMO], 1u); break; } } } } while (0)
struct XcdBarrier { unsigned* bar; unsigned x; volatile LAS unsigned* st; };
__device__ __forceinline__ XcdBarrier xcd_barrier_post(unsigned* bar, volatile LAS unsigned* st, bool leader) {
    XcdBarrier b; b.bar = bar; b.x = xb_xcc_id(); b.st = st;
    if (leader) (void)xb_add(&bar[XB_XCNT(b.x)], 1u);
    return b;
}
__device__ __forceinline__ void xcd_barrier_complete(unsigned* bar, unsigned x, unsigned& nloc, unsigned& nx) {
    const unsigned G = gridDim.x * gridDim.y * gridDim.z;
    unsigned sum, cnt, mine, sp = 0u;
    for (;;) {
        sum = 0u; cnt = 0u; mine = 0u;
#pragma unroll
        for (unsigned j = 0; j < 16; ++j) { const unsigned c = xb_ld(&bar[XB_XCNT(j)]); sum += c; cnt += (c > 0u) ? 1u : 0u; mine = (j == x) ? c : mine; }
        if (sum == G) break;
        __builtin_amdgcn_s_sleep(1);
        if ((++sp & 255u) == 0u) { if (xb_ld(&bar[XB_TMO])) break; if (sp > XB_SPIN_CAP) { atomicAdd(&bar[XB_TMO], 1u); break; } }
    }
    nloc = mine > 0u ? mine : 1u; nx = cnt > 0u ? cnt : 1u;
}
__device__ __forceinline__ void xcd_barrier(const XcdBarrier& b, bool leader) {
    asm volatile("s_waitcnt vmcnt(0)" ::: "memory");
    __syncthreads();
    if (leader) {
        unsigned* bar = b.bar;
        __builtin_amdgcn_s_waitcnt(0);
        unsigned nloc = b.st[0], nx = b.st[1];
        if (nloc == 0u) { xcd_barrier_complete(bar, b.x, nloc, nx); b.st[0] = nloc; b.st[1] = nx; }
        const unsigned old = xb_add(&bar[XB_XSUB(b.x)], 1u);
        const unsigned gen = old / nloc;
        if (old + 1u == (gen + 1u) * nloc) {
            __builtin_amdgcn_fence(__ATOMIC_RELEASE, "agent");
            asm volatile("s_waitcnt vmcnt(0)" ::: "memory");
            const unsigned og = xb_add(&bar[XB_TOP], 1u);
            const unsigned tg = og / nx;
            if (og + 1u == (tg + 1u) * nx) xb_add(&bar[XB_TOPGEN], 1u);
            else XB_SPIN(xb_ld(&bar[XB_TOPGEN]) == tg, bar);
            __builtin_amdgcn_fence(__ATOMIC_ACQUIRE, "agent");
            xb_add(&bar[XB_XGEN(b.x)], 1u);
            asm volatile("s_waitcnt vmcnt(0)" ::: "memory");
        } else {
            XB_SPIN(xb_ld(&bar[XB_XGEN(b.x)]) == gen, bar);
            __builtin_amdgcn_fence(__ATOMIC_ACQUIRE, "agent");
            asm volatile("s_waitcnt vmcnt(0)" ::: "memory");
        }
    }
    __syncthreads();
}

__device__ __forceinline__ const float* inptr(int k) {
    asm volatile("" : "+s"(k));
    return ((const float* const __attribute__((address_space(4)))*)__builtin_amdgcn_kernarg_segment_ptr())[k];
}
#define INP(k) inptr(k)
__device__ __forceinline__ int otid(int wave) { int t = wave * 64 + lane_id(); asm volatile("" : "+v"(t)); return t; }
__device__ __forceinline__ unsigned char* opq_ptr(unsigned char* p) { asm volatile("" : "+s"(p)); return p; }
struct Frame {
    LAS unsigned char* lds;
    volatile LAS unsigned* MISC;
    gu32* ctl;
    int wave;
    int vcu, G;
    float* out;
    unsigned char* ws;
};
__device__ __forceinline__ float wave_sum(float v, int lane) {
#pragma unroll
    for (int o = 1; o < 64; o <<= 1) v += shfl_x(v, lane, o);
    return v;
}

struct P0D { const float* W; int ldw; int K; bf16_t* WT; const float* gain; int kb, nb; int f8; };
__device__ __forceinline__ P0D p0_decode(int it, unsigned char* ws) {
    constexpr int I0 = 16 * 96, I1 = 16 * 32, I2 = 16 * 96, I3 = 16 * 48, I4 = 8 * 32, I5 = 32 * 256, I6 = 32 * 256;
    P0D d; int r = it;
    if (r < I0) { d.f8 = 1; d.W = INP(2); d.ldw = 3088; d.K = 1024; d.WT = (bf16_t*)(ws + WS_WQKVA); d.gain = INP(1); d.kb = r / 96; d.nb = r % 96; return d; } r -= I0;
    if (r < I1) { d.f8 = 0; d.W = INP(6); d.ldw = 1024; d.K = 1024; d.WT = (bf16_t*)(ws + WS_WOA); d.gain = nullptr; d.kb = r / 32; d.nb = r % 32; return d; } r -= I1;
    if (r < I2) { d.f8 = 1; d.W = INP(8); d.ldw = 3072; d.K = 1024; d.WT = (bf16_t*)(ws + WS_WKVQ); d.gain = INP(7); d.kb = r / 96; d.nb = r % 96; return d; } r -= I2;
    if (r < I3) { d.f8 = 1; d.W = INP(12); d.ldw = 1536; d.K = 1024; d.WT = (bf16_t*)(ws + WS_WKVQ + (size_t)3072 * 1024); d.gain = INP(11); d.kb = r / 48; d.nb = r % 48; return d; } r -= I3;
    if (r < I4) { d.f8 = 1; d.W = INP(14); d.ldw = 1024; d.K = 512; d.WT = (bf16_t*)(ws + WS_WOB); d.gain = nullptr; d.kb = r / 32; d.nb = r % 32; return d; } r -= I4;
    if (r < I5) { const int le = r / 256, q = r % 256;
        d.f8 = 1; d.W = INP(20) + (size_t)le * 1024 * 512; d.ldw = 512; d.K = 1024; d.WT = (bf16_t*)(ws + WS_WGU + (size_t)le * 1024 * 1024); d.gain = INP(15) + (le >> 4) * 1024; d.kb = q / 16; d.nb = q % 16; return d; } r -= I5;
    if (r < I6) { const int le = r / 256, q = r % 256;
        d.f8 = 1; d.W = INP(21) + (size_t)le * 1024 * 512; d.ldw = 512; d.K = 1024; d.WT = (bf16_t*)(ws + WS_WGU + (size_t)le * 1024 * 1024 + (size_t)512 * 1024); d.gain = INP(15) + (le >> 4) * 1024; d.kb = q / 16; d.nb = q % 16; return d; } r -= I6;
    { const int le = r / 256, q = r % 256;
        d.f8 = 1; d.W = INP(22) + (size_t)le * 512 * 1024; d.ldw = 1024; d.K = 512; d.WT = (bf16_t*)(ws + WS_WD + (size_t)le * 1024 * 512); d.gain = nullptr; d.kb = q / 32; d.nb = q % 32; return d; }
}
__device__ __forceinline__ void p0_load(const P0D& d, int lane, f32x4 (&v)[8], float (&gv)[8]) {
    const float* src = d.W + (size_t)(64 * d.kb + (lane >> 3)) * d.ldw + 32 * d.nb + 4 * (lane & 7);
#pragma unroll
    for (int i = 0; i < 8; ++i) { v[i] = *(const GAS f32x4*)(src + (size_t)(8 * i) * d.ldw); gv[i] = d.gain ? d.gain[64 * d.kb + (lane >> 3) + 8 * i] : 1.0f; }
}
__device__ __forceinline__ void p0_store(const P0D& d, int lane, const f32x4 (&v)[8], const float (&gv)[8], LAS float* scr) {
#pragma unroll
    for (int i = 0; i < 8; ++i) { LAS float* p = scr + ((lane >> 3) + 8 * i) * 33 + 4 * (lane & 7); const f32x4 x = v[i] * gv[i]; p[0] = x[0]; p[1] = x[1]; p[2] = x[2]; p[3] = x[3]; }
    LDS_WAIT(); asm volatile("" ::: "memory");
    const int c = lane & 7, k0 = 64 * d.kb, n0 = 32 * d.nb;
#pragma unroll
    for (int j = 0; j < 4; ++j) { const int n = (lane >> 3) + 8 * j; const LAS float* s = scr + (8 * c) * 33 + n;
        if (d.f8) { u32x2 o; o.x = pk4_fp8(s[0 * 33] * W8SCALE, s[1 * 33] * W8SCALE, s[2 * 33] * W8SCALE, s[3 * 33] * W8SCALE); o.y = pk4_fp8(s[4 * 33] * W8SCALE, s[5 * 33] * W8SCALE, s[6 * 33] * W8SCALE, s[7 * 33] * W8SCALE);
            *(GAS u32x2*)((unsigned char*)d.WT + (size_t)(n0 + n) * d.K + k0 + 8 * c) = o; }
        else { u32x4 o; o.x = pk2(s[0 * 33], s[1 * 33]); o.y = pk2(s[2 * 33], s[3 * 33]); o.z = pk2(s[4 * 33], s[5 * 33]); o.w = pk2(s[6 * 33], s[7 * 33]);
            *(GAS u32x4*)(d.WT + (size_t)(n0 + n) * d.K + k0 + 8 * c) = o; } }
    LDS_WAIT(); asm volatile("" ::: "memory");
}
struct P0H { const float* W; unsigned char* WT; int kb, nb; };
__device__ __forceinline__ P0H p0h_decode(int idx, unsigned char* ws) { const int le = idx >> 9, hq = idx & 511; P0H d; d.W = INP(22) + (size_t)le * 512 * 1024; d.WT = ws + WS_WD + (size_t)le * 1024 * 512; d.kb = hq >> 6; d.nb = hq & 63; return d; }
__device__ __forceinline__ void p0h_load(const P0H& d, int lane, f32x4 (&v)[4]) {
    const float* src = d.W + (size_t)(64 * d.kb + (lane >> 2)) * 1024 + 16 * d.nb + 4 * (lane & 3);
#pragma unroll
    for (int i = 0; i < 4; ++i) v[i] = *(const GAS f32x4*)(src + (size_t)(16 * i) * 1024);
}
__device__ __forceinline__ void p0h_store(const P0H& d, int lane, const f32x4 (&v)[4], LAS float* scr) {
#pragma unroll
    for (int i = 0; i < 4; ++i) { LAS float* p = scr + ((lane >> 2) + 16 * i) * 17 + 4 * (lane & 3); p[0] = v[i][0]; p[1] = v[i][1]; p[2] = v[i][2]; p[3] = v[i][3]; }
    LDS_WAIT(); asm volatile("" ::: "memory");
    const int n = lane >> 2, c = lane & 3; const LAS float* s = scr + (16 * c) * 17 + n;
    u32x4 o;
    o.x = pk4_fp8(s[0 * 17] * W8SCALE, s[1 * 17] * W8SCALE, s[2 * 17] * W8SCALE, s[3 * 17] * W8SCALE);     o.y = pk4_fp8(s[4 * 17] * W8SCALE, s[5 * 17] * W8SCALE, s[6 * 17] * W8SCALE, s[7 * 17] * W8SCALE);
    o.z = pk4_fp8(s[8 * 17] * W8SCALE, s[9 * 17] * W8SCALE, s[10 * 17] * W8SCALE, s[11 * 17] * W8SCALE); o.w = pk4_fp8(s[12 * 17] * W8SCALE, s[13 * 17] * W8SCALE, s[14 * 17] * W8SCALE, s[15 * 17] * W8SCALE);
    *(GAS u32x4*)(d.WT + (size_t)(16 * d.nb + n) * 512 + 64 * d.kb + 16 * c) = o;
    LDS_WAIT(); asm volatile("" ::: "memory");
}
__device__ __forceinline__ void p0_prologue(Frame& F) {
    const int tid_ = otid(F.wave), lane_ = tid_ & 63;
    LAS float* scr = (LAS float*)(F.lds + F.wave * 16384);
    const int gw = F.vcu * 8 + F.wave, NGW = F.G * 8;
    unsigned char* ws = F.ws;
    constexpr int NITEMS = 16 * 96 + 16 * 32 + 16 * 96 + 16 * 48 + 8 * 32 + 2 * 32 * 256;
    {
        f32x4 va[8], vb[8], vc_[8]; float ga[8], gb[8], gc[8]; P0D da, db, dc;
        int it = gw;
        if (it < NITEMS) { da = p0_decode(it, ws); p0_load(da, lane_, va, ga); }
        if (it + NGW < NITEMS) { db = p0_decode(it + NGW, ws); p0_load(db, lane_, vb, gb); }
        while (it < NITEMS) {
            if (it + 2 * NGW < NITEMS) { dc = p0_decode(it + 2 * NGW, ws); p0_load(dc, lane_, vc_, gc); }
            p0_store(da, lane_, va, ga, scr);
            if (it + NGW >= NITEMS) break;
            if (it + 3 * NGW < NITEMS) { da = p0_decode(it + 3 * NGW, ws); p0_load(da, lane_, va, ga); }
            p0_store(db, lane_, vb, gb, scr);
            if (it + 2 * NGW >= NITEMS) break;
            if (it + 4 * NGW < NITEMS) { db = p0_decode(it + 4 * NGW, ws); p0_load(db, lane_, vb, gb); }
            p0_store(dc, lane_, vc_, gc, scr);
            it += 3 * NGW;
        }
    }
    const int gt = gw * 64 + lane_, NGT = NGW * 64;
    { const float* an = INP(1); const float* awin = INP(2);
    for (int e = gt; e < 16 * 1024; e += NGT) { const int n = e >> 10, k = e & 1023; ((bf16_t*)(ws + WS_WF))[e] = (bf16_t)f2bf(an[k] * awin[(size_t)k * 3088 + 3072 + n]); } }
    const float* fn_ = INP(15); const float* wexp_ = INP(18); const float* wgrp_ = INP(16);
    for (int e = gt; e < 2 * 32 * 1024; e += NGT) { const int l = e >> 15, n = (e >> 10) & 31, k = e & 1023;
        float v = 0.f;
        if (n < 16) v = fn_[l * 1024 + k] * wexp_[((size_t)l * 1024 + k) * 16 + n];
        else if (n < 20) v = fn_[l * 1024 + k] * wgrp_[((size_t)l * 1024 + k) * 4 + (n - 16)];
        const unsigned hb = f2bf(v); const float lo = v - bf2f(hb);
        bf16_t* wr = (bf16_t*)(ws + WS_WR) + (size_t)l * 2 * 32 * 1024;
        wr[n * 1024 + k] = (bf16_t)hb; wr[32 * 1024 + n * 1024 + k] = (bf16_t)f2bf(lo); }
    if (gt < 6 * 64) { const int sgi = gt >> 6, d = gt & 63; float v = 1.0f;
        if (sgi == 0) v = INP(4)[d] * C2; else if (sgi == 1) v = INP(5)[d]; else if (sgi == 3) v = INP(9)[d]; else if (sgi == 5) v = INP(13)[d] * C2;
        ((float*)(ws + WS_GTAB))[gt] = v; }
    const float* x_ = INP(0);
    {
        f32x4 v[4], vn[4], vm[4];
        int m = gw;
        if (m < NTOK) { const GAS f32x4* xr = (const GAS f32x4*)(x_ + (size_t)m * DM) + lane_;
#pragma unroll
            for (int jj = 0; jj < 4; ++jj) v[jj] = xr[64 * jj]; }
        if (m + NGW < NTOK) { const GAS f32x4* xr = (const GAS f32x4*)(x_ + (size_t)(m + NGW) * DM) + lane_;
#pragma unroll
            for (int jj = 0; jj < 4; ++jj) vn[jj] = xr[64 * jj]; }
        while (m < NTOK) {
            if (m + 2 * NGW < NTOK) { const GAS f32x4* xr = (const GAS f32x4*)(x_ + (size_t)(m + 2 * NGW) * DM) + lane_;
#pragma unroll
                for (int jj = 0; jj < 4; ++jj) vm[jj] = xr[64 * jj]; }
            float sq = 0.f;
#pragma unroll
            for (int jj = 0; jj < 4; ++jj) sq += (v[jj].x * v[jj].x + v[jj].y * v[jj].y) + (v[jj].z * v[jj].z + v[jj].w * v[jj].w);
            const float rstd = 1.f / sqrtf(wave_sum(sq, lane_) * (1.f / DM) + EPS);
            GAS unsigned long long* o8 = (GAS unsigned long long*)((bf16_t*)(ws + WS_XB) + (size_t)m * DM) + lane_;
#pragma unroll
            for (int jj = 0; jj < 4; ++jj) o8[64 * jj] = (unsigned long long)pk2(v[jj].x, v[jj].y) | ((unsigned long long)pk2(v[jj].z, v[jj].w) << 32);
            GAS unsigned* q8 = (GAS unsigned*)(ws + WS_XB8 + (size_t)m * DM) + lane_;
#pragma unroll
            for (int jj = 0; jj < 4; ++jj) q8[64 * jj] = pk4_fp8(v[jj].x, v[jj].y, v[jj].z, v[jj].w);
            if (lane_ == 0) ((float*)(ws + WS_RSTD0))[m] = rstd;
#pragma unroll
            for (int jj = 0; jj < 4; ++jj) { v[jj] = vn[jj]; vn[jj] = vm[jj]; }
            m += NGW;
        }
    }
}

__device__ __forceinline__ void forget_phase(Frame& F) {
    const int tid_ = otid(F.wave), lane_ = tid_ & 63;
    const bf16_t* XB = (const bf16_t*)(F.ws + WS_XB); const bf16_t* WF = (const bf16_t*)(F.ws + WS_WF);
    const float* RSTD0 = (const float*)(F.ws + WS_RSTD0); const float* b_f = INP(3);
    float* LC = (float*)(F.ws + WS_LC); float* CT = (float*)(F.ws + WS_CT);
    LAS float* wt = (LAS float*)(F.lds + AUX_OFF);
    const int fr = lane_ & 15, fq = lane_ >> 4;
    for (int chunk = blockIdx.x; chunk < NTOK / 128; chunk += F.G) {
        const int row = chunk * 128 + F.wave * 16 + fr;
        const bf16_t* xa = XB + (size_t)row * DM + 8 * fq; const bf16_t* wb = WF + (size_t)fr * DM + 8 * fq;
        f32x4 acc = {0.f, 0.f, 0.f, 0.f};
#pragma unroll 8
        for (int kb = 0; kb < 32; ++kb) { const bf16x8 a = *(const bf16x8*)(xa + 32 * kb), w = *(const bf16x8*)(wb + 32 * kb); acc = __builtin_amdgcn_mfma_f32_16x16x32_bf16(w, a, acc, 0, 0, 0); }
        const float rs = RSTD0[row];
        float lf[4];
#pragma unroll
        for (int i = 0; i < 4; ++i) { const float z = acc[i] * rs + b_f[4 * fq + i]; lf[i] = fminf(z, 0.f) - log1pf(expf(-fabsf(z))); }
#pragma unroll
        for (int off = 1; off < 16; off <<= 1)
#pragma unroll
            for (int i = 0; i < 4; ++i) { const float t = shfl_from(lf[i], lane_ - off); if (fr >= off) lf[i] += t; }
        if (fr == 15) {
#pragma unroll
            for (int i = 0; i < 4; ++i) wt[F.wave * 16 + 4 * fq + i] = lf[i]; }
        __syncthreads();
#pragma unroll
        for (int i = 0; i < 4; ++i) { float p = 0.f; for (int w = 0; w < F.wave; ++w) p += wt[w * 16 + 4 * fq + i]; lf[i] += p; }
        const int b = row >> 13, s = row & (SEQ - 1);
#pragma unroll
        for (int i = 0; i < 4; ++i) LC[(size_t)(b * 16 + 4 * fq + i) * SEQ + s] = lf[i];
        if (F.wave == 7 && fr == 15) {
#pragma unroll
            for (int i = 0; i < 4; ++i) CT[(b * 16 + 4 * fq + i) * 64 + ((chunk * 128) & (SEQ - 1)) / 128] = lf[i]; }
        __syncthreads();
    }
}

__device__ __forceinline__ void attnA_phase(Frame& F, unsigned char* ldsg) {
    const int tid_ = otid(F.wave), lane_ = tid_ & 63;
    LAS float* NCK = (LAS float*)(F.lds + attn_body::LDS_NCK);
    LAS float* CPs = (LAS float*)(F.lds + AUX_OFF);
    volatile LAS int* ctl = (volatile LAS int*)(F.lds + AUX_OFF + 256);
    const float* LC = (const float*)(F.ws + WS_LC); const float* CT = (const float*)(F.ws + WS_CT);
    float mqk = 0.f;
    { const float* gq_ = INP(4); const float* gk_ = INP(5);
      for (int d = 0; d < 64; ++d) mqk = fmaxf(mqk, fabsf(gq_[d] * gk_[d])); }
    const float thr2 = (40.f + 2.f * 8.f * mqk * 1.03f) * LOG2E;
    unsigned* queue = (unsigned*)(F.ctl + CW_QUEUE);
    for (;;) {
        if (tid_ == 0) ctl[0] = (int)__hip_atomic_fetch_add(queue, 1u, RLX_AGENT);
        __syncthreads();
        const int u = ctl[0];
        if (u >= NBATCH * 16 * 32) break;
        const int qb = 31 - (u >> 6), bh = u & 63, b = bh >> 4, h = bh & 15, q0 = qb * 256, NTf = 4 * qb + 4, nkeys = q0 + 256;
        const float* lcp = LC + (size_t)bh * SEQ;
        f32x4 dva[4]; const P0H ddi = p0h_decode(8 * u + F.wave, F.ws); p0h_load(ddi, lane_, dva);
        if (F.wave == 0) { const float c = CT[bh * 64 + lane_]; float v = c;
#pragma unroll
            for (int off = 1; off < 64; off <<= 1) { const float t = shfl_from(v, lane_ - off); if (lane_ >= off) v += t; }
            const float excl = v - c; CPs[lane_] = excl;
            const float cumq = shfl_from(excl, q0 >> 7) + lcp[q0];
            const bool need = (lane_ <= (q0 >> 7)) && ((cumq - v) * LOG2E >= -thr2);
            const unsigned long long bm = __builtin_amdgcn_ballot_w64(need);
            int t0 = 2 * (int)__builtin_ctzll(bm | (1ull << 63)); t0 = t0 < NTf - 4 ? t0 : NTf - 4;
            if (lane_ == 0) ctl[1] = t0; }
        __syncthreads();
        const int T0 = ctl[1];
        const float cpq = CPs[q0 >> 7], lcq = lcp[q0];
        for (int s = 64 * T0 + tid_; s < nkeys; s += 512) NCK[s] = ((cpq - CPs[s >> 7]) + (lcq - lcp[s])) * LOG2E;
        __syncthreads();
        { const size_t ho = ((size_t)b * SEQ * 1024 + h * 64) * 2;
          attn_body::attn_unit<8, false>(qb, T0, 1024, (const attn_body::bf16*)(F.ws + WS_QA + ho), (const attn_body::bf16*)(F.ws + WS_KA + ho), (const attn_body::bf16*)(F.ws + WS_VA + ho), (attn_body::bf16*)(F.ws + WS_QA + ho), (char*)ldsg, F.wave); }
        p0h_store(ddi, lane_, dva, (LAS float*)(F.lds + F.wave * 8192));
    }
}

__device__ __forceinline__ void router_phase(Frame& F, int layer, const float* stats, float* rstd_out) {
    const int tid_ = otid(F.wave), lane_ = tid_ & 63;
    const bf16_t* XBr = (const bf16_t*)(F.ws + WS_XB); unsigned char* XN8 = (unsigned char*)(F.ws + WS_XN8); const bf16_t* WR = (const bf16_t*)(F.ws + WS_WR) + (size_t)layer * 2 * 32 * 1024;
    const float* b_group = INP(17) + layer * 4; const float* b_expert = INP(19) + layer * 16;
    float* GSORT = (float*)(F.ws + WS_GSORT); int* PERM = (int*)(F.ws + WS_PERM);
    unsigned* CNT = (unsigned*)(F.ctl + (layer == 0 ? CW_CNT0 : CW_CNT1));
    volatile LAS int* lcnt = (volatile LAS int*)(F.lds + AUX_OFF);
    const int fr = lane_ & 15, fq = lane_ >> 4;
#pragma unroll
    for (int p = 0; p < 16; ++p) { const int off = p * 8192 + tid_ * 16, n = off >> 11, pc = (off >> 4) & 127;
        __builtin_amdgcn_global_load_lds((const unsigned*)((const char*)WR + n * 2048 + ((pc ^ (n & 15)) << 4)), (LAS unsigned*)(F.lds + p * 8192 + F.wave * 1024), 16, 0, 0); }
    for (int chunk = blockIdx.x; chunk < NTOK / 128; chunk += F.G) {
        if (tid_ < 64) lcnt[tid_] = 0;
        VM_WAIT();
        __syncthreads();
        const int row = chunk * 128 + F.wave * 16 + fr;
        float ss; { const f32x4 p = *(const GAS f32x4*)(stats + (size_t)row * 16 + 4 * fq); ss = (p[0] + p[1]) + (p[2] + p[3]); ss += shfl_x(ss, 16 * fq + fr, 16); ss += shfl_x(ss, 16 * fq + fr, 32); }
        const float rs = 1.0f / sqrtf(ss * (1.0f / 1024.0f) + EPS);
        const bf16_t* hp = XBr + (size_t)row * DM + 8 * fq;
        unsigned char* x8 = XN8 + (size_t)row * DM + 8 * fq;
        const LAS unsigned char* wl = F.lds + fr * 2048;
        f32x4 a0 = {0.f, 0.f, 0.f, 0.f}, a1 = {0.f, 0.f, 0.f, 0.f};
#pragma unroll 4
        for (int kb = 0; kb < 32; ++kb) {
            const bf16x8 xh = *(const bf16x8*)(hp + 32 * kb);
            const int wc_ = ((4 * kb + fq) ^ fr) << 4;
            const bf16x8 wh0 = *(const LAS bf16x8*)(wl + wc_), wl0 = *(const LAS bf16x8*)(wl + 32 * 2048 + wc_);
            const bf16x8 wh1 = *(const LAS bf16x8*)(wl + 16 * 2048 + wc_), wl1 = *(const LAS bf16x8*)(wl + 48 * 2048 + wc_);
            a0 = __builtin_amdgcn_mfma_f32_16x16x32_bf16(wh0, xh, a0, 0, 0, 0); a0 = __builtin_amdgcn_mfma_f32_16x16x32_bf16(wl0, xh, a0, 0, 0, 0);
            a1 = __builtin_amdgcn_mfma_f32_16x16x32_bf16(wh1, xh, a1, 0, 0, 0); a1 = __builtin_amdgcn_mfma_f32_16x16x32_bf16(wl1, xh, a1, 0, 0, 0);
            u32x2 q8; q8.x = pk4_fp8(bf2f((unsigned short)xh[0]) * rs, bf2f((unsigned short)xh[1]) * rs, bf2f((unsigned short)xh[2]) * rs, bf2f((unsigned short)xh[3]) * rs);
            q8.y = pk4_fp8(bf2f((unsigned short)xh[4]) * rs, bf2f((unsigned short)xh[5]) * rs, bf2f((unsigned short)xh[6]) * rs, bf2f((unsigned short)xh[7]) * rs);
            *(u32x2*)(x8 + 32 * kb) = q8;
        }
        if (fq == 0) ((GAS float*)rstd_out)[row] = rs;
        float gl[4]; int gidx = 0; float gval = 0.f;
        {
#pragma unroll
            for (int i = 0; i < 4; ++i) gl[i] = a1[i] * rs + b_group[i];
            const float mx = fmaxf(fmaxf(gl[0], gl[1]), fmaxf(gl[2], gl[3]));
            float ex[4], sum = 0.f;
#pragma unroll
            for (int i = 0; i < 4; ++i) { ex[i] = expf(gl[i] - mx); sum += ex[i]; }
            float best = -1.f;
#pragma unroll
            for (int i = 0; i < 4; ++i) { const float p = ex[i] / sum; if (p > best) { best = p; gidx = i; } }
            gval = best;
        }
        gidx = shfl_from(gidx, fr); gval = shfl_from(gval, fr);
        int cls = -1, rank = 0; float gwlo = 0.f, gwhi = 0.f;
        if (fq == gidx) {
            float el[4];
#pragma unroll
            for (int i = 0; i < 4; ++i) el[i] = a0[i] * rs + b_expert[4 * fq + i];
            const float mx = fmaxf(fmaxf(el[0], el[1]), fmaxf(el[2], el[3]));
            float pr[4], sum = 0.f;
#pragma unroll
            for (int i = 0; i < 4; ++i) { pr[i] = expf(el[i] - mx); sum += pr[i]; }
#pragma unroll
            for (int i = 0; i < 4; ++i) pr[i] = pr[i] / sum;
            int i1 = 0; float p1 = -1.f;
#pragma unroll
            for (int i = 0; i < 4; ++i) if (pr[i] > p1) { p1 = pr[i]; i1 = i; }
            int i2 = 0; float p2 = -1.f;
#pragma unroll
            for (int i = 0; i < 4; ++i) if (i != i1 && pr[i] > p2) { p2 = pr[i]; i2 = i; }
            const float den = p1 + p2; const float w1g = gval * (p1 / den), w2g = gval * (p2 / den);
            const int lo = i1 < i2 ? i1 : i2, hi = i1 < i2 ? i2 : i1;
            const float wlo = i1 < i2 ? w1g : w2g, whi = i1 < i2 ? w2g : w1g;
            const int pidx = (lo == 0) ? hi - 1 : (lo == 1) ? hi + 1 : 5;
            cls = 6 * gidx + pidx;
            gwlo = wlo; gwhi = whi;
            rank = __hip_atomic_fetch_add((LAS int*)&lcnt[cls], 1, __ATOMIC_RELAXED, __HIP_MEMORY_SCOPE_WORKGROUP);
        }
        __syncthreads();
        if (tid_ < NCLASS) lcnt[32 + tid_] = (int)__hip_atomic_fetch_add(CNT + tid_, (unsigned)lcnt[tid_], RLX_AGENT);
        __syncthreads();
        if (cls >= 0) { const size_t p_ = (size_t)cls * CAP + lcnt[32 + cls] + rank; PERM[p_] = row; *(f32x2*)(GSORT + 2 * p_) = (f32x2){gwlo, gwhi}; }
        __syncthreads();
    }
}
__device__ __forceinline__ void moe_tile_prefix(Frame& F, const int* cnt, volatile LAS int* TP) {
    const int tid_ = otid(F.wave), lane_ = tid_ & 63;
    __syncthreads();
    if (tid_ == 0) { int acc = 0; for (int c = 0; c < NCLASS; ++c) { const int n = cnt[c]; TP[c] = acc; TP[32 + c] = n; acc += (n + 255) >> 8; } TP[NCLASS] = acc; }
    __syncthreads();
    if (tid_ < 160) { int c = 0;
        for (int k = 1; k < NCLASS; ++k) if (TP[k] <= tid_) c = k;
        TP[64 + tid_] = c; }
    __syncthreads();
}

__device__ __forceinline__ void dilated_phase(Frame& F, unsigned char* ldsg) {
    const int tid_ = otid(F.wave);
    LAS float* tb = (LAS float*)(F.lds + attn_body::LDS_NCK);
    const int per = (3072 + F.G - 1) / F.G;
    int gjprev = -1, rho = 0; bool primed = false; bf16x8 qn[4];
    for (int i = 0; i < per; ++i) {
        const int u = blockIdx.x * per + i; if (u >= 3072) break;
        const int g = u >> 10, v = u & 1023, j = v >> 7, b = (v >> 5) & 3, x = v & 31;
        const int D4 = 2 * g, d = 1 << D4, r = x & (d - 1), qb = x >> D4;
        unsigned long long pl_t = 0ull; if (PROBE_A == 5) pl_t = __builtin_amdgcn_s_memrealtime();
        if (g * 8 + j != gjprev) { __syncthreads(); dil::build_table(tb, INP(10), g, d, j, tid_); __syncthreads(); gjprev = g * 8 + j; }
        if (!primed) VM_WAIT();
        __syncthreads();
        if (PROBE_A == 5) { const unsigned d_ = (unsigned)(__builtin_amdgcn_s_memrealtime() - pl_t); if (tid_ == 0) ((LAS unsigned*)(F.lds + MISC_OFF))[121] += d_; }
        const size_t ho = (((size_t)(8 * g + j) * NTOK + (size_t)b * SEQ + (size_t)r * (SEQ >> D4)) * 64) * 2;
        const int T0 = qb == 0 ? 0 : 4 * qb - 2;
        attn_body::Xpf xp{}; xp.primed = primed; xp.has_next = (i + 1 < per) && (u + 1 < 3072);
        if (xp.has_next) { const int u2 = u + 1, g2 = u2 >> 10, v2 = u2 & 1023, j2 = v2 >> 7, b2 = (v2 >> 5) & 3, x2 = v2 & 31;
            const int D42 = 2 * g2, d2 = 1 << D42, r2 = x2 & (d2 - 1), qb2 = x2 >> D42, T02 = qb2 == 0 ? 0 : 4 * qb2 - 2;
            const size_t ho2 = (((size_t)(8 * g2 + j2) * NTOK + (size_t)b2 * SEQ + (size_t)r2 * (SEQ >> D42)) * 64) * 2; xp.Pn = 64;
            xp.Qn = (const attn_body::bf16*)(F.ws + WS_QB + ho2) + (long)qb2 * 256 * xp.Pn;
            xp.Kn = (const attn_body::bf16*)(F.ws + WS_KB + ho2) + (long)T02 * 64 * xp.Pn; xp.Vn = (const attn_body::bf16*)(F.ws + WS_VB + ho2) + (long)T02 * 64 * xp.Pn; }
        attn_body::attn_unit_x<8, true, true>(qb, T0, 64, (const attn_body::bf16*)(F.ws + WS_QB + ho), (const attn_body::bf16*)(F.ws + WS_KB + ho), (const attn_body::bf16*)(F.ws + WS_VB + ho),
                                      (attn_body::bf16*)(F.ws + WS_QB + ho), (char*)ldsg, F.wave, (float*)(F.ws + WS_DPML) + (size_t)(g * 8 + j) * NTOK * 2, (long)b * SEQ + r, d, xp, qn, rho);
        primed = xp.has_next;
    }
}
__device__ __forceinline__ void dilated_merge(Frame& F) {
    const int tid_ = otid(F.wave);
    bf16_t* QB = (bf16_t*)(F.ws + WS_QB); const float* PML = (const float*)(F.ws + WS_DPML);
    for (size_t it = (size_t)blockIdx.x * 512 + tid_; it < (size_t)NTOK * 64; it += (size_t)F.G * 512) {
        const int ch = (int)(it & 7), j = (int)((it >> 3) & 7); const size_t tok = it >> 6;
        f32x2 ml[3]; u32x4 o[3];
#pragma unroll
        for (int g = 0; g < 3; ++g) { ml[g] = *(const f32x2*)(PML + ((size_t)(g * 8 + j) * NTOK + tok) * 2); o[g] = *(const u32x4*)(QB + ((size_t)(8 * g + j) * NTOK + pg8::dil_row((int)tok, 2 * g)) * 64 + 8 * ch); }
        const float M = fmaxf(fmaxf(ml[0][0], ml[1][0]), ml[2][0]);
        float f[3], L = 0.f;
#pragma unroll
        for (int g = 0; g < 3; ++g) { f[g] = __builtin_amdgcn_exp2f(ml[g][0] - M); L += f[g] * ml[g][1]; }
        const float rl = 1.0f / L;
        float r8[8];
#pragma unroll
        for (int e = 0; e < 4; ++e) { float lo = 0.f, hh = 0.f;
#pragma unroll
            for (int g = 0; g < 3; ++g) { lo += bf2f(o[g][e] & 0xffffu) * f[g]; hh += bf2f(o[g][e] >> 16) * f[g]; }
            r8[2 * e] = lo * rl; r8[2 * e + 1] = hh * rl; }
        u32x2 q8; q8.x = pk4_fp8(r8[0], r8[1], r8[2], r8[3]); q8.y = pk4_fp8(r8[4], r8[5], r8[6], r8[7]);
        *(GAS u32x2*)(F.ws + WS_XB8 + tok * 512 + 64 * j + 8 * ch) = q8;
    }
}

struct Args { const float* in[23]; float* out; unsigned char* ws; };
__global__ void __launch_bounds__(512, 2) fwd_kernel(Args args) {
    extern __shared__ __attribute__((aligned(16))) unsigned char lds[];
    Frame F;
    F.lds = (LAS unsigned char*)lds;
    F.MISC = (volatile LAS unsigned*)(F.lds + MISC_OFF);
    F.wave = __builtin_amdgcn_readfirstlane((int)threadIdx.x >> 6);
    F.G = gridDim.x; { const int bx = blockIdx.x; F.vcu = (F.G % 8 == 0) ? (bx % 8) * (F.G / 8) + bx / 8 : bx; }
    F.out = args.out; F.ws = args.ws;
    F.ctl = (gu32*)(args.ws + WS_CTL);
    for (int u = otid(F.wave); u < 128; u += 512) ((LAS unsigned*)(F.lds + MISC_OFF))[u] = 0u;
    __syncthreads();
    XcdBarrier bar = xcd_barrier_post((unsigned*)(F.ctl + CW_BAR), F.MISC + 8, F.wave == 0 && lane_id() == 0);
#define GRID_BAR() xcd_barrier(bar, F.wave == 0 && lane_id() == 0)
#ifndef RUN_FROM
#define RUN_FROM 0
#endif
#define RUN(k) ((k) <= RUN_UPTO && (k) >= RUN_FROM)
#ifndef PROBE_MASK
#define PROBE_MASK 0
#endif
    unsigned long long pr_acc = 0ull, pr_t0 = 0ull;
#define PR_BEGIN(k) do { if ((PROBE_MASK >> (k)) & 1) pr_t0 = __builtin_amdgcn_s_memrealtime(); } while (0)
#define PR_END(k) do { if ((PROBE_MASK >> (k)) & 1) pr_acc += __builtin_amdgcn_s_memrealtime() - pr_t0; } while (0)

#define ws opq_ptr(F.ws)
#define XB ((bf16_t*)(ws + WS_XB))
#define H (F.out)
#define TP ((volatile LAS int*)(F.lds + AUX_OFF + 1024))

    PR_BEGIN(0); if (RUN(0)) { p0_prologue(F); GRID_BAR(); } PR_END(0);

    PR_BEGIN(1);
    if (RUN(1)) {
        pg8::GemmP g{(const void*)(ws + WS_XB8), 1024, 1024, 1 << 20, 32, (PROBE_KSEL >> 1) & 1};
        pg8::DenseSched S; S.so.init(NTOK, 3072, F.G, (int)blockIdx.x); S.Bt = (const bf16_t*)(ws + WS_WQKVA); S.lda = 512; S.ldb = 512;
        pg8::EpiHead E{(bf16_t*)(ws + WS_QA), (size_t)(WS_KA - WS_QA) / 2, (const float*)(ws + WS_GTAB), 2, 4, 8, 1024, (const float*)(ws + WS_RSTD0), nullptr, 1.0f / W8SCALE};
        pg8::gemm_phase<pg8::EpiHead, pg8::DenseSched, true>(F.lds, g, S, E, F.wave);
        forget_phase(F);
        GRID_BAR();
    }
    PR_END(1); PR_BEGIN(2);
    if (RUN(2)) { attnA_phase(F, lds); GRID_BAR(); }
    PR_END(2); PR_BEGIN(3);
    if (RUN(3)) {
        pg8::GemmP g{(const bf16_t*)(ws + WS_QA), 2048, 2048, 1 << 20, 128, (PROBE_KSEL >> 3) & 1};
        pg8::DenseSched S; S.so.init(NTOK, 1024, F.G, (int)blockIdx.x); S.Bt = (const bf16_t*)(ws + WS_WOA); S.lda = 1024; S.ldb = 1024;
        pg8::EpiResid E{XB, (float*)(ws + WS_STATS1), 1.0f};
        pg8::gemm_phase<pg8::EpiResid, pg8::DenseSched>(F.lds, g, S, E, F.wave);
        GRID_BAR();
    }
    PR_END(3);
#define MOE_LAYER(PH, layer, STATS_IN, RSTD_BUF, CW_CNT, LASTL, STATS_OUT) \
    PR_BEGIN(PH); if (RUN(PH)) { router_phase(F, layer, (const float*)(ws + STATS_IN), (float*)(ws + RSTD_BUF)); GRID_BAR(); } PR_END(PH); PR_BEGIN(PH + 1); \
    if (RUN(PH + 1)) { \
        const int* cnt = (const int*)(F.ctl + CW_CNT); moe_tile_prefix(F, cnt, TP); \
        pg8::GemmP g{(const void*)ws, 1024, 1024, 1 << 20, 512, (PROBE_KSEL >> (PH + 1)) & 1}; \
        pg8::MoeMixSched S{TP, cnt, (const int*)(ws + WS_PERM), (const unsigned char*)(ws + WS_WGU) + (size_t)layer * 16 * 1024 * 1024, (const unsigned char*)(ws + WS_WD) + (size_t)layer * 16 * 1024 * 512, \
                           F.G, (int)blockIdx.x, __builtin_amdgcn_readfirstlane(TP[NCLASS]), (unsigned*)(F.ctl + CW_DONE + layer * 16384), (unsigned*)(F.ctl + CW_BAR) + XB_TMO}; \
        pg8::EpiMoe<LASTL> E{pg8::EpiSwiglu{(unsigned char*)(ws + WS_HID), (const float*)(ws + WS_GSORT)}, \
                             pg8::EpiScatter<LASTL>{XB, H, STATS_OUT, (const int*)(ws + WS_PERM), 1.0f / (W8SCALE * H8SCALE)}}; \
        pg8::gemm_phase<pg8::EpiMoe<LASTL>, pg8::MoeMixSched, true>(F.lds, g, S, E, F.wave); \
        if (!(LASTL)) GRID_BAR(); } PR_END(PH + 1);
    MOE_LAYER(4, 0, WS_STATS1, WS_RSTD1, CW_CNT0, false, (float*)(ws + WS_STATS2))
    PR_BEGIN(7);
    if (RUN(7)) {
        pg8::GemmP g{(const void*)(ws + WS_XB8), 1024, 1024, 1 << 20, 32, (PROBE_KSEL >> 7) & 1};
        pg8::DenseSched S; S.so.init(NTOK, 4608, F.G, (int)blockIdx.x); S.Bt = (const bf16_t*)(ws + WS_WKVQ); S.lda = 512; S.ldb = 512;
        pg8::EpiHead E{(bf16_t*)(ws + WS_KB), (size_t)(WS_VB - WS_KB) / 2, (const float*)(ws + WS_GTAB) + 3 * 64, 1, 6, 12, KVW, nullptr, (const float*)(ws + WS_STATS2), 1.0f / W8SCALE, 1};
        pg8::gemm_phase<pg8::EpiHead, pg8::DenseSched, true>(F.lds, g, S, E, F.wave);
        GRID_BAR();
    }
    PR_END(7); PR_BEGIN(8);
    if (RUN(8)) { dilated_phase(F, lds); GRID_BAR(); dilated_merge(F); GRID_BAR(); }
    PR_END(8); PR_BEGIN(9);
    if (RUN(9)) {
        pg8::GemmP g{(const void*)(ws + WS_XB8), 512, 512, 1 << 20, 128, (PROBE_KSEL >> 9) & 1};
        pg8::DenseSched S; S.so.init(NTOK, 1024, F.G, (int)blockIdx.x); S.Bt = (const bf16_t*)(ws + WS_WOB); S.lda = 256; S.ldb = 256;
        pg8::EpiResid E{XB, (float*)(ws + WS_STATS3), 1.0f / W8SCALE};
        pg8::gemm_phase<pg8::EpiResid, pg8::DenseSched, true>(F.lds, g, S, E, F.wave);
        GRID_BAR();
    }
    PR_END(9);
    MOE_LAYER(10, 1, WS_STATS3, WS_RSTD3, CW_CNT1, true, (float*)nullptr)

#if RUN_UPTO < 12
    { const int gt = (blockIdx.x * 512 + otid(F.wave)); const f32x4* xs = (const f32x4*)INP(0); f32x4* od = (f32x4*)F.out;
      for (size_t e = gt; e < (size_t)NTOK * DM / 4; e += (size_t)F.G * 512) od[e] = xs[e]; }
#endif
    if (PROBE_K != 0) pr_acc += ((LAS unsigned*)(F.lds + MISC_OFF))[120];
    if (PROBE_A != 0) pr_acc += ((LAS unsigned*)(F.lds + MISC_OFF))[121];
    if (PROBE_MASK != 0 && blockIdx.x == 0 && otid(F.wave) == 0) { const unsigned long long t1 = __builtin_amdgcn_s_memrealtime(); while (__builtin_amdgcn_s_memrealtime() - t1 < pr_acc) __builtin_amdgcn_s_sleep(8); }
    if (__hip_atomic_load((unsigned*)(F.ctl + CW_BAR) + XB_TMO, RLX_AGENT) != 0u) {
        const int gt = (blockIdx.x * 512 + otid(F.wave)); const float q = __builtin_nanf("");
        for (size_t e = gt; e < (size_t)NTOK * DM; e += (size_t)F.G * 512) F.out[e] = q;
    }
}

#undef ws
#undef XB
#undef H
#undef TP
extern "C" void kernel_launch(void* const* d_in, const int* in_sizes, int n_in, void* d_out, int out_size, void* d_ws, size_t ws_size, hipStream_t stream) {
    static int grid = 0;
    if (grid == 0) {
        if (n_in != 23 || in_sizes[0] != NTOK * DM || out_size != NTOK * DM || ws_size < WS_END) { fprintf(stderr, "kernel_launch: unexpected shapes (n_in %d, in0 %d, out %d, ws %zu)\n", n_in, n_in > 0 ? in_sizes[0] : -1, out_size, ws_size); grid = -1; return; }
        int dev = 0, cus = 0, per_cu = 0;
        if (hipGetDevice(&dev) != hipSuccess || hipDeviceGetAttribute(&cus, hipDeviceAttributeMultiprocessorCount, dev) != hipSuccess) { grid = -1; return; }
        if (hipFuncSetAttribute((const void*)fwd_kernel, hipFuncAttributeMaxDynamicSharedMemorySize, LDS_BYTES) != hipSuccess) { fprintf(stderr, "kernel_launch: hipFuncSetAttribute failed\n"); grid = -1; return; }
        if (hipOccupancyMaxActiveBlocksPerMultiprocessor(&per_cu, (const void*)fwd_kernel, 512, LDS_BYTES) != hipSuccess || per_cu < 1) fprintf(stderr, "kernel_launch: occupancy query reports %d\n", per_cu);
        (void)hipGetLastError();
        grid = cus;
    }
    if (grid < 0) return;
    if (hipMemsetAsync((char*)d_ws + WS_CTL, 0, CTL_ZERO_BYTES, stream) != hipSuccess) return;
    Args a{};
    for (int i = 0; i < 23; ++i) a.in[i] = (const float*)d_in[i];
    a.out = (float*)d_out; a.ws = (unsigned char*)d_ws;
    hipLaunchKernelGGL(fwd_kernel, dim3(grid), dim3(512), LDS_BYTES, stream, a);
}
```

```cpp
#include <hip/hip_runtime.h>
#include <hip/hip_bf16.h>
#include <cstdio>
#include <cstdint>
#include <cmath>

#ifndef RUN_UPTO
#define RUN_UPTO 99
#endif

#define GAS __attribute__((address_space(1)))
#define LAS __attribute__((address_space(3)))
typedef unsigned short bf16_t;
typedef short bf16x8 __attribute__((ext_vector_type(8)));
typedef float f32x2 __attribute__((ext_vector_type(2)));
typedef float f32x4 __attribute__((ext_vector_type(4)));
typedef float f32x16 __attribute__((ext_vector_type(16)));
typedef unsigned u32x2 __attribute__((ext_vector_type(2)));
typedef unsigned u32x4 __attribute__((ext_vector_type(4)));
typedef short s16x4 __attribute__((ext_vector_type(4)));
typedef int i32x4 __attribute__((ext_vector_type(4)));
typedef int i32x8 __attribute__((ext_vector_type(8)));
typedef GAS unsigned gu32;

constexpr int NTOK = 32768, DM = 1024, SEQ = 8192, NBATCH = 4;
constexpr int KVW = 1536;
constexpr float EPS = 1e-6f;
constexpr float LOG2E = 1.4426950408889634f;
constexpr float C2 = 0.125f * LOG2E;
constexpr int NCLASS = 24, CAP = 32768;

constexpr size_t MiB = 1u << 20;
constexpr size_t WS_CTL = 0, CTL_ZERO_BYTES = 256 * 1024;
constexpr size_t WS_RSTD0 = 2 * MiB, WS_RSTD1 = 2 * MiB + 128 * 1024, WS_RSTD3 = 2 * MiB + 256 * 1024;
constexpr size_t WS_STATS1 = 3 * MiB, WS_STATS2 = 5 * MiB, WS_STATS3 = 7 * MiB;
constexpr size_t WS_GATES = 9 * MiB;
constexpr size_t WS_LC = 10 * MiB;
constexpr size_t WS_CT = 12 * MiB;
constexpr size_t WS_WF = 12 * MiB + 64 * 1024;
constexpr size_t WS_WR = 12 * MiB + 128 * 1024;
constexpr size_t WS_GTAB = 12 * MiB + 32 * 1024;
constexpr size_t WS_PERM = 13 * MiB;
constexpr size_t WS_WQKVA = 16 * MiB, WS_WOA = 22 * MiB, WS_WKVQ = 24 * MiB, WS_WOB = 33 * MiB;
constexpr size_t WS_WGU = 34 * MiB;
constexpr size_t WS_XB8 = 66 * MiB;
constexpr size_t WS_DPML = 114 * MiB;
constexpr size_t WS_WD = 98 * MiB;
constexpr size_t WS_GSORT = 120 * MiB;
constexpr size_t WS_XB = 132 * MiB;
constexpr size_t WS_R = 196 * MiB;
constexpr size_t WS_QA = WS_R, WS_KA = WS_R + 64 * MiB, WS_VA = WS_R + 128 * MiB;
constexpr size_t WS_HID = WS_R;
constexpr size_t WS_XN8 = WS_R + 44 * MiB;
constexpr size_t WS_KB = WS_R, WS_VB = WS_R + 96 * MiB, WS_QB = WS_R + 192 * MiB;
constexpr size_t WS_END = WS_R + 288 * MiB;
constexpr int CW_BAR = 4096, CW_QUEUE = 8192, CW_CNT0 = 9216, CW_CNT1 = 9216 + 64, CW_DONE = 32768;

constexpr int RING_BYTES = 131072;
constexpr int MISC_OFF = RING_BYTES;
constexpr int AUX_OFF = RING_BYTES + 512;
constexpr int LDS_BYTES = 155648;
constexpr int AUX_BYTES = LDS_BYTES - AUX_OFF;

#define LDS_WAIT() asm volatile("s_waitcnt lgkmcnt(0)" ::: "memory")
#define VM_WAIT() asm volatile("s_waitcnt vmcnt(0)" ::: "memory")
#define RLX_AGENT __ATOMIC_RELAXED, __HIP_MEMORY_SCOPE_AGENT

__device__ __forceinline__ int lane_id() { int l; asm volatile("v_mbcnt_lo_u32_b32 %0, -1, 0\n\tv_mbcnt_hi_u32_b32 %0, -1, %0" : "=v"(l)); return l; }
__device__ __forceinline__ void st16_wt(void* p, u32x4 v) { asm volatile("global_store_dwordx4 %0, %1, off sc1\n\ts_nop 2" :: "v"((GAS void*)p), "v"(v) : "memory"); }
__device__ __forceinline__ void st8_wt(void* p, u32x2 v) { asm volatile("global_store_dwordx2 %0, %1, off sc1" :: "v"((GAS void*)p), "v"(v) : "memory"); }
__device__ __forceinline__ float shfl_from(float v, int srclane) { return __int_as_float(__builtin_amdgcn_ds_bpermute(srclane << 2, __float_as_int(v))); }
__device__ __forceinline__ int shfl_from(int v, int srclane) { return __builtin_amdgcn_ds_bpermute(srclane << 2, v); }
__device__ __forceinline__ float shfl_x(float v, int lane, int mask) { return shfl_from(v, lane ^ mask); }
__device__ __forceinline__ unsigned f2bf(float f) { unsigned u = __builtin_bit_cast(unsigned, f); return (u + 0x7fffu + ((u >> 16) & 1u)) >> 16; }
__device__ __forceinline__ float bf2f(unsigned b) { return __builtin_bit_cast(float, b << 16); }
__device__ __forceinline__ unsigned pk2(float lo, float hi) { return f2bf(lo) | (f2bf(hi) << 16); }
__device__ __forceinline__ unsigned pk4_fp8(float a, float b, float c, float d) { int v = 0; v = __builtin_amdgcn_cvt_pk_fp8_f32(a, b, v, false); v = __builtin_amdgcn_cvt_pk_fp8_f32(c, d, v, true); return (unsigned)v; }
constexpr float W8SCALE = 32.0f, H8SCALE = 16.0f;
__device__ __forceinline__ unsigned cvt_pk_bf16(float lo, float hi) { unsigned r; asm volatile("v_cvt_pk_bf16_f32 %0, %1, %2" : "=v"(r) : "v"(lo), "v"(hi)); return r; }

namespace pg8 {
constexpr int BM = 256, BK = 64, HALF = 128, HTB = HALF * BK * 2, STAGE_BYTES = 8 * HTB, NXCD = 8, WGM = 8;
__host__ __device__ __forceinline__ int lds_byte(int r, int c) { const int st = (r >> 4) * 2 + (c >> 5), rr = r & 15, cc = c & 31, ob = rr * 64 + cc * 2; return st * 1024 + (ob ^ (((ob >> 9) & 1) << 5)); }
__host__ __device__ __forceinline__ void stage_rc(int b, int& R, int& C) { const int st = b / 1024, sb = b % 1024, swz = sb ^ (((sb >> 9) & 1) << 5); R = (st >> 1) * 16 + swz / 64; C = (st & 1) * 32 + (swz % 64) / 2; }
__host__ __device__ __forceinline__ int perm32(int rho) { const int n = rho >> 4, i = rho & 15; return 8 * (i >> 2) + 4 * n + (i & 3); }

struct Unit { int rowbase; int pn; int permoff; int nvalid; int e1; int e2; int type; };
struct GemmP { const void* A; int ldbB; int Kbytes; int nsplit; int hstepB; int pk = 0; };

struct StaticOrder {
    int nM, nN, nwg, G, c;
    __device__ void init(int M, int N, int G_, int c_) { nM = M / BM; nN = N / BM; nwg = nM * nN; G = G_; c = c_; }
    __device__ bool next(int i, int& pm, int& pn) const {
        const long L = (long)i * G + c; if (L >= nwg) return false;
        int wgid = (int)L; { const int q = nwg / NXCD, r = nwg % NXCD, xcd = wgid % NXCD, off = wgid / NXCD; wgid = (xcd < r ? xcd * (q + 1) : r * (q + 1) + (xcd - r) * q) + off; }
        const int nig = WGM * nN, gid = wgid / nig, fm = gid * WGM, gsz = (nM - fm) < WGM ? (nM - fm) : WGM;
        pm = fm + ((wgid % nig) % gsz); pn = (wgid % nig) / gsz; return true;
    }
};
struct DenseSched {
    static constexpr bool MIX = false;
    StaticOrder so; const bf16_t* Bt; int lda, ldb;
    __device__ __forceinline__ bool next(int i, Unit& u) const { int pm, pn; if (!so.next(i, pm, pn)) return false; u.rowbase = pm * BM; u.pn = pn; u.permoff = 0; u.nvalid = 256; u.e1 = 0; u.e2 = 0; u.type = 0; return true; }
    __device__ __forceinline__ void aoff(const Unit& u, const int (&R)[2], const int (&C)[2], unsigned (&v)[2][2]) const {
#pragma unroll
        for (int h = 0; h < 2; ++h)
#pragma unroll
            for (int i = 0; i < 2; ++i) v[h][i] = (unsigned)((u.rowbase + 128 * h + R[i]) * lda + C[i]) * 2u; }
    __device__ __forceinline__ const char* blo(const Unit& u) const { return (const char*)Bt + (size_t)u.pn * 256 * ldb * 2; }
    __device__ __forceinline__ const char* bhi(const Unit& u) const { return blo(u); }
};
__device__ __forceinline__ bool moe_unit(int L, int npn, int TT, const volatile LAS int* TP, const int* cnt, Unit& u) {
    if (L >= TT * npn) return false;
    const int tau = L / npn; u.pn = L % npn;
    const int c = TP[64 + tau];
    const int rt = tau - TP[c]; const int n = TP[32 + c] - 256 * rt;
    u.rowbase = tau * 256; u.permoff = c * CAP + rt * 256; u.nvalid = n < 256 ? n : 256;
    const int g = c / 6, p = c % 6; const int a = (p < 3) ? 0 : (p < 5) ? 1 : 2; const int b = (p < 3) ? p + 1 : (p < 5) ? p - 1 : 3;
    u.e1 = 4 * g + a; u.e2 = 4 * g + b;
    u.rowbase = __builtin_amdgcn_readfirstlane(u.rowbase); u.pn = __builtin_amdgcn_readfirstlane(u.pn); u.permoff = __builtin_amdgcn_readfirstlane(u.permoff);
    u.nvalid = __builtin_amdgcn_readfirstlane(u.nvalid); u.e1 = __builtin_amdgcn_readfirstlane(u.e1); u.e2 = __builtin_amdgcn_readfirstlane(u.e2);
    return true;
}
struct Moe1Sched {      static constexpr bool MIX = false;
    const volatile LAS int* TP; const int* cnt; const int* perm; const unsigned char* Wgu; int G, c, TT;
    __device__ __forceinline__ bool next(int i, Unit& u) const { return moe_unit(i * G + c, 8, TT, TP, cnt, u); }
    __device__ __forceinline__ void aoff(const Unit& u, const int (&R)[2], const int (&C)[2], unsigned (&v)[2][2]) const {
#pragma unroll
        for (int h = 0; h < 2; ++h)
#pragma unroll
            for (int i = 0; i < 2; ++i) { const int r = 128 * h + R[i]; const int tok = (r < u.nvalid) ? ((const GAS int*)perm)[u.permoff + r] : 0; v[h][i] = (unsigned)(tok * 1024 + 2 * C[i]); } }
    __device__ __forceinline__ const char* blo(const Unit& u) const { const int e = (u.pn < 4) ? u.e1 : u.e2; return (const char*)Wgu + ((size_t)e * 1024 + 128 * (u.pn & 3)) * 1024; }
    __device__ __forceinline__ const char* bhi(const Unit& u) const { return blo(u); }
};
struct Moe2Sched {      static constexpr bool MIX = false;
    const volatile LAS int* TP; const int* cnt; const unsigned char* Wd; int G, c, TT;
    __device__ __forceinline__ bool next(int i, Unit& u) const { return moe_unit(i * G + c, 4, TT, TP, cnt, u); }
    __device__ __forceinline__ void aoff(const Unit& u, const int (&R)[2], const int (&C)[2], unsigned (&v)[2][2]) const {
#pragma unroll
        for (int h = 0; h < 2; ++h)
#pragma unroll
            for (int i = 0; i < 2; ++i) v[h][i] = (unsigned)((u.rowbase + 128 * h + R[i]) * 1024 + 2 * C[i]); }
    __device__ __forceinline__ const char* blo(const Unit& u) const { return (const char*)Wd + ((size_t)u.e1 * 1024 + 256 * u.pn) * 512; }
    __device__ __forceinline__ const char* bhi(const Unit& u) const { return (const char*)Wd + ((size_t)u.e2 * 1024 + 256 * u.pn) * 512 - 4 * 128; }
};

struct MoeMixSched {
    static constexpr bool MIX = true;
    const volatile LAS int* TP; const int* cnt; const int* perm; const unsigned char* Wgu; const unsigned char* Wd; int G, c, TT; unsigned* done; unsigned* tmo;
    __device__ __forceinline__ bool next(int i, Unit& u) const {
        const int cc = (G == 256) ? ((c & 7) * 32 + (c >> 3)) : c;
        const int L = i * G + cc, n1 = TT * 8;
        if (L < n1) { moe_unit(L, 8, TT, TP, cnt, u); u.type = 0; return true; }
        if (!moe_unit(L - n1, 4, TT, TP, cnt, u)) return false; u.type = 1; return true; }
    __device__ __forceinline__ void aoff(const Unit& u, const int (&R)[2], const int (&C)[2], unsigned (&v)[2][2]) const {
#pragma unroll
        for (int h = 0; h < 2; ++h)
#pragma unroll
            for (int i = 0; i < 2; ++i) { const int r = 128 * h + R[i];
                if (u.type == 0) { const int tok = (r < u.nvalid) ? ((const GAS int*)perm)[u.permoff + r] : 0; v[h][i] = (unsigned)WS_XN8 + (unsigned)(tok * 1024 + 2 * C[i]); }
                else v[h][i] = (unsigned)WS_HID + (unsigned)((u.rowbase + r) * 1024 + 2 * C[i]); } }
    __device__ __forceinline__ const char* blo(const Unit& u) const {
        if (u.type == 0) { const int e = (u.pn < 4) ? u.e1 : u.e2; return (const char*)Wgu + ((size_t)e * 1024 + 128 * (u.pn & 3)) * 1024; }
        return (const char*)Wd + ((size_t)u.e1 * 1024 + 256 * u.pn) * 512; }
    __device__ __forceinline__ const char* bhi(const Unit& u) const {
        if (u.type == 0) return blo(u);
        return (const char*)Wd + ((size_t)u.e2 * 1024 + 256 * u.pn) * 512 - 4 * 128; }
    __device__ __forceinline__ int ldbB(const Unit& u) const { return u.type == 0 ? 1024 : 512; }
    __device__ __forceinline__ int hstepB(const Unit& u) const { return u.type == 0 ? 512 : 128; }
    __device__ __forceinline__ int nsplit(const Unit& u) const { return u.type == 0 ? (1 << 20) : 4; }
    __device__ __forceinline__ void a_ready(const Unit& u) const {
        if (u.type == 1) { unsigned* w = done + 64 * (u.rowbase >> 8); unsigned sp = 0;
            while (__hip_atomic_load(w, __ATOMIC_RELAXED, __HIP_MEMORY_SCOPE_AGENT) < 64u) { __builtin_amdgcn_s_sleep(2); if (++sp > (1u << 20)) { __hip_atomic_store(tmo, 1u, __ATOMIC_RELAXED, __HIP_MEMORY_SCOPE_AGENT); break; } }
              } }
    __device__ __forceinline__ const unsigned* poll_addr(const Unit& u) const { return done + 64 * (u.rowbase >> 8); }
    __device__ __forceinline__ int done_tile(const Unit& u) const { return (u.type == 0) ? (u.rowbase >> 8) : -1; }
    __device__ __forceinline__ void signal(int tile, int lane) const { if (lane == 0) __hip_atomic_fetch_add(done + 64 * tile, 1u, __ATOMIC_RELAXED, __HIP_MEMORY_SCOPE_AGENT); }
};

__device__ __forceinline__ int dil_row(int tok, int D4) { const int s = tok & (SEQ - 1); return (tok & ~(SEQ - 1)) + ((s & ((1 << D4) - 1)) << (13 - D4)) + (s >> D4); }
__device__ __forceinline__ float row_rstd16(const float* stats, int row) {
    const f32x4* p = (const f32x4*)(stats + (size_t)row * 16); const f32x4 a = p[0], b = p[1], c = p[2], d = p[3];
    const float s = ((a[0] + a[1]) + (a[2] + a[3])) + ((b[0] + b[1]) + (b[2] + b[3])) + ((c[0] + c[1]) + (c[2] + c[3])) + ((d[0] + d[1]) + (d[2] + d[3]));
    return 1.0f / sqrtf(s * (1.0f / 1024.0f) + EPS);
}
struct EpiHead {
    static constexpr int BMODE = 2; static constexpr int NPF = 0;
    bf16_t* dbase; size_t dstride; const float* gtab; int plain_seg; int e0, e1;
    int ldc; const float* rstd; const float* stats; float ascale;
    int dil = 0;
    __device__ __forceinline__ void operator()(const f32x4 (&acc)[2][2][4][2], const Unit& u, int wr, int wc, int fr, int fq) const {
        asm volatile("" : "+v"(fr), "+v"(fq));
        const int pn = u.pn; const int seg = (pn < e0) ? 0 : (pn < e1) ? 1 : 2;
        bf16_t* dst = dbase + (size_t)seg * dstride; const float* gain = gtab + 64 * seg; const bool norm = (seg != plain_seg);
        const int pnl = pn - (seg == 0 ? 0 : seg == 1 ? e0 : e1);
        const int col0 = 64 * (4 * pnl + wc) + 8 * fq;
        f32x4 gv[2][2];
#pragma unroll
        for (int bj = 0; bj < 2; ++bj)
#pragma unroll
            for (int n = 0; n < 2; ++n) gv[bj][n] = *(const GAS f32x4*)(gain + 32 * bj + 8 * fq + 4 * n);
        float rsv[2][4];
        if (rstd) {
#pragma unroll
            for (int ai = 0; ai < 2; ++ai)
#pragma unroll
                for (int m = 0; m < 4; ++m) rsv[ai][m] = ((const GAS float*)rstd)[u.rowbase + ai * HALF + wr * 64 + m * 16 + fr] * ascale;
        } else {
            f32x4 pq[2][4];
#pragma unroll
            for (int ai = 0; ai < 2; ++ai)
#pragma unroll
                for (int m = 0; m < 4; ++m) pq[ai][m] = *(const GAS f32x4*)(stats + (size_t)(u.rowbase + ai * HALF + wr * 64 + m * 16 + fr) * 16 + 4 * fq);
#pragma unroll
            for (int ai = 0; ai < 2; ++ai)
#pragma unroll
                for (int m = 0; m < 4; ++m) { float sq = (pq[ai][m][0] + pq[ai][m][1]) + (pq[ai][m][2] + pq[ai][m][3]); sq += shfl_x(sq, 16 * fq + fr, 16); sq += shfl_x(sq, 16 * fq + fr, 32);
                    rsv[ai][m] = ascale * __builtin_amdgcn_rsqf(sq * (1.0f / 1024.0f) + EPS); }
        }
#pragma unroll
        for (int ai = 0; ai < 2; ++ai)
#pragma unroll
            for (int m = 0; m < 4; ++m) {
                const int row = u.rowbase + ai * HALF + wr * 64 + m * 16 + fr;
                const float rs = rsv[ai][m];
                float hr = rs;
                if (norm) {
                    float ss = 0.f;
#pragma unroll
                    for (int bj = 0; bj < 2; ++bj)
#pragma unroll
                        for (int n = 0; n < 2; ++n) { const f32x4 x = acc[ai][bj][m][n]; ss += (x[0] * x[0] + x[1] * x[1]) + (x[2] * x[2] + x[3] * x[3]); }
                    ss += shfl_x(ss, 16 * fq + fr, 16); ss += shfl_x(ss, 16 * fq + fr, 32);
                    hr = rs * __builtin_amdgcn_rsqf(ss * rs * rs * (1.0f / 64.0f) + EPS);
                }
                bf16_t* rowp = dil ? dst + ((size_t)(4 * pnl + wc) * NTOK + dil_row(row, 2 * ((4 * pnl + wc) >> 3))) * 64 + 8 * fq : dst + (size_t)row * ldc + col0;
#pragma unroll
                for (int bj = 0; bj < 2; ++bj) {
                    const f32x4 v0 = acc[ai][bj][m][0] * hr * gv[bj][0], v1 = acc[ai][bj][m][1] * hr * gv[bj][1];
                    u32x4 w; w.x = cvt_pk_bf16(v0[0], v0[1]); w.y = cvt_pk_bf16(v0[2], v0[3]); w.z = cvt_pk_bf16(v1[0], v1[1]); w.w = cvt_pk_bf16(v1[2], v1[3]);
                    st16_wt(rowp + 32 * bj, w); }
                if (m & 1) asm volatile("" ::: "memory");
            }
    }
};
__device__ __forceinline__ void unpack8(const u32x4 b, f32x4& lo, f32x4& hi) {
    lo = (f32x4){bf2f(b.x & 0xffffu), bf2f(b.x >> 16), bf2f(b.y & 0xffffu), bf2f(b.y >> 16)}; hi = (f32x4){bf2f(b.z & 0xffffu), bf2f(b.z >> 16), bf2f(b.w & 0xffffu), bf2f(b.w >> 16)}; }
struct EpiResid {
    static constexpr int BMODE = 1; static constexpr int NPF = 0;
    bf16_t* xb; float* stats; float ascale;
    __device__ __forceinline__ void operator()(const f32x4 (&acc)[2][2][4][2], const Unit& u, int wr, int wc, int fr, int fq) const {
        asm volatile("" : "+v"(fr), "+v"(fq));
        const int col0 = u.pn * BM + wc * 32 + 8 * fq;
#pragma unroll
        for (int ai = 0; ai < 2; ++ai) {
        u32x4 bb[2][4][2];
#pragma unroll
            for (int m = 0; m < 4; ++m)
#pragma unroll
                for (int bj = 0; bj < 2; ++bj) bb[ai][m][bj] = *(const GAS u32x4*)(xb + (size_t)(u.rowbase + ai * HALF + wr * 64 + m * 16 + fr) * 1024 + col0 + bj * HALF);
#pragma unroll
            for (int m = 0; m < 4; ++m) {
                const int row = u.rowbase + ai * HALF + wr * 64 + m * 16 + fr; const size_t off = (size_t)row * 1024 + col0; float ss = 0.f;
#pragma unroll
                for (int bj = 0; bj < 2; ++bj) { const size_t o = off + bj * HALF; f32x4 b0, b1; unpack8(bb[ai][m][bj], b0, b1);
                    const f32x4 v0 = b0 + acc[ai][bj][m][0] * ascale, v1 = b1 + acc[ai][bj][m][1] * ascale;
                    ss += ((v0[0] * v0[0] + v0[1] * v0[1]) + (v0[2] * v0[2] + v0[3] * v0[3])) + ((v1[0] * v1[0] + v1[1] * v1[1]) + (v1[2] * v1[2] + v1[3] * v1[3]));
                    u32x4 w; w.x = cvt_pk_bf16(v0[0], v0[1]); w.y = cvt_pk_bf16(v0[2], v0[3]); w.z = cvt_pk_bf16(v1[0], v1[1]); w.w = cvt_pk_bf16(v1[2], v1[3]); *(GAS u32x4*)(xb + o) = w; }
                ss += shfl_x(ss, 16 * fq + fr, 16); ss += shfl_x(ss, 16 * fq + fr, 32);
                if (fq == 0) ((GAS float*)stats)[(size_t)row * 16 + u.pn * 4 + wc] = ss;
            }
        asm volatile("" ::: "memory"); }
    }
};
struct EpiSwiglu {
    static constexpr int BMODE = 1;
    unsigned char* hid; const float* gsort;
    __device__ __forceinline__ void operator()(const f32x4 (&acc)[2][2][4][2], const Unit& u, int wr, int wc, int fr, int fq, int pf0, int pf1) const {
        asm volatile("" : "+v"(fr), "+v"(fq));
        const int col0 = 512 * (u.pn >> 2) + 128 * (u.pn & 3) + 32 * wc + 8 * fq;
#pragma unroll
        for (int ai = 0; ai < 2; ++ai)
#pragma unroll
            for (int m = 0; m < 4; ++m) {
                const int r = ai * HALF + wr * 64 + m * 16 + fr;
                const float gq = __int_as_float(shfl_from(ai == 0 ? pf0 : pf1, m * 16 + fr)); const float gw = (r < u.nvalid) ? gq * H8SCALE : 0.f;
                float h[8];
#pragma unroll
                for (int n = 0; n < 2; ++n)
#pragma unroll
                    for (int i = 0; i < 4; ++i) { const float g = acc[ai][0][m][n][i] * (1.0f / W8SCALE), up = acc[ai][1][m][n][i] * (1.0f / W8SCALE); const float sg = g * __builtin_amdgcn_rcpf(1.0f + __builtin_amdgcn_exp2f(-g * LOG2E)); h[4 * n + i] = __builtin_fminf(__builtin_fmaxf(sg * up * gw, -440.f), 440.f); }
                u32x2 w; w.x = pk4_fp8(h[0], h[1], h[2], h[3]); w.y = pk4_fp8(h[4], h[5], h[6], h[7]);
                { GAS u32x2* hp_ = (GAS u32x2*)(hid + (size_t)(u.rowbase + r) * 1024 + col0); asm volatile("global_store_dwordx2 %0, %1, off sc1" :: "v"(hp_), "v"(w) : "memory"); }
            }
    }
};
template <bool LAST> struct EpiScatter {
    static constexpr int BMODE = 1;
    bf16_t* xb; float* out; float* stats; const int* perm; float ascale;
    __device__ __forceinline__ void operator()(const f32x4 (&acc)[2][2][4][2], const Unit& u, int wr, int wc, int fr, int fq, int pf0, int pf1) const {
        asm volatile("" : "+v"(fr), "+v"(fq));
        const int col0 = u.pn * BM + wc * 32 + 8 * fq;
        int tokv[2][4];
#pragma unroll
        for (int ai = 0; ai < 2; ++ai)
#pragma unroll
            for (int m = 0; m < 4; ++m) { const int r = ai * HALF + wr * 64 + m * 16 + fr; const int tq = shfl_from(ai == 0 ? pf0 : pf1, m * 16 + fr); tokv[ai][m] = (r < u.nvalid) ? tq : -1; }
#pragma unroll
        for (int ai = 0; ai < 2; ++ai) {
        u32x4 bb[2][4][2];
#pragma unroll
            for (int m = 0; m < 4; ++m)
#pragma unroll
                for (int bj = 0; bj < 2; ++bj) bb[ai][m][bj] = *(const GAS u32x4*)(xb + (size_t)(tokv[ai][m] >= 0 ? tokv[ai][m] : 0) * 1024 + col0 + bj * HALF);
#pragma unroll
            for (int m = 0; m < 4; ++m) {
                const bool valid = tokv[ai][m] >= 0; const int tok = valid ? tokv[ai][m] : 0;
                const size_t off = (size_t)tok * 1024 + col0; float ss = 0.f;
#pragma unroll
                for (int bj = 0; bj < 2; ++bj) { const size_t o = off + bj * HALF; f32x4 b0, b1; unpack8(bb[ai][m][bj], b0, b1);
                    const f32x4 v0 = b0 + acc[ai][bj][m][0] * ascale, v1 = b1 + acc[ai][bj][m][1] * ascale;
                    ss += ((v0[0] * v0[0] + v0[1] * v0[1]) + (v0[2] * v0[2] + v0[3] * v0[3])) + ((v1[0] * v1[0] + v1[1] * v1[1]) + (v1[2] * v1[2] + v1[3] * v1[3]));
                    if (valid) {
                        if constexpr (LAST) { *(GAS f32x4*)(out + o) = v0; *(GAS f32x4*)(out + o + 4) = v1; }
                        else { u32x4 w; w.x = cvt_pk_bf16(v0[0], v0[1]); w.y = cvt_pk_bf16(v0[2], v0[3]); w.z = cvt_pk_bf16(v1[0], v1[1]); w.w = cvt_pk_bf16(v1[2], v1[3]); *(GAS u32x4*)(xb + o) = w;
                               u32x2 q8; q8.x = pk4_fp8(v0[0], v0[1], v0[2], v0[3]); q8.y = pk4_fp8(v1[0], v1[1], v1[2], v1[3]); *(GAS u32x2*)((unsigned char*)xb - (WS_XB - WS_XB8) + o) = q8; } } }
                if (!LAST) { ss += shfl_x(ss, 16 * fq + fr, 16); ss += shfl_x(ss, 16 * fq + fr, 32);
                    if (valid && fq == 0) ((GAS float*)stats)[(size_t)tok * 16 + u.pn * 4 + wc] = ss; }
            }
        asm volatile("" ::: "memory"); }
    }
};

template <bool LAST> struct EpiMoe {
    static constexpr int BMODE = 1;
    static constexpr int NPF = 2;
    EpiSwiglu sw; EpiScatter<LAST> sc;
    __device__ __forceinline__ void prefetch(const Unit& u, int wr, int lane, int& pf0, int& pf1) const {
        const int r0 = wr * 64 + lane;
        const GAS int* p0 = (u.type == 0) ? (const GAS int*)sw.gsort + 2 * (size_t)(u.permoff + r0) + (u.pn >> 2) : (const GAS int*)sc.perm + (u.permoff + r0);
        const GAS int* p1 = p0 + ((u.type == 0) ? 2 * HALF : HALF);
        asm volatile("global_load_dword %0, %2, off\n\tglobal_load_dword %1, %3, off" : "=&v"(pf0), "=&v"(pf1) : "v"(p0), "v"(p1) : "memory"); }
    __device__ __forceinline__ void operator()(const f32x4 (&acc)[2][2][4][2], const Unit& u, int wr, int wc, int fr, int fq, int pf0, int pf1) const {
        if (u.type == 0) sw(acc, u, wr, wc, fr, fq, pf0, pf1); else sc(acc, u, wr, wc, fr, fq, pf0, pf1); }
};

template <class Epi, class Sched, bool F8 = false>
__device__ __forceinline__ void gemm_phase(LAS unsigned char* lds, const GemmP g, const Sched& S, const Epi& E, int wave) {
    int tid = wave * 64 + lane_id(); asm volatile("" : "+v"(tid));
    const int wid = __builtin_amdgcn_readfirstlane(tid >> 6), lane = tid & 63, wr = wid >> 2, wc = wid & 3, fr = lane & 15, fq = lane >> 4;
    const int nt = g.Kbytes / 128;
    unsigned voffB[2]; int RbB[2], CbB[2];
#pragma unroll
    for (int i = 0; i < 2; ++i) { int R[2], C[2]; stage_rc(tid * 16 + i * 8192, R[i], C[i]);
        RbB[i] = (Epi::BMODE == 0) ? R[i] : (Epi::BMODE == 1) ? ((R[i] & ~31) + perm32(R[i] & 31)) : (64 * (R[i] >> 5) + perm32(R[i] & 31)); CbB[i] = 2 * C[i];
        voffB[i] = (unsigned)(RbB[i] * g.ldbB + CbB[i]); }
    const size_t kstep = (size_t)(BK * 2);
    size_t hstepB = (size_t)g.hstepB * g.ldbB; int nsplit = g.nsplit;
    const unsigned ldsw = (unsigned)wid * 1024u;
    const int aoff = lds_byte(wr * 64 + fr, fq * 8), boff = lds_byte(wc * 32 + fr, fq * 8);
    const char* const Ab = (const char*)g.A;
#define PG8_SA(b, h) (((b) * 2 + (h)) * HTB)
#define PG8_SB(b, h) ((4 + (b) * 2 + (h)) * HTB)
#define PG8_STAGE(bufoff, gbase, voff) do { _Pragma("unroll") for (int _i = 0; _i < 2; ++_i) \
        __builtin_amdgcn_global_load_lds((const unsigned*)((const char*)(gbase) + (voff)[_i]), (LAS unsigned*)(lds + (bufoff) + ldsw + _i * 8192), 16, 0, 0); } while (0)
#define PG8_LD8(p) __builtin_shufflevector(*(const LAS i32x4*)(p), *(const LAS i32x4*)((p) + 1024), 0, 1, 2, 3, 4, 5, 6, 7)
#define PG8_LDA(dst, b, h) do { if constexpr (F8) { _Pragma("unroll") for (int m = 0; m < 4; ++m) dst##8[m] = PG8_LD8(lds + PG8_SA(b, h) + aoff + m * 2048); } \
        else { _Pragma("unroll") for (int m = 0; m < 4; ++m) _Pragma("unroll") for (int k = 0; k < 2; ++k) dst[m][k] = *(const LAS bf16x8*)(lds + PG8_SA(b, h) + aoff + m * 2048 + k * 1024); } } while (0)
#define PG8_LDB(dst, b, h) do { if constexpr (F8) { _Pragma("unroll") for (int n = 0; n < 2; ++n) dst##8[n] = PG8_LD8(lds + PG8_SB(b, h) + boff + n * 2048); } \
        else { _Pragma("unroll") for (int n = 0; n < 2; ++n) _Pragma("unroll") for (int k = 0; k < 2; ++k) dst[n][k] = *(const LAS bf16x8*)(lds + PG8_SB(b, h) + boff + n * 2048 + k * 1024); } } while (0)
#define PG8_MMA(ai, bj, At, Bt) do { __builtin_amdgcn_s_setprio(1); \
        if constexpr (F8) { _Pragma("unroll") for (int m = 0; m < 4; ++m) _Pragma("unroll") for (int n = 0; n < 2; ++n) \
            acc[ai][bj][m][n] = __builtin_amdgcn_mfma_scale_f32_16x16x128_f8f6f4(Bt##8[n], At##8[m], acc[ai][bj][m][n], 0, 0, 0, 0, 0, 0); } \
        else { _Pragma("unroll") for (int m = 0; m < 4; ++m) _Pragma("unroll") for (int n = 0; n < 2; ++n) _Pragma("unroll") for (int k = 0; k < 2; ++k) \
            acc[ai][bj][m][n] = __builtin_amdgcn_mfma_f32_16x16x32_bf16(Bt[n][k], At[m][k], acc[ai][bj][m][n], 0, 0, 0); } \
        __builtin_amdgcn_s_setprio(0); } while (0)
#define PG8_WAIT_V(n) asm volatile("s_waitcnt vmcnt(" #n ")" ::: "memory")
#define PG8_WAIT_L(n) asm volatile("s_waitcnt lgkmcnt(" #n ")" ::: "memory")
#define PG8_BAR __builtin_amdgcn_s_barrier()
#define PG8_SCHED __builtin_amdgcn_sched_barrier(0)
#ifndef PROBE_K
#define PROBE_K 0
#endif
#ifndef PROBE_KSEL
#define PROBE_KSEL 0
#endif
    unsigned long long pk_acc = 0ull, pk_t0 = 0ull;
    unsigned pollv = 64u;
    int pf0 = 0, pf1 = 0, pend = -1;
    Unit cur, nxt; int ui = 0;
    if (!S.next(0, cur)) return;
    unsigned vc[2][2];
    LAS unsigned* const vnl = (LAS unsigned*)(lds + AUX_OFF + 2048) + tid;
    bool gath = false;
    { int R[2], C[2]; int t_ = tid; asm volatile("" : "+v"(t_)); stage_rc(t_ * 16, R[0], C[0]); stage_rc(t_ * 16 + 8192, R[1], C[1]); S.aoff(cur, R, C, vc); }
    f32x4 acc[2][2][4][2];
#pragma unroll
    for (int a = 0; a < 2; ++a)
#pragma unroll
        for (int b = 0; b < 2; ++b)
#pragma unroll
            for (int m = 0; m < 4; ++m)
#pragma unroll
                for (int n = 0; n < 2; ++n) acc[a][b][m][n] = (f32x4){0.f, 0.f, 0.f, 0.f};
    bf16x8 At[4][2], B0[2][2], B1[2][2]; i32x8 At8[4], B08[2], B18[2];
    const char* cBl = S.blo(cur); const char* cBh = S.bhi(cur);
    if constexpr (Sched::MIX) { const int lb_ = S.ldbB(cur); voffB[0] = (unsigned)(RbB[0] * lb_ + CbB[0]); voffB[1] = (unsigned)(RbB[1] * lb_ + CbB[1]); hstepB = (size_t)S.hstepB(cur) * lb_; nsplit = S.nsplit(cur); S.a_ready(cur); }
    PG8_STAGE(PG8_SB(0, 0), cBl, voffB); PG8_STAGE(PG8_SB(0, 1), cBl + hstepB, voffB); PG8_STAGE(PG8_SA(0, 0), Ab, vc[0]); PG8_STAGE(PG8_SA(0, 1), Ab, vc[1]);
    if (wr == 1) PG8_BAR;
    PG8_WAIT_V(2); PG8_BAR;
    PG8_STAGE(PG8_SB(1, 0), cBl + kstep, voffB); PG8_STAGE(PG8_SA(1, 0), Ab + kstep, vc[0]); PG8_STAGE(PG8_SB(1, 1), cBl + hstepB + kstep, voffB);
    PG8_WAIT_V(6); PG8_BAR;
    for (;;) {
        const bool has_next = S.next(ui + 1, nxt);
        gath = false;
        if constexpr (Sched::MIX) { gath = has_next && nxt.type == 0; }
        if (gath) { if constexpr (Sched::MIX) {
            int R[2], C[2]; int t_ = tid; asm volatile("" : "+v"(t_)); stage_rc(t_ * 16, R[0], C[0]); stage_rc(t_ * 16 + 8192, R[1], C[1]);
#pragma unroll
            for (int h = 0; h < 2; ++h)
#pragma unroll
                for (int i = 0; i < 2; ++i) { const int r = 128 * h + R[i];
                    __builtin_amdgcn_global_load_lds((const unsigned*)(S.perm + nxt.permoff + (r < nxt.nvalid ? r : 0)), (LAS unsigned*)(lds + AUX_OFF + 2048 + (2 * h + i) * 2048 + wid * 256), 4, 0, 0); } } }
        else { unsigned vn[2][2];
          if (has_next) { int R[2], C[2]; int t_ = tid; asm volatile("" : "+v"(t_)); stage_rc(t_ * 16, R[0], C[0]); stage_rc(t_ * 16 + 8192, R[1], C[1]); S.aoff(nxt, R, C, vn); } else {
#pragma unroll
            for (int h = 0; h < 2; ++h)
#pragma unroll
                for (int i = 0; i < 2; ++i) vn[h][i] = vc[h][i]; }
          vnl[0] = vn[0][0]; vnl[512] = vn[0][1]; vnl[1024] = vn[1][0]; vnl[1536] = vn[1][1]; }
        const char* nBl = has_next ? S.blo(nxt) : cBl; const char* nBh = has_next ? S.bhi(nxt) : cBh;
        if (PROBE_K == 1 || PROBE_K == 3) pk_t0 = __builtin_amdgcn_s_memrealtime();
#pragma unroll 1
        for (int t = 0; t < nt; t += 2) {
            const bool last = (t == nt - 2);
            const char* a1 = Ab + (size_t)(t + 1) * kstep;
            const char* a2 = last ? Ab : Ab + (size_t)(t + 2) * kstep;
            const char* b2 = last ? nBl : (((t + 2) < nsplit) ? cBl : cBh) + (size_t)(t + 2) * kstep;
            const char* a3 = a2 + kstep; const char* b3 = b2 + kstep;
            PG8_LDB(B0, 0, 0); PG8_LDB(B1, 0, 1); PG8_SCHED; PG8_LDA(At, 0, 0); PG8_STAGE(PG8_SA(1, 1), a1, vc[1]);
            PG8_WAIT_V(8); PG8_WAIT_L(0); PG8_BAR; PG8_MMA(0, 0, At, B0); PG8_MMA(0, 1, At, B1); PG8_BAR; PG8_SCHED;
            if constexpr (Sched::MIX) { if (t == nt - 4 && !last && has_next && nxt.type == 1) { const GAS unsigned* pa_ = (const GAS unsigned*)S.poll_addr(nxt);
                asm volatile("global_load_dword %0, %1, off sc1" : "=v"(pollv) : "v"(pa_) : "memory"); } }
            if (last) { if constexpr (Epi::NPF > 0) E.prefetch(cur, wr, lane, pf0, pf1);
                vc[0][0] = vnl[0]; vc[0][1] = vnl[512]; vc[1][0] = vnl[1024]; vc[1][1] = vnl[1536];
                if (gath) { int R_[2], C_[2]; int t_ = tid; asm volatile("" : "+v"(t_)); stage_rc(t_ * 16, R_[0], C_[0]); stage_rc(t_ * 16 + 8192, R_[1], C_[1]);
#pragma unroll
                    for (int h = 0; h < 2; ++h)
#pragma unroll
                        for (int i = 0; i < 2; ++i) vc[h][i] = (unsigned)WS_XN8 + (unsigned)(vc[h][i] * 1024u + 2u * (unsigned)C_[i]); }
                if constexpr (Sched::MIX) { if (has_next) { const int lb_ = S.ldbB(nxt); voffB[0] = (unsigned)(RbB[0] * lb_ + CbB[0]); voffB[1] = (unsigned)(RbB[1] * lb_ + CbB[1]); hstepB = (size_t)S.hstepB(nxt) * lb_;
                    if (nxt.type == 1) {
                        bool ok_ = false;
                        if (nt >= 8) { asm volatile("s_waitcnt vmcnt(18)" : "+v"(pollv) :: "memory"); ok_ = (unsigned)__builtin_amdgcn_readfirstlane((int)pollv) >= 64u; }
                        if (!ok_) S.a_ready(nxt); } } } }
            PG8_LDA(At, 0, 1); PG8_STAGE(PG8_SB(0, 0), b2, voffB); PG8_STAGE(PG8_SB(0, 1), b2 + hstepB, voffB); PG8_STAGE(PG8_SA(0, 0), a2, vc[0]);
            if (Epi::NPF > 0 && last) PG8_WAIT_V(10); else PG8_WAIT_V(8);
            PG8_WAIT_L(0); PG8_BAR; PG8_MMA(1, 0, At, B0); PG8_MMA(1, 1, At, B1); PG8_BAR; PG8_SCHED;
            PG8_LDB(B0, 1, 0); PG8_LDB(B1, 1, 1); PG8_SCHED; PG8_LDA(At, 1, 0); PG8_STAGE(PG8_SA(0, 1), a2, vc[1]);
            PG8_WAIT_V(8); PG8_WAIT_L(0); PG8_BAR; PG8_MMA(0, 0, At, B0); PG8_MMA(0, 1, At, B1); PG8_BAR; PG8_SCHED;
            if constexpr (Sched::MIX) { if (t == 0 && pend >= 0) { S.signal(pend, lane); pend = -1; } }
            PG8_LDA(At, 1, 1); PG8_STAGE(PG8_SB(1, 0), b3, voffB); PG8_STAGE(PG8_SB(1, 1), b3 + hstepB, voffB); PG8_STAGE(PG8_SA(1, 0), a3, vc[0]);
            PG8_WAIT_V(8); PG8_WAIT_L(0); PG8_BAR; PG8_MMA(1, 0, At, B0); PG8_MMA(1, 1, At, B1); PG8_BAR; PG8_SCHED;
        }
        if (PROBE_K == 1) pk_acc += __builtin_amdgcn_s_memrealtime() - pk_t0;
        if (PROBE_K == 2) pk_t0 = __builtin_amdgcn_s_memrealtime();
        if (wr == 0) PG8_BAR;
        if constexpr (Epi::NPF > 0) { asm volatile("s_waitcnt vmcnt(14)" : "+v"(pf0), "+v"(pf1) :: "memory"); E(acc, cur, wr, wc, fr, fq, pf0, pf1); }
        else E(acc, cur, wr, wc, fr, fq);
        if constexpr (Sched::MIX) pend = S.done_tile(cur);
        if (PROBE_K == 2) { asm volatile("s_waitcnt vmcnt(0)" ::: "memory"); pk_acc += __builtin_amdgcn_s_memrealtime() - pk_t0; }
        if (PROBE_K == 3) pk_acc += __builtin_amdgcn_s_memrealtime() - pk_t0;
        if (!has_next) break;
#pragma unroll
        for (int a = 0; a < 2; ++a)
#pragma unroll
            for (int b = 0; b < 2; ++b)
#pragma unroll
                for (int m = 0; m < 4; ++m)
#pragma unroll
                    for (int n = 0; n < 2; ++n) acc[a][b][m][n] = (f32x4){0.f, 0.f, 0.f, 0.f};
        cur = nxt; cBl = nBl; cBh = nBh; ++ui;
        if constexpr (Sched::MIX) nsplit = S.nsplit(cur);
        if (wr == 1) PG8_BAR;
    }
    PG8_WAIT_V(0);
    if constexpr (Sched::MIX) { if (pend >= 0) S.signal(pend, lane); }
    PG8_BAR;
    if (PROBE_K != 0 && g.pk && tid == 0) { LAS unsigned* pw_ = (LAS unsigned*)(lds + MISC_OFF) + 120; *pw_ += (unsigned)pk_acc; }
#undef PG8_SA
#undef PG8_SB
#undef PG8_STAGE
#undef PG8_LDA
#undef PG8_LDB
#undef PG8_MMA
#undef PG8_LD8
#undef PG8_WAIT_V
#undef PG8_WAIT_L
#undef PG8_BAR
#undef PG8_SCHED
}
}

namespace attn_body {
using bf16 = __hip_bfloat16;
constexpr int NHEAD = 16, D = 64, DMQ = NHEAD * D;
constexpr int NW = 8, QBLK = 32, QB = QBLK * NW, KVBLK = 64;
__device__ __forceinline__ int crow(int r, int hi) { return (r & 3) + 8 * (r >> 2) + 4 * hi; }
#define SBAR() __builtin_amdgcn_sched_barrier(0)
__device__ __forceinline__ void cmask(f32x16& p0, f32x16& p1, int jb, int qrel, int hi) {
  const float NEG = -INFINITY; int kb = 64 * jb + 4 * hi;
  #pragma unroll
  for (int r = 0; r < 16; ++r) { int kv = kb + (r & 3) + 8 * (r >> 2); if (kv > qrel) p0[r] = NEG; if (kv + 32 > qrel) p1[r] = NEG; }
}
constexpr int NSLOT = 3, SLOTB = 8192;
constexpr int LDS_K = 0, LDS_V = NSLOT * SLOTB, LDS_WS = 2 * NSLOT * SLOTB, LDS_OST = LDS_WS + NW * 64 * 4, ATT_LDS_BYTES = LDS_OST + NW * 4096;
constexpr int LDS_NCK = 86016;
__device__ __forceinline__ void glds16(const void* gsrc, unsigned lds_dst) { unsigned keep;
  asm volatile("s_mov_b32 %0, m0\n\ts_mov_b32 m0, %2\n\ts_nop 0\n\tglobal_load_lds_dwordx4 %1, off\n\ts_mov_b32 m0, %0" : "=&s"(keep) : "v"(gsrc), "s"(lds_dst) : "memory"); }
__device__ __forceinline__ float max3f(float a, float b, float c) { float r; asm("v_max3_f32 %0, %1, %2, %3" : "=v"(r) : "v"(a), "v"(b), "v"(c)); return r; }
__device__ __forceinline__ float max2f(float a, float b) { float r; asm("v_max_f32_e32 %0, %1, %2" : "=v"(r) : "v"(a), "v"(b)); return r; }
__device__ __forceinline__ float fadd_s(float a, float b) { float r; asm("v_add_f32_e32 %0, %1, %2" : "=v"(r) : "v"(a), "v"(b)); return r; }
__device__ __forceinline__ float fsub_s(float a, float b) { float r; asm("v_sub_f32_e32 %0, %1, %2" : "=v"(r) : "v"(a), "v"(b)); return r; }
typedef __bf16 bf16x2_t __attribute__((ext_vector_type(2)));
__device__ __forceinline__ unsigned cvtpk_s(float lo, float hi) { f32x2 v = {lo, hi}; bf16x2_t b = __builtin_convertvector(v, bf16x2_t); return __builtin_bit_cast(unsigned, b); }
#define WAIT_BAR(N) asm volatile("s_waitcnt vmcnt(" #N ") lgkmcnt(0)\n\ts_barrier" ::: "memory")
typedef LAS const char* lds_cptr;
typedef short v4i16_t __attribute__((ext_vector_type(4)));
__device__ __forceinline__ void qkt(f32x16& p0, f32x16& p1, lds_cptr Kslot, const bf16x8* qr, const f32x16& negm, int r32, int hi) {
  lds_cptr kb = Kslot + hi * 1024 + r32 * 16;
  #pragma unroll
  for (int d0 = 0; d0 < 4; ++d0) {
    const bf16x8 b0 = *(const LAS bf16x8*)(kb + d0 * 2048);
    const bf16x8 b1 = *(const LAS bf16x8*)(kb + d0 * 2048 + 512);
    if (d0 == 0) { p0 = __builtin_amdgcn_mfma_f32_32x32x16_bf16(b0, qr[0], negm, 0, 0, 0); p1 = __builtin_amdgcn_mfma_f32_32x32x16_bf16(b1, qr[0], negm, 0, 0, 0); }
    else { p0 = __builtin_amdgcn_mfma_f32_32x32x16_bf16(b0, qr[d0], p0, 0, 0, 0); p1 = __builtin_amdgcn_mfma_f32_32x32x16_bf16(b1, qr[d0], p1, 0, 0, 0); } }
}
__device__ __forceinline__ void kload8(bf16x8* kf, lds_cptr kp) {
  kf[0] = *(const LAS bf16x8*)(kp);        kf[1] = *(const LAS bf16x8*)(kp + 512);
  kf[2] = *(const LAS bf16x8*)(kp + 2048); kf[3] = *(const LAS bf16x8*)(kp + 2560);
  kf[4] = *(const LAS bf16x8*)(kp + 4096); kf[5] = *(const LAS bf16x8*)(kp + 4608);
  kf[6] = *(const LAS bf16x8*)(kp + 6144); kf[7] = *(const LAS bf16x8*)(kp + 6656);
}
__device__ __forceinline__ void kload2(bf16x8* kf, lds_cptr kp, int j) { kf[2 * j] = *(const LAS bf16x8*)(kp + j * 2048); kf[2 * j + 1] = *(const LAS bf16x8*)(kp + j * 2048 + 512); }
__device__ __forceinline__ s16x4 vtr(lds_cptr p) { return __builtin_bit_cast(s16x4, __builtin_amdgcn_ds_read_tr16_b64_v4i16((LAS v4i16_t*)p)); }
__device__ __forceinline__ float rowmax(const f32x16& p0, const f32x16& p1) {
  float a = max3f(p0[0], p0[1], p1[0]), b = max3f(p0[2], p0[3], p1[1]); a = max3f(a, p1[2], p1[3]);
  #pragma unroll
  for (int r = 4; r < 16; r += 4) { a = max3f(a, p0[r], p0[r + 1]); b = max3f(b, p0[r + 2], p0[r + 3]); a = max3f(a, p1[r], p1[r + 1]); b = max3f(b, p1[r + 2], p1[r + 3]); }
  const float m = max2f(a, b);
  auto rr = __builtin_amdgcn_permlane32_swap(__float_as_uint(m), __float_as_uint(m), false, false);
  return max2f(__uint_as_float(rr[0]), __uint_as_float(rr[1]));
}
__device__ __forceinline__ void pv(f32x16* o, int vb, bf16x8 pa0, bf16x8 pa1, bf16x8 pa2, bf16x8 pa3) {
  #pragma unroll
  for (int d0 = 0; d0 < 2; ++d0) { s16x4 lo[4], hi[4];
    #pragma unroll
    for (int ks = 0; ks < 4; ++ks) {
      asm volatile("ds_read_b64_tr_b16 %0,%1 offset:%c2" : "=&v"(lo[ks]) : "v"(vb), "i"(d0 * 4096 + ks * 1024) : "memory");
      asm volatile("ds_read_b64_tr_b16 %0,%1 offset:%c2" : "=&v"(hi[ks]) : "v"(vb), "i"(d0 * 4096 + ks * 1024 + 512) : "memory"); }
    asm volatile("s_waitcnt lgkmcnt(0)" ::: "memory"); SBAR();
    #define PK(k) (bf16x8){lo[k][0], lo[k][1], lo[k][2], lo[k][3], hi[k][0], hi[k][1], hi[k][2], hi[k][3]}
    o[d0] = __builtin_amdgcn_mfma_f32_32x32x16_bf16(pa0, PK(0), o[d0], 0, 0, 0);
    o[d0] = __builtin_amdgcn_mfma_f32_32x32x16_bf16(pa1, PK(1), o[d0], 0, 0, 0);
    o[d0] = __builtin_amdgcn_mfma_f32_32x32x16_bf16(pa2, PK(2), o[d0], 0, 0, 0);
    o[d0] = __builtin_amdgcn_mfma_f32_32x32x16_bf16(pa3, PK(3), o[d0], 0, 0, 0);
    #undef PK
  }
}

struct Xpf { bool primed, has_next; long Pn; const bf16* Qn; const bf16* Kn; const bf16* Vn; };
template<int THRL, bool WIN, bool XP> __device__ __forceinline__ void attn_unit_x(int qb, int T0, long P, const bf16* Q, const bf16* __restrict__ K, const bf16* __restrict__ V, bf16* O, char* shm, int wave,
                                                                        float* PML, long wtok0, int wtstride, const Xpf xp, bf16x8 (&qn)[4], int& rho) {
#ifndef PROBE_A
#define PROBE_A 0
#endif
  unsigned long long pa_t = 0ull;
#define PA_T0(k) do { if (WIN && PROBE_A == (k)) pa_t = __builtin_amdgcn_s_memrealtime(); } while (0)
#define PA_T1(k) do { if (WIN && PROBE_A == (k)) { const unsigned d_ = (unsigned)(__builtin_amdgcn_s_memrealtime() - pa_t); if (tid == 0) *(unsigned*)(shm + MISC_OFF + 4 * 121) += d_; } } while (0)
  int tid = wave * 64 + lane_id(); asm volatile("" : "+v"(tid));
  const int lane = tid & 63, r32 = lane & 31, hi = lane >> 5; const int wid = __builtin_amdgcn_readfirstlane(tid >> 6);
  PA_T0(1);
  const int q0 = qb * QB;
  const bf16* Qw = Q + (long)(q0 + wid * QBLK) * P;
  const bf16* Kh = K + (long)T0 * KVBLK * P, *Vh = V + (long)T0 * KVBLK * P;
  const unsigned lds0 = (unsigned)(uintptr_t)shm; const lds_cptr shm3 = (lds_cptr)shm;
  float* wsf = (float*)(shm + LDS_WS) + wid * 64;
  const int wbj = 383 - (q0 + wid * QBLK + r32 - T0 * KVBLK) + 4 * hi;
  const LAS float* nck0 = WIN ? (const LAS float*)((lds_cptr)shm + LDS_NCK) + (wbj & 3) * 640 + (wbj & ~3)
                              : (const LAS float*)((lds_cptr)shm + LDS_NCK) + T0 * KVBLK + 4 * hi;
  const float cq2 = WIN ? 0.f : -((const LAS float*)((lds_cptr)shm + LDS_NCK))[q0 + wid * QBLK + r32];
  const bf16* ksrc = Kh + (long)lane * P + wid * 8;
  const bf16* vsrc = Vh + (long)(16 * (wid & 3) + (lane >> 2)) * P + (wid >> 2) * 32 + (lane & 3) * 8;
  const unsigned kdst = lds0 + LDS_K + wid * 1024, vdst = lds0 + LDS_V + wid * 1024;
  #define DMA_K(t, slot) glds16(ksrc + (long)(t) * KVBLK * P, (unsigned)__builtin_amdgcn_readfirstlane(kdst + (slot)))
  #define DMA_V(t, slot) glds16(vsrc + (long)(t) * KVBLK * P, (unsigned)__builtin_amdgcn_readfirstlane(vdst + (slot)))
  const int vb0 = (int)(lds0 + LDS_V) + ((lane >> 4) & 1) * 32 + (lane & 3) * 8 + (4 * hi + ((lane & 15) >> 2)) * 64;
  bf16x8 kf[8];
  const lds_cptr kp0 = shm3 + LDS_K + hi * 1024 + r32 * 16; const lds_cptr vp0 = shm3 + LDS_V + ((lane >> 4) & 1) * 32 + (lane & 3) * 8 + (4 * hi + ((lane & 15) >> 2)) * 64;
  const int NT = (q0 + QB) / KVBLK - T0;
  #define NXS(s) (((s) == (NSLOT - 1) * SLOTB) ? 0 : (s) + SLOTB)
  const int s0 = XP ? __builtin_amdgcn_readfirstlane(rho) * SLOTB : 0, s1 = NXS(s0), s2 = NXS(s1);
  const bool primed = XP && xp.primed;
  if (!primed) { DMA_K(0, s0); DMA_V(0, s0); DMA_K(1, s1); }
  bf16x8 qr[4];
  const lds_cptr qp = shm3 + LDS_OST + wid * 4096 + lane * 16;
  if (!primed) {
  #pragma unroll
  for (int d0 = 0; d0 < 4; ++d0) qr[d0] = *reinterpret_cast<const bf16x8*>(&Qw[(long)r32 * P + d0 * 16 + hi * 8]);
  #pragma unroll
  for (int d0 = 0; d0 < 4; ++d0) *(LAS bf16x8*)(qp + d0 * 1024) = qr[d0];
  } else {
  #pragma unroll
  for (int d0 = 0; d0 < 4; ++d0) qr[d0] = qn[d0];
  }
  #define QLD(d) (*(const LAS bf16x8*)(qp + (d) * 1024))
  float nm = cq2, l_reg = 0.f; f32x16 o[2]; o[0] = f32x16{}; o[1] = f32x16{};
  const int qrel = wid * QBLK + r32;
  #define CMASK(P0, P1, t) do { if (!WIN) { int jb_ = (t) - (NT - 4); if (jb_ >= 0) cmask(P0, P1, jb_, qrel, hi); } } while (0)
  #define DECAY(P0, P1, t) do { const LAS float* nk_ = nck0 + ((t) << 6); \
    _Pragma("unroll") for (int g_ = 0; g_ < 4; ++g_) { const f32x4 a_ = *(const LAS f32x4*)(nk_ + 8 * g_); const f32x4 b_ = *(const LAS f32x4*)(nk_ + 32 + 8 * g_); \
      P0[4 * g_] += a_[0]; P0[4 * g_ + 1] += a_[1]; P0[4 * g_ + 2] += a_[2]; P0[4 * g_ + 3] += a_[3]; P1[4 * g_] += b_[0]; P1[4 * g_ + 1] += b_[1]; P1[4 * g_ + 2] += b_[2]; P1[4 * g_ + 3] += b_[3]; SBAR(); } } while (0)
  bool resc = false;
  #define START(P0, P1) do { const float rm = rowmax(P0, P1); resc = false; \
    { const float dl = max2f(rm, -1000.f); nm = fsub_s(nm, dl); \
      _Pragma("unroll") for (int r = 0; r < 16; ++r) { P0[r] = fsub_s(P0[r], dl); P1[r] = fsub_s(P1[r], dl); } } \
    _Pragma("unroll") for (int r = 0; r < 16; ++r) P0[r] = __builtin_amdgcn_exp2f(P0[r]); } while (0)
  #define RESC() do { if (resc) { asm volatile("s_waitcnt lgkmcnt(0)" ::: "memory"); \
      _Pragma("unroll") for (int d_ = 0; d_ < 2; ++d_) _Pragma("unroll") for (int r = 0; r < 16; ++r) o[d_][r] *= wsf[crow(r, hi)]; } } while (0)
  f32x16 pA0, pA1, pB0, pB1;
  int sl_prev = s0, sl_cur = s0, sl_next = s1;
  #define ROT() do { sl_prev = sl_cur; sl_cur = sl_next; sl_next = (sl_next == (NSLOT - 1) * SLOTB) ? 0 : sl_next + SLOTB; } while (0)
  if (!primed) { DMA_K(2, s2); WAIT_BAR(3); }
  PA_T1(1); PA_T0(2);
  { f32x16 negm;
    #pragma unroll
    for (int r = 0; r < 16; ++r) negm[r] = nm;
    qkt(pA0, pA1, shm3 + LDS_K + s0, qr, negm, r32, hi); }
  asm volatile("s_nop 15\n\ts_nop 7" : "+v"(pA0), "+v"(pA1)); DECAY(pA0, pA1, 0); CMASK(pA0, pA1, 0);
  asm volatile("s_nop 1" : "+v"(pA0), "+v"(pA1));
  START(pA0, pA1);
  _Pragma("unroll") for (int r = 0; r < 16; ++r) pA1[r] = __builtin_amdgcn_exp2f(pA1[r]);
  WAIT_BAR(0);
  DMA_K(3, s0); DMA_V(1, s1);
  ROT();
  kload8(kf, kp0 + sl_cur);
  WAIT_BAR(2);
  PA_T1(2); PA_T0(3);
  s16x4 vlo[8], vhi[8]; u32x4 pw0, pw1, pw2, pw3; bf16x8 qfa = QLD(0), qfb = QLD(1);
  #define PKW(P, B) cvtpk_s(P[B], P[B + 1])
  #define PAF(k) __builtin_bit_cast(bf16x8, pw##k)
  #define VFR(i) (bf16x8){vlo[i][0], vlo[i][1], vlo[i][2], vlo[i][3], vhi[i][0], vhi[i][1], vhi[i][2], vhi[i][3]}
  #define PIN(x) asm volatile("" : "+v"(x))
  #define MX3(a, b, c) __builtin_fmaxf(__builtin_fmaxf((a), (b)), (c))
  #define SPLAT(X) do { _Pragma("unroll") for (int r_ = 0; r_ < 16; ++r_) X[r_] = nm; PIN(X); } while (0)
  #define GAPA(MF, A0, A1, A2, A3, W0, W1, PW) do { MF; sacc += A0; sacc += A1; sacc += A2; sacc += A3; PIN(sacc); W0; W1; PIN(PW); SBAR(); } while (0)
  #define EX(v) __builtin_amdgcn_exp2f(v)
  #define GAPB(MF, X, B) do { MF; X[B] = EX(X[B]); X[B + 1] = EX(X[B + 1]); X[B + 2] = EX(X[B + 2]); X[B + 3] = EX(X[B + 3]); PIN(X); SBAR(); } while (0)
  #define VRD(i) do { vlo[i] = vtr(vp_ + (((i) >> 2) * 4096 + ((i) & 3) * 1024)); vhi[i] = vtr(vp_ + (((i) >> 2) * 4096 + ((i) & 3) * 1024 + 512)); } while (0)
  #define KRD(G, j) do { if (G) { kload2(kf, kp0 + sl_next, j); SBAR(); } } while (0)
  #define STEP(C0, C1, P0, P1, t, GK, GV, GL) do { SBAR(); \
    const lds_cptr vp_ = vp0 + sl_prev; \
    SPLAT(C0); VRD(0); SBAR(); float sacc = (P0[0] + P0[1]); \
    GAPA(C0 = __builtin_amdgcn_mfma_f32_32x32x16_bf16(kf[0], qfa, C0, 0, 0, 0), P0[2], P0[3], P0[4], P0[5],     pw0[0] = PKW(P0, 0), pw0[1] = PKW(P0, 2), pw0); \
    SPLAT(C1); VRD(4); SBAR(); GAPA(C1 = __builtin_amdgcn_mfma_f32_32x32x16_bf16(kf[1], qfa, C1, 0, 0, 0), P0[6], P0[7], P0[8], P0[9],     pw0[2] = PKW(P0, 4), pw0[3] = PKW(P0, 6), pw0); \
    qfa = QLD(2); VRD(1); SBAR(); GAPA(C0 = __builtin_amdgcn_mfma_f32_32x32x16_bf16(kf[2], qfb, C0, 0, 0, 0),   P0[10], P0[11], P0[12], P0[13], pw1[0] = PKW(P0, 8), pw1[1] = PKW(P0, 10), pw1); \
    VRD(5); SBAR(); GAPA(C1 = __builtin_amdgcn_mfma_f32_32x32x16_bf16(kf[3], qfb, C1, 0, 0, 0),   P0[14], P0[15], P1[0], P1[1],   pw1[2] = PKW(P0, 12), pw1[3] = PKW(P0, 14), pw1); \
    qfb = QLD(3); VRD(2); SBAR(); GAPA(C0 = __builtin_amdgcn_mfma_f32_32x32x16_bf16(kf[4], qfa, C0, 0, 0, 0),   P1[2], P1[3], P1[4], P1[5],     pw2[0] = PKW(P1, 0), pw2[1] = PKW(P1, 2), pw2); \
    VRD(6); SBAR(); GAPA(C1 = __builtin_amdgcn_mfma_f32_32x32x16_bf16(kf[5], qfa, C1, 0, 0, 0),   P1[6], P1[7], P1[8], P1[9],     pw2[2] = PKW(P1, 4), pw2[3] = PKW(P1, 6), pw2); \
    VRD(3); SBAR(); GAPA(C0 = __builtin_amdgcn_mfma_f32_32x32x16_bf16(kf[6], qfb, C0, 0, 0, 0),   P1[10], P1[11], P1[12], P1[13], pw3[0] = PKW(P1, 8), pw3[1] = PKW(P1, 10), pw3); \
    VRD(7); SBAR(); GAPA(C1 = __builtin_amdgcn_mfma_f32_32x32x16_bf16(kf[7], qfb, C1, 0, 0, 0),   P1[14], P1[15], 0.f, 0.f,       pw3[2] = PKW(P1, 12), pw3[3] = PKW(P1, 14), pw3); \
    l_reg += sacc; \
    if (GK) { DMA_K((t) + 3, sl_cur); } if (GV) { DMA_V((t) + 1, sl_next); } \
    DECAY(C0, C1, t); \
    CMASK(C0, C1, t); \
    { float a = MX3(C0[0], C0[1], C1[0]), b = MX3(C0[2], C0[3], C1[1]); a = MX3(a, C1[2], C1[3]); \
      _Pragma("unroll") for (int r = 4; r < 16; r += 4) { a = MX3(a, C0[r], C0[r + 1]); b = MX3(b, C0[r + 2], C0[r + 3]); a = MX3(a, C1[r], C1[r + 1]); b = MX3(b, C1[r + 2], C1[r + 3]); } \
      float rm = __builtin_fmaxf(a, b); { auto rr = __builtin_amdgcn_permlane32_swap(__float_as_uint(rm), __float_as_uint(rm), false, false); rm = __builtin_fmaxf(__uint_as_float(rr[0]), __uint_as_float(rr[1])); } \
      resc = false; \
      if (__builtin_expect(__any(rm > (float)THRL), 0)) { const float dl = __builtin_fmaxf(rm, 0.f); nm -= dl; \
        _Pragma("unroll") for (int r = 0; r < 16; ++r) { C0[r] -= dl; C1[r] -= dl; } \
        const float f = __builtin_amdgcn_exp2f(-dl); l_reg *= f; if (hi == 0) wsf[r32] = f; resc = true; } } \
    SBAR(); \
    GAPB(o[0] = __builtin_amdgcn_mfma_f32_32x32x16_bf16(PAF(0), VFR(0), o[0], 0, 0, 0), C0, 0); \
    GAPB(o[1] = __builtin_amdgcn_mfma_f32_32x32x16_bf16(PAF(0), VFR(4), o[1], 0, 0, 0), C0, 4); \
    KRD(GL, 0); GAPB(o[0] = __builtin_amdgcn_mfma_f32_32x32x16_bf16(PAF(1), VFR(1), o[0], 0, 0, 0), C0, 8); \
    KRD(GL, 1); GAPB(o[1] = __builtin_amdgcn_mfma_f32_32x32x16_bf16(PAF(1), VFR(5), o[1], 0, 0, 0), C0, 12); \
    KRD(GL, 2); GAPB(o[0] = __builtin_amdgcn_mfma_f32_32x32x16_bf16(PAF(2), VFR(2), o[0], 0, 0, 0), C1, 0); \
    KRD(GL, 3); GAPB(o[1] = __builtin_amdgcn_mfma_f32_32x32x16_bf16(PAF(2), VFR(6), o[1], 0, 0, 0), C1, 4); \
    GAPB(o[0] = __builtin_amdgcn_mfma_f32_32x32x16_bf16(PAF(3), VFR(3), o[0], 0, 0, 0), C1, 8); \
    qfa = QLD(0); qfb = QLD(1); SBAR(); \
    GAPB(o[1] = __builtin_amdgcn_mfma_f32_32x32x16_bf16(PAF(3), VFR(7), o[1], 0, 0, 0), C1, 12); \
    } while (0)
  int t = 1;
  #undef CMASK
  #define CMASK(P0, P1, t) do {} while (0)
  for (; t + 5 < NT; t += 2) {
    STEP(pB0, pB1, pA0, pA1, t, true, true, true);     WAIT_BAR(2); RESC(); ROT();
    STEP(pA0, pA1, pB0, pB1, t + 1, true, true, true); WAIT_BAR(2); RESC(); ROT();
  }
  #undef CMASK
  #define CMASK(P0, P1, t) do { if (!WIN) { int jb_ = (t) - (NT - 4); if (jb_ >= 0) cmask(P0, P1, jb_, qrel, hi); } } while (0)
  #define ENDW(tt) do { if ((tt) + 3 < NT) { WAIT_BAR(2); } else if ((tt) + 2 < NT) { WAIT_BAR(1); } else { WAIT_BAR(0); } } while (0)
  for (; t + 1 < NT; t += 2) {
    STEP(pB0, pB1, pA0, pA1, t, (t + 3 < NT), (t + 1 < NT), (t + 1 < NT));       ENDW(t);     RESC(); ROT();
    STEP(pA0, pA1, pB0, pB1, t + 1, (t + 4 < NT), (t + 2 < NT), (t + 2 < NT));   ENDW(t + 1); RESC(); ROT();
  }
  bool pf_next = false;
  if constexpr (XP) { pf_next = xp.has_next; if (pf_next) {
    const int n0 = sl_next, n1 = NXS(n0), n2 = NXS(n1);
    const bf16* ksn = xp.Kn + (long)lane * xp.Pn + wid * 8;
    const bf16* vsn = xp.Vn + (long)(16 * (wid & 3) + (lane >> 2)) * xp.Pn + (wid >> 2) * 32 + (lane & 3) * 8;
    glds16(ksn, (unsigned)__builtin_amdgcn_readfirstlane(kdst + n0));
    const bf16* Qwn = xp.Qn + (long)(wid * QBLK) * xp.Pn;
    #pragma unroll
    for (int d0 = 0; d0 < 4; ++d0) qn[d0] = *reinterpret_cast<const bf16x8*>(&Qwn[(long)r32 * xp.Pn + d0 * 16 + hi * 8]);
    glds16(vsn, (unsigned)__builtin_amdgcn_readfirstlane(vdst + n0));
    glds16(ksn + (long)KVBLK * xp.Pn, (unsigned)__builtin_amdgcn_readfirstlane(kdst + n1));
    glds16(ksn + (long)2 * KVBLK * xp.Pn, (unsigned)__builtin_amdgcn_readfirstlane(kdst + n2));
    rho = n0 / SLOTB; } }
  STEP(pB0, pB1, pA0, pA1, NT - 1, false, false, false); RESC();
  { float sacc = pB0[0] + pB0[1]; _Pragma("unroll") for (int r = 2; r < 16; ++r) sacc += pB0[r]; _Pragma("unroll") for (int r = 0; r < 16; ++r) sacc += pB1[r]; l_reg += sacc;
    pw0 = (u32x4){PKW(pB0, 0), PKW(pB0, 2), PKW(pB0, 4), PKW(pB0, 6)}; pw1 = (u32x4){PKW(pB0, 8), PKW(pB0, 10), PKW(pB0, 12), PKW(pB0, 14)}; pw2 = (u32x4){PKW(pB1, 0), PKW(pB1, 2), PKW(pB1, 4), PKW(pB1, 6)}; pw3 = (u32x4){PKW(pB1, 8), PKW(pB1, 10), PKW(pB1, 12), PKW(pB1, 14)};
    SBAR(); pv(o, vb0 + sl_cur, PAF(0), PAF(1), PAF(2), PAF(3)); }
  PA_T1(3); PA_T0(4);
  #undef PKW
  #undef PAF
  #undef VFR
  #undef PIN
  #undef MX3
  #undef GAPA
  #undef SPLAT
  #undef GAPB
  #undef EX
  #undef VRD
  #undef KRD
  #undef STEP
  #undef ENDW
  { auto rr = __builtin_amdgcn_permlane32_swap(__float_as_uint(l_reg), __float_as_uint(l_reg), false, false); l_reg = __uint_as_float(rr[0]) + __uint_as_float(rr[1]); }
  if (hi == 0) wsf[32 + r32] = l_reg; asm volatile("s_waitcnt lgkmcnt(0)" ::: "memory");
  float rli[16];
  #pragma unroll
  for (int r = 0; r < 16; ++r) rli[r] = WIN ? 1.0f : __builtin_amdgcn_rcpf(wsf[32 + crow(r, hi)]);
  if (WIN) { if (hi == 0) *(f32x2*)(PML + 2 * (wtok0 + (long)wtstride * (q0 + wid * QBLK + r32))) = (f32x2){-nm, l_reg}; }
  bf16* Ow = O + (long)(q0 + wid * QBLK) * P;
  { bf16* stg = (bf16*)(shm + LDS_OST) + wid * 2048;
    #pragma unroll
    for (int r = 0; r < 16; ++r) { const int orow = crow(r, hi);
      #pragma unroll
      for (int d0 = 0; d0 < 2; ++d0) stg[orow * 64 + d0 * 32 + r32] = __float2bfloat16(o[d0][r] * rli[r]); }
    asm volatile("s_waitcnt lgkmcnt(0)" ::: "memory");
    #pragma unroll
    for (int i = 0; i < 4; ++i) { const int row = i * 8 + (lane >> 3), ch = lane & 7; const u32x4 v = *(const u32x4*)(stg + row * 64 + ch * 8); *(u32x4*)(Ow + (long)row * P + ch * 8) = v; } }
  if constexpr (XP) { if (pf_next) {
    asm volatile("s_waitcnt vmcnt(5)" ::: "memory");
    #pragma unroll
    for (int d0 = 0; d0 < 4; ++d0) asm volatile("ds_write_b128 %0, %1 offset:%c2" :: "v"((unsigned)(uintptr_t)qp), "v"(qn[d0]), "i"(d0 * 1024) : "memory"); } }
  asm volatile("s_waitcnt lgkmcnt(0)\n\ts_barrier" ::: "memory");
  PA_T1(4);
  #undef DMA_K
  #undef DMA_V
  #undef NXS
  #undef CMASK
  #undef DECAY
  #undef START
  #undef RESC
  #undef ROT
  #undef QLD
}
template<int THRL, bool WIN> __device__ __forceinline__ void attn_unit(int qb, int T0, long P, const bf16* Q, const bf16* __restrict__ K, const bf16* __restrict__ V, bf16* O, char* shm, int wave,
                                                                        float* PML = nullptr, long wtok0 = 0, int wtstride = 0) {
  Xpf xp{}; bf16x8 qn[4]; int rho = 0;
  attn_unit_x<THRL, WIN, false>(qb, T0, P, Q, K, V, O, shm, wave, PML, wtok0, wtstride, xp, qn, rho);
}
#undef WAIT_BAR
}

namespace dil {
constexpr float NEGBIG = -1.0e30f;
__device__ __forceinline__ int t5_bucket(int dist) {
    if (dist < 16) return dist;
    const float v = logf((float)dist / 16.0f) / 4.852030263919617f * 16.0f;
    const int l = 16 + (int)v; return l < 31 ? l : 31;
}
__device__ __forceinline__ void build_table(LAS float* tb, const float* rel_bias, int g, int d, int j, int tid) {
    asm volatile("" : "+v"(tid));
    for (int e = tid; e < 640; e += 512) { const int n = e - 256; const float v = (n >= 0 && n <= 128) ? rel_bias[t5_bucket(n * d) * 24 + 8 * g + j] * LOG2E : NEGBIG; const int m = 639 - e;
#pragma unroll
        for (int sft = 0; sft < 4; ++sft) if (m - sft >= 0) tb[640 * sft + m - sft] = v; }
}
}

#define XB_TMO      128
#define XB_XCNT(j)  (256  + 64 * (j))
#define XB_XSUB(j)  (1280 + 64 * (j))
#define XB_XGEN(j)  (2304 + 64 * (j))
#define XB_TOP      3328
#define XB_TOPGEN   3392
#define XCD_BAR_WORDS 3456
#define XB_SPIN_CAP (1u << 18)
__device__ __forceinline__ unsigned xb_ld(unsigned* p)              { return __hip_atomic_load(p, __ATOMIC_RELAXED, __HIP_MEMORY_SCOPE_AGENT); }
__device__ __forceinline__ unsigned xb_add(unsigned* p, unsigned v) { return __hip_atomic_fetch_add(p, v, __ATOMIC_RELAXED, __HIP_MEMORY_SCOPE_AGENT); }
__device__ __forceinline__ unsigned xb_xcc_id() { return (unsigned)__builtin_amdgcn_s_getreg((3 << 11) | 20) & 0xFu; }
#define XB_SPIN(cond, bar) do { unsigned _sp = 0; while (cond) { __builtin_amdgcn_s_sleep(1); \
    if ((++_sp & 255u) == 0u) { if (xb_ld(&(bar)[XB_TMO])) break; if (_sp > XB_SPIN_CAP) { atomicAdd(&(bar)[XB_TMO], 1u); break; } } } } while (0)
struct XcdBarrier { unsigned* bar; unsigned x; volatile LAS unsigned* st; };
__device__ __forceinline__ XcdBarrier xcd_barrier_post(unsigned* bar, volatile LAS unsigned* st, bool leader) {
    XcdBarrier b; b.bar = bar; b.x = xb_xcc_id(); b.st = st;
    if (leader) (void)xb_add(&bar[XB_XCNT(b.x)], 1u);
    return b;
}
__device__ __forceinline__ void xcd_barrier_complete(unsigned* bar, unsigned x, unsigned& nloc, unsigned& nx) {
    const unsigned G = gridDim.x * gridDim.y * gridDim.z;
    unsigned sum, cnt, mine, sp = 0u;
    for (;;) {
        sum = 0u; cnt = 0u; mine = 0u;
#pragma unroll
        for (unsigned j = 0; j < 16; ++j) { const unsigned c = xb_ld(&bar[XB_XCNT(j)]); sum += c; cnt += (c > 0u) ? 1u : 0u; mine = (j == x) ? c : mine; }
        if (sum == G) break;
        __builtin_amdgcn_s_sleep(1);
        if ((++sp & 255u) == 0u) { if (xb_ld(&bar[XB_TMO])) break; if (sp > XB_SPIN_CAP) { atomicAdd(&bar[XB_TMO], 1u); break; } }
    }
    nloc = mine > 0u ? mine : 1u; nx = cnt > 0u ? cnt : 1u;
}
__device__ __forceinline__ void xcd_barrier(const XcdBarrier& b, bool leader) {
    asm volatile("s_waitcnt vmcnt(0)" ::: "memory");
    __syncthreads();
    if (leader) {
        unsigned* bar = b.bar;
        __builtin_amdgcn_s_waitcnt(0);
        unsigned nloc = b.st[0], nx = b.st[1];
        if (nloc == 0u) { xcd_barrier_complete(bar, b.x, nloc, nx); b.st[0] = nloc; b.st[1] = nx; }
        const unsigned old = xb_add(&bar[XB_XSUB(b.x)], 1u);
        const unsigned gen = old / nloc;
        if (old + 1u == (gen + 1u) * nloc) {
            __builtin_amdgcn_fence(__ATOMIC_RELEASE, "agent");
            asm volatile("s_waitcnt vmcnt(0)" ::: "memory");
            const unsigned og = xb_add(&bar[XB_TOP], 1u);
            const unsigned tg = og / nx;
            if (og + 1u == (tg + 1u) * nx) xb_add(&bar[XB_TOPGEN], 1u);
            else XB_SPIN(xb_ld(&bar[XB_TOPGEN]) == tg, bar);
            __builtin_amdgcn_fence(__ATOMIC_ACQUIRE, "agent");
            xb_add(&bar[XB_XGEN(b.x)], 1u);
            asm volatile("s_waitcnt vmcnt(0)" ::: "memory");
        } else {
            XB_SPIN(xb_ld(&bar[XB_XGEN(b.x)]) == gen, bar);
            __builtin_amdgcn_fence(__ATOMIC_ACQUIRE, "agent");
            asm volatile("s_waitcnt vmcnt(0)" ::: "memory");
        }
    }
    __syncthreads();
}

__device__ __forceinline__ const float* inptr(int k) {
    asm volatile("" : "+s"(k));
    return ((const float* const __attribute__((address_space(4)))*)__builtin_amdgcn_kernarg_segment_ptr())[k];
}
#define INP(k) inptr(k)
__device__ __forceinline__ int otid(int wave) { int t = wave * 64 + lane_id(); asm volatile("" : "+v"(t)); return t; }
__device__ __forceinline__ unsigned char* opq_ptr(unsigned char* p) { asm volatile("" : "+s"(p)); return p; }
struct Frame {
    LAS unsigned char* lds;
    volatile LAS unsigned* MISC;
    gu32* ctl;
    int wave;
    int vcu, G;
    float* out;
    unsigned char* ws;
};
__device__ __forceinline__ float wave_sum(float v, int lane) {
#pragma unroll
    for (int o = 1; o < 64; o <<= 1) v += shfl_x(v, lane, o);
    return v;
}

struct P0D { const float* W; int ldw; int K; bf16_t* WT; const float* gain; int kb, nb; int f8; };
__device__ __forceinline__ P0D p0_decode(int it, unsigned char* ws) {
    constexpr int I0 = 16 * 96, I1 = 16 * 32, I2 = 16 * 96, I3 = 16 * 48, I4 = 8 * 32, I5 = 32 * 256, I6 = 32 * 256;
    P0D d; int r = it;
    if (r < I0) { d.f8 = 1; d.W = INP(2); d.ldw = 3088; d.K = 1024; d.WT = (bf16_t*)(ws + WS_WQKVA); d.gain = INP(1); d.kb = r / 96; d.nb = r % 96; return d; } r -= I0;
    if (r < I1) { d.f8 = 0; d.W = INP(6); d.ldw = 1024; d.K = 1024; d.WT = (bf16_t*)(ws + WS_WOA); d.gain = nullptr; d.kb = r / 32; d.nb = r % 32; return d; } r -= I1;
    if (r < I2) { d.f8 = 1; d.W = INP(8); d.ldw = 3072; d.K = 1024; d.WT = (bf16_t*)(ws + WS_WKVQ); d.gain = INP(7); d.kb = r / 96; d.nb = r % 96; return d; } r -= I2;
    if (r < I3) { d.f8 = 1; d.W = INP(12); d.ldw = 1536; d.K = 1024; d.WT = (bf16_t*)(ws + WS_WKVQ + (size_t)3072 * 1024); d.gain = INP(11); d.kb = r / 48; d.nb = r % 48; return d; } r -= I3;
    if (r < I4) { d.f8 = 1; d.W = INP(14); d.ldw = 1024; d.K = 512; d.WT = (bf16_t*)(ws + WS_WOB); d.gain = nullptr; d.kb = r / 32; d.nb = r % 32; return d; } r -= I4;
    if (r < I5) { const int le = r / 256, q = r % 256;
        d.f8 = 1; d.W = INP(20) + (size_t)le * 1024 * 512; d.ldw = 512; d.K = 1024; d.WT = (bf16_t*)(ws + WS_WGU + (size_t)le * 1024 * 1024); d.gain = INP(15) + (le >> 4) * 1024; d.kb = q / 16; d.nb = q % 16; return d; } r -= I5;
    if (r < I6) { const int le = r / 256, q = r % 256;
        d.f8 = 1; d.W = INP(21) + (size_t)le * 1024 * 512; d.ldw = 512; d.K = 1024; d.WT = (bf16_t*)(ws + WS_WGU + (size_t)le * 1024 * 1024 + (size_t)512 * 1024); d.gain = INP(15) + (le >> 4) * 1024; d.kb = q / 16; d.nb = q % 16; return d; } r -= I6;
    { const int le = r / 256, q = r % 256;
        d.f8 = 1; d.W = INP(22) + (size_t)le * 512 * 1024; d.ldw = 1024; d.K = 512; d.WT = (bf16_t*)(ws + WS_WD + (size_t)le * 1024 * 512); d.gain = nullptr; d.kb = q / 32; d.nb = q % 32; return d; }
}
__device__ __forceinline__ void p0_load(const P0D& d, int lane, f32x4 (&v)[8], float (&gv)[8]) {
    const float* src = d.W + (size_t)(64 * d.kb + (lane >> 3)) * d.ldw + 32 * d.nb + 4 * (lane & 7);
#pragma unroll
    for (int i = 0; i < 8; ++i) { v[i] = __builtin_nontemporal_load((const GAS f32x4*)(src + (size_t)(8 * i) * d.ldw)); gv[i] = d.gain ? d.gain[64 * d.kb + (lane >> 3) + 8 * i] : 1.0f; }
}
__device__ __forceinline__ void p0_store(const P0D& d, int lane, const f32x4 (&v)[8], const float (&gv)[8], LAS float* scr) {
#pragma unroll
    for (int i = 0; i < 8; ++i) { LAS float* p = scr + ((lane >> 3) + 8 * i) * 33 + 4 * (lane & 7); const f32x4 x = v[i] * gv[i]; p[0] = x[0]; p[1] = x[1]; p[2] = x[2]; p[3] = x[3]; }
    LDS_WAIT(); asm volatile("" ::: "memory");
    const int c = lane & 7, k0 = 64 * d.kb, n0 = 32 * d.nb;
#pragma unroll
    for (int j = 0; j < 4; ++j) { const int n = (lane >> 3) + 8 * j; const LAS float* s = scr + (8 * c) * 33 + n;
        if (d.f8) { u32x2 o; o.x = pk4_fp8(s[0 * 33] * W8SCALE, s[1 * 33] * W8SCALE, s[2 * 33] * W8SCALE, s[3 * 33] * W8SCALE); o.y = pk4_fp8(s[4 * 33] * W8SCALE, s[5 * 33] * W8SCALE, s[6 * 33] * W8SCALE, s[7 * 33] * W8SCALE);
            *(GAS u32x2*)((unsigned char*)d.WT + (size_t)(n0 + n) * d.K + k0 + 8 * c) = o; }
        else { u32x4 o; o.x = pk2(s[0 * 33], s[1 * 33]); o.y = pk2(s[2 * 33], s[3 * 33]); o.z = pk2(s[4 * 33], s[5 * 33]); o.w = pk2(s[6 * 33], s[7 * 33]);
            *(GAS u32x4*)(d.WT + (size_t)(n0 + n) * d.K + k0 + 8 * c) = o; } }
    LDS_WAIT(); asm volatile("" ::: "memory");
}
struct P0H { const float* W; unsigned char* WT; int kb, nb; };
__device__ __forceinline__ P0H p0h_decode(int idx, unsigned char* ws) { const int le = idx >> 9, hq = idx & 511; P0H d; d.W = INP(22) + (size_t)le * 512 * 1024; d.WT = ws + WS_WD + (size_t)le * 1024 * 512; d.kb = hq >> 6; d.nb = hq & 63; return d; }
__device__ __forceinline__ void p0h_load(const P0H& d, int lane, f32x4 (&v)[4]) {
    const float* src = d.W + (size_t)(64 * d.kb + (lane >> 2)) * 1024 + 16 * d.nb + 4 * (lane & 3);
#pragma unroll
    for (int i = 0; i < 4; ++i) v[i] = __builtin_nontemporal_load((const GAS f32x4*)(src + (size_t)(16 * i) * 1024));
}
__device__ __forceinline__ void p0h_store(const P0H& d, int lane, const f32x4 (&v)[4], LAS float* scr) {
#pragma unroll
    for (int i = 0; i < 4; ++i) { LAS float* p = scr + ((lane >> 2) + 16 * i) * 17 + 4 * (lane & 3); p[0] = v[i][0]; p[1] = v[i][1]; p[2] = v[i][2]; p[3] = v[i][3]; }
    LDS_WAIT(); asm volatile("" ::: "memory");
    const int n = lane >> 2, c = lane & 3; const LAS float* s = scr + (16 * c) * 17 + n;
    u32x4 o;
    o.x = pk4_fp8(s[0 * 17] * W8SCALE, s[1 * 17] * W8SCALE, s[2 * 17] * W8SCALE, s[3 * 17] * W8SCALE);     o.y = pk4_fp8(s[4 * 17] * W8SCALE, s[5 * 17] * W8SCALE, s[6 * 17] * W8SCALE, s[7 * 17] * W8SCALE);
    o.z = pk4_fp8(s[8 * 17] * W8SCALE, s[9 * 17] * W8SCALE, s[10 * 17] * W8SCALE, s[11 * 17] * W8SCALE); o.w = pk4_fp8(s[12 * 17] * W8SCALE, s[13 * 17] * W8SCALE, s[14 * 17] * W8SCALE, s[15 * 17] * W8SCALE);
    *(GAS u32x4*)(d.WT + (size_t)(16 * d.nb + n) * 512 + 64 * d.kb + 16 * c) = o;
    LDS_WAIT(); asm volatile("" ::: "memory");
}
template <int MAP> __device__ __forceinline__ int p0_map(int it) {
    if (MAP == 0) return it < 4608 + 4096 ? it : it + 4096;
    return it < 4096 ? 4608 + 4096 + it : 4608 + 3 * 4096 + (it - 4096);
}
template <int MAP> __device__ __forceinline__ void p0_items(Frame& F, int first, int stride, int n) {
    const int lane_ = otid(F.wave) & 63;
    LAS float* scr = (LAS float*)(F.lds + F.wave * 16384);
    unsigned char* ws = F.ws;
    f32x4 va[8], vb[8], vc_[8]; float ga[8], gb[8], gc[8]; P0D da, db, dc;
    int it = first; const int NGW = stride, NITEMS = n;
    if (it < NITEMS) { da = p0_decode(p0_map<MAP>(it), ws); p0_load(da, lane_, va, ga); }
    if (it + NGW < NITEMS) { db = p0_decode(p0_map<MAP>(it + NGW), ws); p0_load(db, lane_, vb, gb); }
    while (it < NITEMS) {
        if (it + 2 * NGW < NITEMS) { dc = p0_decode(p0_map<MAP>(it + 2 * NGW), ws); p0_load(dc, lane_, vc_, gc); }
        p0_store(da, lane_, va, ga, scr);
        if (it + NGW >= NITEMS) break;
        if (it + 3 * NGW < NITEMS) { da = p0_decode(p0_map<MAP>(it + 3 * NGW), ws); p0_load(da, lane_, va, ga); }
        p0_store(db, lane_, vb, gb, scr);
        if (it + 2 * NGW >= NITEMS) break;
        if (it + 4 * NGW < NITEMS) { db = p0_decode(p0_map<MAP>(it + 4 * NGW), ws); p0_load(db, lane_, vb, gb); }
        p0_store(dc, lane_, vc_, gc, scr);
        it += 3 * NGW;
    }
}
__device__ __forceinline__ void p0_tail(Frame& F, int nunits, int cc) {
    const int G = F.G, rounds = (nunits + G - 1) / G, rem = nunits - (rounds - 1) * G;
    int nw = G - rem, rank = cc - rem;
    if (nw < 64) { nw = G; rank = cc; }
    if (rank < 0) return;
    __syncthreads();
    p0_items<1>(F, rank * 8 + F.wave, nw * 8, 8192);
}
__device__ __forceinline__ void p0_prologue(Frame& F) {
    const int tid_ = otid(F.wave), lane_ = tid_ & 63;
    const int gw = F.vcu * 8 + F.wave, NGW = F.G * 8;
    unsigned char* ws = F.ws;
    p0_items<0>(F, gw, NGW, 4608 + 2 * 4096);
    const int gt = gw * 64 + lane_, NGT = NGW * 64;
    { const float* an = INP(1); const float* awin = INP(2);
    for (int e = gt; e < 16 * 1024; e += NGT) { const int n = e >> 10, k = e & 1023; ((bf16_t*)(ws + WS_WF))[e] = (bf16_t)f2bf(an[k] * awin[(size_t)k * 3088 + 3072 + n]); } }
    const float* fn_ = INP(15); const float* wexp_ = INP(18); const float* wgrp_ = INP(16);
    for (int e = gt; e < 2 * 32 * 1024; e += NGT) { const int l = e >> 15, n = (e >> 10) & 31, k = e & 1023;
        float v = 0.f;
        if (n < 16) v = fn_[l * 1024 + k] * wexp_[((size_t)l * 1024 + k) * 16 + n];
        else if (n < 20) v = fn_[l * 1024 + k] * wgrp_[((size_t)l * 1024 + k) * 4 + (n - 16)];
        const unsigned hb = f2bf(v); const float lo = v - bf2f(hb);
        bf16_t* wr = (bf16_t*)(ws + WS_WR) + (size_t)l * 2 * 32 * 1024;
        wr[n * 1024 + k] = (bf16_t)hb; wr[32 * 1024 + n * 1024 + k] = (bf16_t)f2bf(lo); }
    if (gt < 6 * 64) { const int sgi = gt >> 6, d = gt & 63; float v = 1.0f;
        if (sgi == 0) v = INP(4)[d] * C2; else if (sgi == 1) v = INP(5)[d]; else if (sgi == 3) v = INP(9)[d]; else if (sgi == 5) v = INP(13)[d] * C2;
        ((float*)(ws + WS_GTAB))[gt] = v; }
    const float* x_ = INP(0);
    {
        f32x4 v[4], vn[4], vm[4];
        int m = gw;
        if (m < NTOK) { const GAS f32x4* xr = (const GAS f32x4*)(x_ + (size_t)m * DM) + lane_;
#pragma unroll
            for (int jj = 0; jj < 4; ++jj) v[jj] = __builtin_nontemporal_load(xr + 64 * jj); }
        if (m + NGW < NTOK) { const GAS f32x4* xr = (const GAS f32x4*)(x_ + (size_t)(m + NGW) * DM) + lane_;
#pragma unroll
            for (int jj = 0; jj < 4; ++jj) vn[jj] = __builtin_nontemporal_load(xr + 64 * jj); }
        while (m < NTOK) {
            if (m + 2 * NGW < NTOK) { const GAS f32x4* xr = (const GAS f32x4*)(x_ + (size_t)(m + 2 * NGW) * DM) + lane_;
#pragma unroll
                for (int jj = 0; jj < 4; ++jj) vm[jj] = __builtin_nontemporal_load(xr + 64 * jj); }
            float sq = 0.f;
#pragma unroll
            for (int jj = 0; jj < 4; ++jj) sq += (v[jj].x * v[jj].x + v[jj].y * v[jj].y) + (v[jj].z * v[jj].z + v[jj].w * v[jj].w);
            const float rstd = 1.f / sqrtf(wave_sum(sq, lane_) * (1.f / DM) + EPS);
            GAS unsigned long long* o8 = (GAS unsigned long long*)((bf16_t*)(ws + WS_XB) + (size_t)m * DM) + lane_;
#pragma unroll
            for (int jj = 0; jj < 4; ++jj) o8[64 * jj] = (unsigned long long)pk2(v[jj].x, v[jj].y) | ((unsigned long long)pk2(v[jj].z, v[jj].w) << 32);
            GAS unsigned* q8 = (GAS unsigned*)(ws + WS_XB8 + (size_t)m * DM) + lane_;
#pragma unroll
            for (int jj = 0; jj < 4; ++jj) q8[64 * jj] = pk4_fp8(v[jj].x, v[jj].y, v[jj].z, v[jj].w);
            if (lane_ == 0) ((float*)(ws + WS_RSTD0))[m] = rstd;
#pragma unroll
            for (int jj = 0; jj < 4; ++jj) { v[jj] = vn[jj]; vn[jj] = vm[jj]; }
            m += NGW;
        }
    }
}

__device__ __forceinline__ void forget_phase(Frame& F) {
    const int tid_ = otid(F.wave), lane_ = tid_ & 63;
    const bf16_t* XB = (const bf16_t*)(F.ws + WS_XB); const bf16_t* WF = (const bf16_t*)(F.ws + WS_WF);
    const float* RSTD0 = (const float*)(F.ws + WS_RSTD0); const float* b_f = INP(3);
    float* LC = (float*)(F.ws + WS_LC); float* CT = (float*)(F.ws + WS_CT);
    LAS float* wt = (LAS float*)(F.lds + AUX_OFF);
    const int fr = lane_ & 15, fq = lane_ >> 4;
    for (int chunk = blockIdx.x; chunk < NTOK / 128; chunk += F.G) {
        const int row = chunk * 128 + F.wave * 16 + fr;
        const bf16_t* xa = XB + (size_t)row * DM + 8 * fq; const bf16_t* wb = WF + (size_t)fr * DM + 8 * fq;
        f32x4 acc = {0.f, 0.f, 0.f, 0.f};
#pragma unroll 8
        for (int kb = 0; kb < 32; ++kb) { const bf16x8 a = *(const bf16x8*)(xa + 32 * kb), w = *(const bf16x8*)(wb + 32 * kb); acc = __builtin_amdgcn_mfma_f32_16x16x32_bf16(w, a, acc, 0, 0, 0); }
        const float rs = RSTD0[row];
        float lf[4];
#pragma unroll
        for (int i = 0; i < 4; ++i) { const float z = acc[i] * rs + b_f[4 * fq + i]; lf[i] = fminf(z, 0.f) - log1pf(expf(-fabsf(z))); }
#pragma unroll
        for (int off = 1; off < 16; off <<= 1)
#pragma unroll
            for (int i = 0; i < 4; ++i) { const float t = shfl_from(lf[i], lane_ - off); if (fr >= off) lf[i] += t; }
        if (fr == 15) {
#pragma unroll
            for (int i = 0; i < 4; ++i) wt[F.wave * 16 + 4 * fq + i] = lf[i]; }
        __syncthreads();
#pragma unroll
        for (int i = 0; i < 4; ++i) { float p = 0.f; for (int w = 0; w < F.wave; ++w) p += wt[w * 16 + 4 * fq + i]; lf[i] += p; }
        const int b = row >> 13, s = row & (SEQ - 1);
#pragma unroll
        for (int i = 0; i < 4; ++i) LC[(size_t)(b * 16 + 4 * fq + i) * SEQ + s] = lf[i];
        if (F.wave == 7 && fr == 15) {
#pragma unroll
            for (int i = 0; i < 4; ++i) CT[(b * 16 + 4 * fq + i) * 64 + ((chunk * 128) & (SEQ - 1)) / 128] = lf[i]; }
        __syncthreads();
    }
}

__device__ __forceinline__ void attnA_phase(Frame& F, unsigned char* ldsg) {
    const int tid_ = otid(F.wave), lane_ = tid_ & 63;
    LAS float* NCK = (LAS float*)(F.lds + attn_body::LDS_NCK);
    LAS float* CPs = (LAS float*)(F.lds + AUX_OFF);
    volatile LAS int* ctl = (volatile LAS int*)(F.lds + AUX_OFF + 256);
    const float* LC = (const float*)(F.ws + WS_LC); const float* CT = (const float*)(F.ws + WS_CT);
    float mqk = 0.f;
    { const float* gq_ = INP(4); const float* gk_ = INP(5);
      for (int d = 0; d < 64; ++d) mqk = fmaxf(mqk, fabsf(gq_[d] * gk_[d])); }
    const float thr2 = (40.f + 2.f * 8.f * mqk * 1.03f) * LOG2E;
    unsigned* queue = (unsigned*)(F.ctl + CW_QUEUE);
    for (;;) {
        if (tid_ == 0) ctl[0] = (int)__hip_atomic_fetch_add(queue, 1u, RLX_AGENT);
        __syncthreads();
        const int u = ctl[0];
        if (u >= NBATCH * 16 * 32) break;
        const int qb = 31 - (u >> 6), bh = u & 63, b = bh >> 4, h = bh & 15, q0 = qb * 256, NTf = 4 * qb + 4, nkeys = q0 + 256;
        const float* lcp = LC + (size_t)bh * SEQ;
        f32x4 dva[4]; const P0H ddi = p0h_decode(8 * u + F.wave, F.ws); p0h_load(ddi, lane_, dva);
        if (F.wave == 0) { const float c = CT[bh * 64 + lane_]; float v = c;
#pragma unroll
            for (int off = 1; off < 64; off <<= 1) { const float t = shfl_from(v, lane_ - off); if (lane_ >= off) v += t; }
            const float excl = v - c; CPs[lane_] = excl;
            const float cumq = shfl_from(excl, q0 >> 7) + lcp[q0];
            const bool need = (lane_ <= (q0 >> 7)) && ((cumq - v) * LOG2E >= -thr2);
            const unsigned long long bm = __builtin_amdgcn_ballot_w64(need);
            int t0 = 2 * (int)__builtin_ctzll(bm | (1ull << 63)); t0 = t0 < NTf - 4 ? t0 : NTf - 4;
            if (lane_ == 0) ctl[1] = t0; }
        __syncthreads();
        const int T0 = ctl[1];
        const float cpq = CPs[q0 >> 7], lcq = lcp[q0];
        for (int s = 64 * T0 + tid_; s < nkeys; s += 512) NCK[s] = ((cpq - CPs[s >> 7]) + (lcq - lcp[s])) * LOG2E;
        __syncthreads();
        { const size_t ho = ((size_t)b * SEQ * 1024 + h * 64) * 2;
          attn_body::attn_unit<64, false>(qb, T0, 1024, (const attn_body::bf16*)(F.ws + WS_QA + ho), (const attn_body::bf16*)(F.ws + WS_KA + ho), (const attn_body::bf16*)(F.ws + WS_VA + ho), (attn_body::bf16*)(F.ws + WS_QA + ho), (char*)ldsg, F.wave); }
        p0h_store(ddi, lane_, dva, (LAS float*)(F.lds + F.wave * 8192));
    }
}

__device__ __forceinline__ void router_phase(Frame& F, int layer, const float* stats, float* rstd_out) {
    const int tid_ = otid(F.wave), lane_ = tid_ & 63;
    const bf16_t* XBr = (const bf16_t*)(F.ws + WS_XB); unsigned char* XN8 = (unsigned char*)(F.ws + WS_XN8); const bf16_t* WR = (const bf16_t*)(F.ws + WS_WR) + (size_t)layer * 2 * 32 * 1024;
    const float* b_group = INP(17) + layer * 4; const float* b_expert = INP(19) + layer * 16;
    float* GSORT = (float*)(F.ws + WS_GSORT); int* PERM = (int*)(F.ws + WS_PERM);
    unsigned* CNT = (unsigned*)(F.ctl + (layer == 0 ? CW_CNT0 : CW_CNT1));
    volatile LAS int* lcnt = (volatile LAS int*)(F.lds + AUX_OFF);
    const int fr = lane_ & 15, fq = lane_ >> 4;
#pragma unroll
    for (int p = 0; p < 16; ++p) { const int off = p * 8192 + tid_ * 16, n = off >> 11, pc = (off >> 4) & 127;
        __builtin_amdgcn_global_load_lds((const unsigned*)((const char*)WR + n * 2048 + ((pc ^ (n & 15)) << 4)), (LAS unsigned*)(F.lds + p * 8192 + F.wave * 1024), 16, 0, 0); }
    for (int chunk = blockIdx.x; chunk < NTOK / 128; chunk += F.G) {
        if (tid_ < 64) lcnt[tid_] = 0;
        VM_WAIT();
        __syncthreads();
        const int row = chunk * 128 + F.wave * 16 + fr;
        float ss; { const f32x4 p = *(const GAS f32x4*)(stats + (size_t)row * 16 + 4 * fq); ss = (p[0] + p[1]) + (p[2] + p[3]); ss += shfl_x(ss, 16 * fq + fr, 16); ss += shfl_x(ss, 16 * fq + fr, 32); }
        const float rs = 1.0f / sqrtf(ss * (1.0f / 1024.0f) + EPS);
        const bf16_t* hp = XBr + (size_t)row * DM + 8 * fq;
        unsigned char* x8 = XN8 + (size_t)row * DM + 8 * fq;
        const LAS unsigned char* wl = F.lds + fr * 2048;
        f32x4 a0 = {0.f, 0.f, 0.f, 0.f}, a1 = {0.f, 0.f, 0.f, 0.f};
#pragma unroll 4
        for (int kb = 0; kb < 32; ++kb) {
            const bf16x8 xh = *(const bf16x8*)(hp + 32 * kb);
            const int wc_ = ((4 * kb + fq) ^ fr) << 4;
            const bf16x8 wh0 = *(const LAS bf16x8*)(wl + wc_), wl0 = *(const LAS bf16x8*)(wl + 32 * 2048 + wc_);
            const bf16x8 wh1 = *(const LAS bf16x8*)(wl + 16 * 2048 + wc_), wl1 = *(const LAS bf16x8*)(wl + 48 * 2048 + wc_);
            a0 = __builtin_amdgcn_mfma_f32_16x16x32_bf16(wh0, xh, a0, 0, 0, 0); a0 = __builtin_amdgcn_mfma_f32_16x16x32_bf16(wl0, xh, a0, 0, 0, 0);
            a1 = __builtin_amdgcn_mfma_f32_16x16x32_bf16(wh1, xh, a1, 0, 0, 0); a1 = __builtin_amdgcn_mfma_f32_16x16x32_bf16(wl1, xh, a1, 0, 0, 0);
            u32x2 q8; q8.x = pk4_fp8(bf2f((unsigned short)xh[0]) * rs, bf2f((unsigned short)xh[1]) * rs, bf2f((unsigned short)xh[2]) * rs, bf2f((unsigned short)xh[3]) * rs);
            q8.y = pk4_fp8(bf2f((unsigned short)xh[4]) * rs, bf2f((unsigned short)xh[5]) * rs, bf2f((unsigned short)xh[6]) * rs, bf2f((unsigned short)xh[7]) * rs);
            *(u32x2*)(x8 + 32 * kb) = q8;
        }
        if (fq == 0) ((GAS float*)rstd_out)[row] = rs;
        float gl[4]; int gidx = 0; float gval = 0.f;
        {
#pragma unroll
            for (int i = 0; i < 4; ++i) gl[i] = a1[i] * rs + b_group[i];
            const float mx = fmaxf(fmaxf(gl[0], gl[1]), fmaxf(gl[2], gl[3]));
            float ex[4], sum = 0.f;
#pragma unroll
            for (int i = 0; i < 4; ++i) { ex[i] = expf(gl[i] - mx); sum += ex[i]; }
            float best = -1.f;
#pragma unroll
            for (int i = 0; i < 4; ++i) { const float p = ex[i] / sum; if (p > best) { best = p; gidx = i; } }
            gval = best;
        }
        gidx = shfl_from(gidx, fr); gval = shfl_from(gval, fr);
        int cls = -1, rank = 0; float gwlo = 0.f, gwhi = 0.f;
        if (fq == gidx) {
            float el[4];
#pragma unroll
            for (int i = 0; i < 4; ++i) el[i] = a0[i] * rs + b_expert[4 * fq + i];
            const float mx = fmaxf(fmaxf(el[0], el[1]), fmaxf(el[2], el[3]));
            float pr[4], sum = 0.f;
#pragma unroll
            for (int i = 0; i < 4; ++i) { pr[i] = expf(el[i] - mx); sum += pr[i]; }
#pragma unroll
            for (int i = 0; i < 4; ++i) pr[i] = pr[i] / sum;
            int i1 = 0; float p1 = -1.f;
#pragma unroll
            for (int i = 0; i < 4; ++i) if (pr[i] > p1) { p1 = pr[i]; i1 = i; }
            int i2 = 0; float p2 = -1.f;
#pragma unroll
            for (int i = 0; i < 4; ++i) if (i != i1 && pr[i] > p2) { p2 = pr[i]; i2 = i; }
            const float den = p1 + p2; const float w1g = gval * (p1 / den), w2g = gval * (p2 / den);
            const int lo = i1 < i2 ? i1 : i2, hi = i1 < i2 ? i2 : i1;
            const float wlo = i1 < i2 ? w1g : w2g, whi = i1 < i2 ? w2g : w1g;
            const int pidx = (lo == 0) ? hi - 1 : (lo == 1) ? hi + 1 : 5;
            cls = 6 * gidx + pidx;
            gwlo = wlo; gwhi = whi;
            rank = __hip_atomic_fetch_add((LAS int*)&lcnt[cls], 1, __ATOMIC_RELAXED, __HIP_MEMORY_SCOPE_WORKGROUP);
        }
        __syncthreads();
        if (tid_ < NCLASS) lcnt[32 + tid_] = (int)__hip_atomic_fetch_add(CNT + tid_, (unsigned)lcnt[tid_], RLX_AGENT);
        __syncthreads();
        if (cls >= 0) { const size_t p_ = (size_t)cls * CAP + lcnt[32 + cls] + rank; PERM[p_] = row; *(f32x2*)(GSORT + 2 * p_) = (f32x2){gwlo, gwhi}; }
        __syncthreads();
    }
}
__device__ __forceinline__ void moe_tile_prefix(Frame& F, const int* cnt, volatile LAS int* TP) {
    const int tid_ = otid(F.wave), lane_ = tid_ & 63;
    __syncthreads();
    if (tid_ == 0) { int acc = 0; for (int c = 0; c < NCLASS; ++c) { const int n = cnt[c]; TP[c] = acc; TP[32 + c] = n; acc += (n + 255) >> 8; } TP[NCLASS] = acc; }
    __syncthreads();
    if (tid_ < 160) { int c = 0;
        for (int k = 1; k < NCLASS; ++k) if (TP[k] <= tid_) c = k;
        TP[64 + tid_] = c; }
    __syncthreads();
}

__device__ __forceinline__ void dilated_phase(Frame& F, unsigned char* ldsg) {
    const int tid_ = otid(F.wave);
    LAS float* tb = (LAS float*)(F.lds + attn_body::LDS_NCK);
    const int per = (3072 + F.G - 1) / F.G;
    int gjprev = -1, rho = 0; bool primed = false; bf16x8 qn[4];
    for (int i = 0; i < per; ++i) {
        const int u = blockIdx.x * per + i; if (u >= 3072) break;
        const int g = u >> 10, v = u & 1023, j = v >> 7, b = (v >> 5) & 3, x = v & 31;
        const int D4 = 2 * g, d = 1 << D4, r = x & (d - 1), qb = x >> D4;
        unsigned long long pl_t = 0ull; if (PROBE_A == 5) pl_t = __builtin_amdgcn_s_memrealtime();
        if (g * 8 + j != gjprev) { __syncthreads(); dil::build_table(tb, INP(10), g, d, j, tid_); __syncthreads(); gjprev = g * 8 + j; }
        if (!primed) VM_WAIT();
        __syncthreads();
        if (PROBE_A == 5) { const unsigned d_ = (unsigned)(__builtin_amdgcn_s_memrealtime() - pl_t); if (tid_ == 0) ((LAS unsigned*)(F.lds + MISC_OFF))[121] += d_; }
        const size_t ho = (((size_t)(8 * g + j) * NTOK + (size_t)b * SEQ + (size_t)r * (SEQ >> D4)) * 64) * 2;
        const int T0 = qb == 0 ? 0 : 4 * qb - 2;
        attn_body::Xpf xp{}; xp.primed = primed; xp.has_next = (i + 1 < per) && (u + 1 < 3072);
        if (xp.has_next) { const int u2 = u + 1, g2 = u2 >> 10, v2 = u2 & 1023, j2 = v2 >> 7, b2 = (v2 >> 5) & 3, x2 = v2 & 31;
            const int D42 = 2 * g2, d2 = 1 << D42, r2 = x2 & (d2 - 1), qb2 = x2 >> D42, T02 = qb2 == 0 ? 0 : 4 * qb2 - 2;
            const size_t ho2 = (((size_t)(8 * g2 + j2) * NTOK + (size_t)b2 * SEQ + (size_t)r2 * (SEQ >> D42)) * 64) * 2; xp.Pn = 64;
            xp.Qn = (const attn_body::bf16*)(F.ws + WS_QB + ho2) + (long)qb2 * 256 * xp.Pn;
            xp.Kn = (const attn_body::bf16*)(F.ws + WS_KB + ho2) + (long)T02 * 64 * xp.Pn; xp.Vn = (const attn_body::bf16*)(F.ws + WS_VB + ho2) + (long)T02 * 64 * xp.Pn; }
        attn_body::attn_unit_x<64, true, true>(qb, T0, 64, (const attn_body::bf16*)(F.ws + WS_QB + ho), (const attn_body::bf16*)(F.ws + WS_KB + ho), (const attn_body::bf16*)(F.ws + WS_VB + ho),
                                      (attn_body::bf16*)(F.ws + WS_QB + ho), (char*)ldsg, F.wave, (float*)(F.ws + WS_DPML) + (size_t)(g * 8 + j) * NTOK * 2, (long)b * SEQ + r, d, xp, qn, rho);
        primed = xp.has_next;
    }
}
__device__ __forceinline__ void dilated_merge(Frame& F) {
    const int tid_ = otid(F.wave);
    bf16_t* QB = (bf16_t*)(F.ws + WS_QB); const float* PML = (const float*)(F.ws + WS_DPML);
    for (size_t it = (size_t)blockIdx.x * 512 + tid_; it < (size_t)NTOK * 64; it += (size_t)F.G * 512) {
        const int ch = (int)(it & 7), j = (int)((it >> 3) & 7); const size_t tok = it >> 6;
        f32x2 ml[3]; u32x4 o[3];
#pragma unroll
        for (int g = 0; g < 3; ++g) { ml[g] = *(const f32x2*)(PML + ((size_t)(g * 8 + j) * NTOK + tok) * 2); o[g] = *(const u32x4*)(QB + ((size_t)(8 * g + j) * NTOK + pg8::dil_row((int)tok, 2 * g)) * 64 + 8 * ch); }
        const float M = fmaxf(fmaxf(ml[0][0], ml[1][0]), ml[2][0]);
        float f[3], L = 0.f;
#pragma unroll
        for (int g = 0; g < 3; ++g) { f[g] = __builtin_amdgcn_exp2f(ml[g][0] - M); L += f[g] * ml[g][1]; }
        const float rl = 1.0f / L;
        float r8[8];
#pragma unroll
        for (int e = 0; e < 4; ++e) { float lo = 0.f, hh = 0.f;
#pragma unroll
            for (int g = 0; g < 3; ++g) { lo += bf2f(o[g][e] & 0xffffu) * f[g]; hh += bf2f(o[g][e] >> 16) * f[g]; }
            r8[2 * e] = lo * rl; r8[2 * e + 1] = hh * rl; }
        u32x2 q8; q8.x = pk4_fp8(r8[0], r8[1], r8[2], r8[3]); q8.y = pk4_fp8(r8[4], r8[5], r8[6], r8[7]);
        *(GAS u32x2*)(F.ws + WS_XB8 + tok * 512 + 64 * j + 8 * ch) = q8;
    }
}

struct Args { const float* in[23]; float* out; unsigned char* ws; };
__global__ void __launch_bounds__(512, 2) fwd_kernel(Args args) {
    extern __shared__ __attribute__((aligned(16))) unsigned char lds[];
    Frame F;
    F.lds = (LAS unsigned char*)lds;
    F.MISC = (volatile LAS unsigned*)(F.lds + MISC_OFF);
    F.wave = __builtin_amdgcn_readfirstlane((int)threadIdx.x >> 6);
    F.G = gridDim.x; { const int bx = blockIdx.x; F.vcu = (F.G % 8 == 0) ? (bx % 8) * (F.G / 8) + bx / 8 : bx; }
    F.out = args.out; F.ws = args.ws;
    F.ctl = (gu32*)(args.ws + WS_CTL);
    for (int u = otid(F.wave); u < 128; u += 512) ((LAS unsigned*)(F.lds + MISC_OFF))[u] = 0u;
    __syncthreads();
    XcdBarrier bar = xcd_barrier_post((unsigned*)(F.ctl + CW_BAR), F.MISC + 8, F.wave == 0 && lane_id() == 0);
#define GRID_BAR() xcd_barrier(bar, F.wave == 0 && lane_id() == 0)
#ifndef RUN_FROM
#define RUN_FROM 0
#endif
#define RUN(k) ((k) <= RUN_UPTO && (k) >= RUN_FROM)
#ifndef PROBE_MASK
#define PROBE_MASK 0
#endif
    unsigned long long pr_acc = 0ull, pr_t0 = 0ull;
#define PR_BEGIN(k) do { if ((PROBE_MASK >> (k)) & 1) pr_t0 = __builtin_amdgcn_s_memrealtime(); } while (0)
#define PR_END(k) do { if ((PROBE_MASK >> (k)) & 1) pr_acc += __builtin_amdgcn_s_memrealtime() - pr_t0; } while (0)

#define ws opq_ptr(F.ws)
#define XB ((bf16_t*)(ws + WS_XB))
#define H (F.out)
#define TP ((volatile LAS int*)(F.lds + AUX_OFF + 1024))

    PR_BEGIN(0); if (RUN(0)) { p0_prologue(F); GRID_BAR(); } PR_END(0);

    PR_BEGIN(1);
    if (RUN(1)) {
        pg8::GemmP g{(const void*)(ws + WS_XB8), 1024, 1024, 1 << 20, 32, (PROBE_KSEL >> 1) & 1};
        pg8::DenseSched S; S.so.init(NTOK, 3072, F.G, (int)blockIdx.x); S.Bt = (const bf16_t*)(ws + WS_WQKVA); S.lda = 512; S.ldb = 512;
        pg8::EpiHead E{(bf16_t*)(ws + WS_QA), (size_t)(WS_KA - WS_QA) / 2, (const float*)(ws + WS_GTAB), 2, 4, 8, 1024, (const float*)(ws + WS_RSTD0), nullptr, 1.0f / W8SCALE};
        pg8::gemm_phase<pg8::EpiHead, pg8::DenseSched, true>(F.lds, g, S, E, F.wave);
        forget_phase(F);
        GRID_BAR();
    }
    PR_END(1); PR_BEGIN(2);
    if (RUN(2)) { attnA_phase(F, lds); GRID_BAR(); }
    PR_END(2); PR_BEGIN(3);
    if (RUN(3)) {
        pg8::GemmP g{(const bf16_t*)(ws + WS_QA), 2048, 2048, 1 << 20, 128, (PROBE_KSEL >> 3) & 1};
        pg8::DenseSched S; S.so.init(NTOK, 1024, F.G, (int)blockIdx.x); S.Bt = (const bf16_t*)(ws + WS_WOA); S.lda = 1024; S.ldb = 1024;
        pg8::EpiResid E{XB, (float*)(ws + WS_STATS1), 1.0f};
        pg8::gemm_phase<pg8::EpiResid, pg8::DenseSched>(F.lds, g, S, E, F.wave);
        GRID_BAR();
    }
    PR_END(3);
#define MOE_LAYER(PH, layer, STATS_IN, RSTD_BUF, CW_CNT, LASTL, STATS_OUT) \
    PR_BEGIN(PH); if (RUN(PH)) { router_phase(F, layer, (const float*)(ws + STATS_IN), (float*)(ws + RSTD_BUF)); GRID_BAR(); } PR_END(PH); PR_BEGIN(PH + 1); \
    if (RUN(PH + 1)) { \
        const int* cnt = (const int*)(F.ctl + CW_CNT); moe_tile_prefix(F, cnt, TP); \
        pg8::GemmP g{(const void*)ws, 1024, 1024, 1 << 20, 512, (PROBE_KSEL >> (PH + 1)) & 1}; \
        pg8::MoeMixSched S{TP, cnt, (const int*)(ws + WS_PERM), (const unsigned char*)(ws + WS_WGU) + (size_t)layer * 16 * 1024 * 1024, (const unsigned char*)(ws + WS_WD) + (size_t)layer * 16 * 1024 * 512, \
                           F.G, (int)blockIdx.x, __builtin_amdgcn_readfirstlane(TP[NCLASS]), (unsigned*)(F.ctl + CW_DONE + layer * 16384), (unsigned*)(F.ctl + CW_BAR) + XB_TMO}; \
        pg8::EpiMoe<LASTL> E{pg8::EpiSwiglu{(unsigned char*)(ws + WS_HID), (const float*)(ws + WS_GSORT)}, \
                             pg8::EpiScatter<LASTL>{XB, H, STATS_OUT, (const int*)(ws + WS_PERM), 1.0f / (W8SCALE * H8SCALE)}}; \
        pg8::gemm_phase<pg8::EpiMoe<LASTL>, pg8::MoeMixSched, true>(F.lds, g, S, E, F.wave); \
        if (!(LASTL)) p0_tail(F, 12 * S.TT, (F.G == 256) ? (((int)blockIdx.x & 7) * 32 + ((int)blockIdx.x >> 3)) : (int)blockIdx.x); \
        if (!(LASTL)) GRID_BAR(); } PR_END(PH + 1);
    MOE_LAYER(4, 0, WS_STATS1, WS_RSTD1, CW_CNT0, false, (float*)(ws + WS_STATS2))
    PR_BEGIN(7);
    if (RUN(7)) {
        pg8::GemmP g{(const void*)(ws + WS_XB8), 1024, 1024, 1 << 20, 32, (PROBE_KSEL >> 7) & 1};
        pg8::DenseSched S; S.so.init(NTOK, 4608, F.G, (int)blockIdx.x); S.Bt = (const bf16_t*)(ws + WS_WKVQ); S.lda = 512; S.ldb = 512;
        pg8::EpiHead E{(bf16_t*)(ws + WS_KB), (size_t)(WS_VB - WS_KB) / 2, (const float*)(ws + WS_GTAB) + 3 * 64, 1, 6, 12, KVW, nullptr, (const float*)(ws + WS_STATS2), 1.0f / W8SCALE, 1};
        pg8::gemm_phase<pg8::EpiHead, pg8::DenseSched, true>(F.lds, g, S, E, F.wave);
        GRID_BAR();
    }
    PR_END(7); PR_BEGIN(8);
    if (RUN(8)) { dilated_phase(F, lds); GRID_BAR(); dilated_merge(F); GRID_BAR(); }
    PR_END(8); PR_BEGIN(9);
    if (RUN(9)) {
        pg8::GemmP g{(const void*)(ws + WS_XB8), 512, 512, 1 << 20, 128, (PROBE_KSEL >> 9) & 1};
        pg8::DenseSched S; S.so.init(NTOK, 1024, F.G, (int)blockIdx.x); S.Bt = (const bf16_t*)(ws + WS_WOB); S.lda = 256; S.ldb = 256;
        pg8::EpiResid E{XB, (float*)(ws + WS_STATS3), 1.0f / W8SCALE};
        pg8::gemm_phase<pg8::EpiResid, pg8::DenseSched, true>(F.lds, g, S, E, F.wave);
        GRID_BAR();
    }
    PR_END(9);
    MOE_LAYER(10, 1, WS_STATS3, WS_RSTD3, CW_CNT1, true, (float*)nullptr)

#if RUN_UPTO < 12
    { const int gt = (blockIdx.x * 512 + otid(F.wave)); const f32x4* xs = (const f32x4*)INP(0); f32x4* od = (f32x4*)F.out;
      for (size_t e = gt; e < (size_t)NTOK * DM / 4; e += (size_t)F.G * 512) od[e] = xs[e]; }
#endif
    if (PROBE_K != 0) pr_acc += ((LAS unsigned*)(F.lds + MISC_OFF))[120];
    if (PROBE_A != 0) pr_acc += ((LAS unsigned*)(F.lds + MISC_OFF))[121];
    if (PROBE_MASK != 0 && blockIdx.x == 0 && otid(F.wave) == 0) { const unsigned long long t1 = __builtin_amdgcn_s_memrealtime(); while (__builtin_amdgcn_s_memrealtime() - t1 < pr_acc) __builtin_amdgcn_s_sleep(8); }
    if (__hip_atomic_load((unsigned*)(F.ctl + CW_BAR) + XB_TMO, RLX_AGENT) != 0u) {
        const int gt = (blockIdx.x * 512 + otid(F.wave)); const float q = __builtin_nanf("");
        for (size_t e = gt; e < (size_t)NTOK * DM; e += (size_t)F.G * 512) F.out[e] = q;
    }
}

#undef ws
#undef XB
#undef H
#undef TP
extern "C" void kernel_launch(void* const* d_in, const int* in_sizes, int n_in, void* d_out, int out_size, void* d_ws, size_t ws_size, hipStream_t stream) {
    static int grid = 0;
    if (grid == 0) {
        if (n_in != 23 || in_sizes[0] != NTOK * DM || out_size != NTOK * DM || ws_size < WS_END) { fprintf(stderr, "kernel_launch: unexpected shapes (n_in %d, in0 %d, out %d, ws %zu)\n", n_in, n_in > 0 ? in_sizes[0] : -1, out_size, ws_size); grid = -1; return; }
        int dev = 0, cus = 0, per_cu = 0;
        if (hipGetDevice(&dev) != hipSuccess || hipDeviceGetAttribute(&cus, hipDeviceAttributeMultiprocessorCount, dev) != hipSuccess) { grid = -1; return; }
        if (hipFuncSetAttribute((const void*)fwd_kernel, hipFuncAttributeMaxDynamicSharedMemorySize, LDS_BYTES) != hipSuccess) { fprintf(stderr, "kernel_launch: hipFuncSetAttribute failed\n"); grid = -1; return; }
        if (hipOccupancyMaxActiveBlocksPerMultiprocessor(&per_cu, (const void*)fwd_kernel, 512, LDS_BYTES) != hipSuccess || per_cu < 1) fprintf(stderr, "kernel_launch: occupancy query reports %d\n", per_cu);
        (void)hipGetLastError();
        grid = cus;
    }
    if (grid < 0) return;
    if (hipMemsetAsync((char*)d_ws + WS_CTL, 0, CTL_ZERO_BYTES, stream) != hipSuccess) return;
    Args a{};
    for (int i = 0; i < 23; ++i) a.in[i] = (const float*)d_in[i];
    a.out = (float*)d_out; a.ws = (unsigned char*)d_ws;
    hipLaunchKernelGGL(fwd_kernel, dim3(grid), dim3(512), LDS_BYTES, stream, a);
}
```
